# Optimizing an MI355X kernel written in HIP

```python
import math
import jax, jax.numpy as jnp
from jax import lax
import numpy as np

D_MODEL = 1024
BATCH = 4
SEQ = 8192
DEPTH = 2

N_HEADS = 16
HEAD_DIM = D_MODEL // N_HEADS
HD = N_HEADS * HEAD_DIM
ROT_DIM = HEAD_DIM // 4
ROPE_THETA = 500000.0
Q_BLOCK = 128
N_KV_GROUPS = 2
HEADS_PER_GROUP = N_HEADS // N_KV_GROUPS
CMP_LEN = 32
CMP_STRIDE = 16
CMP_HIDDEN = 256
SLC_LEN = 64
SLC_TOPK = 16
WIN = 512
D_FF = 2816
CONV_W = 3
N_A_LAYERS = (DEPTH + 1) // 2
N_B_LAYERS = DEPTH // 2
RMS_EPS = 1e-6
NEG = -1e30
FORCED_SCORE = 1e6
FORGET_BIAS = 3.0

kernel_name = "yoco_fox_nsa_convffn"


def rms_norm(x, g):
    xf = x.astype(jnp.float32)
    y = xf * lax.rsqrt(jnp.mean(xf * xf, axis=-1, keepdims=True) + RMS_EPS)
    return (y * g.astype(jnp.float32)).astype(x.dtype)


def partial_rope(x, pos):
    half = ROT_DIM // 2
    inv = ROPE_THETA ** (-jnp.arange(half, dtype=jnp.float32) * (2.0 / ROT_DIM))
    ang = pos.astype(jnp.float32)[..., None] * inv
    cos = jnp.cos(ang)[..., None, :]
    sin = jnp.sin(ang)[..., None, :]
    xf = x.astype(jnp.float32)
    x1 = xf[..., :half]
    x2 = xf[..., half:ROT_DIM]
    out = jnp.concatenate([x1 * cos - x2 * sin, x2 * cos + x1 * sin, xf[..., ROT_DIM:]], axis=-1)
    return out.astype(x.dtype)


def forgetting_attention(xn, w_in, b_f, q_gain, k_gain, w_out):
    B, T, _ = xn.shape
    proj = xn @ w_in
    q = rms_norm(proj[..., :HD].reshape(B, T, N_HEADS, HEAD_DIM), q_gain)
    k = rms_norm(proj[..., HD:2 * HD].reshape(B, T, N_HEADS, HEAD_DIM), k_gain)
    v = proj[..., 2 * HD:3 * HD].reshape(B, T, N_HEADS, HEAD_DIM)
    log_f = jax.nn.log_sigmoid((proj[..., 3 * HD:] + b_f).astype(jnp.float32))
    c = jnp.cumsum(log_f, axis=1).transpose(0, 2, 1)
    q = q.transpose(0, 2, 1, 3)
    k = k.transpose(0, 2, 1, 3)
    v = v.transpose(0, 2, 1, 3)
    scale = HEAD_DIM ** -0.5
    kpos = jnp.arange(T)

    def block(i):
        q0 = i * Q_BLOCK
        qb = lax.dynamic_slice_in_dim(q, q0, Q_BLOCK, axis=2)
        cb = lax.dynamic_slice_in_dim(c, q0, Q_BLOCK, axis=2)
        s = jnp.einsum('bhqd,bhkd->bhqk', qb, k, preferred_element_type=jnp.float32) * scale
        s = s + cb[..., :, None] - c[..., None, :]
        qpos = q0 + jnp.arange(Q_BLOCK)
        s = jnp.where(kpos[None, :] <= qpos[:, None], s, -jnp.inf)
        p = jax.nn.softmax(s, axis=-1)
        return jnp.einsum('bhqk,bhkd->bqhd', p.astype(v.dtype), v)

    o = lax.map(block, jnp.arange(T // Q_BLOCK))
    o = jnp.moveaxis(o, 0, 1).reshape(B, T, HD)
    return o @ w_out


def conv_ffn(xn, w_up, conv_w, conv_b, w_down):
    T = xn.shape[1]
    u = xn @ w_up
    u_pad = jnp.pad(u, ((0, 0), (CONV_W - 1, 0), (0, 0)))
    c = sum((conv_w[j] * u_pad[:, j:j + T] for j in range(CONV_W)), conv_b)
    gate, val = jnp.split(c, 2, axis=-1)
    return (jax.nn.silu(gate) * val) @ w_down


def shared_kv(h, positions, kv_norm, kv_w, kc_pe, vc_pe, kc_w1, kc_w2, vc_w1, vc_w2, kc_gain, ks_gain, kw_gain):
    B, T, _ = h.shape
    hn = rms_norm(h, kv_norm)
    parts = (hn @ kv_w).reshape(B, T, 6, N_KV_GROUPS, HEAD_DIM)
    kc_raw, vc_raw = parts[:, :, 0], parts[:, :, 1]
    ks, vs = parts[:, :, 2], parts[:, :, 3]
    kw, vw = parts[:, :, 4], parts[:, :, 5]
    n_cmp = (T - CMP_LEN) // CMP_STRIDE + 1
    starts = jnp.arange(n_cmp) * CMP_STRIDE
    idx = starts[:, None] + jnp.arange(CMP_LEN)[None, :]

    def compress(raw, pe, w1, w2):
        blk = raw[:, idx] + pe[None, None, :, None, :]
        blk = jnp.moveaxis(blk, 3, 2).reshape(B, n_cmp, N_KV_GROUPS, CMP_LEN * HEAD_DIM)
        return jax.nn.gelu(blk @ w1) @ w2

    kc = compress(kc_raw, kc_pe, kc_w1, kc_w2)
    vc = compress(vc_raw, vc_pe, vc_w1, vc_w2)
    ends = starts + CMP_LEN - 1
    kc = partial_rope(rms_norm(kc, kc_gain), positions[:, ends])
    ks = partial_rope(rms_norm(ks, ks_gain), positions)
    kw = partial_rope(rms_norm(kw, kw_gain), positions)
    return kc, vc, ks, vs, kw, vw


def native_sparse_attention(xn, positions, kc, vc, ks, vs, kw, vw, w_in, b_gate, q_gain, w_out):
    B, T, _ = xn.shape
    G, HG, dh = N_KV_GROUPS, HEADS_PER_GROUP, HEAD_DIM
    proj = xn @ w_in
    q = partial_rope(rms_norm(proj[..., :HD].reshape(B, T, N_HEADS, dh), q_gain), positions)
    q = q.reshape(B, T, G, HG, dh).transpose(0, 2, 3, 1, 4)
    gates = jax.nn.sigmoid((proj[..., HD:] + b_gate).astype(jnp.float32)).reshape(B, T, 3, G, HG)
    n_cmp = kc.shape[1]
    n_slc = T // SLC_LEN
    top_k = min(SLC_TOPK, n_slc)
    kc_g = kc.transpose(0, 2, 1, 3)
    vc_g = vc.transpose(0, 2, 1, 3)
    ks_blk = ks.transpose(0, 2, 1, 3).reshape(B, G, n_slc, SLC_LEN * dh)
    vs_blk = vs.transpose(0, 2, 1, 3).reshape(B, G, n_slc, SLC_LEN * dh)
    pad = ((0, 0), (0, 0), (WIN, 0), (0, 0))
    kw_pad = jnp.pad(kw.transpose(0, 2, 1, 3), pad)
    vw_pad = jnp.pad(vw.transpose(0, 2, 1, 3), pad)
    cmp_start = jnp.arange(n_cmp) * CMP_STRIDE
    cmp_end = cmp_start + CMP_LEN - 1
    slc_start = jnp.arange(n_slc) * SLC_LEN
    overlap = jnp.maximum(jnp.minimum(cmp_start[:, None] + CMP_LEN, slc_start[None, :] + SLC_LEN)
                          - jnp.maximum(cmp_start[:, None], slc_start[None, :]), 0).astype(jnp.float32) / CMP_LEN
    scale = dh ** -0.5
    bidx = jnp.arange(B)[:, None, None]
    gidx = jnp.arange(G)[None, :, None]
    jb = jnp.arange(n_slc)

    def block(i):
        q0 = i * Q_BLOCK
        qpos = q0 + jnp.arange(Q_BLOCK)
        qb = lax.dynamic_slice_in_dim(q, q0, Q_BLOCK, axis=3)
        s_c = jnp.einsum('bghqd,bgkd->bghqk', qb, kc_g, preferred_element_type=jnp.float32) * scale
        m_c = cmp_end[None, :] <= qpos[:, None]
        s_c = jnp.where(m_c, s_c, NEG)
        e_c = jnp.exp(s_c - jnp.max(s_c, axis=-1, keepdims=True)) * m_c
        p_c = e_c / jnp.maximum(jnp.sum(e_c, axis=-1, keepdims=True), 1.0)
        o_c = jnp.einsum('bghqk,bgkd->bqghd', p_c.astype(vc_g.dtype), vc_g)
        imp = jnp.einsum('bghqk,kn->bgqn', p_c, overlap)
        cur = qpos // SLC_LEN
        forced = (jb[None, :] == 0) | (jb[None, :] == cur[:, None]) | (jb[None, :] == cur[:, None] - 1)
        eligible = slc_start[None, :] <= qpos[:, None]
        score = jnp.where(eligible, jnp.where(forced, FORCED_SCORE, imp), NEG)
        _, sel = lax.top_k(score, top_k)
        flat = sel.reshape(B, G, Q_BLOCK * top_k)
        k_sel = ks_blk[bidx, gidx, flat].reshape(B, G, Q_BLOCK, top_k * SLC_LEN, dh)
        v_sel = vs_blk[bidx, gidx, flat].reshape(B, G, Q_BLOCK, top_k * SLC_LEN, dh)
        tok = (sel[..., None] * SLC_LEN + jnp.arange(SLC_LEN)).reshape(B, G, Q_BLOCK, top_k * SLC_LEN)
        m_s = tok <= qpos[None, None, :, None]
        s_s = jnp.einsum('bghqd,bgqkd->bghqk', qb, k_sel, preferred_element_type=jnp.float32) * scale
        p_s = jax.nn.softmax(jnp.where(m_s[:, :, None], s_s, -jnp.inf), axis=-1)
        o_s = jnp.einsum('bghqk,bgqkd->bqghd', p_s.astype(v_sel.dtype), v_sel)
        k_win = lax.dynamic_slice_in_dim(kw_pad, q0, WIN + Q_BLOCK, axis=2)
        v_win = lax.dynamic_slice_in_dim(vw_pad, q0, WIN + Q_BLOCK, axis=2)
        kpos = q0 - WIN + jnp.arange(WIN + Q_BLOCK)
        dist = qpos[:, None] - kpos[None, :]
        m_w = (dist >= 0) & (dist < WIN) & (kpos[None, :] >= 0)
        s_w = jnp.einsum('bghqd,bgkd->bghqk', qb, k_win, preferred_element_type=jnp.float32) * scale
        p_w = jax.nn.softmax(jnp.where(m_w, s_w, -jnp.inf), axis=-1)
        o_w = jnp.einsum('bghqk,bgkd->bqghd', p_w.astype(v_win.dtype), v_win)
        g = lax.dynamic_slice_in_dim(gates, q0, Q_BLOCK, axis=1)[..., None]
        o = g[:, :, 0] * o_c + g[:, :, 1] * o_s + g[:, :, 2] * o_w
        return o.astype(xn.dtype)

    o = lax.map(block, jnp.arange(T // Q_BLOCK))
    o = jnp.moveaxis(o, 0, 1).reshape(B, T, HD)
    return o @ w_out


def setup_inputs(seed: int = 0) -> dict:
    key = jax.random.key(seed)
    ks = jax.random.split(key, 32)
    f32 = jnp.float32
    nrm = lambda k, shape, s: jax.random.normal(k, shape, f32) * s
    gain = lambda k, shape: 1.0 + 0.02 * jax.random.normal(k, shape, f32)
    D, F, G = D_MODEL, D_FF, N_KV_GROUPS
    return {
        "x": jax.random.normal(ks[0], (BATCH, SEQ, D), f32),
        "positions": jnp.broadcast_to(jnp.arange(SEQ, dtype=jnp.int32), (BATCH, SEQ)),
        "a_norm": gain(ks[1], (N_A_LAYERS, D)),
        "a_w_in": nrm(ks[2], (N_A_LAYERS, D, 3 * HD + N_HEADS), D ** -0.5),
        "a_b_f": FORGET_BIAS + 0.1 * jax.random.normal(ks[3], (N_A_LAYERS, N_HEADS), f32),
        "a_q_gain": gain(ks[4], (N_A_LAYERS, HEAD_DIM)),
        "a_k_gain": gain(ks[5], (N_A_LAYERS, HEAD_DIM)),
        "a_w_out": nrm(ks[6], (N_A_LAYERS, HD, D), HD ** -0.5),
        "kv_norm": gain(ks[7], (D,)),
        "kv_w": nrm(ks[8], (D, 6 * G * HEAD_DIM), D ** -0.5),
        "kc_pe": nrm(ks[9], (CMP_LEN, HEAD_DIM), 0.02),
        "vc_pe": nrm(ks[10], (CMP_LEN, HEAD_DIM), 0.02),
        "kc_w1": nrm(ks[11], (CMP_LEN * HEAD_DIM, CMP_HIDDEN), (CMP_LEN * HEAD_DIM) ** -0.5),
        "kc_w2": nrm(ks[12], (CMP_HIDDEN, HEAD_DIM), CMP_HIDDEN ** -0.5),
        "vc_w1": nrm(ks[13], (CMP_LEN * HEAD_DIM, CMP_HIDDEN), (CMP_LEN * HEAD_DIM) ** -0.5),
        "vc_w2": nrm(ks[14], (CMP_HIDDEN, HEAD_DIM), CMP_HIDDEN ** -0.5),
        "kc_gain": gain(ks[15], (HEAD_DIM,)),
        "ks_gain": gain(ks[16], (HEAD_DIM,)),
        "kw_gain": gain(ks[17], (HEAD_DIM,)),
        "b_norm": gain(ks[18], (N_B_LAYERS, D)),
        "b_w_in": nrm(ks[19], (N_B_LAYERS, D, HD + 3 * N_HEADS), D ** -0.5),
        "b_b_gate": nrm(ks[20], (N_B_LAYERS, 3 * N_HEADS), 0.01),
        "b_q_gain": gain(ks[21], (N_B_LAYERS, HEAD_DIM)),
        "b_w_out": nrm(ks[22], (N_B_LAYERS, HD, D), HD ** -0.5),
        "f_norm": gain(ks[23], (DEPTH, D)),
        "f_w_up": nrm(ks[24], (DEPTH, D, 2 * F), D ** -0.5),
        "f_conv_w": nrm(ks[25], (DEPTH, CONV_W, 2 * F), CONV_W ** -0.5),
        "f_conv_b": nrm(ks[26], (DEPTH, 2 * F), 0.01),
        "f_w_down": nrm(ks[27], (DEPTH, F, D), F ** -0.5),
    }


def reference(x, positions, a_norm, a_w_in, a_b_f, a_q_gain, a_k_gain, a_w_out, kv_norm, kv_w, kc_pe, vc_pe, kc_w1, kc_w2, vc_w1, vc_w2, kc_gain, ks_gain, kw_gain, b_norm, b_w_in, b_b_gate, b_q_gain, b_w_out, f_norm, f_w_up, f_conv_w, f_conv_b, f_w_down):
    h = x
    kv = None
    for layer in range(DEPTH):
        if layer < N_A_LAYERS:
            i = layer
            h = h + forgetting_attention(rms_norm(h, a_norm[i]), a_w_in[i], a_b_f[i], a_q_gain[i], a_k_gain[i], a_w_out[i])
        else:
            i = layer - N_A_LAYERS
            kc, vc, ks, vs, kw, vw = kv
            h = h + native_sparse_attention(rms_norm(h, b_norm[i]), positions, kc, vc, ks, vs, kw, vw,
                                            b_w_in[i], b_b_gate[i], b_q_gain[i], b_w_out[i])
        h = h + conv_ffn(rms_norm(h, f_norm[layer]), f_w_up[layer], f_conv_w[layer], f_conv_b[layer], f_w_down[layer])
        if layer == N_A_LAYERS - 1:
            kv = shared_kv(h, positions, kv_norm, kv_w, kc_pe, vc_pe, kc_w1, kc_w2, vc_w1, vc_w2, kc_gain, ks_gain, kw_gain)
    return h
```

```cpp
#include <hip/hip_runtime.h>
#include <hip/hip_cooperative_groups.h>
#include <stdint.h>
#include <cstdio>
namespace cg = cooperative_groups;

#ifndef N_LAUNCH_SPLIT
#define N_LAUNCH_SPLIT 0
#endif

#define DI __device__ __forceinline__
typedef unsigned short bf16_t;
typedef short bf16x8 __attribute__((ext_vector_type(8)));
typedef short bf16x4 __attribute__((ext_vector_type(4)));
typedef float f32x16 __attribute__((ext_vector_type(16)));
typedef float f32x4 __attribute__((ext_vector_type(4)));
typedef unsigned u32x4 __attribute__((ext_vector_type(4)));
typedef unsigned u32x2 __attribute__((ext_vector_type(2)));

constexpr int T_ = 8192;
constexpr int NTOK = 32768;
constexpr int FF = 2816;
constexpr int NPHASE = 14;
constexpr int SMEM_BYTES = 66560;

struct Params {
  const float* x; const int* pos;
  const float *a_norm, *a_w_in, *a_b_f, *a_q_gain, *a_k_gain, *a_w_out;
  const float *kv_norm, *kv_w, *kc_pe, *vc_pe, *kc_w1, *kc_w2, *vc_w1, *vc_w2, *kc_gain, *ks_gain, *kw_gain;
  const float *b_norm, *b_w_in, *b_b_gate, *b_q_gain, *b_w_out;
  const float *f_norm, *f_w_up, *f_conv_w, *f_conv_b, *f_w_down;
  float* out;
  bf16_t *w_ain, *w_aout, *w_kv, *w_kc1, *w_vc1, *w_kc2, *w_vc2, *w_bin, *w_bout, *w_up0, *w_up1, *w_dn0, *w_dn1;
  bf16_t* hb; float* part; float* lf; float* cc; bf16_t* ob;
  bf16_t *qb, *kb, *vT; bf16_t* act;
  bf16_t *rawc, *ksb, *vsT, *kwb, *vwT, *qn; float* gates; bf16_t *hid, *kcb, *vcT;
};

DI bf16_t f2bf(float x) { unsigned u = __float_as_uint(x); u += 0x7fffu + ((u >> 16) & 1u); return (bf16_t)(u >> 16); }
DI unsigned pack2(float a, float b) { return (unsigned)f2bf(a) | ((unsigned)f2bf(b) << 16); }
DI float bf2f(bf16_t v) { return __uint_as_float(((unsigned)v) << 16); }
DI int crow(int i, int h) { return (i & 3) + 8 * (i >> 2) + 4 * h; }
DI f32x16 mfma32(bf16x8 a, bf16x8 b, f32x16 c) { return __builtin_amdgcn_mfma_f32_32x32x16_bf16(a, b, c, 0, 0, 0); }
DI f32x4 mfma16(bf16x8 a, bf16x8 b, f32x4 c) { return __builtin_amdgcn_mfma_f32_16x16x32_bf16(a, b, c, 0, 0, 0); }
DI float row_rstd(const float* part, int row) {
  const f32x4* q = (const f32x4*)(part + (size_t)row * 16);
  f32x4 a = q[0], b = q[1], c = q[2], d = q[3];
  float s = ((a.x + a.y) + (a.z + a.w)) + ((b.x + b.y) + (b.z + b.w)) + ((c.x + c.y) + (c.z + c.w)) + ((d.x + d.y) + (d.z + d.w));
  return rsqrtf(s * (1.0f / 1024.0f) + 1e-6f);
}
DI void store_bf4(bf16_t* dst, float a, float b, float c, float d) { u32x2 v; v.x = pack2(a, b); v.y = pack2(c, d); *(u32x2*)dst = v; }

struct WJob { const float* src; bf16_t* dst; const float* gain; int K, Nsrc, Ndst, mode; };
DI WJob get_job(const Params& p, int j) {
  WJob w; w.gain = nullptr; w.mode = 0;
  switch (j) {
    case 0: w.src = p.a_w_in; w.dst = p.w_ain; w.gain = p.a_norm; w.K = 1024; w.Nsrc = 3088; w.Ndst = 3200; break;
    case 1: w.src = p.a_w_out; w.dst = p.w_aout; w.K = 1024; w.Nsrc = 1024; w.Ndst = 1024; break;
    case 2: w.src = p.kv_w; w.dst = p.w_kv; w.gain = p.kv_norm; w.K = 1024; w.Nsrc = 768; w.Ndst = 768; break;
    case 3: w.src = p.kc_w1; w.dst = p.w_kc1; w.K = 2048; w.Nsrc = 256; w.Ndst = 256; break;
    case 4: w.src = p.vc_w1; w.dst = p.w_vc1; w.K = 2048; w.Nsrc = 256; w.Ndst = 256; break;
    case 5: w.src = p.kc_w2; w.dst = p.w_kc2; w.K = 256; w.Nsrc = 64; w.Ndst = 128; break;
    case 6: w.src = p.vc_w2; w.dst = p.w_vc2; w.K = 256; w.Nsrc = 64; w.Ndst = 128; break;
    case 7: w.src = p.b_w_in; w.dst = p.w_bin; w.gain = p.b_norm; w.K = 1024; w.Nsrc = 1072; w.Ndst = 1152; break;
    case 8: w.src = p.b_w_out; w.dst = p.w_bout; w.K = 1024; w.Nsrc = 1024; w.Ndst = 1024; break;
    case 9: w.src = p.f_w_up; w.dst = p.w_up0; w.gain = p.f_norm; w.K = 1024; w.Nsrc = 5632; w.Ndst = 5632; w.mode = 1; break;
    case 10: w.src = p.f_w_up + (size_t)1024 * 5632; w.dst = p.w_up1; w.gain = p.f_norm + 1024; w.K = 1024; w.Nsrc = 5632; w.Ndst = 5632; w.mode = 1; break;
    case 11: w.src = p.f_w_down; w.dst = p.w_dn0; w.K = 2816; w.Nsrc = 1024; w.Ndst = 1024; break;
    default: w.src = p.f_w_down + (size_t)2816 * 1024; w.dst = p.w_dn1; w.K = 2816; w.Nsrc = 1024; w.Ndst = 1024; break;
  }
  return w;
}

DI void phase_prep(const Params& p, char* smem) {
  float* sT = (float*)smem;
  const int tid = threadIdx.x;
  int base = 0;
  for (int j = 0; j < 13; ++j) {
    WJob w = get_job(p, j);
    const int nkt = w.K >> 6, nnt = w.Ndst >> 6, ntile = nkt * nnt;
    int first = (int)blockIdx.x - (base % (int)gridDim.x); if (first < 0) first += gridDim.x;
    for (int t = first; t < ntile; t += gridDim.x) {
      const int kt = t % nkt, nt = t / nkt;
      const int k0 = kt << 6, n0d = nt << 6;
      int sbase = n0d;
      if (w.mode == 1) { const int tile = n0d >> 7, half = (n0d >> 6) & 1; sbase = half * FF + tile * 64; }
      __syncthreads();
#pragma unroll
      for (int i = 0; i < 4; ++i) {
        const int kk = (tid >> 4) + 16 * i, nn = (tid & 15) * 4, col = sbase + nn;
        f32x4 v = (f32x4){0.f, 0.f, 0.f, 0.f};
        if (col < w.Nsrc) v = *(const f32x4*)(w.src + (size_t)(k0 + kk) * w.Nsrc + col);
        const float g = w.gain ? w.gain[k0 + kk] : 1.0f;
        sT[kk * 65 + nn + 0] = v.x * g; sT[kk * 65 + nn + 1] = v.y * g; sT[kk * 65 + nn + 2] = v.z * g; sT[kk * 65 + nn + 3] = v.w * g;
      }
      __syncthreads();
      const int n = tid >> 2, kseg = (tid & 3) * 16;
      unsigned o[8];
#pragma unroll
      for (int q = 0; q < 8; ++q) o[q] = pack2(sT[(kseg + 2 * q) * 65 + n], sT[(kseg + 2 * q + 1) * 65 + n]);
      u32x4* dst = (u32x4*)(w.dst + (size_t)(n0d + n) * w.K + k0 + kseg);
      dst[0] = (u32x4){o[0], o[1], o[2], o[3]}; dst[1] = (u32x4){o[4], o[5], o[6], o[7]};
    }
    base += ntile;
  }
  const int lane = tid & 63, gw = blockIdx.x * 4 + (tid >> 6), nw = gridDim.x * 4;
  for (int row = gw; row < NTOK; row += nw) {
    float ss = 0.f;
#pragma unroll
    for (int i = 0; i < 4; ++i) {
      const int col = i * 256 + lane * 4;
      f32x4 v = *(const f32x4*)(p.x + (size_t)row * 1024 + col);
      ss += v.x * v.x + v.y * v.y + v.z * v.z + v.w * v.w;
      store_bf4(p.hb + (size_t)row * 1024 + col, v.x, v.y, v.z, v.w);
    }
#pragma unroll
    for (int o = 32; o >= 1; o >>= 1) ss += __shfl_xor(ss, o);
    if (lane < 16) p.part[(size_t)row * 16 + lane] = lane == 0 ? ss : 0.f;
  }
  if (blockIdx.x == 0) {
    for (int i = tid; i < 8 * 64; i += 256) {
      const int bg = i >> 6, d = i & 63;
      p.kcb[((size_t)bg * 512 + 511) * 64 + d] = 0;
      p.vcT[((size_t)bg * 64 + d) * 512 + 511] = 0;
    }
  }
}

template <class AL, class EP>
DI void gemm_tile(const AL& al, const bf16_t* __restrict__ Wt, int K, int mt, int nt, const EP& ep, char* smem) {
  bf16_t* sX = (bf16_t*)smem; bf16_t* sW = sX + 128 * 72;
  const int tid = threadIdx.x, lane = tid & 63, wave = tid >> 6, wr = wave >> 1, wc = wave & 1, r = lane & 31, h = lane >> 5;
  const int n0 = nt * 128;
  f32x16 acc[2][2];
#pragma unroll
  for (int a = 0; a < 2; ++a)
#pragma unroll
    for (int b = 0; b < 2; ++b)
#pragma unroll
      for (int i = 0; i < 16; ++i) acc[a][b][i] = 0.f;
  u32x4 xa[4], wa[4];
#pragma unroll
  for (int i = 0; i < 4; ++i) {
    const int c = tid + 256 * i, row = c >> 3, kc = (c & 7) * 8;
    xa[i] = al(mt, row, kc);
    wa[i] = *(const u32x4*)(Wt + (size_t)(n0 + row) * K + kc);
  }
  for (int k0 = 0; k0 < K; k0 += 64) {
    __syncthreads();
#pragma unroll
    for (int i = 0; i < 4; ++i) {
      const int c = tid + 256 * i, row = c >> 3, kc = (c & 7) * 8;
      *(u32x4*)(sX + row * 72 + kc) = xa[i];
      *(u32x4*)(sW + row * 72 + kc) = wa[i];
    }
    __syncthreads();
    if (k0 + 64 < K) {
#pragma unroll
      for (int i = 0; i < 4; ++i) {
        const int c = tid + 256 * i, row = c >> 3, kc = (c & 7) * 8;
        xa[i] = al(mt, row, k0 + 64 + kc);
        wa[i] = *(const u32x4*)(Wt + (size_t)(n0 + row) * K + k0 + 64 + kc);
      }
    }
#pragma unroll
    for (int ks = 0; ks < 4; ++ks) {
      bf16x8 wf[2], xf[2];
#pragma unroll
      for (int s = 0; s < 2; ++s) {
        wf[s] = *(const bf16x8*)(sW + (64 * wc + 32 * s + r) * 72 + 16 * ks + 8 * h);
        xf[s] = *(const bf16x8*)(sX + (64 * wr + 32 * s + r) * 72 + 16 * ks + 8 * h);
      }
#pragma unroll
      for (int ms = 0; ms < 2; ++ms)
#pragma unroll
        for (int ns = 0; ns < 2; ++ns) acc[ms][ns] = mfma32(wf[ns], xf[ms], acc[ms][ns]);
    }
  }
  ep(acc, mt, nt, wr, wc, lane, smem);
}

template <class AL, class EP>
DI void gemm_phase(const AL& al, const bf16_t* Wt, int K, int numM, int numN, const EP& ep, char* smem) {
  const int xcd = blockIdx.x & 7, lb = blockIdx.x >> 3, nlb = gridDim.x >> 3;
  const int mper = (numM + 7) >> 3, srows = (mper + 7) >> 3;
  const int total = srows * 8 * numN;
  for (int li = lb; li < total; li += nlb) {
    const int s = li / (8 * numN), rem = li - s * 8 * numN;
    const int nt = rem >> 3, mtl = s * 8 + (rem & 7);
    const int mt = xcd * mper + mtl;
    if (mtl >= mper || mt >= numM) continue;
    gemm_tile(al, Wt, K, mt, nt, ep, smem);
  }
}

struct ALPlain { const bf16_t* A; int lda; DI u32x4 operator()(int mt, int ml, int k) const { return *(const u32x4*)(A + (size_t)(mt * 128 + ml) * lda + k); } };
struct ALFfn {
  const bf16_t* A;
  DI u32x4 operator()(int mt, int ml, int k) const {
    const int b = mt / 66, it = mt - b * 66, t = 126 * it - 2 + ml;
    if (t < 0 || t >= T_) return (u32x4){0, 0, 0, 0};
    return *(const u32x4*)(A + ((size_t)b * T_ + t) * 1024 + k);
  }
};
struct ALCmp1 {
  const bf16_t* raw; const float* pe;
  DI u32x4 operator()(int mt, int ml, int k) const {
    const int m = mt * 128 + ml;
    if (m >= 4088) return (u32x4){0, 0, 0, 0};
    const int bg = m / 511, n = m - bg * 511;
    u32x4 v = *(const u32x4*)(raw + ((size_t)bg * T_ + 16 * n) * 64 + k);
    const f32x4 p0 = *(const f32x4*)(pe + k), p1 = *(const f32x4*)(pe + k + 4);
    u32x4 o;
    o.x = pack2(bf2f((bf16_t)(v.x & 0xffff)) + p0.x, bf2f((bf16_t)(v.x >> 16)) + p0.y);
    o.y = pack2(bf2f((bf16_t)(v.y & 0xffff)) + p0.z, bf2f((bf16_t)(v.y >> 16)) + p0.w);
    o.z = pack2(bf2f((bf16_t)(v.z & 0xffff)) + p1.x, bf2f((bf16_t)(v.z >> 16)) + p1.y);
    o.w = pack2(bf2f((bf16_t)(v.w & 0xffff)) + p1.z, bf2f((bf16_t)(v.w >> 16)) + p1.w);
    return o;
  }
};
struct ALCmp2 { const bf16_t* A; DI u32x4 operator()(int mt, int ml, int k) const { const int m = mt * 128 + ml; if (m >= 4088) return (u32x4){0, 0, 0, 0}; return *(const u32x4*)(A + (size_t)m * 256 + k); } };

__device__ const float ROPE_INV[8] = {1.0f, 0.19392274474868576f, 0.03760603093086393f, 0.007292664737217109f, 0.001414213562373095f, 0.0002742481756762073f, 5.318295896944988e-05f, 1.031338537721246e-05f};

template <bool ROPE>
DI void norm_store(f32x16 (&a)[2], float rs, const float* gain, int pos, bf16_t* dst, int h) {
  float ss = 0.f;
#pragma unroll
  for (int ns = 0; ns < 2; ++ns)
#pragma unroll
    for (int i = 0; i < 16; ++i) { const float v = a[ns][i] * rs; a[ns][i] = v; ss += v * v; }
  ss += __shfl_xor(ss, 32);
  const float inv = rsqrtf(ss * (1.0f / 64.0f) + 1e-6f);
#pragma unroll
  for (int ns = 0; ns < 2; ++ns)
#pragma unroll
    for (int i = 0; i < 16; ++i) a[ns][i] = a[ns][i] * inv * gain[32 * ns + crow(i, h)];
  if (ROPE) {
    const float fp = (float)pos;
#pragma unroll
    for (int ii = 0; ii < 4; ++ii) {
      const float ang = fp * ROPE_INV[4 * h + ii];
      const float c = cosf(ang), s = sinf(ang);
      const float x1 = a[0][ii], x2 = a[0][4 + ii];
      a[0][ii] = x1 * c - x2 * s; a[0][4 + ii] = x2 * c + x1 * s;
    }
  }
#pragma unroll
  for (int ns = 0; ns < 2; ++ns)
#pragma unroll
    for (int q = 0; q < 4; ++q) store_bf4(dst + 32 * ns + 8 * q + 4 * h, a[ns][4 * q], a[ns][4 * q + 1], a[ns][4 * q + 2], a[ns][4 * q + 3]);
}

struct EpiFoxIn {
  const Params& p;
  DI void operator()(f32x16 (&acc)[2][2], int mt, int nt, int wr, int wc, int lane, char*) const {
    const int r = lane & 31, h = lane >> 5, nb = nt * 128 + 64 * wc;
#pragma unroll
    for (int ms = 0; ms < 2; ++ms) {
      const int row = mt * 128 + 64 * wr + 32 * ms + r;
      const float rs = row_rstd(p.part, row);
      const int b = row >> 13, t = row & 8191;
      if (nb < 2048) {
        const bool isq = nb < 1024;
        norm_store<false>(acc[ms], rs, isq ? p.a_q_gain : p.a_k_gain, 0, (isq ? p.qb : p.kb) + (size_t)row * 1024 + (nb & 1023), h);
      } else if (nb < 3072) {
        const int head = (nb - 2048) >> 6;
        bf16_t* dst = p.vT + ((size_t)(b * 16 + head) * 64) * T_ + t;
#pragma unroll
        for (int ns = 0; ns < 2; ++ns)
#pragma unroll
          for (int i = 0; i < 16; ++i) dst[(size_t)(32 * ns + crow(i, h)) * T_] = f2bf(acc[ms][ns][i] * rs);
      } else if (nb == 3072) {
#pragma unroll
        for (int i = 0; i < 8; ++i) {
          const int head = crow(i, h);
          const float z = acc[ms][0][i] * rs + p.a_b_f[head];
          p.lf[((size_t)(b * 16 + head)) * T_ + t] = fminf(z, 0.f) - log1pf(expf(-fabsf(z)));
        }
      }
    }
  }
};

struct EpiResid {
  const float* res; float* out; bf16_t* hb; float* part;
  DI void operator()(f32x16 (&acc)[2][2], int mt, int nt, int wr, int wc, int lane, char*) const {
    const int r = lane & 31, h = lane >> 5;
#pragma unroll
    for (int ms = 0; ms < 2; ++ms) {
      const int row = mt * 128 + 64 * wr + 32 * ms + r;
      float ss = 0.f;
#pragma unroll
      for (int ns = 0; ns < 2; ++ns)
#pragma unroll
        for (int q = 0; q < 4; ++q) {
          const int n = nt * 128 + 64 * wc + 32 * ns + 8 * q + 4 * h;
          const f32x4 rv = *(const f32x4*)(res + (size_t)row * 1024 + n);
          f32x4 o;
          o.x = rv.x + acc[ms][ns][4 * q]; o.y = rv.y + acc[ms][ns][4 * q + 1]; o.z = rv.z + acc[ms][ns][4 * q + 2]; o.w = rv.w + acc[ms][ns][4 * q + 3];
          *(f32x4*)(out + (size_t)row * 1024 + n) = o;
          store_bf4(hb + (size_t)row * 1024 + n, o.x, o.y, o.z, o.w);
          ss += o.x * o.x + o.y * o.y + o.z * o.z + o.w * o.w;
        }
      ss += __shfl_xor(ss, 32);
      if (h == 0) part[(size_t)row * 16 + nt * 2 + wc] = ss;
    }
  }
};

struct EpiFfnUp {
  const float* part; const float* cw; const float* cb; bf16_t* act;
  DI void operator()(f32x16 (&acc)[2][2], int mt, int nt, int wr, int wc, int lane, char* smem) const {
    float* sU = (float*)smem;
    const int r = lane & 31, h = lane >> 5, tid = threadIdx.x;
    const int b = mt / 66, it = mt - b * 66, tb = 126 * it - 2;
    __syncthreads();
#pragma unroll
    for (int ms = 0; ms < 2; ++ms) {
      const int ml = 64 * wr + 32 * ms + r, t = tb + ml;
      const float rs = (t >= 0 && t < T_) ? row_rstd(part, b * T_ + t) : 0.f;
#pragma unroll
      for (int ns = 0; ns < 2; ++ns)
#pragma unroll
        for (int i = 0; i < 16; ++i) sU[ml * 129 + 64 * wc + 32 * ns + crow(i, h)] = acc[ms][ns][i] * rs;
    }
    __syncthreads();
    const int jj = tid & 63, rg = tid >> 6, j = nt * 64 + jj;
    const float wg0 = cw[j], wg1 = cw[5632 + j], wg2 = cw[2 * 5632 + j], bgt = cb[j];
    const float wv0 = cw[FF + j], wv1 = cw[5632 + FF + j], wv2 = cw[2 * 5632 + FF + j], bvl = cb[FF + j];
    for (int ml = 2 + rg; ml < 128; ml += 4) {
      const int t = tb + ml;
      if (t >= T_) break;
      const float g = bgt + wg0 * sU[(ml - 2) * 129 + jj] + wg1 * sU[(ml - 1) * 129 + jj] + wg2 * sU[ml * 129 + jj];
      const float v = bvl + wv0 * sU[(ml - 2) * 129 + 64 + jj] + wv1 * sU[(ml - 1) * 129 + 64 + jj] + wv2 * sU[ml * 129 + 64 + jj];
      const float a = g / (1.0f + __expf(-g)) * v;
      act[((size_t)b * T_ + t) * FF + j] = f2bf(a);
    }
  }
};

struct EpiKv {
  const Params& p;
  DI void operator()(f32x16 (&acc)[2][2], int mt, int nt, int wr, int wc, int lane, char*) const {
    const int r = lane & 31, h = lane >> 5, g = wc;
#pragma unroll
    for (int ms = 0; ms < 2; ++ms) {
      const int row = mt * 128 + 64 * wr + 32 * ms + r;
      const float rs = row_rstd(p.part, row);
      const int b = row >> 13, t = row & 8191, bg = b * 2 + g;
      if (nt < 2) {
        bf16_t* dst = p.rawc + (((size_t)(nt * 8 + bg)) * T_ + t) * 64;
#pragma unroll
        for (int ns = 0; ns < 2; ++ns)
#pragma unroll
          for (int q = 0; q < 4; ++q)
            store_bf4(dst + 32 * ns + 8 * q + 4 * h, acc[ms][ns][4 * q] * rs, acc[ms][ns][4 * q + 1] * rs, acc[ms][ns][4 * q + 2] * rs, acc[ms][ns][4 * q + 3] * rs);
      } else if (nt == 2 || nt == 4) {
        norm_store<true>(acc[ms], rs, nt == 2 ? p.ks_gain : p.kw_gain, p.pos[row], (nt == 2 ? p.ksb : p.kwb) + ((size_t)bg * T_ + t) * 64, h);
      } else if (nt == 3) {
        bf16_t* dst = p.vsT + ((size_t)bg * 128 + (t >> 6)) * 4096 + (t & 63);
#pragma unroll
        for (int ns = 0; ns < 2; ++ns)
#pragma unroll
          for (int i = 0; i < 16; ++i) dst[(32 * ns + crow(i, h)) * 64] = f2bf(acc[ms][ns][i] * rs);
      } else {
        bf16_t* dst = p.vwT + ((size_t)bg * 64) * T_ + t;
#pragma unroll
        for (int ns = 0; ns < 2; ++ns)
#pragma unroll
          for (int i = 0; i < 16; ++i) dst[(size_t)(32 * ns + crow(i, h)) * T_] = f2bf(acc[ms][ns][i] * rs);
      }
    }
  }
};

struct EpiBIn {
  const Params& p;
  DI void operator()(f32x16 (&acc)[2][2], int mt, int nt, int wr, int wc, int lane, char*) const {
    const int r = lane & 31, h = lane >> 5, nb = nt * 128 + 64 * wc;
#pragma unroll
    for (int ms = 0; ms < 2; ++ms) {
      const int row = mt * 128 + 64 * wr + 32 * ms + r;
      const float rs = row_rstd(p.part, row);
      if (nb < 1024) {
        norm_store<true>(acc[ms], rs, p.b_q_gain, p.pos[row], p.qn + (size_t)row * 1024 + nb, h);
      } else if (nb == 1024) {
#pragma unroll
        for (int ns = 0; ns < 2; ++ns)
#pragma unroll
          for (int i = 0; i < 16; ++i) {
            const int c = 32 * ns + crow(i, h);
            if (c < 48) { const float z = acc[ms][ns][i] * rs + p.b_b_gate[c]; p.gates[(size_t)row * 48 + c] = 1.0f / (1.0f + __expf(-z)); }
          }
      }
    }
  }
};

struct EpiCmp1 {
  bf16_t* hid;
  DI void operator()(f32x16 (&acc)[2][2], int mt, int nt, int wr, int wc, int lane, char*) const {
    const int r = lane & 31, h = lane >> 5;
#pragma unroll
    for (int ms = 0; ms < 2; ++ms) {
      const int m = mt * 128 + 64 * wr + 32 * ms + r;
      if (m >= 4088) continue;
#pragma unroll
      for (int ns = 0; ns < 2; ++ns) {
        float g[16];
#pragma unroll
        for (int i = 0; i < 16; ++i) { const float x = acc[ms][ns][i]; g[i] = 0.5f * x * (1.0f + tanhf(0.7978845608028654f * (x + 0.044715f * x * x * x))); }
#pragma unroll
        for (int q = 0; q < 4; ++q) store_bf4(hid + (size_t)m * 256 + nt * 128 + 64 * wc + 32 * ns + 8 * q + 4 * h, g[4 * q], g[4 * q + 1], g[4 * q + 2], g[4 * q + 3]);
      }
    }
  }
};

struct EpiCmp2 {
  const Params& p; int sel;
  DI void operator()(f32x16 (&acc)[2][2], int mt, int nt, int wr, int wc, int lane, char*) const {
    if (wc != 0) return;
    const int r = lane & 31, h = lane >> 5;
#pragma unroll
    for (int ms = 0; ms < 2; ++ms) {
      const int m = mt * 128 + 64 * wr + 32 * ms + r;
      if (m < 4088) {
        const int bg = m / 511, n = m - bg * 511, b = bg >> 1;
        if (sel == 0) {
          norm_store<true>(acc[ms], 1.0f, p.kc_gain, p.pos[b * T_ + 16 * n + 31], p.kcb + ((size_t)bg * 512 + n) * 64, h);
        } else {
          bf16_t* dst = p.vcT + ((size_t)bg * 64) * 512 + n;
#pragma unroll
          for (int ns = 0; ns < 2; ++ns)
#pragma unroll
            for (int i = 0; i < 16; ++i) dst[(32 * ns + crow(i, h)) * 512] = f2bf(acc[ms][ns][i]);
        }
      } else {
      }
    }
  }
};

DI void phase_scan(const Params& p) {
  const int lane = threadIdx.x & 63, gw = blockIdx.x * 4 + (threadIdx.x >> 6);
  if (gw >= 64) return;
  const float* src = p.lf + (size_t)gw * T_ + lane * 128;
  float* dst = p.cc + (size_t)gw * T_ + lane * 128;
  float s = 0.f;
  for (int i = 0; i < 128; i += 4) { const f32x4 v = *(const f32x4*)(src + i); s += v.x; s += v.y; s += v.z; s += v.w; }
  float inc = s;
#pragma unroll
  for (int o = 1; o < 64; o <<= 1) { const float u = __shfl_up(inc, o); if (lane >= o) inc += u; }
  float run = inc - s;
  for (int i = 0; i < 128; i += 4) {
    const f32x4 v = *(const f32x4*)(src + i); f32x4 o;
    run += v.x; o.x = run; run += v.y; o.y = run; run += v.z; o.z = run; run += v.w; o.w = run;
    *(f32x4*)(dst + i) = o;
  }
}

template <int MODE>
DI void flash_step(f32x16 (&o)[2], float& m, float& l, const bf16x8 (&qf)[4], const bf16_t* sK, const bf16_t* sV, const float* sC,
                   int kbase, int tq, float cq, float inv_l, float* sImpRow, int lane) {
  const int r = lane & 31, h = lane >> 5;
#pragma unroll 1
  for (int sub = 0; sub < 2; ++sub) {
    f32x16 s;
#pragma unroll
    for (int i = 0; i < 16; ++i) s[i] = 0.f;
#pragma unroll
    for (int ks = 0; ks < 4; ++ks) {
      const bf16x8 a = *(const bf16x8*)(sK + (32 * sub + r) * 72 + 16 * ks + 8 * h);
      s = mfma32(a, qf[ks], s);
    }
    float mloc = -1e30f;
#pragma unroll
    for (int i = 0; i < 16; ++i) {
      const int kl = 32 * sub + crow(i, h), key = kbase + kl;
      float x = s[i] * 0.125f;
      bool valid;
      if (MODE == 0) { x += cq - sC[kl]; valid = key <= tq; }
      else if (MODE == 1) { valid = (key <= tq) && (tq - key < 512); }
      else { valid = (16 * key + 31) <= tq; }
      x = valid ? x : -1e30f;
      s[i] = x; mloc = fmaxf(mloc, x);
    }
    mloc = fmaxf(mloc, __shfl_xor(mloc, 32));
    const float mn = fmaxf(m, mloc);
    const float alpha = __expf(m - mn);
    m = mn;
    float ls = 0.f;
#pragma unroll
    for (int i = 0; i < 16; ++i) { const float x = s[i]; const float pv = (x > -1e29f) ? __expf(x - mn) : 0.f; s[i] = pv; ls += pv; }
    l = l * alpha + ls;
    if (MODE == 2) continue;
#pragma unroll
    for (int d = 0; d < 2; ++d)
#pragma unroll
      for (int i = 0; i < 16; ++i) o[d][i] *= alpha;
    if (MODE == 3) {
#pragma unroll
      for (int q = 0; q < 4; ++q) {
        const float p3 = s[4 * q + 3] * inv_l;
        float A = (s[4 * q] + s[4 * q + 1] + s[4 * q + 2]) * inv_l + 0.5f * p3, B = 0.5f * p3;
        A += __shfl_xor(A, 1); A += __shfl_xor(A, 2); A += __shfl_xor(A, 4);
        B += __shfl_xor(B, 1); B += __shfl_xor(B, 2); B += __shfl_xor(B, 4);
        if ((r & 7) == 0) { const int j = ((kbase + 32 * sub) >> 2) + 2 * q + h; atomicAdd(&sImpRow[j], A); atomicAdd(&sImpRow[j + 1], B); }
      }
    }
#pragma unroll
    for (int st = 0; st < 2; ++st) {
      u32x4 pk;
      pk.x = pack2(s[8 * st + 0], s[8 * st + 1]); pk.y = pack2(s[8 * st + 2], s[8 * st + 3]);
      pk.z = pack2(s[8 * st + 4], s[8 * st + 5]); pk.w = pack2(s[8 * st + 6], s[8 * st + 7]);
      const bf16x8 pf = __builtin_bit_cast(bf16x8, pk);
#pragma unroll
      for (int d = 0; d < 2; ++d) {
        const bf16_t* vp = sV + (32 * d + r) * 72 + 32 * sub + 16 * st + 4 * h;
        const bf16x4 lo = *(const bf16x4*)vp, hi = *(const bf16x4*)(vp + 8);
        const bf16x8 vf = __builtin_shufflevector(lo, hi, 0, 1, 2, 3, 4, 5, 6, 7);
        o[d] = mfma32(vf, pf, o[d]);
      }
    }
  }
}

DI void tile_load(u32x4 (&kr)[2], u32x4 (&vr)[2], const bf16_t* kptr, int kstride, const bf16_t* vptr, int vstride, bool withV, int tid) {
#pragma unroll
  for (int i = 0; i < 2; ++i) {
    const int c = tid + 256 * i, row = c >> 3, ch = (c & 7) * 8;
    kr[i] = *(const u32x4*)(kptr + (size_t)row * kstride + ch);
    if (withV) vr[i] = *(const u32x4*)(vptr + (size_t)row * vstride + ch);
  }
}
DI void tile_store(const u32x4 (&kr)[2], const u32x4 (&vr)[2], bf16_t* sK, bf16_t* sV, bool withV, int tid) {
#pragma unroll
  for (int i = 0; i < 2; ++i) {
    const int c = tid + 256 * i, row = c >> 3, ch = (c & 7) * 8;
    *(u32x4*)(sK + row * 72 + ch) = kr[i];
    if (withV) *(u32x4*)(sV + row * 72 + ch) = vr[i];
  }
}

DI void phase_fox(const Params& p, char* smem) {
  bf16_t* sK = (bf16_t*)smem; bf16_t* sV = sK + 64 * 72; float* sC = (float*)(sV + 64 * 72);
  const int tid = threadIdx.x, lane = tid & 63, w = tid >> 6, r = lane & 31, h = lane >> 5;
  float gq = 0.f, gk = 0.f;
  for (int i = 0; i < 64; ++i) { gq = fmaxf(gq, fabsf(p.a_q_gain[i])); gk = fmaxf(gk, fabsf(p.a_k_gain[i])); }
  const float thr = 40.0f + 2.0f * 8.0f * gq * gk * 1.05f;
  for (int item = blockIdx.x; item < 4096; item += gridDim.x) {
    const int bh = item & 63, qt = 63 - (item >> 6), b = bh >> 4, head = bh & 15, t0 = qt * 128;
    const int tq = t0 + 32 * w + r;
    const bf16_t* qrow = p.qb + ((size_t)b * T_ + tq) * 1024 + head * 64;
    bf16x8 qf[4];
#pragma unroll
    for (int ks = 0; ks < 4; ++ks) qf[ks] = *(const bf16x8*)(qrow + 16 * ks + 8 * h);
    const float* cseq = p.cc + (size_t)bh * T_;
    const float cq = cseq[tq], c0 = cseq[t0];
    const bf16_t* kbp = p.kb + ((size_t)b * T_) * 1024 + head * 64;
    const bf16_t* vbp = p.vT + ((size_t)bh * 64) * T_;
    f32x16 o[2];
#pragma unroll
    for (int d = 0; d < 2; ++d)
#pragma unroll
      for (int i = 0; i < 16; ++i) o[d][i] = 0.f;
    float m = -1e30f, l = 0.f;
    u32x4 kr[2], vr[2]; f32x4 cr = (f32x4){0.f, 0.f, 0.f, 0.f};
    int jt = 2 * qt + 1;
    tile_load(kr, vr, kbp + (size_t)(64 * jt) * 1024, 1024, vbp + 64 * jt, T_, true, tid);
    if (tid < 16) cr = *(const f32x4*)(cseq + 64 * jt + 4 * tid);
    for (; jt >= 0; --jt) {
      const int kbase = 64 * jt;
      if (c0 - cseq[kbase + 63] < -thr) break;
      __syncthreads();
      tile_store(kr, vr, sK, sV, true, tid);
      if (tid < 16) *(f32x4*)(sC + 4 * tid) = cr;
      __syncthreads();
      if (jt > 0) {
        tile_load(kr, vr, kbp + (size_t)(64 * (jt - 1)) * 1024, 1024, vbp + 64 * (jt - 1), T_, true, tid);
        if (tid < 16) cr = *(const f32x4*)(cseq + 64 * (jt - 1) + 4 * tid);
      }
      if (kbase <= t0 + 32 * w + 31) flash_step<0>(o, m, l, qf, sK, sV, sC, kbase, tq, cq, 0.f, nullptr, lane);
    }
    const float lt = l + __shfl_xor(l, 32);
    const float inv = 1.0f / lt;
    bf16_t* orow = p.ob + ((size_t)b * T_ + tq) * 1024 + head * 64;
#pragma unroll
    for (int d = 0; d < 2; ++d)
#pragma unroll
      for (int q = 0; q < 4; ++q) store_bf4(orow + 32 * d + 8 * q + 4 * h, o[d][4 * q] * inv, o[d][4 * q + 1] * inv, o[d][4 * q + 2] * inv, o[d][4 * q + 3] * inv);
  }
}

DI void phase_nsa(const Params& p, char* smem) {
  bf16_t* sK = (bf16_t*)smem; bf16_t* sV = sK + 64 * 72;
  float* sImp = (float*)(sV + 64 * 72);
  float* sO = sImp + 16 * 132;
  int* sSel = (int*)(sO + 128 * 65);
  int* sCnt = sSel + 256;
  const int tid = threadIdx.x, lane = tid & 63, w = tid >> 6, r = lane & 31, h = lane >> 5;
  for (int item = blockIdx.x; item < 4096; item += gridDim.x) {
    const int bg = item & 7, tt = 511 - (item >> 3), b = bg >> 1, g = bg & 1, t0 = tt * 16;
    const int tokl = 4 * w + (r >> 3), head = r & 7, tq = t0 + tokl;
    __syncthreads();
    for (int i = tid; i < 16 * 132; i += 256) sImp[i] = 0.f;
    bf16x8 qf[4];
    {
      const bf16_t* qrow = p.qn + ((size_t)b * T_ + tq) * 1024 + (g * 8 + head) * 64;
#pragma unroll
      for (int ks = 0; ks < 4; ++ks) qf[ks] = *(const bf16x8*)(qrow + 16 * ks + 8 * h);
    }
    const float* grow = p.gates + ((size_t)b * T_ + tq) * 48 + g * 8 + head;
    const float gate_c = grow[0], gate_w = grow[32];
    f32x16 o[2];
    float m = -1e30f, l = 0.f;
    u32x4 kr[2], vr[2];
    const int ncmp = t0 >> 4, nct = (ncmp + 63) >> 6;
    const bf16_t* kcp = p.kcb + (size_t)bg * 512 * 64;
    const bf16_t* vcp = p.vcT + (size_t)bg * 64 * 512;
    if (nct > 0) tile_load(kr, vr, kcp, 64, vcp, 512, false, tid);
    for (int jt = 0; jt < nct; ++jt) {
      __syncthreads();
      tile_store(kr, vr, sK, sV, false, tid);
      __syncthreads();
      if (jt + 1 < nct) tile_load(kr, vr, kcp + (size_t)(64 * (jt + 1)) * 64, 64, vcp, 512, false, tid);
      flash_step<2>(o, m, l, qf, sK, sV, nullptr, 64 * jt, tq, 0.f, 0.f, nullptr, lane);
    }
    const float lc = l + __shfl_xor(l, 32);
    const float inv_lc = 1.0f / fmaxf(lc, 1.0f);
#pragma unroll
    for (int d = 0; d < 2; ++d)
#pragma unroll
      for (int i = 0; i < 16; ++i) o[d][i] = 0.f;
    float l2 = 0.f;
    if (nct > 0) tile_load(kr, vr, kcp, 64, vcp, 512, true, tid);
    for (int jt = 0; jt < nct; ++jt) {
      __syncthreads();
      tile_store(kr, vr, sK, sV, true, tid);
      __syncthreads();
      if (jt + 1 < nct) tile_load(kr, vr, kcp + (size_t)(64 * (jt + 1)) * 64, 64, vcp + 64 * (jt + 1), 512, true, tid);
      flash_step<3>(o, m, l2, qf, sK, sV, nullptr, 64 * jt, tq, 0.f, inv_lc, sImp + tokl * 132, lane);
    }
    {
      const float sc = gate_c * inv_lc;
      float* orow = sO + (32 * w + r) * 65;
#pragma unroll
      for (int d = 0; d < 2; ++d)
#pragma unroll
        for (int i = 0; i < 16; ++i) orow[32 * d + crow(i, h)] = o[d][i] * sc;
    }
    __syncthreads();
    const int cur = t0 >> 6;
    for (int tk = 0; tk < 4; ++tk) {
      const int tok = 4 * w + tk;
      float* sc = sImp + tok * 132;
      for (int j = lane; j <= cur; j += 64) if (j == 0 || j == cur || j == cur - 1) sc[j] = 1e6f;
    }
    __syncthreads();
    for (int tk = 0; tk < 4; ++tk) {
      const int tok = 4 * w + tk;
      const float* sc = sImp + tok * 132;
      int basecnt = 0;
      for (int half = 0; half < 2; ++half) {
        const int j = lane + 64 * half;
        const bool vj = j <= cur;
        const float sj = vj ? sc[j] : 0.f;
        int rank = 0;
        for (int i = 0; i <= cur; ++i) { const float si = sc[i]; rank += ((si > sj) || (si == sj && i < j)) ? 1 : 0; }
        const bool selj = vj && rank < 16;
        const unsigned long long mk = __ballot(selj);
        const int pos = __popcll(mk & ((1ull << lane) - 1ull));
        if (selj) sSel[tok * 16 + basecnt + pos] = j;
        basecnt += __popcll(mk);
      }
      if (lane == 0) sCnt[tok] = basecnt;
    }
    __syncthreads();
    {
      const int c16 = lane & 15, quad = lane >> 4, hd = c16 & 7;
      for (int tk = 0; tk < 4; ++tk) {
        const int tok = 4 * w + tk, tqq = t0 + tok, nsel = sCnt[tok];
        const bf16_t* qrow = p.qn + ((size_t)b * T_ + tqq) * 1024 + (g * 8 + hd) * 64;
        bf16x8 qs[2];
        qs[0] = *(const bf16x8*)(qrow + quad * 8); qs[1] = *(const bf16x8*)(qrow + 32 + quad * 8);
        f32x4 oo[4];
#pragma unroll
        for (int d = 0; d < 4; ++d) oo[d] = (f32x4){0.f, 0.f, 0.f, 0.f};
        float ms = -1e30f, ls = 0.f;
        for (int e = 0; e < nsel; ++e) {
          const int blk = sSel[tok * 16 + e];
          const bf16_t* kptr = p.ksb + ((size_t)bg * T_ + blk * 64) * 64;
          const bf16_t* vptr = p.vsT + ((size_t)bg * 128 + blk) * 4096;
          f32x4 s4[4];
#pragma unroll
          for (int sub = 0; sub < 4; ++sub) {
            s4[sub] = (f32x4){0.f, 0.f, 0.f, 0.f};
#pragma unroll
            for (int ks = 0; ks < 2; ++ks) {
              const bf16x8 a = *(const bf16x8*)(kptr + (16 * sub + c16) * 64 + 32 * ks + quad * 8);
              s4[sub] = mfma16(a, qs[ks], s4[sub]);
            }
          }
          float mloc = -1e30f;
#pragma unroll
          for (int sub = 0; sub < 4; ++sub)
#pragma unroll
            for (int j = 0; j < 4; ++j) {
              const int key = blk * 64 + 16 * sub + quad * 4 + j;
              const float x = (key <= tqq) ? s4[sub][j] * 0.125f : -1e30f;
              s4[sub][j] = x; mloc = fmaxf(mloc, x);
            }
          mloc = fmaxf(mloc, __shfl_xor(mloc, 16)); mloc = fmaxf(mloc, __shfl_xor(mloc, 32));
          const float mn = fmaxf(ms, mloc), alpha = __expf(ms - mn);
          ms = mn;
          float lsum = 0.f;
#pragma unroll
          for (int sub = 0; sub < 4; ++sub)
#pragma unroll
            for (int j = 0; j < 4; ++j) { const float x = s4[sub][j]; const float pv = (x > -1e29f) ? __expf(x - mn) : 0.f; s4[sub][j] = pv; lsum += pv; }
          ls = ls * alpha + lsum;
#pragma unroll
          for (int d = 0; d < 4; ++d)
#pragma unroll
            for (int j = 0; j < 4; ++j) oo[d][j] *= alpha;
#pragma unroll
          for (int st = 0; st < 2; ++st) {
            u32x4 pk;
            pk.x = pack2(s4[2 * st][0], s4[2 * st][1]); pk.y = pack2(s4[2 * st][2], s4[2 * st][3]);
            pk.z = pack2(s4[2 * st + 1][0], s4[2 * st + 1][1]); pk.w = pack2(s4[2 * st + 1][2], s4[2 * st + 1][3]);
            const bf16x8 pf = __builtin_bit_cast(bf16x8, pk);
#pragma unroll
            for (int d = 0; d < 4; ++d) {
              const bf16_t* vp = vptr + (16 * d + c16) * 64 + 32 * st + quad * 4;
              const bf16x4 lo = *(const bf16x4*)vp, hi = *(const bf16x4*)(vp + 16);
              const bf16x8 vf = __builtin_shufflevector(lo, hi, 0, 1, 2, 3, 4, 5, 6, 7);
              oo[d] = mfma16(vf, pf, oo[d]);
            }
          }
        }
        float lt = ls; lt += __shfl_xor(lt, 16); lt += __shfl_xor(lt, 32);
        if (c16 < 8) {
          const float gs = p.gates[((size_t)b * T_ + tqq) * 48 + 16 + g * 8 + hd] / lt;
          float* orow = sO + (tok * 8 + c16) * 65;
#pragma unroll
          for (int d = 0; d < 4; ++d)
#pragma unroll
            for (int j = 0; j < 4; ++j) orow[16 * d + quad * 4 + j] += oo[d][j] * gs;
        }
      }
    }
#pragma unroll
    for (int d = 0; d < 2; ++d)
#pragma unroll
      for (int i = 0; i < 16; ++i) o[d][i] = 0.f;
    m = -1e30f; l = 0.f;
    {
      const int klo = t0 - 511 > 0 ? t0 - 511 : 0, jt0 = klo >> 6, jt1 = (t0 + 15) >> 6;
      const bf16_t* kwp = p.kwb + (size_t)bg * T_ * 64;
      const bf16_t* vwp = p.vwT + (size_t)bg * 64 * T_;
      tile_load(kr, vr, kwp + (size_t)(64 * jt0) * 64, 64, vwp + 64 * jt0, T_, true, tid);
      for (int jt = jt0; jt <= jt1; ++jt) {
        __syncthreads();
        tile_store(kr, vr, sK, sV, true, tid);
        __syncthreads();
        if (jt < jt1) tile_load(kr, vr, kwp + (size_t)(64 * (jt + 1)) * 64, 64, vwp + 64 * (jt + 1), T_, true, tid);
        flash_step<1>(o, m, l, qf, sK, sV, nullptr, 64 * jt, tq, 0.f, 0.f, nullptr, lane);
      }
      const float lt = l + __shfl_xor(l, 32);
      const float sc = gate_w / lt;
      float* orow = sO + (32 * w + r) * 65;
#pragma unroll
      for (int d = 0; d < 2; ++d)
#pragma unroll
        for (int i = 0; i < 16; ++i) orow[32 * d + crow(i, h)] += o[d][i] * sc;
    }
    __syncthreads();
    for (int c = tid; c < 128 * 16; c += 256) {
      const int row = c >> 4, d4 = (c & 15) * 4, tok = row >> 3, hd = row & 7;
      const float* s = sO + row * 65 + d4;
      store_bf4(p.ob + ((size_t)b * T_ + t0 + tok) * 1024 + (g * 8 + hd) * 64 + d4, s[0], s[1], s[2], s[3]);
    }
  }
}

#ifdef ONLY_PHASE
#define PH_ON(n) ((n) == ONLY_PHASE)
#else
#define PH_ON(n) true
#endif
#define PHASE(n, ...) \
  if (PH_ON(n) && ph_lo <= (n) && (n) < ph_hi) { __VA_ARGS__ } \
  if (ph_lo <= (n) && (n) + 1 < ph_hi) cg::this_grid().sync();

__global__ void __launch_bounds__(256, 2) yoco_megakernel(Params p, int ph_lo, int ph_hi) {
  __shared__ __attribute__((aligned(16))) char smem[SMEM_BYTES];
  PHASE(0, phase_prep(p, smem);)
  PHASE(1, { ALPlain al{p.hb, 1024}; EpiFoxIn ep{p}; gemm_phase(al, p.w_ain, 1024, 256, 25, ep, smem); })
  PHASE(2, phase_scan(p);)
  PHASE(3, phase_fox(p, smem);)
  PHASE(4, { ALPlain al{p.ob, 1024}; EpiResid ep{p.x, p.out, p.hb, p.part}; gemm_phase(al, p.w_aout, 1024, 256, 8, ep, smem); })
  PHASE(5, { ALFfn al{p.hb}; EpiFfnUp ep{p.part, p.f_conv_w, p.f_conv_b, p.act}; gemm_phase(al, p.w_up0, 1024, 264, 44, ep, smem); })
  PHASE(6, { ALPlain al{p.act, FF}; EpiResid ep{p.out, p.out, p.hb, p.part}; gemm_phase(al, p.w_dn0, FF, 256, 8, ep, smem); })
  PHASE(7, {
    ALPlain al{p.hb, 1024};
    { EpiKv ep{p}; gemm_phase(al, p.w_kv, 1024, 256, 6, ep, smem); }
    { EpiBIn ep{p}; gemm_phase(al, p.w_bin, 1024, 256, 9, ep, smem); }
  })
  PHASE(8, {
    { ALCmp1 al{p.rawc, p.kc_pe}; EpiCmp1 ep{p.hid}; gemm_phase(al, p.w_kc1, 2048, 32, 2, ep, smem); }
    { ALCmp1 al{p.rawc + (size_t)8 * T_ * 64, p.vc_pe}; EpiCmp1 ep{p.hid + (size_t)4096 * 256}; gemm_phase(al, p.w_vc1, 2048, 32, 2, ep, smem); }
  })
  PHASE(9, {
    { ALCmp2 al{p.hid}; EpiCmp2 ep{p, 0}; gemm_phase(al, p.w_kc2, 256, 32, 1, ep, smem); }
    { ALCmp2 al{p.hid + (size_t)4096 * 256}; EpiCmp2 ep{p, 1}; gemm_phase(al, p.w_vc2, 256, 32, 1, ep, smem); }
  })
  PHASE(10, phase_nsa(p, smem);)
  PHASE(11, { ALPlain al{p.ob, 1024}; EpiResid ep{p.out, p.out, p.hb, p.part}; gemm_phase(al, p.w_bout, 1024, 256, 8, ep, smem); })
  PHASE(12, { ALFfn al{p.hb}; EpiFfnUp ep{p.part, p.f_conv_w + 3 * 5632, p.f_conv_b + 5632, p.act}; gemm_phase(al, p.w_up1, 1024, 264, 44, ep, smem); })
  PHASE(13, { ALPlain al{p.act, FF}; EpiResid ep{p.out, p.out, p.hb, p.part}; gemm_phase(al, p.w_dn1, FF, 256, 8, ep, smem); })
}

extern "C" void kernel_launch(void* const* d_in, const int* in_sizes, int n_in, void* d_out, int out_size, void* d_ws, size_t ws_size, hipStream_t stream) {
  Params p{};
  p.x = (const float*)d_in[0]; p.pos = (const int*)d_in[1];
  p.a_norm = (const float*)d_in[2]; p.a_w_in = (const float*)d_in[3]; p.a_b_f = (const float*)d_in[4]; p.a_q_gain = (const float*)d_in[5];
  p.a_k_gain = (const float*)d_in[6]; p.a_w_out = (const float*)d_in[7]; p.kv_norm = (const float*)d_in[8]; p.kv_w = (const float*)d_in[9];
  p.kc_pe = (const float*)d_in[10]; p.vc_pe = (const float*)d_in[11]; p.kc_w1 = (const float*)d_in[12]; p.kc_w2 = (const float*)d_in[13];
  p.vc_w1 = (const float*)d_in[14]; p.vc_w2 = (const float*)d_in[15]; p.kc_gain = (const float*)d_in[16]; p.ks_gain = (const float*)d_in[17];
  p.kw_gain = (const float*)d_in[18]; p.b_norm = (const float*)d_in[19]; p.b_w_in = (const float*)d_in[20]; p.b_b_gate = (const float*)d_in[21];
  p.b_q_gain = (const float*)d_in[22]; p.b_w_out = (const float*)d_in[23]; p.f_norm = (const float*)d_in[24]; p.f_w_up = (const float*)d_in[25];
  p.f_conv_w = (const float*)d_in[26]; p.f_conv_b = (const float*)d_in[27]; p.f_w_down = (const float*)d_in[28];
  p.out = (float*)d_out;
  char* ws = (char*)d_ws; size_t off = 0;
  auto take = [&](size_t bytes) { char* q = ws + off; off += (bytes + 255) & ~(size_t)255; return q; };
  p.w_ain = (bf16_t*)take((size_t)3200 * 1024 * 2); p.w_aout = (bf16_t*)take((size_t)1024 * 1024 * 2); p.w_kv = (bf16_t*)take((size_t)768 * 1024 * 2);
  p.w_kc1 = (bf16_t*)take((size_t)256 * 2048 * 2); p.w_vc1 = (bf16_t*)take((size_t)256 * 2048 * 2);
  p.w_kc2 = (bf16_t*)take((size_t)128 * 256 * 2); p.w_vc2 = (bf16_t*)take((size_t)128 * 256 * 2);
  p.w_bin = (bf16_t*)take((size_t)1152 * 1024 * 2); p.w_bout = (bf16_t*)take((size_t)1024 * 1024 * 2);
  p.w_up0 = (bf16_t*)take((size_t)5632 * 1024 * 2); p.w_up1 = (bf16_t*)take((size_t)5632 * 1024 * 2);
  p.w_dn0 = (bf16_t*)take((size_t)1024 * FF * 2); p.w_dn1 = (bf16_t*)take((size_t)1024 * FF * 2);
  p.hb = (bf16_t*)take((size_t)NTOK * 1024 * 2); p.part = (float*)take((size_t)NTOK * 16 * 4);
  p.lf = (float*)take((size_t)64 * T_ * 4); p.cc = (float*)take((size_t)64 * T_ * 4);
  p.ob = (bf16_t*)take((size_t)NTOK * 1024 * 2);
  char* R = take((size_t)NTOK * 1024 * 2 * 3);
  p.qb = (bf16_t*)R; p.kb = p.qb + (size_t)NTOK * 1024; p.vT = p.kb + (size_t)NTOK * 1024;
  p.act = (bf16_t*)R;
  {
    char* q = R;
    p.qn = (bf16_t*)q; q += (size_t)NTOK * 1024 * 2;
    p.rawc = (bf16_t*)q; q += (size_t)2 * 8 * T_ * 64 * 2;
    p.ksb = (bf16_t*)q; q += (size_t)8 * T_ * 64 * 2;
    p.vsT = (bf16_t*)q; q += (size_t)8 * T_ * 64 * 2;
    p.kwb = (bf16_t*)q; q += (size_t)8 * T_ * 64 * 2;
    p.vwT = (bf16_t*)q; q += (size_t)8 * T_ * 64 * 2;
    p.gates = (float*)q; q += (size_t)NTOK * 48 * 4;
    p.hid = (bf16_t*)q; q += (size_t)2 * 4096 * 256 * 2;
    p.kcb = (bf16_t*)q; q += (size_t)8 * 512 * 64 * 2;
    p.vcT = (bf16_t*)q; q += (size_t)8 * 64 * 512 * 2;
  }
  static int grid_blocks = 0;
  if (!grid_blocks) {
    int dev = 0, cus = 0, per_cu = 0;
    hipGetDevice(&dev);
    hipDeviceGetAttribute(&cus, hipDeviceAttributeMultiprocessorCount, dev);
    hipOccupancyMaxActiveBlocksPerMultiprocessor(&per_cu, yoco_megakernel, 256, 0);
    if (per_cu > 2) per_cu = 2;
    if (per_cu < 1) per_cu = 1;
    grid_blocks = cus * per_cu;
    grid_blocks &= ~7;
  }
#if N_LAUNCH_SPLIT
  for (int ph = 0; ph < NPHASE; ++ph) {
    int lo = ph, hi = ph + 1;
    hipLaunchKernelGGL(yoco_megakernel, dim3(grid_blocks), dim3(256), 0, stream, p, lo, hi);
  }
#else
  int lo = 0, hi = NPHASE;
  void* args[] = {&p, &lo, &hi};
  hipError_t e = hipLaunchCooperativeKernel((void*)yoco_megakernel, dim3(grid_blocks), dim3(256), args, 0, stream);
  if (e != hipSuccess) fprintf(stderr, "cooperative launch failed: %s (grid %d)\n", hipGetErrorString(e), grid_blocks);
#endif
}
```

```cpp
#include <hip/hip_runtime.h>
#include <hip/hip_cooperative_groups.h>
#include <stdint.h>
#include <cstdio>
namespace cg = cooperative_groups;

#ifndef N_LAUNCH_SPLIT
#define N_LAUNCH_SPLIT 0
#endif

#define DI __device__ __forceinline__
typedef unsigned short bf16_t;
typedef short bf16x8 __attribute__((ext_vector_type(8)));
typedef short bf16x4 __attribute__((ext_vector_type(4)));
typedef float f32x16 __attribute__((ext_vector_type(16)));
typedef float f32x4 __attribute__((ext_vector_type(4)));
typedef unsigned u32x4 __attribute__((ext_vector_type(4)));
typedef unsigned u32x2 __attribute__((ext_vector_type(2)));

constexpr int T_ = 8192;
constexpr int NTOK = 32768;
constexpr int FF = 2816;
constexpr int NPHASE = 14;
constexpr int SMEM_BYTES = 66560;

struct Params {
  const float* x; const int* pos;
  const float *a_norm, *a_w_in, *a_b_f, *a_q_gain, *a_k_gain, *a_w_out;
  const float *kv_norm, *kv_w, *kc_pe, *vc_pe, *kc_w1, *kc_w2, *vc_w1, *vc_w2, *kc_gain, *ks_gain, *kw_gain;
  const float *b_norm, *b_w_in, *b_b_gate, *b_q_gain, *b_w_out;
  const float *f_norm, *f_w_up, *f_conv_w, *f_conv_b, *f_w_down;
  float* out;
  bf16_t *w_ain, *w_aout, *w_kv, *w_kc1, *w_vc1, *w_kc2, *w_vc2, *w_bin, *w_bout, *w_up0, *w_up1, *w_dn0, *w_dn1;
  bf16_t* hb; float* part; float* lf; float* cc; bf16_t* ob;
  bf16_t *qb, *kb, *vT; bf16_t* act;
  bf16_t *rawc, *ksb, *vsT, *kwb, *vwT, *qn; float* gates; bf16_t *hid, *kcb, *vcT;
};

typedef __bf16 bf16v2 __attribute__((ext_vector_type(2)));
typedef float f32x2 __attribute__((ext_vector_type(2)));
DI bf16_t f2bf(float x) { return __builtin_bit_cast(bf16_t, (__bf16)x); }
DI unsigned pack2(float a, float b) { f32x2 v = {a, b}; return __builtin_bit_cast(unsigned, __builtin_convertvector(v, bf16v2)); }
DI float bf2f(bf16_t v) { return __uint_as_float(((unsigned)v) << 16); }
DI int crow(int i, int h) { return (i & 3) + 8 * (i >> 2) + 4 * h; }
DI f32x16 mfma32(bf16x8 a, bf16x8 b, f32x16 c) { return __builtin_amdgcn_mfma_f32_32x32x16_bf16(a, b, c, 0, 0, 0); }
DI f32x4 mfma16(bf16x8 a, bf16x8 b, f32x4 c) { return __builtin_amdgcn_mfma_f32_16x16x32_bf16(a, b, c, 0, 0, 0); }
DI float row_rstd(const float* part, int row) {
  const f32x4* q = (const f32x4*)(part + (size_t)row * 16);
  f32x4 a = q[0], b = q[1], c = q[2], d = q[3];
  float s = ((a.x + a.y) + (a.z + a.w)) + ((b.x + b.y) + (b.z + b.w)) + ((c.x + c.y) + (c.z + c.w)) + ((d.x + d.y) + (d.z + d.w));
  return rsqrtf(s * (1.0f / 1024.0f) + 1e-6f);
}
DI void store_bf4(bf16_t* dst, float a, float b, float c, float d) { u32x2 v; v.x = pack2(a, b); v.y = pack2(c, d); *(u32x2*)dst = v; }

struct WJob { const float* src; bf16_t* dst; const float* gain; int K, Nsrc, Ndst, mode; };
DI WJob get_job(const Params& p, int j) {
  WJob w; w.gain = nullptr; w.mode = 0;
  switch (j) {
    case 0: w.src = p.a_w_in; w.dst = p.w_ain; w.gain = p.a_norm; w.K = 1024; w.Nsrc = 3088; w.Ndst = 3200; break;
    case 1: w.src = p.a_w_out; w.dst = p.w_aout; w.K = 1024; w.Nsrc = 1024; w.Ndst = 1024; break;
    case 2: w.src = p.kv_w; w.dst = p.w_kv; w.gain = p.kv_norm; w.K = 1024; w.Nsrc = 768; w.Ndst = 768; break;
    case 3: w.src = p.kc_w1; w.dst = p.w_kc1; w.K = 2048; w.Nsrc = 256; w.Ndst = 256; break;
    case 4: w.src = p.vc_w1; w.dst = p.w_vc1; w.K = 2048; w.Nsrc = 256; w.Ndst = 256; break;
    case 5: w.src = p.kc_w2; w.dst = p.w_kc2; w.K = 256; w.Nsrc = 64; w.Ndst = 128; break;
    case 6: w.src = p.vc_w2; w.dst = p.w_vc2; w.K = 256; w.Nsrc = 64; w.Ndst = 128; break;
    case 7: w.src = p.b_w_in; w.dst = p.w_bin; w.gain = p.b_norm; w.K = 1024; w.Nsrc = 1072; w.Ndst = 1152; break;
    case 8: w.src = p.b_w_out; w.dst = p.w_bout; w.K = 1024; w.Nsrc = 1024; w.Ndst = 1024; break;
    case 9: w.src = p.f_w_up; w.dst = p.w_up0; w.gain = p.f_norm; w.K = 1024; w.Nsrc = 5632; w.Ndst = 5632; w.mode = 1; break;
    case 10: w.src = p.f_w_up + (size_t)1024 * 5632; w.dst = p.w_up1; w.gain = p.f_norm + 1024; w.K = 1024; w.Nsrc = 5632; w.Ndst = 5632; w.mode = 1; break;
    case 11: w.src = p.f_w_down; w.dst = p.w_dn0; w.K = 2816; w.Nsrc = 1024; w.Ndst = 1024; break;
    default: w.src = p.f_w_down + (size_t)2816 * 1024; w.dst = p.w_dn1; w.K = 2816; w.Nsrc = 1024; w.Ndst = 1024; break;
  }
  return w;
}

DI void phase_prep(const Params& p, char* smem) {
  float* sT = (float*)smem;
  const int tid = threadIdx.x;
  int base = 0;
  for (int j = 0; j < 13; ++j) {
    WJob w = get_job(p, j);
    const int nkt = w.K >> 6, nnt = w.Ndst >> 6, ntile = nkt * nnt;
    int first = (int)blockIdx.x - (base % (int)gridDim.x); if (first < 0) first += gridDim.x;
    for (int t = first; t < ntile; t += gridDim.x) {
      const int kt = t % nkt, nt = t / nkt;
      const int k0 = kt << 6, n0d = nt << 6;
      int sbase = n0d;
      if (w.mode == 1) { const int tile = n0d >> 7, half = (n0d >> 6) & 1; sbase = half * FF + tile * 64; }
      __syncthreads();
#pragma unroll
      for (int i = 0; i < 4; ++i) {
        const int kk = (tid >> 4) + 16 * i, nn = (tid & 15) * 4, col = sbase + nn;
        f32x4 v = (f32x4){0.f, 0.f, 0.f, 0.f};
        if (col < w.Nsrc) v = *(const f32x4*)(w.src + (size_t)(k0 + kk) * w.Nsrc + col);
        const float g = w.gain ? w.gain[k0 + kk] : 1.0f;
        sT[kk * 65 + nn + 0] = v.x * g; sT[kk * 65 + nn + 1] = v.y * g; sT[kk * 65 + nn + 2] = v.z * g; sT[kk * 65 + nn + 3] = v.w * g;
      }
      __syncthreads();
      const int n = tid >> 2, kseg = (tid & 3) * 16;
      unsigned o[8];
#pragma unroll
      for (int q = 0; q < 8; ++q) o[q] = pack2(sT[(kseg + 2 * q) * 65 + n], sT[(kseg + 2 * q + 1) * 65 + n]);
      u32x4* dst = (u32x4*)(w.dst + (size_t)(n0d + n) * w.K + k0 + kseg);
      dst[0] = (u32x4){o[0], o[1], o[2], o[3]}; dst[1] = (u32x4){o[4], o[5], o[6], o[7]};
    }
    base += ntile;
  }
  const int lane = tid & 63, gw = blockIdx.x * 4 + (tid >> 6), nw = gridDim.x * 4;
  for (int row = gw; row < NTOK; row += nw) {
    float ss = 0.f;
#pragma unroll
    for (int i = 0; i < 4; ++i) {
      const int col = i * 256 + lane * 4;
      f32x4 v = *(const f32x4*)(p.x + (size_t)row * 1024 + col);
      ss += v.x * v.x + v.y * v.y + v.z * v.z + v.w * v.w;
      store_bf4(p.hb + (size_t)row * 1024 + col, v.x, v.y, v.z, v.w);
    }
#pragma unroll
    for (int o = 32; o >= 1; o >>= 1) ss += __shfl_xor(ss, o);
    if (lane < 16) p.part[(size_t)row * 16 + lane] = lane == 0 ? ss : 0.f;
  }
  if (blockIdx.x == 0) {
    for (int i = tid; i < 8 * 64; i += 256) {
      const int bg = i >> 6, d = i & 63;
      p.kcb[((size_t)bg * 512 + 511) * 64 + d] = 0;
      p.vcT[((size_t)bg * 64 + d) * 512 + 511] = 0;
    }
  }
}

template <class AL, class EP>
DI void gemm_tile(const AL& al, const bf16_t* __restrict__ Wt, int K, int mt, int nt, const EP& ep, char* smem) {
  bf16_t* sX = (bf16_t*)smem; bf16_t* sW = sX + 128 * 72;
  const int tid = threadIdx.x, lane = tid & 63, wave = tid >> 6, wr = wave >> 1, wc = wave & 1, r = lane & 31, h = lane >> 5;
  const int n0 = nt * 128;
  f32x16 acc[2][2];
#pragma unroll
  for (int a = 0; a < 2; ++a)
#pragma unroll
    for (int b = 0; b < 2; ++b)
#pragma unroll
      for (int i = 0; i < 16; ++i) acc[a][b][i] = 0.f;
  u32x4 xa[4], wa[4];
#pragma unroll
  for (int i = 0; i < 4; ++i) {
    const int c = tid + 256 * i, row = c >> 3, kc = (c & 7) * 8;
    xa[i] = al(mt, row, kc);
    wa[i] = *(const u32x4*)(Wt + (size_t)(n0 + row) * K + kc);
  }
  for (int k0 = 0; k0 < K; k0 += 64) {
    __syncthreads();
#pragma unroll
    for (int i = 0; i < 4; ++i) {
      const int c = tid + 256 * i, row = c >> 3, kc = (c & 7) * 8;
      *(u32x4*)(sX + row * 72 + kc) = xa[i];
      *(u32x4*)(sW + row * 72 + kc) = wa[i];
    }
    __syncthreads();
    if (k0 + 64 < K) {
#pragma unroll
      for (int i = 0; i < 4; ++i) {
        const int c = tid + 256 * i, row = c >> 3, kc = (c & 7) * 8;
        xa[i] = al(mt, row, k0 + 64 + kc);
        wa[i] = *(const u32x4*)(Wt + (size_t)(n0 + row) * K + k0 + 64 + kc);
      }
    }
#pragma unroll
    for (int ks = 0; ks < 4; ++ks) {
      bf16x8 wf[2], xf[2];
#pragma unroll
      for (int s = 0; s < 2; ++s) {
        wf[s] = *(const bf16x8*)(sW + (64 * wc + 32 * s + r) * 72 + 16 * ks + 8 * h);
        xf[s] = *(const bf16x8*)(sX + (64 * wr + 32 * s + r) * 72 + 16 * ks + 8 * h);
      }
#pragma unroll
      for (int ms = 0; ms < 2; ++ms)
#pragma unroll
        for (int ns = 0; ns < 2; ++ns) acc[ms][ns] = mfma32(wf[ns], xf[ms], acc[ms][ns]);
    }
  }
  ep(acc, mt, nt, wr, wc, lane, smem);
}

template <class AL, class EP>
DI void gemm_phase(const AL& al, const bf16_t* Wt, int K, int numM, int numN, const EP& ep, char* smem) {
  const int xcd = blockIdx.x & 7, lb = blockIdx.x >> 3, nlb = gridDim.x >> 3;
  const int mper = (numM + 7) >> 3, srows = (mper + 7) >> 3;
  const int total = srows * 8 * numN;
  for (int li = lb; li < total; li += nlb) {
    const int s = li / (8 * numN), rem = li - s * 8 * numN;
    const int nt = rem >> 3, mtl = s * 8 + (rem & 7);
    const int mt = xcd * mper + mtl;
    if (mtl >= mper || mt >= numM) continue;
    gemm_tile(al, Wt, K, mt, nt, ep, smem);
  }
}

struct ALPlain { const bf16_t* A; int lda; DI u32x4 operator()(int mt, int ml, int k) const { return *(const u32x4*)(A + (size_t)(mt * 128 + ml) * lda + k); } };
struct ALFfn {
  const bf16_t* A;
  DI u32x4 operator()(int mt, int ml, int k) const {
    const int b = mt / 66, it = mt - b * 66, t = 126 * it - 2 + ml;
    if (t < 0 || t >= T_) return (u32x4){0, 0, 0, 0};
    return *(const u32x4*)(A + ((size_t)b * T_ + t) * 1024 + k);
  }
};
struct ALCmp1 {
  const bf16_t* raw; const float* pe;
  DI u32x4 operator()(int mt, int ml, int k) const {
    const int m = mt * 128 + ml;
    if (m >= 4088) return (u32x4){0, 0, 0, 0};
    const int bg = m / 511, n = m - bg * 511;
    u32x4 v = *(const u32x4*)(raw + ((size_t)bg * T_ + 16 * n) * 64 + k);
    const f32x4 p0 = *(const f32x4*)(pe + k), p1 = *(const f32x4*)(pe + k + 4);
    u32x4 o;
    o.x = pack2(bf2f((bf16_t)(v.x & 0xffff)) + p0.x, bf2f((bf16_t)(v.x >> 16)) + p0.y);
    o.y = pack2(bf2f((bf16_t)(v.y & 0xffff)) + p0.z, bf2f((bf16_t)(v.y >> 16)) + p0.w);
    o.z = pack2(bf2f((bf16_t)(v.z & 0xffff)) + p1.x, bf2f((bf16_t)(v.z >> 16)) + p1.y);
    o.w = pack2(bf2f((bf16_t)(v.w & 0xffff)) + p1.z, bf2f((bf16_t)(v.w >> 16)) + p1.w);
    return o;
  }
};
struct ALCmp2 { const bf16_t* A; DI u32x4 operator()(int mt, int ml, int k) const { const int m = mt * 128 + ml; if (m >= 4088) return (u32x4){0, 0, 0, 0}; return *(const u32x4*)(A + (size_t)m * 256 + k); } };

__device__ const float ROPE_INV[8] = {1.0f, 0.19392274474868576f, 0.03760603093086393f, 0.007292664737217109f, 0.001414213562373095f, 0.0002742481756762073f, 5.318295896944988e-05f, 1.031338537721246e-05f};

template <bool ROPE>
DI void norm_store(f32x16 (&a)[2], float rs, const float* gain, int pos, bf16_t* dst, int h) {
  float ss = 0.f;
#pragma unroll
  for (int ns = 0; ns < 2; ++ns)
#pragma unroll
    for (int i = 0; i < 16; ++i) { const float v = a[ns][i] * rs; a[ns][i] = v; ss += v * v; }
  ss += __shfl_xor(ss, 32);
  const float inv = rsqrtf(ss * (1.0f / 64.0f) + 1e-6f);
#pragma unroll
  for (int ns = 0; ns < 2; ++ns)
#pragma unroll
    for (int i = 0; i < 16; ++i) a[ns][i] = a[ns][i] * inv * gain[32 * ns + crow(i, h)];
  if (ROPE) {
    const float fp = (float)pos;
#pragma unroll
    for (int ii = 0; ii < 4; ++ii) {
      const float ang = fp * ROPE_INV[4 * h + ii];
      const float c = cosf(ang), s = sinf(ang);
      const float x1 = a[0][ii], x2 = a[0][4 + ii];
      a[0][ii] = x1 * c - x2 * s; a[0][4 + ii] = x2 * c + x1 * s;
    }
  }
#pragma unroll
  for (int ns = 0; ns < 2; ++ns)
#pragma unroll
    for (int q = 0; q < 4; ++q) store_bf4(dst + 32 * ns + 8 * q + 4 * h, a[ns][4 * q], a[ns][4 * q + 1], a[ns][4 * q + 2], a[ns][4 * q + 3]);
}

struct EpiFoxIn {
  const Params& p;
  DI void operator()(f32x16 (&acc)[2][2], int mt, int nt, int wr, int wc, int lane, char*) const {
    const int r = lane & 31, h = lane >> 5, nb = nt * 128 + 64 * wc;
#pragma unroll
    for (int ms = 0; ms < 2; ++ms) {
      const int row = mt * 128 + 64 * wr + 32 * ms + r;
      const float rs = row_rstd(p.part, row);
      const int b = row >> 13, t = row & 8191;
      if (nb < 2048) {
        const bool isq = nb < 1024;
        norm_store<false>(acc[ms], rs, isq ? p.a_q_gain : p.a_k_gain, 0, (isq ? p.qb : p.kb) + (size_t)row * 1024 + (nb & 1023), h);
      } else if (nb < 3072) {
        const int head = (nb - 2048) >> 6;
        bf16_t* dst = p.vT + ((size_t)(b * 16 + head) * 64) * T_ + t;
#pragma unroll
        for (int ns = 0; ns < 2; ++ns)
#pragma unroll
          for (int i = 0; i < 16; ++i) dst[(size_t)(32 * ns + crow(i, h)) * T_] = f2bf(acc[ms][ns][i] * rs);
      } else if (nb == 3072) {
#pragma unroll
        for (int i = 0; i < 8; ++i) {
          const int head = crow(i, h);
          const float z = acc[ms][0][i] * rs + p.a_b_f[head];
          p.lf[((size_t)(b * 16 + head)) * T_ + t] = fminf(z, 0.f) - log1pf(expf(-fabsf(z)));
        }
      }
    }
  }
};

struct EpiResid {
  const float* res; float* out; bf16_t* hb; float* part;
  DI void operator()(f32x16 (&acc)[2][2], int mt, int nt, int wr, int wc, int lane, char*) const {
    const int r = lane & 31, h = lane >> 5;
#pragma unroll
    for (int ms = 0; ms < 2; ++ms) {
      const int row = mt * 128 + 64 * wr + 32 * ms + r;
      float ss = 0.f;
#pragma unroll
      for (int ns = 0; ns < 2; ++ns)
#pragma unroll
        for (int q = 0; q < 4; ++q) {
          const int n = nt * 128 + 64 * wc + 32 * ns + 8 * q + 4 * h;
          const f32x4 rv = *(const f32x4*)(res + (size_t)row * 1024 + n);
          f32x4 o;
          o.x = rv.x + acc[ms][ns][4 * q]; o.y = rv.y + acc[ms][ns][4 * q + 1]; o.z = rv.z + acc[ms][ns][4 * q + 2]; o.w = rv.w + acc[ms][ns][4 * q + 3];
          *(f32x4*)(out + (size_t)row * 1024 + n) = o;
          store_bf4(hb + (size_t)row * 1024 + n, o.x, o.y, o.z, o.w);
          ss += o.x * o.x + o.y * o.y + o.z * o.z + o.w * o.w;
        }
      ss += __shfl_xor(ss, 32);
      if (h == 0) part[(size_t)row * 16 + nt * 2 + wc] = ss;
    }
  }
};

struct EpiFfnUp {
  const float* part; const float* cw; const float* cb; bf16_t* act;
  DI void operator()(f32x16 (&acc)[2][2], int mt, int nt, int wr, int wc, int lane, char* smem) const {
    float* sU = (float*)smem;
    const int r = lane & 31, h = lane >> 5, tid = threadIdx.x;
    const int b = mt / 66, it = mt - b * 66, tb = 126 * it - 2;
    __syncthreads();
#pragma unroll
    for (int ms = 0; ms < 2; ++ms) {
      const int ml = 64 * wr + 32 * ms + r, t = tb + ml;
      const float rs = (t >= 0 && t < T_) ? row_rstd(part, b * T_ + t) : 0.f;
#pragma unroll
      for (int ns = 0; ns < 2; ++ns)
#pragma unroll
        for (int i = 0; i < 16; ++i) sU[ml * 129 + 64 * wc + 32 * ns + crow(i, h)] = acc[ms][ns][i] * rs;
    }
    __syncthreads();
    const int jj = tid & 63, rg = tid >> 6, j = nt * 64 + jj;
    const float wg0 = cw[j], wg1 = cw[5632 + j], wg2 = cw[2 * 5632 + j], bgt = cb[j];
    const float wv0 = cw[FF + j], wv1 = cw[5632 + FF + j], wv2 = cw[2 * 5632 + FF + j], bvl = cb[FF + j];
    for (int ml = 2 + rg; ml < 128; ml += 4) {
      const int t = tb + ml;
      if (t >= T_) break;
      const float g = bgt + wg0 * sU[(ml - 2) * 129 + jj] + wg1 * sU[(ml - 1) * 129 + jj] + wg2 * sU[ml * 129 + jj];
      const float v = bvl + wv0 * sU[(ml - 2) * 129 + 64 + jj] + wv1 * sU[(ml - 1) * 129 + 64 + jj] + wv2 * sU[ml * 129 + 64 + jj];
      const float a = g / (1.0f + __expf(-g)) * v;
      act[((size_t)b * T_ + t) * FF + j] = f2bf(a);
    }
  }
};

struct EpiKv {
  const Params& p;
  DI void operator()(f32x16 (&acc)[2][2], int mt, int nt, int wr, int wc, int lane, char*) const {
    const int r = lane & 31, h = lane >> 5, g = wc;
#pragma unroll
    for (int ms = 0; ms < 2; ++ms) {
      const int row = mt * 128 + 64 * wr + 32 * ms + r;
      const float rs = row_rstd(p.part, row);
      const int b = row >> 13, t = row & 8191, bg = b * 2 + g;
      if (nt < 2) {
        bf16_t* dst = p.rawc + (((size_t)(nt * 8 + bg)) * T_ + t) * 64;
#pragma unroll
        for (int ns = 0; ns < 2; ++ns)
#pragma unroll
          for (int q = 0; q < 4; ++q)
            store_bf4(dst + 32 * ns + 8 * q + 4 * h, acc[ms][ns][4 * q] * rs, acc[ms][ns][4 * q + 1] * rs, acc[ms][ns][4 * q + 2] * rs, acc[ms][ns][4 * q + 3] * rs);
      } else if (nt == 2 || nt == 4) {
        norm_store<true>(acc[ms], rs, nt == 2 ? p.ks_gain : p.kw_gain, p.pos[row], (nt == 2 ? p.ksb : p.kwb) + ((size_t)bg * T_ + t) * 64, h);
      } else if (nt == 3) {
        bf16_t* dst = p.vsT + ((size_t)bg * 128 + (t >> 6)) * 4096 + (t & 63);
#pragma unroll
        for (int ns = 0; ns < 2; ++ns)
#pragma unroll
          for (int i = 0; i < 16; ++i) dst[(32 * ns + crow(i, h)) * 64] = f2bf(acc[ms][ns][i] * rs);
      } else {
        bf16_t* dst = p.vwT + ((size_t)bg * 64) * T_ + t;
#pragma unroll
        for (int ns = 0; ns < 2; ++ns)
#pragma unroll
          for (int i = 0; i < 16; ++i) dst[(size_t)(32 * ns + crow(i, h)) * T_] = f2bf(acc[ms][ns][i] * rs);
      }
    }
  }
};

struct EpiBIn {
  const Params& p;
  DI void operator()(f32x16 (&acc)[2][2], int mt, int nt, int wr, int wc, int lane, char*) const {
    const int r = lane & 31, h = lane >> 5, nb = nt * 128 + 64 * wc;
#pragma unroll
    for (int ms = 0; ms < 2; ++ms) {
      const int row = mt * 128 + 64 * wr + 32 * ms + r;
      const float rs = row_rstd(p.part, row);
      if (nb < 1024) {
        norm_store<true>(acc[ms], rs, p.b_q_gain, p.pos[row], p.qn + (size_t)row * 1024 + nb, h);
      } else if (nb == 1024) {
#pragma unroll
        for (int ns = 0; ns < 2; ++ns)
#pragma unroll
          for (int i = 0; i < 16; ++i) {
            const int c = 32 * ns + crow(i, h);
            if (c < 48) { const float z = acc[ms][ns][i] * rs + p.b_b_gate[c]; p.gates[(size_t)row * 48 + c] = 1.0f / (1.0f + __expf(-z)); }
          }
      }
    }
  }
};

struct EpiCmp1 {
  bf16_t* hid;
  DI void operator()(f32x16 (&acc)[2][2], int mt, int nt, int wr, int wc, int lane, char*) const {
    const int r = lane & 31, h = lane >> 5;
#pragma unroll
    for (int ms = 0; ms < 2; ++ms) {
      const int m = mt * 128 + 64 * wr + 32 * ms + r;
      if (m >= 4088) continue;
#pragma unroll
      for (int ns = 0; ns < 2; ++ns) {
        float g[16];
#pragma unroll
        for (int i = 0; i < 16; ++i) { const float x = acc[ms][ns][i]; g[i] = 0.5f * x * (1.0f + tanhf(0.7978845608028654f * (x + 0.044715f * x * x * x))); }
#pragma unroll
        for (int q = 0; q < 4; ++q) store_bf4(hid + (size_t)m * 256 + nt * 128 + 64 * wc + 32 * ns + 8 * q + 4 * h, g[4 * q], g[4 * q + 1], g[4 * q + 2], g[4 * q + 3]);
      }
    }
  }
};

struct EpiCmp2 {
  const Params& p; int sel;
  DI void operator()(f32x16 (&acc)[2][2], int mt, int nt, int wr, int wc, int lane, char*) const {
    if (wc != 0) return;
    const int r = lane & 31, h = lane >> 5;
#pragma unroll
    for (int ms = 0; ms < 2; ++ms) {
      const int m = mt * 128 + 64 * wr + 32 * ms + r;
      if (m < 4088) {
        const int bg = m / 511, n = m - bg * 511, b = bg >> 1;
        if (sel == 0) {
          norm_store<true>(acc[ms], 1.0f, p.kc_gain, p.pos[b * T_ + 16 * n + 31], p.kcb + ((size_t)bg * 512 + n) * 64, h);
        } else {
          bf16_t* dst = p.vcT + ((size_t)bg * 64) * 512 + n;
#pragma unroll
          for (int ns = 0; ns < 2; ++ns)
#pragma unroll
            for (int i = 0; i < 16; ++i) dst[(32 * ns + crow(i, h)) * 512] = f2bf(acc[ms][ns][i]);
        }
      } else {
      }
    }
  }
};

DI void phase_scan(const Params& p) {
  const int lane = threadIdx.x & 63, gw = blockIdx.x * 4 + (threadIdx.x >> 6);
  if (gw >= 64) return;
  const float* src = p.lf + (size_t)gw * T_ + lane * 128;
  float* dst = p.cc + (size_t)gw * T_ + lane * 128;
  float s = 0.f;
  for (int i = 0; i < 128; i += 4) { const f32x4 v = *(const f32x4*)(src + i); s += v.x; s += v.y; s += v.z; s += v.w; }
  float inc = s;
#pragma unroll
  for (int o = 1; o < 64; o <<= 1) { const float u = __shfl_up(inc, o); if (lane >= o) inc += u; }
  float run = inc - s;
  for (int i = 0; i < 128; i += 4) {
    const f32x4 v = *(const f32x4*)(src + i); f32x4 o;
    run += v.x; o.x = run; run += v.y; o.y = run; run += v.z; o.z = run; run += v.w; o.w = run;
    *(f32x4*)(dst + i) = o;
  }
}

template <int MODE>
DI void flash_step(f32x16 (&o)[2], float& m, float& l, const bf16x8 (&qf)[4], const bf16_t* sK, const bf16_t* sV, const float* sC,
                   int kbase, int tq, float cq2, float inv_l, float* sImpRow, int lane, bool selok = true) {
  const int r = lane & 31, h = lane >> 5;
  constexpr float SC = 0.125f * 1.4426950408889634f;
  const int base_hi = (MODE == 2 || MODE == 3) ? ((tq - 31) >> 4) : tq;
#pragma unroll 1
  for (int sub = 0; sub < 2; ++sub) {
    f32x16 s;
#pragma unroll
    for (int i = 0; i < 16; ++i) s[i] = 0.f;
#pragma unroll
    for (int ks = 0; ks < 4; ++ks) {
      const bf16x8 a = *(const bf16x8*)(sK + (32 * sub + r) * 72 + 16 * ks + 8 * h);
      s = mfma32(a, qf[ks], s);
    }
    int hi = base_hi - kbase - 32 * sub - 4 * h;
    if (MODE == 4 && !selok) hi = -1;
    const int lo = (MODE == 1) ? hi - 511 : -1000000;
    const bool nomask = __all((hi >= 27) && (lo <= 0));
    if (MODE == 0) {
#pragma unroll
      for (int q = 0; q < 4; ++q) {
        const f32x4 c4 = *(const f32x4*)(sC + 32 * sub + 8 * q + 4 * h);
#pragma unroll
        for (int j = 0; j < 4; ++j) s[4 * q + j] = s[4 * q + j] * SC + (cq2 - c4[j]);
      }
    } else {
#pragma unroll
      for (int i = 0; i < 16; ++i) s[i] *= SC;
    }
    if (!nomask) {
#pragma unroll
      for (int i = 0; i < 16; ++i) { const int cst = (i & 3) + 8 * (i >> 2); s[i] = (cst <= hi && cst >= lo) ? s[i] : -3e38f; }
    }
    float mloc = s[0];
#pragma unroll
    for (int i = 1; i < 16; ++i) mloc = fmaxf(mloc, s[i]);
    mloc = fmaxf(mloc, __shfl_xor(mloc, 32));
    const float mn = fmaxf(m, mloc);
    const float alpha = __builtin_amdgcn_exp2f(m - mn);
    m = mn;
    float ls = 0.f;
#pragma unroll
    for (int i = 0; i < 16; ++i) { const float pv = __builtin_amdgcn_exp2f(s[i] - mn); s[i] = pv; ls += pv; }
    l = l * alpha + ls;
    if (MODE == 2) continue;
    if (__any(alpha != 1.0f)) {
#pragma unroll
      for (int d = 0; d < 2; ++d)
#pragma unroll
        for (int i = 0; i < 16; ++i) o[d][i] *= alpha;
    }
    if (MODE == 3) {
#pragma unroll
      for (int q = 0; q < 4; ++q) {
        const float p3 = s[4 * q + 3] * inv_l;
        float A = (s[4 * q] + s[4 * q + 1] + s[4 * q + 2]) * inv_l + 0.5f * p3, B = 0.5f * p3;
        A += __shfl_xor(A, 1); A += __shfl_xor(A, 2); A += __shfl_xor(A, 4);
        B += __shfl_xor(B, 1); B += __shfl_xor(B, 2); B += __shfl_xor(B, 4);
        if ((r & 7) == 0) { const int j = ((kbase + 32 * sub) >> 2) + 2 * q + h; atomicAdd(&sImpRow[j], A); atomicAdd(&sImpRow[j + 1], B); }
      }
    }
#pragma unroll
    for (int st = 0; st < 2; ++st) {
      u32x4 pk;
      pk.x = pack2(s[8 * st + 0], s[8 * st + 1]); pk.y = pack2(s[8 * st + 2], s[8 * st + 3]);
      pk.z = pack2(s[8 * st + 4], s[8 * st + 5]); pk.w = pack2(s[8 * st + 6], s[8 * st + 7]);
      const bf16x8 pf = __builtin_bit_cast(bf16x8, pk);
#pragma unroll
      for (int d = 0; d < 2; ++d) {
        const bf16_t* vp = sV + (32 * d + r) * 72 + 32 * sub + 16 * st + 4 * h;
        const bf16x4 lo4 = *(const bf16x4*)vp, hi4 = *(const bf16x4*)(vp + 8);
        const bf16x8 vf = __builtin_shufflevector(lo4, hi4, 0, 1, 2, 3, 4, 5, 6, 7);
        o[d] = mfma32(vf, pf, o[d]);
      }
    }
  }
}

DI void tile_load(u32x4 (&kr)[2], u32x4 (&vr)[2], const bf16_t* kptr, int kstride, const bf16_t* vptr, int vstride, bool withV, int tid) {
#pragma unroll
  for (int i = 0; i < 2; ++i) {
    const int c = tid + 256 * i, row = c >> 3, ch = (c & 7) * 8;
    kr[i] = *(const u32x4*)(kptr + (size_t)row * kstride + ch);
    if (withV) vr[i] = *(const u32x4*)(vptr + (size_t)row * vstride + ch);
  }
}
DI void tile_store(const u32x4 (&kr)[2], const u32x4 (&vr)[2], bf16_t* sK, bf16_t* sV, bool withV, int tid) {
#pragma unroll
  for (int i = 0; i < 2; ++i) {
    const int c = tid + 256 * i, row = c >> 3, ch = (c & 7) * 8;
    *(u32x4*)(sK + row * 72 + ch) = kr[i];
    if (withV) *(u32x4*)(sV + row * 72 + ch) = vr[i];
  }
}

DI void phase_fox(const Params& p, char* smem) {
  bf16_t* sK = (bf16_t*)smem; bf16_t* sV = sK + 64 * 72; float* sC = (float*)(sV + 64 * 72);
  const int tid = threadIdx.x, lane = tid & 63, w = tid >> 6, r = lane & 31, h = lane >> 5;
  float gq = 0.f, gk = 0.f;
  for (int i = 0; i < 64; ++i) { gq = fmaxf(gq, fabsf(p.a_q_gain[i])); gk = fmaxf(gk, fabsf(p.a_k_gain[i])); }
  const float thr = 40.0f + 2.0f * 8.0f * gq * gk * 1.05f;
  for (int item = blockIdx.x; item < 4096; item += gridDim.x) {
    const int bh = item & 63, qt = 63 - (item >> 6), b = bh >> 4, head = bh & 15, t0 = qt * 128;
    const int tq = t0 + 32 * w + r;
    const bf16_t* qrow = p.qb + ((size_t)b * T_ + tq) * 1024 + head * 64;
    bf16x8 qf[4];
#pragma unroll
    for (int ks = 0; ks < 4; ++ks) qf[ks] = *(const bf16x8*)(qrow + 16 * ks + 8 * h);
    const float* cseq = p.cc + (size_t)bh * T_;
    const float cq = cseq[tq] * 1.4426950408889634f, c0 = cseq[t0];
    const bf16_t* kbp = p.kb + ((size_t)b * T_) * 1024 + head * 64;
    const bf16_t* vbp = p.vT + ((size_t)bh * 64) * T_;
    f32x16 o[2];
#pragma unroll
    for (int d = 0; d < 2; ++d)
#pragma unroll
      for (int i = 0; i < 16; ++i) o[d][i] = 0.f;
    float m = -1e30f, l = 0.f;
    u32x4 kr[2], vr[2]; f32x4 cr = (f32x4){0.f, 0.f, 0.f, 0.f};
    int jt = 2 * qt + 1;
    tile_load(kr, vr, kbp + (size_t)(64 * jt) * 1024, 1024, vbp + 64 * jt, T_, true, tid);
    if (tid < 16) cr = *(const f32x4*)(cseq + 64 * jt + 4 * tid);
    for (; jt >= 0; --jt) {
      const int kbase = 64 * jt;
      if (c0 - cseq[kbase + 63] < -thr) break;
      __syncthreads();
      tile_store(kr, vr, sK, sV, true, tid);
      if (tid < 16) *(f32x4*)(sC + 4 * tid) = cr * 1.4426950408889634f;
      __syncthreads();
      if (jt > 0) {
        tile_load(kr, vr, kbp + (size_t)(64 * (jt - 1)) * 1024, 1024, vbp + 64 * (jt - 1), T_, true, tid);
        if (tid < 16) cr = *(const f32x4*)(cseq + 64 * (jt - 1) + 4 * tid);
      }
      if (kbase <= t0 + 32 * w + 31) flash_step<0>(o, m, l, qf, sK, sV, sC, kbase, tq, cq, 0.f, nullptr, lane);
    }
    const float lt = l + __shfl_xor(l, 32);
    const float inv = 1.0f / lt;
    bf16_t* orow = p.ob + ((size_t)b * T_ + tq) * 1024 + head * 64;
#pragma unroll
    for (int d = 0; d < 2; ++d)
#pragma unroll
      for (int q = 0; q < 4; ++q) store_bf4(orow + 32 * d + 8 * q + 4 * h, o[d][4 * q] * inv, o[d][4 * q + 1] * inv, o[d][4 * q + 2] * inv, o[d][4 * q + 3] * inv);
  }
}

DI void phase_nsa(const Params& p, char* smem) {
  bf16_t* sK = (bf16_t*)smem; bf16_t* sV = sK + 64 * 72;
  float* sImp = (float*)(sV + 64 * 72);
  float* sO = sImp + 16 * 132;
  unsigned* sMask = (unsigned*)(sO + 128 * 65);
  int* sList = (int*)(sMask + 64);
  const int tid = threadIdx.x, lane = tid & 63, w = tid >> 6, r = lane & 31, h = lane >> 5;
  for (int item = blockIdx.x; item < 4096; item += gridDim.x) {
    const int bg = item & 7, tt = 511 - (item >> 3), b = bg >> 1, g = bg & 1, t0 = tt * 16;
    const int tokl = 4 * w + (r >> 3), head = r & 7, tq = t0 + tokl;
    __syncthreads();
    for (int i = tid; i < 16 * 132; i += 256) sImp[i] = 0.f;
    bf16x8 qf[4];
    {
      const bf16_t* qrow = p.qn + ((size_t)b * T_ + tq) * 1024 + (g * 8 + head) * 64;
#pragma unroll
      for (int ks = 0; ks < 4; ++ks) qf[ks] = *(const bf16x8*)(qrow + 16 * ks + 8 * h);
    }
    const float* grow = p.gates + ((size_t)b * T_ + tq) * 48 + g * 8 + head;
    const float gate_c = grow[0], gate_w = grow[32];
    f32x16 o[2];
    float m = -1e30f, l = 0.f;
    u32x4 kr[2], vr[2];
    const int ncmp = t0 >> 4, nct = (ncmp + 63) >> 6;
    const bf16_t* kcp = p.kcb + (size_t)bg * 512 * 64;
    const bf16_t* vcp = p.vcT + (size_t)bg * 64 * 512;
    if (nct > 0) tile_load(kr, vr, kcp, 64, vcp, 512, false, tid);
    for (int jt = 0; jt < nct; ++jt) {
      __syncthreads();
      tile_store(kr, vr, sK, sV, false, tid);
      __syncthreads();
      if (jt + 1 < nct) tile_load(kr, vr, kcp + (size_t)(64 * (jt + 1)) * 64, 64, vcp, 512, false, tid);
      flash_step<2>(o, m, l, qf, sK, sV, nullptr, 64 * jt, tq, 0.f, 0.f, nullptr, lane);
    }
    const float lc = l + __shfl_xor(l, 32);
    const float inv_lc = 1.0f / fmaxf(lc, 1.0f);
#pragma unroll
    for (int d = 0; d < 2; ++d)
#pragma unroll
      for (int i = 0; i < 16; ++i) o[d][i] = 0.f;
    float l2 = 0.f;
    if (nct > 0) tile_load(kr, vr, kcp, 64, vcp, 512, true, tid);
    for (int jt = 0; jt < nct; ++jt) {
      __syncthreads();
      tile_store(kr, vr, sK, sV, true, tid);
      __syncthreads();
      if (jt + 1 < nct) tile_load(kr, vr, kcp + (size_t)(64 * (jt + 1)) * 64, 64, vcp + 64 * (jt + 1), 512, true, tid);
      flash_step<3>(o, m, l2, qf, sK, sV, nullptr, 64 * jt, tq, 0.f, inv_lc, sImp + tokl * 132, lane);
    }
    {
      const float sc = gate_c * inv_lc;
      float* orow = sO + (32 * w + r) * 65;
#pragma unroll
      for (int d = 0; d < 2; ++d)
#pragma unroll
        for (int i = 0; i < 16; ++i) orow[32 * d + crow(i, h)] = o[d][i] * sc;
    }
    __syncthreads();
    const int cur = t0 >> 6;
    for (int tk = 0; tk < 4; ++tk) {
      const int tok = 4 * w + tk;
      float* sc = sImp + tok * 132;
      for (int j = lane; j <= cur; j += 64) if (j == 0 || j == cur || j == cur - 1) sc[j] = 1e6f;
    }
    __syncthreads();
    for (int tk = 0; tk < 4; ++tk) {
      const int tok = 4 * w + tk;
      const float* sc = sImp + tok * 132;
      unsigned long long mk0, mk1;
      {
        const int j = lane;
        const bool vj = j <= cur;
        const float sj = vj ? sc[j] : 0.f;
        int rank = 0;
        for (int i = 0; i <= cur; ++i) { const float si = sc[i]; rank += ((si > sj) || (si == sj && i < j)) ? 1 : 0; }
        mk0 = __ballot(vj && rank < 16);
      }
      {
        const int j = lane + 64;
        const bool vj = j <= cur;
        const float sj = vj ? sc[j] : 0.f;
        int rank = 0;
        for (int i = 0; i <= cur; ++i) { const float si = sc[i]; rank += ((si > sj) || (si == sj && i < j)) ? 1 : 0; }
        mk1 = __ballot(vj && rank < 16);
      }
      if (lane == 0) {
        sMask[tok * 4 + 0] = (unsigned)mk0; sMask[tok * 4 + 1] = (unsigned)(mk0 >> 32);
        sMask[tok * 4 + 2] = (unsigned)mk1; sMask[tok * 4 + 3] = (unsigned)(mk1 >> 32);
      }
    }
    __syncthreads();
    int n_un;
    {
      unsigned u0 = 0, u1 = 0, u2 = 0, u3 = 0;
      for (int tok = 0; tok < 16; ++tok) { u0 |= sMask[tok * 4]; u1 |= sMask[tok * 4 + 1]; u2 |= sMask[tok * 4 + 2]; u3 |= sMask[tok * 4 + 3]; }
      const int c0 = __popc(u0), c1 = __popc(u1), c2 = __popc(u2), c3 = __popc(u3);
      n_un = c0 + c1 + c2 + c3;
      if (tid < 128) {
        const int wd = tid >> 5, bit = tid & 31;
        const unsigned uw = wd == 0 ? u0 : wd == 1 ? u1 : wd == 2 ? u2 : u3;
        if ((uw >> bit) & 1u) {
          const int pre = (wd > 0 ? c0 : 0) + (wd > 1 ? c1 : 0) + (wd > 2 ? c2 : 0);
          sList[pre + __popc(uw & ((1u << bit) - 1u))] = tid;
        }
      }
    }
    __syncthreads();
#pragma unroll
    for (int d = 0; d < 2; ++d)
#pragma unroll
      for (int i = 0; i < 16; ++i) o[d][i] = 0.f;
    m = -1e30f; l = 0.f;
    {
      const bf16_t* ksp = p.ksb + (size_t)bg * T_ * 64;
      const bf16_t* vsp = p.vsT + (size_t)bg * 128 * 4096;
      {
        const int blk = sList[0];
        tile_load(kr, vr, ksp + (size_t)blk * 4096, 64, vsp + (size_t)blk * 4096, 64, true, tid);
      }
      for (int e = 0; e < n_un; ++e) {
        const int blk = sList[e];
        __syncthreads();
        tile_store(kr, vr, sK, sV, true, tid);
        __syncthreads();
        if (e + 1 < n_un) {
          const int nb = sList[e + 1];
          tile_load(kr, vr, ksp + (size_t)nb * 4096, 64, vsp + (size_t)nb * 4096, 64, true, tid);
        }
        const int wd = blk >> 5, bit = blk & 31;
        const unsigned wm = sMask[(4 * w) * 4 + wd] | sMask[(4 * w + 1) * 4 + wd] | sMask[(4 * w + 2) * 4 + wd] | sMask[(4 * w + 3) * 4 + wd];
        if ((wm >> bit) & 1u) {
          const bool selok = (sMask[tokl * 4 + wd] >> bit) & 1u;
          flash_step<4>(o, m, l, qf, sK, sV, nullptr, 64 * blk, tq, 0.f, 0.f, nullptr, lane, selok);
        }
      }
      const float lt = l + __shfl_xor(l, 32);
      const float sc = grow[16] / lt;
      float* orow = sO + (32 * w + r) * 65;
#pragma unroll
      for (int d = 0; d < 2; ++d)
#pragma unroll
        for (int i = 0; i < 16; ++i) orow[32 * d + crow(i, h)] += o[d][i] * sc;
    }
#pragma unroll
    for (int d = 0; d < 2; ++d)
#pragma unroll
      for (int i = 0; i < 16; ++i) o[d][i] = 0.f;
    m = -1e30f; l = 0.f;
    {
      const int klo = t0 - 511 > 0 ? t0 - 511 : 0, jt0 = klo >> 6, jt1 = (t0 + 15) >> 6;
      const bf16_t* kwp = p.kwb + (size_t)bg * T_ * 64;
      const bf16_t* vwp = p.vwT + (size_t)bg * 64 * T_;
      tile_load(kr, vr, kwp + (size_t)(64 * jt0) * 64, 64, vwp + 64 * jt0, T_, true, tid);
      for (int jt = jt0; jt <= jt1; ++jt) {
        __syncthreads();
        tile_store(kr, vr, sK, sV, true, tid);
        __syncthreads();
        if (jt < jt1) tile_load(kr, vr, kwp + (size_t)(64 * (jt + 1)) * 64, 64, vwp + 64 * (jt + 1), T_, true, tid);
        flash_step<1>(o, m, l, qf, sK, sV, nullptr, 64 * jt, tq, 0.f, 0.f, nullptr, lane);
      }
      const float lt = l + __shfl_xor(l, 32);
      const float sc = gate_w / lt;
      float* orow = sO + (32 * w + r) * 65;
#pragma unroll
      for (int d = 0; d < 2; ++d)
#pragma unroll
        for (int i = 0; i < 16; ++i) orow[32 * d + crow(i, h)] += o[d][i] * sc;
    }
    __syncthreads();
    for (int c = tid; c < 128 * 16; c += 256) {
      const int row = c >> 4, d4 = (c & 15) * 4, tok = row >> 3, hd = row & 7;
      const float* s = sO + row * 65 + d4;
      store_bf4(p.ob + ((size_t)b * T_ + t0 + tok) * 1024 + (g * 8 + hd) * 64 + d4, s[0], s[1], s[2], s[3]);
    }
  }
}

#ifdef ONLY_PHASE
#define PH_ON(n) ((n) == ONLY_PHASE)
#else
#define PH_ON(n) true
#endif
#define REP_PHASE -1
#define PHASE(n, ...) \
  if (PH_ON(n) && ph_lo <= (n) && (n) < ph_hi) { __VA_ARGS__ } \
  if ((n) == REP_PHASE) { cg::this_grid().sync(); { __VA_ARGS__ } } \
  if (ph_lo <= (n) && (n) + 1 < ph_hi) cg::this_grid().sync();

__global__ void __launch_bounds__(256, 2) yoco_megakernel(Params p, int ph_lo, int ph_hi) {
  __shared__ __attribute__((aligned(16))) char smem[SMEM_BYTES];
  PHASE(0, phase_prep(p, smem);)
  PHASE(1, { ALPlain al{p.hb, 1024}; EpiFoxIn ep{p}; gemm_phase(al, p.w_ain, 1024, 256, 25, ep, smem); })
  PHASE(2, phase_scan(p);)
  PHASE(3, phase_fox(p, smem);)
  PHASE(4, { ALPlain al{p.ob, 1024}; EpiResid ep{p.x, p.out, p.hb, p.part}; gemm_phase(al, p.w_aout, 1024, 256, 8, ep, smem); })
  PHASE(5, { ALFfn al{p.hb}; EpiFfnUp ep{p.part, p.f_conv_w, p.f_conv_b, p.act}; gemm_phase(al, p.w_up0, 1024, 264, 44, ep, smem); })
  PHASE(6, { ALPlain al{p.act, FF}; EpiResid ep{p.out, p.out, p.hb, p.part}; gemm_phase(al, p.w_dn0, FF, 256, 8, ep, smem); })
  PHASE(7, {
    ALPlain al{p.hb, 1024};
    { EpiKv ep{p}; gemm_phase(al, p.w_kv, 1024, 256, 6, ep, smem); }
    { EpiBIn ep{p}; gemm_phase(al, p.w_bin, 1024, 256, 9, ep, smem); }
  })
  PHASE(8, {
    { ALCmp1 al{p.rawc, p.kc_pe}; EpiCmp1 ep{p.hid}; gemm_phase(al, p.w_kc1, 2048, 32, 2, ep, smem); }
    { ALCmp1 al{p.rawc + (size_t)8 * T_ * 64, p.vc_pe}; EpiCmp1 ep{p.hid + (size_t)4096 * 256}; gemm_phase(al, p.w_vc1, 2048, 32, 2, ep, smem); }
  })
  PHASE(9, {
    { ALCmp2 al{p.hid}; EpiCmp2 ep{p, 0}; gemm_phase(al, p.w_kc2, 256, 32, 1, ep, smem); }
    { ALCmp2 al{p.hid + (size_t)4096 * 256}; EpiCmp2 ep{p, 1}; gemm_phase(al, p.w_vc2, 256, 32, 1, ep, smem); }
  })
  PHASE(10, phase_nsa(p, smem);)
  PHASE(11, { ALPlain al{p.ob, 1024}; EpiResid ep{p.out, p.out, p.hb, p.part}; gemm_phase(al, p.w_bout, 1024, 256, 8, ep, smem); })
  PHASE(12, { ALFfn al{p.hb}; EpiFfnUp ep{p.part, p.f_conv_w + 3 * 5632, p.f_conv_b + 5632, p.act}; gemm_phase(al, p.w_up1, 1024, 264, 44, ep, smem); })
  PHASE(13, { ALPlain al{p.act, FF}; EpiResid ep{p.out, p.out, p.hb, p.part}; gemm_phase(al, p.w_dn1, FF, 256, 8, ep, smem); })
}

extern "C" void kernel_launch(void* const* d_in, const int* in_sizes, int n_in, void* d_out, int out_size, void* d_ws, size_t ws_size, hipStream_t stream) {
  Params p{};
  p.x = (const float*)d_in[0]; p.pos = (const int*)d_in[1];
  p.a_norm = (const float*)d_in[2]; p.a_w_in = (const float*)d_in[3]; p.a_b_f = (const float*)d_in[4]; p.a_q_gain = (const float*)d_in[5];
  p.a_k_gain = (const float*)d_in[6]; p.a_w_out = (const float*)d_in[7]; p.kv_norm = (const float*)d_in[8]; p.kv_w = (const float*)d_in[9];
  p.kc_pe = (const float*)d_in[10]; p.vc_pe = (const float*)d_in[11]; p.kc_w1 = (const float*)d_in[12]; p.kc_w2 = (const float*)d_in[13];
  p.vc_w1 = (const float*)d_in[14]; p.vc_w2 = (const float*)d_in[15]; p.kc_gain = (const float*)d_in[16]; p.ks_gain = (const float*)d_in[17];
  p.kw_gain = (const float*)d_in[18]; p.b_norm = (const float*)d_in[19]; p.b_w_in = (const float*)d_in[20]; p.b_b_gate = (const float*)d_in[21];
  p.b_q_gain = (const float*)d_in[22]; p.b_w_out = (const float*)d_in[23]; p.f_norm = (const float*)d_in[24]; p.f_w_up = (const float*)d_in[25];
  p.f_conv_w = (const float*)d_in[26]; p.f_conv_b = (const float*)d_in[27]; p.f_w_down = (const float*)d_in[28];
  p.out = (float*)d_out;
  char* ws = (char*)d_ws; size_t off = 0;
  auto take = [&](size_t bytes) { char* q = ws + off; off += (bytes + 255) & ~(size_t)255; return q; };
  p.w_ain = (bf16_t*)take((size_t)3200 * 1024 * 2); p.w_aout = (bf16_t*)take((size_t)1024 * 1024 * 2); p.w_kv = (bf16_t*)take((size_t)768 * 1024 * 2);
  p.w_kc1 = (bf16_t*)take((size_t)256 * 2048 * 2); p.w_vc1 = (bf16_t*)take((size_t)256 * 2048 * 2);
  p.w_kc2 = (bf16_t*)take((size_t)128 * 256 * 2); p.w_vc2 = (bf16_t*)take((size_t)128 * 256 * 2);
  p.w_bin = (bf16_t*)take((size_t)1152 * 1024 * 2); p.w_bout = (bf16_t*)take((size_t)1024 * 1024 * 2);
  p.w_up0 = (bf16_t*)take((size_t)5632 * 1024 * 2); p.w_up1 = (bf16_t*)take((size_t)5632 * 1024 * 2);
  p.w_dn0 = (bf16_t*)take((size_t)1024 * FF * 2); p.w_dn1 = (bf16_t*)take((size_t)1024 * FF * 2);
  p.hb = (bf16_t*)take((size_t)NTOK * 1024 * 2); p.part = (float*)take((size_t)NTOK * 16 * 4);
  p.lf = (float*)take((size_t)64 * T_ * 4); p.cc = (float*)take((size_t)64 * T_ * 4);
  p.ob = (bf16_t*)take((size_t)NTOK * 1024 * 2);
  char* R = take((size_t)NTOK * 1024 * 2 * 3);
  p.qb = (bf16_t*)R; p.kb = p.qb + (size_t)NTOK * 1024; p.vT = p.kb + (size_t)NTOK * 1024;
  p.act = (bf16_t*)R;
  {
    char* q = R;
    p.qn = (bf16_t*)q; q += (size_t)NTOK * 1024 * 2;
    p.rawc = (bf16_t*)q; q += (size_t)2 * 8 * T_ * 64 * 2;
    p.ksb = (bf16_t*)q; q += (size_t)8 * T_ * 64 * 2;
    p.vsT = (bf16_t*)q; q += (size_t)8 * T_ * 64 * 2;
    p.kwb = (bf16_t*)q; q += (size_t)8 * T_ * 64 * 2;
    p.vwT = (bf16_t*)q; q += (size_t)8 * T_ * 64 * 2;
    p.gates = (float*)q; q += (size_t)NTOK * 48 * 4;
    p.hid = (bf16_t*)q; q += (size_t)2 * 4096 * 256 * 2;
    p.kcb = (bf16_t*)q; q += (size_t)8 * 512 * 64 * 2;
    p.vcT = (bf16_t*)q; q += (size_t)8 * 64 * 512 * 2;
  }
  static int grid_blocks = 0;
  if (!grid_blocks) {
    int dev = 0, cus = 0, per_cu = 0;
    hipGetDevice(&dev);
    hipDeviceGetAttribute(&cus, hipDeviceAttributeMultiprocessorCount, dev);
    hipOccupancyMaxActiveBlocksPerMultiprocessor(&per_cu, yoco_megakernel, 256, 0);
    if (per_cu > 2) per_cu = 2;
    if (per_cu < 1) per_cu = 1;
    grid_blocks = cus * per_cu;
    grid_blocks &= ~7;
  }
#if N_LAUNCH_SPLIT
  for (int ph = 0; ph < NPHASE; ++ph) {
    int lo = ph, hi = ph + 1;
    hipLaunchKernelGGL(yoco_megakernel, dim3(grid_blocks), dim3(256), 0, stream, p, lo, hi);
  }
#else
  int lo = 0, hi = NPHASE;
  void* args[] = {&p, &lo, &hi};
  hipError_t e = hipLaunchCooperativeKernel((void*)yoco_megakernel, dim3(grid_blocks), dim3(256), args, 0, stream);
  if (e != hipSuccess) fprintf(stderr, "cooperative launch failed: %s (grid %d)\n", hipGetErrorString(e), grid_blocks);
#endif
}
```

```cpp
#include <hip/hip_runtime.h>
#include <hip/hip_cooperative_groups.h>
#include <stdint.h>
#include <cstdio>
namespace cg = cooperative_groups;

#ifndef N_LAUNCH_SPLIT
#define N_LAUNCH_SPLIT 0
#endif

#define DI __device__ __forceinline__
typedef unsigned short bf16_t;
typedef short bf16x8 __attribute__((ext_vector_type(8)));
typedef short bf16x4 __attribute__((ext_vector_type(4)));
typedef float f32x16 __attribute__((ext_vector_type(16)));
typedef float f32x4 __attribute__((ext_vector_type(4)));
typedef unsigned u32x4 __attribute__((ext_vector_type(4)));
typedef unsigned u32x2 __attribute__((ext_vector_type(2)));

constexpr int T_ = 8192;
constexpr int NTOK = 32768;
constexpr int FF = 2816;
constexpr int NPHASE = 14;
constexpr int SMEM_BYTES = 73728;

struct Params {
  const float* x; const int* pos;
  const float *a_norm, *a_w_in, *a_b_f, *a_q_gain, *a_k_gain, *a_w_out;
  const float *kv_norm, *kv_w, *kc_pe, *vc_pe, *kc_w1, *kc_w2, *vc_w1, *vc_w2, *kc_gain, *ks_gain, *kw_gain;
  const float *b_norm, *b_w_in, *b_b_gate, *b_q_gain, *b_w_out;
  const float *f_norm, *f_w_up, *f_conv_w, *f_conv_b, *f_w_down;
  float* out;
  bf16_t *w_ain, *w_aout, *w_kv, *w_kc1, *w_vc1, *w_kc2, *w_vc2, *w_bin, *w_bout, *w_up0, *w_up1, *w_dn0, *w_dn1;
  bf16_t* hb; float* part; float* lf; float* cc; bf16_t* ob;
  bf16_t *qb, *kb, *vT; bf16_t* act;
  bf16_t *rawc, *ksb, *vsT, *kwb, *vwT, *qn; float* gates; bf16_t *hid, *kcb, *vcT;
};

typedef __bf16 bf16v2 __attribute__((ext_vector_type(2)));
typedef float f32x2 __attribute__((ext_vector_type(2)));
DI bf16_t f2bf(float x) { return __builtin_bit_cast(bf16_t, (__bf16)x); }
DI unsigned pack2(float a, float b) { f32x2 v = {a, b}; return __builtin_bit_cast(unsigned, __builtin_convertvector(v, bf16v2)); }
DI float bf2f(bf16_t v) { return __uint_as_float(((unsigned)v) << 16); }
DI int crow(int i, int h) { return (i & 3) + 8 * (i >> 2) + 4 * h; }
DI f32x16 mfma32(bf16x8 a, bf16x8 b, f32x16 c) { return __builtin_amdgcn_mfma_f32_32x32x16_bf16(a, b, c, 0, 0, 0); }
DI f32x4 mfma16(bf16x8 a, bf16x8 b, f32x4 c) { return __builtin_amdgcn_mfma_f32_16x16x32_bf16(a, b, c, 0, 0, 0); }
DI float row_rstd(const float* part, int row) {
  const f32x4* q = (const f32x4*)(part + (size_t)row * 16);
  f32x4 a = q[0], b = q[1], c = q[2], d = q[3];
  float s = ((a.x + a.y) + (a.z + a.w)) + ((b.x + b.y) + (b.z + b.w)) + ((c.x + c.y) + (c.z + c.w)) + ((d.x + d.y) + (d.z + d.w));
  return rsqrtf(s * (1.0f / 1024.0f) + 1e-6f);
}
DI size_t a_off(int row, int k, int KB) { return (((size_t)((row >> 7) * KB + (k >> 6))) << 13) + ((row & 127) << 6) + (k & 63); }
DI void store_bf4(bf16_t* dst, float a, float b, float c, float d) { u32x2 v; v.x = pack2(a, b); v.y = pack2(c, d); *(u32x2*)dst = v; }

struct WJob { const float* src; bf16_t* dst; const float* gain; int K, Nsrc, Ndst, mode; };
DI WJob get_job(const Params& p, int j) {
  WJob w; w.gain = nullptr; w.mode = 0;
  switch (j) {
    case 0: w.src = p.a_w_in; w.dst = p.w_ain; w.gain = p.a_norm; w.K = 1024; w.Nsrc = 3088; w.Ndst = 3200; break;
    case 1: w.src = p.a_w_out; w.dst = p.w_aout; w.K = 1024; w.Nsrc = 1024; w.Ndst = 1024; break;
    case 2: w.src = p.kv_w; w.dst = p.w_kv; w.gain = p.kv_norm; w.K = 1024; w.Nsrc = 768; w.Ndst = 768; break;
    case 3: w.src = p.kc_w1; w.dst = p.w_kc1; w.K = 2048; w.Nsrc = 256; w.Ndst = 256; break;
    case 4: w.src = p.vc_w1; w.dst = p.w_vc1; w.K = 2048; w.Nsrc = 256; w.Ndst = 256; break;
    case 5: w.src = p.kc_w2; w.dst = p.w_kc2; w.K = 256; w.Nsrc = 64; w.Ndst = 128; break;
    case 6: w.src = p.vc_w2; w.dst = p.w_vc2; w.K = 256; w.Nsrc = 64; w.Ndst = 128; break;
    case 7: w.src = p.b_w_in; w.dst = p.w_bin; w.gain = p.b_norm; w.K = 1024; w.Nsrc = 1072; w.Ndst = 1152; break;
    case 8: w.src = p.b_w_out; w.dst = p.w_bout; w.K = 1024; w.Nsrc = 1024; w.Ndst = 1024; break;
    case 9: w.src = p.f_w_up; w.dst = p.w_up0; w.gain = p.f_norm; w.K = 1024; w.Nsrc = 5632; w.Ndst = 5632; w.mode = 1; break;
    case 10: w.src = p.f_w_up + (size_t)1024 * 5632; w.dst = p.w_up1; w.gain = p.f_norm + 1024; w.K = 1024; w.Nsrc = 5632; w.Ndst = 5632; w.mode = 1; break;
    case 11: w.src = p.f_w_down; w.dst = p.w_dn0; w.K = 2816; w.Nsrc = 1024; w.Ndst = 1024; break;
    default: w.src = p.f_w_down + (size_t)2816 * 1024; w.dst = p.w_dn1; w.K = 2816; w.Nsrc = 1024; w.Ndst = 1024; break;
  }
  return w;
}

DI void phase_prep(const Params& p, char* smem) {
  float* sT = (float*)smem;
  const int tid = threadIdx.x;
  int base = 0;
  for (int j = 0; j < 13; ++j) {
    WJob w = get_job(p, j);
    const int nkt = w.K >> 6, nnt = w.Ndst >> 6, ntile = nkt * nnt;
    int first = (int)blockIdx.x - (base % (int)gridDim.x); if (first < 0) first += gridDim.x;
    for (int t = first; t < ntile; t += gridDim.x) {
      const int kt = t % nkt, nt = t / nkt;
      const int k0 = kt << 6, n0d = nt << 6;
      int sbase = n0d;
      if (w.mode == 1) { const int tile = n0d >> 7, half = (n0d >> 6) & 1; sbase = half * FF + tile * 64; }
      __syncthreads();
#pragma unroll
      for (int i = 0; i < 4; ++i) {
        const int kk = (tid >> 4) + 16 * i, nn = (tid & 15) * 4, col = sbase + nn;
        f32x4 v = (f32x4){0.f, 0.f, 0.f, 0.f};
        if (col < w.Nsrc) v = *(const f32x4*)(w.src + (size_t)(k0 + kk) * w.Nsrc + col);
        const float g = w.gain ? w.gain[k0 + kk] : 1.0f;
        sT[kk * 65 + nn + 0] = v.x * g; sT[kk * 65 + nn + 1] = v.y * g; sT[kk * 65 + nn + 2] = v.z * g; sT[kk * 65 + nn + 3] = v.w * g;
      }
      __syncthreads();
      const int n = tid >> 2, kseg = (tid & 3) * 16;
      unsigned o[8];
#pragma unroll
      for (int q = 0; q < 8; ++q) o[q] = pack2(sT[(kseg + 2 * q) * 65 + n], sT[(kseg + 2 * q + 1) * 65 + n]);
      u32x4* dst = (u32x4*)(w.dst + a_off(n0d + n, k0 + kseg, nkt));
      dst[0] = (u32x4){o[0], o[1], o[2], o[3]}; dst[1] = (u32x4){o[4], o[5], o[6], o[7]};
    }
    base += ntile;
  }
  const int lane = tid & 63, gw = blockIdx.x * 4 + (tid >> 6), nw = gridDim.x * 4;
  for (int row = gw; row < NTOK; row += nw) {
    float ss = 0.f;
#pragma unroll
    for (int i = 0; i < 4; ++i) {
      const int col = i * 256 + lane * 4;
      f32x4 v = *(const f32x4*)(p.x + (size_t)row * 1024 + col);
      ss += v.x * v.x + v.y * v.y + v.z * v.z + v.w * v.w;
      store_bf4(p.hb + a_off(row, col, 16), v.x, v.y, v.z, v.w);
    }
#pragma unroll
    for (int o = 32; o >= 1; o >>= 1) ss += __shfl_xor(ss, o);
    if (lane < 16) p.part[(size_t)row * 16 + lane] = lane == 0 ? ss : 0.f;
  }
  if (blockIdx.x == 0) {
    for (int i = tid; i < 8 * 64; i += 256) {
      const int bg = i >> 6, d = i & 63;
      p.kcb[((size_t)bg * 512 + 511) * 64 + d] = 0;
      p.vcT[((size_t)(bg * 8 + 7) * 64 + d) * 64 + 63] = 0;
    }
  }
}

template <class AL, class EP>
DI void gemm_tile(const AL& al, const bf16_t* __restrict__ Wt, int K, int mt, int nt, const EP& ep, char* smem) {
  bf16_t* sbuf = (bf16_t*)smem;
  constexpr int STAGE = 2 * 128 * 72;
  const int tid = threadIdx.x, lane = tid & 63, wave = tid >> 6, wr = wave >> 1, wc = wave & 1, r = lane & 31, h = lane >> 5;
  const int KB = K >> 6;
  const bf16_t* wbase = Wt + (((size_t)nt * KB) << 13) + tid * 8;
  f32x16 acc[2][2];
#pragma unroll
  for (int a = 0; a < 2; ++a)
#pragma unroll
    for (int b = 0; b < 2; ++b)
#pragma unroll
      for (int i = 0; i < 16; ++i) acc[a][b][i] = 0.f;
  u32x4 xa[4], wa[4];
#define GEMM_LOAD(kb_)                                                                  \
  _Pragma("unroll") for (int i = 0; i < 4; ++i) {                                        \
    const int c = tid + 256 * i;                                                         \
    xa[i] = al(mt, c >> 3, (kb_) * 64 + (c & 7) * 8);                                    \
    wa[i] = *(const u32x4*)(wbase + ((size_t)(kb_) << 13) + 2048 * i);                   \
  }
#define GEMM_STORE(st_)                                                                 \
  _Pragma("unroll") for (int i = 0; i < 4; ++i) {                                        \
    const int c = tid + 256 * i, row = c >> 3, kc = (c & 7) * 8;                         \
    *(u32x4*)(sbuf + (st_) * STAGE + row * 72 + kc) = xa[i];                             \
    *(u32x4*)(sbuf + (st_) * STAGE + 128 * 72 + row * 72 + kc) = wa[i];                  \
  }
  __syncthreads();
  GEMM_LOAD(0)
  GEMM_STORE(0)
  if (KB > 1) { GEMM_LOAD(1) }
  __syncthreads();
  for (int it = 0; it < KB; ++it) {
    const int cur = it & 1;
    if (it + 1 < KB) { GEMM_STORE(cur ^ 1) }
    if (it + 2 < KB) { GEMM_LOAD(it + 2) }
    const bf16_t* sX = sbuf + cur * STAGE; const bf16_t* sW = sX + 128 * 72;
#pragma unroll
    for (int ks = 0; ks < 4; ++ks) {
      bf16x8 wf[2], xf[2];
#pragma unroll
      for (int q = 0; q < 2; ++q) {
        wf[q] = *(const bf16x8*)(sW + (64 * wc + 32 * q + r) * 72 + 16 * ks + 8 * h);
        xf[q] = *(const bf16x8*)(sX + (64 * wr + 32 * q + r) * 72 + 16 * ks + 8 * h);
      }
#pragma unroll
      for (int ms = 0; ms < 2; ++ms)
#pragma unroll
        for (int ns = 0; ns < 2; ++ns) acc[ms][ns] = mfma32(wf[ns], xf[ms], acc[ms][ns]);
    }
    __syncthreads();
  }
#undef GEMM_LOAD
#undef GEMM_STORE
  ep(acc, mt, nt, wr, wc, lane, smem);
}

template <class AL, class EP>
DI void gemm_phase(const AL& al, const bf16_t* Wt, int K, int numM, int numN, const EP& ep, char* smem) {
  const int xcd = blockIdx.x & 7, lb = blockIdx.x >> 3, nlb = gridDim.x >> 3;
  const int mper = (numM + 7) >> 3, srows = (mper + 7) >> 3;
  const int total = srows * 8 * numN;
  for (int li = lb; li < total; li += nlb) {
    const int s = li / (8 * numN), rem = li - s * 8 * numN;
    const int nt = rem >> 3, mtl = s * 8 + (rem & 7);
    const int mt = xcd * mper + mtl;
    if (mtl >= mper || mt >= numM) continue;
    gemm_tile(al, Wt, K, mt, nt, ep, smem);
  }
}

struct ALPlain { const bf16_t* A; int KB; DI u32x4 operator()(int mt, int ml, int k) const { return *(const u32x4*)(A + (((size_t)(mt * KB + (k >> 6))) << 13) + (ml << 6) + (k & 63)); } };
struct ALFfn {
  const bf16_t* A;
  DI u32x4 operator()(int mt, int ml, int k) const {
    const int b = mt / 66, it = mt - b * 66, t = 126 * it - 2 + ml;
    if (t < 0 || t >= T_) return (u32x4){0, 0, 0, 0};
    return *(const u32x4*)(A + a_off(b * T_ + t, k, 16));
  }
};
struct ALCmp1 {
  const bf16_t* raw; const float* pe;
  DI u32x4 operator()(int mt, int ml, int k) const {
    const int m = mt * 128 + ml;
    if (m >= 4088) return (u32x4){0, 0, 0, 0};
    const int bg = m / 511, n = m - bg * 511;
    u32x4 v = *(const u32x4*)(raw + ((size_t)bg * T_ + 16 * n) * 64 + k);
    const f32x4 p0 = *(const f32x4*)(pe + k), p1 = *(const f32x4*)(pe + k + 4);
    u32x4 o;
    o.x = pack2(bf2f((bf16_t)(v.x & 0xffff)) + p0.x, bf2f((bf16_t)(v.x >> 16)) + p0.y);
    o.y = pack2(bf2f((bf16_t)(v.y & 0xffff)) + p0.z, bf2f((bf16_t)(v.y >> 16)) + p0.w);
    o.z = pack2(bf2f((bf16_t)(v.z & 0xffff)) + p1.x, bf2f((bf16_t)(v.z >> 16)) + p1.y);
    o.w = pack2(bf2f((bf16_t)(v.w & 0xffff)) + p1.z, bf2f((bf16_t)(v.w >> 16)) + p1.w);
    return o;
  }
};
struct ALCmp2 { const bf16_t* A; DI u32x4 operator()(int mt, int ml, int k) const { const int m = mt * 128 + ml; if (m >= 4088) return (u32x4){0, 0, 0, 0}; return *(const u32x4*)(A + (size_t)m * 256 + k); } };

__device__ const float ROPE_INV[8] = {1.0f, 0.19392274474868576f, 0.03760603093086393f, 0.007292664737217109f, 0.001414213562373095f, 0.0002742481756762073f, 5.318295896944988e-05f, 1.031338537721246e-05f};

template <bool ROPE>
DI void norm_store(f32x16 (&a)[2], float rs, const float* gain, int pos, bf16_t* dst, int h) {
  float ss = 0.f;
#pragma unroll
  for (int ns = 0; ns < 2; ++ns)
#pragma unroll
    for (int i = 0; i < 16; ++i) { const float v = a[ns][i] * rs; a[ns][i] = v; ss += v * v; }
  ss += __shfl_xor(ss, 32);
  const float inv = rsqrtf(ss * (1.0f / 64.0f) + 1e-6f);
#pragma unroll
  for (int ns = 0; ns < 2; ++ns)
#pragma unroll
    for (int i = 0; i < 16; ++i) a[ns][i] = a[ns][i] * inv * gain[32 * ns + crow(i, h)];
  if (ROPE) {
    const float fp = (float)pos;
#pragma unroll
    for (int ii = 0; ii < 4; ++ii) {
      const float ang = fp * ROPE_INV[4 * h + ii];
      const float c = cosf(ang), s = sinf(ang);
      const float x1 = a[0][ii], x2 = a[0][4 + ii];
      a[0][ii] = x1 * c - x2 * s; a[0][4 + ii] = x2 * c + x1 * s;
    }
  }
#pragma unroll
  for (int ns = 0; ns < 2; ++ns)
#pragma unroll
    for (int q = 0; q < 4; ++q) store_bf4(dst + 32 * ns + 8 * q + 4 * h, a[ns][4 * q], a[ns][4 * q + 1], a[ns][4 * q + 2], a[ns][4 * q + 3]);
}

struct EpiFoxIn {
  const Params& p;
  DI void operator()(f32x16 (&acc)[2][2], int mt, int nt, int wr, int wc, int lane, char*) const {
    const int r = lane & 31, h = lane >> 5, nb = nt * 128 + 64 * wc;
#pragma unroll
    for (int ms = 0; ms < 2; ++ms) {
      const int row = mt * 128 + 64 * wr + 32 * ms + r;
      const float rs = row_rstd(p.part, row);
      const int b = row >> 13, t = row & 8191;
      if (nb < 2048) {
        const bool isq = nb < 1024;
        norm_store<false>(acc[ms], rs, isq ? p.a_q_gain : p.a_k_gain, 0, (isq ? p.qb : p.kb) + ((size_t)(b * 16 + ((nb & 1023) >> 6)) * T_ + t) * 64, h);
      } else if (nb < 3072) {
        const int head = (nb - 2048) >> 6;
        bf16_t* dst = p.vT + ((size_t)((b * 16 + head) * 128 + (t >> 6))) * 4096 + (t & 63);
#pragma unroll
        for (int ns = 0; ns < 2; ++ns)
#pragma unroll
          for (int i = 0; i < 16; ++i) dst[(32 * ns + crow(i, h)) * 64] = f2bf(acc[ms][ns][i] * rs);
      } else if (nb == 3072) {
#pragma unroll
        for (int i = 0; i < 8; ++i) {
          const int head = crow(i, h);
          const float z = acc[ms][0][i] * rs + p.a_b_f[head];
          p.lf[((size_t)(b * 16 + head)) * T_ + t] = fminf(z, 0.f) - log1pf(expf(-fabsf(z)));
        }
      }
    }
  }
};

struct EpiResid {
  const float* res; float* out; bf16_t* hb; float* part;
  DI void operator()(f32x16 (&acc)[2][2], int mt, int nt, int wr, int wc, int lane, char* smem) const {
    float* sU = (float*)smem;
    const int r = lane & 31, h = lane >> 5, tid = threadIdx.x;
    __syncthreads();
#pragma unroll
    for (int ms = 0; ms < 2; ++ms) {
      const int ml = 64 * wr + 32 * ms + r;
#pragma unroll
      for (int ns = 0; ns < 2; ++ns)
#pragma unroll
        for (int i = 0; i < 16; ++i) sU[ml * 132 + 64 * wc + 32 * ns + crow(i, h)] = acc[ms][ns][i];
    }
    __syncthreads();
    const int c4 = (tid & 31) * 4, n = nt * 128 + c4;
#pragma unroll 1
    for (int hh = 0; hh < 2; ++hh) {
      f32x4 rv[8];
#pragma unroll
      for (int it = 0; it < 8; ++it) rv[it] = *(const f32x4*)(res + (size_t)(mt * 128 + (hh * 8 + it) * 8 + (tid >> 5)) * 1024 + n);
#pragma unroll
      for (int it = 0; it < 8; ++it) {
        const int rl = (hh * 8 + it) * 8 + (tid >> 5), row = mt * 128 + rl;
        const f32x4 o = rv[it] + *(const f32x4*)(sU + rl * 132 + c4);
        *(f32x4*)(out + (size_t)row * 1024 + n) = o;
        store_bf4(hb + a_off(row, n, 16), o.x, o.y, o.z, o.w);
        float ss = o.x * o.x + o.y * o.y + o.z * o.z + o.w * o.w;
        ss += __shfl_xor(ss, 1); ss += __shfl_xor(ss, 2); ss += __shfl_xor(ss, 4); ss += __shfl_xor(ss, 8); ss += __shfl_xor(ss, 16);
        if ((tid & 31) == 0) { part[(size_t)row * 16 + nt * 2] = ss; part[(size_t)row * 16 + nt * 2 + 1] = 0.f; }
      }
    }
  }
};

struct EpiFfnUp {
  const float* part; const float* cw; const float* cb; bf16_t* act;
  DI void operator()(f32x16 (&acc)[2][2], int mt, int nt, int wr, int wc, int lane, char* smem) const {
    float* sU = (float*)smem;
    const int r = lane & 31, h = lane >> 5, tid = threadIdx.x;
    const int b = mt / 66, it = mt - b * 66, tb = 126 * it - 2;
    __syncthreads();
#pragma unroll
    for (int ms = 0; ms < 2; ++ms) {
      const int ml = 64 * wr + 32 * ms + r, t = tb + ml;
      const float rs = (t >= 0 && t < T_) ? row_rstd(part, b * T_ + t) : 0.f;
#pragma unroll
      for (int ns = 0; ns < 2; ++ns)
#pragma unroll
        for (int i = 0; i < 16; ++i) sU[ml * 129 + 64 * wc + 32 * ns + crow(i, h)] = acc[ms][ns][i] * rs;
    }
    __syncthreads();
    const int jj = tid & 63, rg = tid >> 6, j = nt * 64 + jj;
    const float wg0 = cw[j], wg1 = cw[5632 + j], wg2 = cw[2 * 5632 + j], bgt = cb[j];
    const float wv0 = cw[FF + j], wv1 = cw[5632 + FF + j], wv2 = cw[2 * 5632 + FF + j], bvl = cb[FF + j];
    for (int ml = 2 + rg; ml < 128; ml += 4) {
      const int t = tb + ml;
      if (t >= T_) break;
      const float g = bgt + wg0 * sU[(ml - 2) * 129 + jj] + wg1 * sU[(ml - 1) * 129 + jj] + wg2 * sU[ml * 129 + jj];
      const float v = bvl + wv0 * sU[(ml - 2) * 129 + 64 + jj] + wv1 * sU[(ml - 1) * 129 + 64 + jj] + wv2 * sU[ml * 129 + 64 + jj];
      const float a = g / (1.0f + __expf(-g)) * v;
      act[a_off(b * T_ + t, j, 44)] = f2bf(a);
    }
  }
};

struct EpiKv {
  const Params& p;
  DI void operator()(f32x16 (&acc)[2][2], int mt, int nt, int wr, int wc, int lane, char*) const {
    const int r = lane & 31, h = lane >> 5, g = wc;
#pragma unroll
    for (int ms = 0; ms < 2; ++ms) {
      const int row = mt * 128 + 64 * wr + 32 * ms + r;
      const float rs = row_rstd(p.part, row);
      const int b = row >> 13, t = row & 8191, bg = b * 2 + g;
      if (nt < 2) {
        bf16_t* dst = p.rawc + (((size_t)(nt * 8 + bg)) * T_ + t) * 64;
#pragma unroll
        for (int ns = 0; ns < 2; ++ns)
#pragma unroll
          for (int q = 0; q < 4; ++q)
            store_bf4(dst + 32 * ns + 8 * q + 4 * h, acc[ms][ns][4 * q] * rs, acc[ms][ns][4 * q + 1] * rs, acc[ms][ns][4 * q + 2] * rs, acc[ms][ns][4 * q + 3] * rs);
      } else if (nt == 2 || nt == 4) {
        norm_store<true>(acc[ms], rs, nt == 2 ? p.ks_gain : p.kw_gain, p.pos[row], (nt == 2 ? p.ksb : p.kwb) + ((size_t)bg * T_ + t) * 64, h);
      } else if (nt == 3) {
        bf16_t* dst = p.vsT + ((size_t)bg * 128 + (t >> 6)) * 4096 + (t & 63);
#pragma unroll
        for (int ns = 0; ns < 2; ++ns)
#pragma unroll
          for (int i = 0; i < 16; ++i) dst[(32 * ns + crow(i, h)) * 64] = f2bf(acc[ms][ns][i] * rs);
      } else {
        bf16_t* dst = p.vwT + ((size_t)bg * 128 + (t >> 6)) * 4096 + (t & 63);
#pragma unroll
        for (int ns = 0; ns < 2; ++ns)
#pragma unroll
          for (int i = 0; i < 16; ++i) dst[(32 * ns + crow(i, h)) * 64] = f2bf(acc[ms][ns][i] * rs);
      }
    }
  }
};

struct EpiBIn {
  const Params& p;
  DI void operator()(f32x16 (&acc)[2][2], int mt, int nt, int wr, int wc, int lane, char*) const {
    const int r = lane & 31, h = lane >> 5, nb = nt * 128 + 64 * wc;
#pragma unroll
    for (int ms = 0; ms < 2; ++ms) {
      const int row = mt * 128 + 64 * wr + 32 * ms + r;
      const float rs = row_rstd(p.part, row);
      if (nb < 1024) {
        norm_store<true>(acc[ms], rs, p.b_q_gain, p.pos[row], p.qn + (size_t)row * 1024 + nb, h);
      } else if (nb == 1024) {
#pragma unroll
        for (int ns = 0; ns < 2; ++ns)
#pragma unroll
          for (int i = 0; i < 16; ++i) {
            const int c = 32 * ns + crow(i, h);
            if (c < 48) { const float z = acc[ms][ns][i] * rs + p.b_b_gate[c]; p.gates[(size_t)row * 48 + c] = 1.0f / (1.0f + __expf(-z)); }
          }
      }
    }
  }
};

struct EpiCmp1 {
  bf16_t* hid;
  DI void operator()(f32x16 (&acc)[2][2], int mt, int nt, int wr, int wc, int lane, char*) const {
    const int r = lane & 31, h = lane >> 5;
#pragma unroll
    for (int ms = 0; ms < 2; ++ms) {
      const int m = mt * 128 + 64 * wr + 32 * ms + r;
      if (m >= 4088) continue;
#pragma unroll
      for (int ns = 0; ns < 2; ++ns) {
        float g[16];
#pragma unroll
        for (int i = 0; i < 16; ++i) { const float x = acc[ms][ns][i]; g[i] = 0.5f * x * (1.0f + tanhf(0.7978845608028654f * (x + 0.044715f * x * x * x))); }
#pragma unroll
        for (int q = 0; q < 4; ++q) store_bf4(hid + (size_t)m * 256 + nt * 128 + 64 * wc + 32 * ns + 8 * q + 4 * h, g[4 * q], g[4 * q + 1], g[4 * q + 2], g[4 * q + 3]);
      }
    }
  }
};

struct EpiCmp2 {
  const Params& p; int sel;
  DI void operator()(f32x16 (&acc)[2][2], int mt, int nt, int wr, int wc, int lane, char*) const {
    if (wc != 0) return;
    const int r = lane & 31, h = lane >> 5;
#pragma unroll
    for (int ms = 0; ms < 2; ++ms) {
      const int m = mt * 128 + 64 * wr + 32 * ms + r;
      if (m < 4088) {
        const int bg = m / 511, n = m - bg * 511, b = bg >> 1;
        if (sel == 0) {
          norm_store<true>(acc[ms], 1.0f, p.kc_gain, p.pos[b * T_ + 16 * n + 31], p.kcb + ((size_t)bg * 512 + n) * 64, h);
        } else {
          bf16_t* dst = p.vcT + ((size_t)(bg * 8 + (n >> 6))) * 4096 + (n & 63);
#pragma unroll
          for (int ns = 0; ns < 2; ++ns)
#pragma unroll
            for (int i = 0; i < 16; ++i) dst[(32 * ns + crow(i, h)) * 64] = f2bf(acc[ms][ns][i]);
        }
      } else {
      }
    }
  }
};

DI void phase_scan(const Params& p) {
  const int lane = threadIdx.x & 63, gw = blockIdx.x * 4 + (threadIdx.x >> 6);
  if (gw >= 64) return;
  const float* src = p.lf + (size_t)gw * T_ + lane * 128;
  float* dst = p.cc + (size_t)gw * T_ + lane * 128;
  float s = 0.f;
  for (int i = 0; i < 128; i += 4) { const f32x4 v = *(const f32x4*)(src + i); s += v.x; s += v.y; s += v.z; s += v.w; }
  float inc = s;
#pragma unroll
  for (int o = 1; o < 64; o <<= 1) { const float u = __shfl_up(inc, o); if (lane >= o) inc += u; }
  float run = inc - s;
  for (int i = 0; i < 128; i += 4) {
    const f32x4 v = *(const f32x4*)(src + i); f32x4 o;
    run += v.x; o.x = run; run += v.y; o.y = run; run += v.z; o.z = run; run += v.w; o.w = run;
    *(f32x4*)(dst + i) = o;
  }
}

template <int MODE>
DI void flash_step(f32x16 (&o)[2], float& m, float& l, const bf16x8 (&qf)[4], const bf16_t* sK, const bf16_t* sV, const float* sC,
                   int kbase, int tq, float cq2, float inv_l, float* sImpRow, int lane, bool selok = true) {
  const int r = lane & 31, h = lane >> 5;
  constexpr float SC = 0.125f * 1.4426950408889634f;
  const int base_hi = (MODE == 2 || MODE == 3) ? ((tq - 31) >> 4) : tq;
#pragma unroll 1
  for (int sub = 0; sub < 2; ++sub) {
    f32x16 s;
#pragma unroll
    for (int i = 0; i < 16; ++i) s[i] = 0.f;
#pragma unroll
    for (int ks = 0; ks < 4; ++ks) {
      const bf16x8 a = *(const bf16x8*)(sK + (32 * sub + r) * 72 + 16 * ks + 8 * h);
      s = mfma32(a, qf[ks], s);
    }
    int hi = base_hi - kbase - 32 * sub - 4 * h;
    if (MODE == 4 && !selok) hi = -1;
    const int lo = (MODE == 1) ? hi - 511 : -1000000;
    const bool nomask = __all((hi >= 27) && (lo <= 0));
    if (MODE == 0) {
#pragma unroll
      for (int q = 0; q < 4; ++q) {
        const f32x4 c4 = *(const f32x4*)(sC + 32 * sub + 8 * q + 4 * h);
#pragma unroll
        for (int j = 0; j < 4; ++j) s[4 * q + j] = s[4 * q + j] * SC + (cq2 - c4[j]);
      }
    } else {
#pragma unroll
      for (int i = 0; i < 16; ++i) s[i] *= SC;
    }
    if (!nomask) {
#pragma unroll
      for (int i = 0; i < 16; ++i) { const int cst = (i & 3) + 8 * (i >> 2); s[i] = (cst <= hi && cst >= lo) ? s[i] : -3e38f; }
    }
    float mloc = s[0];
#pragma unroll
    for (int i = 1; i < 16; ++i) mloc = fmaxf(mloc, s[i]);
    mloc = fmaxf(mloc, __shfl_xor(mloc, 32));
    const float mn = fmaxf(m, mloc);
    const float alpha = __builtin_amdgcn_exp2f(m - mn);
    m = mn;
    float ls = 0.f;
#pragma unroll
    for (int i = 0; i < 16; ++i) { const float pv = __builtin_amdgcn_exp2f(s[i] - mn); s[i] = pv; ls += pv; }
    l = l * alpha + ls;
    if (MODE == 2) continue;
    if (__any(alpha != 1.0f)) {
#pragma unroll
      for (int d = 0; d < 2; ++d)
#pragma unroll
        for (int i = 0; i < 16; ++i) o[d][i] *= alpha;
    }
    if (MODE == 3) {
#pragma unroll
      for (int q = 0; q < 4; ++q) {
        const float p3 = s[4 * q + 3] * inv_l;
        float A = (s[4 * q] + s[4 * q + 1] + s[4 * q + 2]) * inv_l + 0.5f * p3, B = 0.5f * p3;
        A += __shfl_xor(A, 1); A += __shfl_xor(A, 2); A += __shfl_xor(A, 4);
        B += __shfl_xor(B, 1); B += __shfl_xor(B, 2); B += __shfl_xor(B, 4);
        if ((r & 7) == 0) { const int j = ((kbase + 32 * sub) >> 2) + 2 * q + h; atomicAdd(&sImpRow[j], A); atomicAdd(&sImpRow[j + 1], B); }
      }
    }
#pragma unroll
    for (int st = 0; st < 2; ++st) {
      u32x4 pk;
      pk.x = pack2(s[8 * st + 0], s[8 * st + 1]); pk.y = pack2(s[8 * st + 2], s[8 * st + 3]);
      pk.z = pack2(s[8 * st + 4], s[8 * st + 5]); pk.w = pack2(s[8 * st + 6], s[8 * st + 7]);
      const bf16x8 pf = __builtin_bit_cast(bf16x8, pk);
#pragma unroll
      for (int d = 0; d < 2; ++d) {
        const bf16_t* vp = sV + (32 * d + r) * 72 + 32 * sub + 16 * st + 4 * h;
        const bf16x4 lo4 = *(const bf16x4*)vp, hi4 = *(const bf16x4*)(vp + 8);
        const bf16x8 vf = __builtin_shufflevector(lo4, hi4, 0, 1, 2, 3, 4, 5, 6, 7);
        o[d] = mfma32(vf, pf, o[d]);
      }
    }
  }
}

DI void tile_load(u32x4 (&kr)[2], u32x4 (&vr)[2], const bf16_t* kptr, int kstride, const bf16_t* vptr, int vstride, bool withV, int tid) {
#pragma unroll
  for (int i = 0; i < 2; ++i) {
    const int c = tid + 256 * i, row = c >> 3, ch = (c & 7) * 8;
    kr[i] = *(const u32x4*)(kptr + (size_t)row * kstride + ch);
    if (withV) vr[i] = *(const u32x4*)(vptr + (size_t)row * vstride + ch);
  }
}
DI void tile_store(const u32x4 (&kr)[2], const u32x4 (&vr)[2], bf16_t* sK, bf16_t* sV, bool withV, int tid) {
#pragma unroll
  for (int i = 0; i < 2; ++i) {
    const int c = tid + 256 * i, row = c >> 3, ch = (c & 7) * 8;
    *(u32x4*)(sK + row * 72 + ch) = kr[i];
    if (withV) *(u32x4*)(sV + row * 72 + ch) = vr[i];
  }
}

DI void phase_fox(const Params& p, char* smem) {
  bf16_t* sK = (bf16_t*)smem; bf16_t* sV = sK + 64 * 72; float* sC = (float*)(sV + 64 * 72);
  const int tid = threadIdx.x, lane = tid & 63, w = tid >> 6, r = lane & 31, h = lane >> 5;
  float gq = 0.f, gk = 0.f;
  for (int i = 0; i < 64; ++i) { gq = fmaxf(gq, fabsf(p.a_q_gain[i])); gk = fmaxf(gk, fabsf(p.a_k_gain[i])); }
  const float thr = 40.0f + 2.0f * 8.0f * gq * gk * 1.05f;
  for (int item = blockIdx.x; item < 4096; item += gridDim.x) {
    const int bh = item & 63, qt = 63 - (item >> 6), b = bh >> 4, head = bh & 15, t0 = qt * 128;
    const int tq = t0 + 32 * w + r;
    const bf16_t* qrow = p.qb + ((size_t)bh * T_ + tq) * 64;
    bf16x8 qf[4];
#pragma unroll
    for (int ks = 0; ks < 4; ++ks) qf[ks] = *(const bf16x8*)(qrow + 16 * ks + 8 * h);
    const float* cseq = p.cc + (size_t)bh * T_;
    const float cq = cseq[tq] * 1.4426950408889634f, c0 = cseq[t0];
    const bf16_t* kbp = p.kb + (size_t)bh * T_ * 64;
    const bf16_t* vbp = p.vT + (size_t)bh * 128 * 4096;
    f32x16 o[2];
#pragma unroll
    for (int d = 0; d < 2; ++d)
#pragma unroll
      for (int i = 0; i < 16; ++i) o[d][i] = 0.f;
    float m = -1e30f, l = 0.f;
    u32x4 kr[2], vr[2]; f32x4 cr = (f32x4){0.f, 0.f, 0.f, 0.f};
    int jt = 2 * qt + 1;
    tile_load(kr, vr, kbp + (size_t)jt * 4096, 64, vbp + (size_t)jt * 4096, 64, true, tid);
    if (tid < 16) cr = *(const f32x4*)(cseq + 64 * jt + 4 * tid);
    for (; jt >= 0; --jt) {
      const int kbase = 64 * jt;
      if (c0 - cseq[kbase + 63] < -thr) break;
      __syncthreads();
      tile_store(kr, vr, sK, sV, true, tid);
      if (tid < 16) *(f32x4*)(sC + 4 * tid) = cr * 1.4426950408889634f;
      __syncthreads();
      if (jt > 0) {
        tile_load(kr, vr, kbp + (size_t)(jt - 1) * 4096, 64, vbp + (size_t)(jt - 1) * 4096, 64, true, tid);
        if (tid < 16) cr = *(const f32x4*)(cseq + 64 * (jt - 1) + 4 * tid);
      }
      if (kbase <= t0 + 32 * w + 31) flash_step<0>(o, m, l, qf, sK, sV, sC, kbase, tq, cq, 0.f, nullptr, lane);
    }
    const float lt = l + __shfl_xor(l, 32);
    const float inv = 1.0f / lt;
    bf16_t* orow = p.ob + a_off(b * T_ + tq, head * 64, 16);
#pragma unroll
    for (int d = 0; d < 2; ++d)
#pragma unroll
      for (int q = 0; q < 4; ++q) store_bf4(orow + 32 * d + 8 * q + 4 * h, o[d][4 * q] * inv, o[d][4 * q + 1] * inv, o[d][4 * q + 2] * inv, o[d][4 * q + 3] * inv);
  }
}

DI void phase_nsa(const Params& p, char* smem) {
  bf16_t* sK = (bf16_t*)smem; bf16_t* sV = sK + 64 * 72;
  float* sImp = (float*)(sV + 64 * 72);
  float* sO = sImp + 16 * 132;
  unsigned* sMask = (unsigned*)(sO + 128 * 65);
  int* sList = (int*)(sMask + 64);
  const int tid = threadIdx.x, lane = tid & 63, w = tid >> 6, r = lane & 31, h = lane >> 5;
  for (int item = blockIdx.x; item < 4096; item += gridDim.x) {
    const int bg = item & 7, tt = 511 - (item >> 3), b = bg >> 1, g = bg & 1, t0 = tt * 16;
    const int tokl = 4 * w + (r >> 3), head = r & 7, tq = t0 + tokl;
    __syncthreads();
    for (int i = tid; i < 16 * 132; i += 256) sImp[i] = 0.f;
    bf16x8 qf[4];
    {
      const bf16_t* qrow = p.qn + ((size_t)b * T_ + tq) * 1024 + (g * 8 + head) * 64;
#pragma unroll
      for (int ks = 0; ks < 4; ++ks) qf[ks] = *(const bf16x8*)(qrow + 16 * ks + 8 * h);
    }
    const float* grow = p.gates + ((size_t)b * T_ + tq) * 48 + g * 8 + head;
    const float gate_c = grow[0], gate_w = grow[32];
    f32x16 o[2];
    float m = -1e30f, l = 0.f;
    u32x4 kr[2], vr[2];
    const int ncmp = t0 >> 4, nct = (ncmp + 63) >> 6;
    const bf16_t* kcp = p.kcb + (size_t)bg * 512 * 64;
    const bf16_t* vcp = p.vcT + (size_t)bg * 8 * 4096;
    if (nct > 0) tile_load(kr, vr, kcp, 64, vcp, 64, false, tid);
    for (int jt = 0; jt < nct; ++jt) {
      __syncthreads();
      tile_store(kr, vr, sK, sV, false, tid);
      __syncthreads();
      if (jt + 1 < nct) tile_load(kr, vr, kcp + (size_t)(jt + 1) * 4096, 64, vcp, 64, false, tid);
      flash_step<2>(o, m, l, qf, sK, sV, nullptr, 64 * jt, tq, 0.f, 0.f, nullptr, lane);
    }
    const float lc = l + __shfl_xor(l, 32);
    const float inv_lc = 1.0f / fmaxf(lc, 1.0f);
#pragma unroll
    for (int d = 0; d < 2; ++d)
#pragma unroll
      for (int i = 0; i < 16; ++i) o[d][i] = 0.f;
    float l2 = 0.f;
    if (nct > 0) tile_load(kr, vr, kcp, 64, vcp, 64, true, tid);
    for (int jt = 0; jt < nct; ++jt) {
      __syncthreads();
      tile_store(kr, vr, sK, sV, true, tid);
      __syncthreads();
      if (jt + 1 < nct) tile_load(kr, vr, kcp + (size_t)(jt + 1) * 4096, 64, vcp + (size_t)(jt + 1) * 4096, 64, true, tid);
      flash_step<3>(o, m, l2, qf, sK, sV, nullptr, 64 * jt, tq, 0.f, inv_lc, sImp + tokl * 132, lane);
    }
    {
      const float sc = gate_c * inv_lc;
      float* orow = sO + (32 * w + r) * 65;
#pragma unroll
      for (int d = 0; d < 2; ++d)
#pragma unroll
        for (int i = 0; i < 16; ++i) orow[32 * d + crow(i, h)] = o[d][i] * sc;
    }
    __syncthreads();
    const int cur = t0 >> 6;
    for (int tk = 0; tk < 4; ++tk) {
      const int tok = 4 * w + tk;
      float* sc = sImp + tok * 132;
      for (int j = lane; j <= cur; j += 64) if (j == 0 || j == cur || j == cur - 1) sc[j] = 1e6f;
    }
    __syncthreads();
    for (int tk = 0; tk < 4; ++tk) {
      const int tok = 4 * w + tk;
      const float* sc = sImp + tok * 132;
      unsigned long long mk0, mk1;
      {
        const int j = lane;
        const bool vj = j <= cur;
        const float sj = vj ? sc[j] : 0.f;
        int rank = 0;
        for (int i = 0; i <= cur; ++i) { const float si = sc[i]; rank += ((si > sj) || (si == sj && i < j)) ? 1 : 0; }
        mk0 = __ballot(vj && rank < 16);
      }
      {
        const int j = lane + 64;
        const bool vj = j <= cur;
        const float sj = vj ? sc[j] : 0.f;
        int rank = 0;
        for (int i = 0; i <= cur; ++i) { const float si = sc[i]; rank += ((si > sj) || (si == sj && i < j)) ? 1 : 0; }
        mk1 = __ballot(vj && rank < 16);
      }
      if (lane == 0) {
        sMask[tok * 4 + 0] = (unsigned)mk0; sMask[tok * 4 + 1] = (unsigned)(mk0 >> 32);
        sMask[tok * 4 + 2] = (unsigned)mk1; sMask[tok * 4 + 3] = (unsigned)(mk1 >> 32);
      }
    }
    __syncthreads();
    int n_un;
    {
      unsigned u0 = 0, u1 = 0, u2 = 0, u3 = 0;
      for (int tok = 0; tok < 16; ++tok) { u0 |= sMask[tok * 4]; u1 |= sMask[tok * 4 + 1]; u2 |= sMask[tok * 4 + 2]; u3 |= sMask[tok * 4 + 3]; }
      const int c0 = __popc(u0), c1 = __popc(u1), c2 = __popc(u2), c3 = __popc(u3);
      n_un = c0 + c1 + c2 + c3;
      if (tid < 128) {
        const int wd = tid >> 5, bit = tid & 31;
        const unsigned uw = wd == 0 ? u0 : wd == 1 ? u1 : wd == 2 ? u2 : u3;
        if ((uw >> bit) & 1u) {
          const int pre = (wd > 0 ? c0 : 0) + (wd > 1 ? c1 : 0) + (wd > 2 ? c2 : 0);
          sList[pre + __popc(uw & ((1u << bit) - 1u))] = tid;
        }
      }
    }
    __syncthreads();
#pragma unroll
    for (int d = 0; d < 2; ++d)
#pragma unroll
      for (int i = 0; i < 16; ++i) o[d][i] = 0.f;
    m = -1e30f; l = 0.f;
    {
      const bf16_t* ksp = p.ksb + (size_t)bg * T_ * 64;
      const bf16_t* vsp = p.vsT + (size_t)bg * 128 * 4096;
      {
        const int blk = sList[0];
        tile_load(kr, vr, ksp + (size_t)blk * 4096, 64, vsp + (size_t)blk * 4096, 64, true, tid);
      }
      for (int e = 0; e < n_un; ++e) {
        const int blk = sList[e];
        __syncthreads();
        tile_store(kr, vr, sK, sV, true, tid);
        __syncthreads();
        if (e + 1 < n_un) {
          const int nb = sList[e + 1];
          tile_load(kr, vr, ksp + (size_t)nb * 4096, 64, vsp + (size_t)nb * 4096, 64, true, tid);
        }
        const int wd = blk >> 5, bit = blk & 31;
        const unsigned wm = sMask[(4 * w) * 4 + wd] | sMask[(4 * w + 1) * 4 + wd] | sMask[(4 * w + 2) * 4 + wd] | sMask[(4 * w + 3) * 4 + wd];
        if ((wm >> bit) & 1u) {
          const bool selok = (sMask[tokl * 4 + wd] >> bit) & 1u;
          flash_step<4>(o, m, l, qf, sK, sV, nullptr, 64 * blk, tq, 0.f, 0.f, nullptr, lane, selok);
        }
      }
      const float lt = l + __shfl_xor(l, 32);
      const float sc = grow[16] / lt;
      float* orow = sO + (32 * w + r) * 65;
#pragma unroll
      for (int d = 0; d < 2; ++d)
#pragma unroll
        for (int i = 0; i < 16; ++i) orow[32 * d + crow(i, h)] += o[d][i] * sc;
    }
#pragma unroll
    for (int d = 0; d < 2; ++d)
#pragma unroll
      for (int i = 0; i < 16; ++i) o[d][i] = 0.f;
    m = -1e30f; l = 0.f;
    {
      const int klo = t0 - 511 > 0 ? t0 - 511 : 0, jt0 = klo >> 6, jt1 = (t0 + 15) >> 6;
      const bf16_t* kwp = p.kwb + (size_t)bg * T_ * 64;
      const bf16_t* vwp = p.vwT + (size_t)bg * 128 * 4096;
      tile_load(kr, vr, kwp + (size_t)jt0 * 4096, 64, vwp + (size_t)jt0 * 4096, 64, true, tid);
      for (int jt = jt0; jt <= jt1; ++jt) {
        __syncthreads();
        tile_store(kr, vr, sK, sV, true, tid);
        __syncthreads();
        if (jt < jt1) tile_load(kr, vr, kwp + (size_t)(jt + 1) * 4096, 64, vwp + (size_t)(jt + 1) * 4096, 64, true, tid);
        flash_step<1>(o, m, l, qf, sK, sV, nullptr, 64 * jt, tq, 0.f, 0.f, nullptr, lane);
      }
      const float lt = l + __shfl_xor(l, 32);
      const float sc = gate_w / lt;
      float* orow = sO + (32 * w + r) * 65;
#pragma unroll
      for (int d = 0; d < 2; ++d)
#pragma unroll
        for (int i = 0; i < 16; ++i) orow[32 * d + crow(i, h)] += o[d][i] * sc;
    }
    __syncthreads();
    for (int c = tid; c < 128 * 16; c += 256) {
      const int row = c >> 4, d4 = (c & 15) * 4, tok = row >> 3, hd = row & 7;
      const float* s = sO + row * 65 + d4;
      store_bf4(p.ob + a_off(b * T_ + t0 + tok, (g * 8 + hd) * 64 + d4, 16), s[0], s[1], s[2], s[3]);
    }
  }
}

#ifdef ONLY_PHASE
#define PH_ON(n) ((n) == ONLY_PHASE)
#else
#define PH_ON(n) true
#endif
#define REP_PHASE -1
#define PHASE(n, ...) \
  if (PH_ON(n) && ph_lo <= (n) && (n) < ph_hi) { __VA_ARGS__ } \
  if ((n) == REP_PHASE) { cg::this_grid().sync(); { __VA_ARGS__ } } \
  if (ph_lo <= (n) && (n) + 1 < ph_hi) cg::this_grid().sync();

__global__ void __launch_bounds__(256, 2) yoco_megakernel(Params p, int ph_lo, int ph_hi) {
  __shared__ __attribute__((aligned(16))) char smem[SMEM_BYTES];
  PHASE(0, phase_prep(p, smem);)
  PHASE(1, { ALPlain al{p.hb, 16}; EpiFoxIn ep{p}; gemm_phase(al, p.w_ain, 1024, 256, 25, ep, smem); })
  PHASE(2, phase_scan(p);)
  PHASE(3, phase_fox(p, smem);)
  PHASE(4, { ALPlain al{p.ob, 16}; EpiResid ep{p.x, p.out, p.hb, p.part}; gemm_phase(al, p.w_aout, 1024, 256, 8, ep, smem); })
  PHASE(5, { ALFfn al{p.hb}; EpiFfnUp ep{p.part, p.f_conv_w, p.f_conv_b, p.act}; gemm_phase(al, p.w_up0, 1024, 264, 44, ep, smem); })
  PHASE(6, { ALPlain al{p.act, 44}; EpiResid ep{p.out, p.out, p.hb, p.part}; gemm_phase(al, p.w_dn0, FF, 256, 8, ep, smem); })
  PHASE(7, {
    ALPlain al{p.hb, 16};
    { EpiKv ep{p}; gemm_phase(al, p.w_kv, 1024, 256, 6, ep, smem); }
    { EpiBIn ep{p}; gemm_phase(al, p.w_bin, 1024, 256, 9, ep, smem); }
  })
  PHASE(8, {
    { ALCmp1 al{p.rawc, p.kc_pe}; EpiCmp1 ep{p.hid}; gemm_phase(al, p.w_kc1, 2048, 32, 2, ep, smem); }
    { ALCmp1 al{p.rawc + (size_t)8 * T_ * 64, p.vc_pe}; EpiCmp1 ep{p.hid + (size_t)4096 * 256}; gemm_phase(al, p.w_vc1, 2048, 32, 2, ep, smem); }
  })
  PHASE(9, {
    { ALCmp2 al{p.hid}; EpiCmp2 ep{p, 0}; gemm_phase(al, p.w_kc2, 256, 32, 1, ep, smem); }
    { ALCmp2 al{p.hid + (size_t)4096 * 256}; EpiCmp2 ep{p, 1}; gemm_phase(al, p.w_vc2, 256, 32, 1, ep, smem); }
  })
  PHASE(10, phase_nsa(p, smem);)
  PHASE(11, { ALPlain al{p.ob, 16}; EpiResid ep{p.out, p.out, p.hb, p.part}; gemm_phase(al, p.w_bout, 1024, 256, 8, ep, smem); })
  PHASE(12, { ALFfn al{p.hb}; EpiFfnUp ep{p.part, p.f_conv_w + 3 * 5632, p.f_conv_b + 5632, p.act}; gemm_phase(al, p.w_up1, 1024, 264, 44, ep, smem); })
  PHASE(13, { ALPlain al{p.act, 44}; EpiResid ep{p.out, p.out, p.hb, p.part}; gemm_phase(al, p.w_dn1, FF, 256, 8, ep, smem); })
}

extern "C" void kernel_launch(void* const* d_in, const int* in_sizes, int n_in, void* d_out, int out_size, void* d_ws, size_t ws_size, hipStream_t stream) {
  Params p{};
  p.x = (const float*)d_in[0]; p.pos = (const int*)d_in[1];
  p.a_norm = (const float*)d_in[2]; p.a_w_in = (const float*)d_in[3]; p.a_b_f = (const float*)d_in[4]; p.a_q_gain = (const float*)d_in[5];
  p.a_k_gain = (const float*)d_in[6]; p.a_w_out = (const float*)d_in[7]; p.kv_norm = (const float*)d_in[8]; p.kv_w = (const float*)d_in[9];
  p.kc_pe = (const float*)d_in[10]; p.vc_pe = (const float*)d_in[11]; p.kc_w1 = (const float*)d_in[12]; p.kc_w2 = (const float*)d_in[13];
  p.vc_w1 = (const float*)d_in[14]; p.vc_w2 = (const float*)d_in[15]; p.kc_gain = (const float*)d_in[16]; p.ks_gain = (const float*)d_in[17];
  p.kw_gain = (const float*)d_in[18]; p.b_norm = (const float*)d_in[19]; p.b_w_in = (const float*)d_in[20]; p.b_b_gate = (const float*)d_in[21];
  p.b_q_gain = (const float*)d_in[22]; p.b_w_out = (const float*)d_in[23]; p.f_norm = (const float*)d_in[24]; p.f_w_up = (const float*)d_in[25];
  p.f_conv_w = (const float*)d_in[26]; p.f_conv_b = (const float*)d_in[27]; p.f_w_down = (const float*)d_in[28];
  p.out = (float*)d_out;
  char* ws = (char*)d_ws; size_t off = 0;
  auto take = [&](size_t bytes) { char* q = ws + off; off += (bytes + 255) & ~(size_t)255; return q; };
  p.w_ain = (bf16_t*)take((size_t)3200 * 1024 * 2); p.w_aout = (bf16_t*)take((size_t)1024 * 1024 * 2); p.w_kv = (bf16_t*)take((size_t)768 * 1024 * 2);
  p.w_kc1 = (bf16_t*)take((size_t)256 * 2048 * 2); p.w_vc1 = (bf16_t*)take((size_t)256 * 2048 * 2);
  p.w_kc2 = (bf16_t*)take((size_t)128 * 256 * 2); p.w_vc2 = (bf16_t*)take((size_t)128 * 256 * 2);
  p.w_bin = (bf16_t*)take((size_t)1152 * 1024 * 2); p.w_bout = (bf16_t*)take((size_t)1024 * 1024 * 2);
  p.w_up0 = (bf16_t*)take((size_t)5632 * 1024 * 2); p.w_up1 = (bf16_t*)take((size_t)5632 * 1024 * 2);
  p.w_dn0 = (bf16_t*)take((size_t)1024 * FF * 2); p.w_dn1 = (bf16_t*)take((size_t)1024 * FF * 2);
  p.hb = (bf16_t*)take((size_t)NTOK * 1024 * 2); p.part = (float*)take((size_t)NTOK * 16 * 4);
  p.lf = (float*)take((size_t)64 * T_ * 4); p.cc = (float*)take((size_t)64 * T_ * 4);
  p.ob = (bf16_t*)take((size_t)NTOK * 1024 * 2);
  char* R = take((size_t)NTOK * 1024 * 2 * 3);
  p.qb = (bf16_t*)R; p.kb = p.qb + (size_t)NTOK * 1024; p.vT = p.kb + (size_t)NTOK * 1024;
  p.act = (bf16_t*)R;
  {
    char* q = R;
    p.qn = (bf16_t*)q; q += (size_t)NTOK * 1024 * 2;
    p.rawc = (bf16_t*)q; q += (size_t)2 * 8 * T_ * 64 * 2;
    p.ksb = (bf16_t*)q; q += (size_t)8 * T_ * 64 * 2;
    p.vsT = (bf16_t*)q; q += (size_t)8 * T_ * 64 * 2;
    p.kwb = (bf16_t*)q; q += (size_t)8 * T_ * 64 * 2;
    p.vwT = (bf16_t*)q; q += (size_t)8 * T_ * 64 * 2;
    p.gates = (float*)q; q += (size_t)NTOK * 48 * 4;
    p.hid = (bf16_t*)q; q += (size_t)2 * 4096 * 256 * 2;
    p.kcb = (bf16_t*)q; q += (size_t)8 * 512 * 64 * 2;
    p.vcT = (bf16_t*)q; q += (size_t)8 * 64 * 512 * 2;
  }
  static int grid_blocks = 0;
  if (!grid_blocks) {
    int dev = 0, cus = 0, per_cu = 0;
    hipGetDevice(&dev);
    hipDeviceGetAttribute(&cus, hipDeviceAttributeMultiprocessorCount, dev);
    hipOccupancyMaxActiveBlocksPerMultiprocessor(&per_cu, yoco_megakernel, 256, 0);
    if (per_cu > 2) per_cu = 2;
    if (per_cu < 1) per_cu = 1;
    grid_blocks = cus * per_cu;
    grid_blocks &= ~7;
  }
#if N_LAUNCH_SPLIT
  for (int ph = 0; ph < NPHASE; ++ph) {
    int lo = ph, hi = ph + 1;
    hipLaunchKernelGGL(yoco_megakernel, dim3(grid_blocks), dim3(256), 0, stream, p, lo, hi);
  }
#else
  int lo = 0, hi = NPHASE;
  void* args[] = {&p, &lo, &hi};
  hipError_t e = hipLaunchCooperativeKernel((void*)yoco_megakernel, dim3(grid_blocks), dim3(256), args, 0, stream);
  if (e != hipSuccess) fprintf(stderr, "cooperative launch failed: %s (grid %d)\n", hipGetErrorString(e), grid_blocks);
#endif
}
```

```cpp
#include <hip/hip_runtime.h>
#include <hip/hip_cooperative_groups.h>
#include <stdint.h>
#include <cstdio>
namespace cg = cooperative_groups;

#ifndef N_LAUNCH_SPLIT
#define N_LAUNCH_SPLIT 0
#endif

#define DI __device__ __forceinline__
typedef unsigned short bf16_t;
typedef short bf16x8 __attribute__((ext_vector_type(8)));
typedef short bf16x4 __attribute__((ext_vector_type(4)));
typedef float f32x16 __attribute__((ext_vector_type(16)));
typedef float f32x4 __attribute__((ext_vector_type(4)));
typedef unsigned u32x4 __attribute__((ext_vector_type(4)));
typedef unsigned u32x2 __attribute__((ext_vector_type(2)));

constexpr int T_ = 8192;
constexpr int NTOK = 32768;
constexpr int FF = 2816;
constexpr int NPHASE = 14;
constexpr int SMEM_BYTES = 73728;

struct Params {
  const float* x; const int* pos;
  const float *a_norm, *a_w_in, *a_b_f, *a_q_gain, *a_k_gain, *a_w_out;
  const float *kv_norm, *kv_w, *kc_pe, *vc_pe, *kc_w1, *kc_w2, *vc_w1, *vc_w2, *kc_gain, *ks_gain, *kw_gain;
  const float *b_norm, *b_w_in, *b_b_gate, *b_q_gain, *b_w_out;
  const float *f_norm, *f_w_up, *f_conv_w, *f_conv_b, *f_w_down;
  float* out;
  bf16_t *w_ain, *w_aout, *w_kv, *w_kc1, *w_vc1, *w_kc2, *w_vc2, *w_bin, *w_bout, *w_up0, *w_up1, *w_dn0, *w_dn1;
  bf16_t* hb; float* part; float* lf; float* cc; bf16_t* ob;
  bf16_t *qb, *kb, *vT; bf16_t* act;
  bf16_t *rawc, *ksb, *vsT, *kwb, *vwT, *qn; float* gates; bf16_t *hid, *kcb, *vcT;
};

typedef __bf16 bf16v2 __attribute__((ext_vector_type(2)));
typedef float f32x2 __attribute__((ext_vector_type(2)));
DI bf16_t f2bf(float x) { return __builtin_bit_cast(bf16_t, (__bf16)x); }
DI unsigned pack2(float a, float b) { f32x2 v = {a, b}; return __builtin_bit_cast(unsigned, __builtin_convertvector(v, bf16v2)); }
DI float bf2f(bf16_t v) { return __uint_as_float(((unsigned)v) << 16); }
DI int crow(int i, int h) { return (i & 3) + 8 * (i >> 2) + 4 * h; }
DI f32x16 mfma32(bf16x8 a, bf16x8 b, f32x16 c) { return __builtin_amdgcn_mfma_f32_32x32x16_bf16(a, b, c, 0, 0, 0); }
DI f32x4 mfma16(bf16x8 a, bf16x8 b, f32x4 c) { return __builtin_amdgcn_mfma_f32_16x16x32_bf16(a, b, c, 0, 0, 0); }
DI float row_rstd(const float* part, int row) {
  const f32x4* q = (const f32x4*)(part + (size_t)row * 16);
  f32x4 a = q[0], b = q[1], c = q[2], d = q[3];
  float s = ((a.x + a.y) + (a.z + a.w)) + ((b.x + b.y) + (b.z + b.w)) + ((c.x + c.y) + (c.z + c.w)) + ((d.x + d.y) + (d.z + d.w));
  return rsqrtf(s * (1.0f / 1024.0f) + 1e-6f);
}
DI size_t a_off(int row, int k, int KB) { return (((size_t)((row >> 7) * KB + (k >> 6))) << 13) + ((row & 127) << 6) + (k & 63); }
DI void store_bf4(bf16_t* dst, float a, float b, float c, float d) { u32x2 v; v.x = pack2(a, b); v.y = pack2(c, d); *(u32x2*)dst = v; }

struct WJob { const float* src; bf16_t* dst; const float* gain; int K, Nsrc, Ndst, mode; };
DI WJob get_job(const Params& p, int j) {
  WJob w; w.gain = nullptr; w.mode = 0;
  switch (j) {
    case 0: w.src = p.a_w_in; w.dst = p.w_ain; w.gain = p.a_norm; w.K = 1024; w.Nsrc = 3088; w.Ndst = 3200; break;
    case 1: w.src = p.a_w_out; w.dst = p.w_aout; w.K = 1024; w.Nsrc = 1024; w.Ndst = 1024; break;
    case 2: w.src = p.kv_w; w.dst = p.w_kv; w.gain = p.kv_norm; w.K = 1024; w.Nsrc = 768; w.Ndst = 768; break;
    case 3: w.src = p.kc_w1; w.dst = p.w_kc1; w.K = 2048; w.Nsrc = 256; w.Ndst = 256; break;
    case 4: w.src = p.vc_w1; w.dst = p.w_vc1; w.K = 2048; w.Nsrc = 256; w.Ndst = 256; break;
    case 5: w.src = p.kc_w2; w.dst = p.w_kc2; w.K = 256; w.Nsrc = 64; w.Ndst = 128; break;
    case 6: w.src = p.vc_w2; w.dst = p.w_vc2; w.K = 256; w.Nsrc = 64; w.Ndst = 128; break;
    case 7: w.src = p.b_w_in; w.dst = p.w_bin; w.gain = p.b_norm; w.K = 1024; w.Nsrc = 1072; w.Ndst = 1152; break;
    case 8: w.src = p.b_w_out; w.dst = p.w_bout; w.K = 1024; w.Nsrc = 1024; w.Ndst = 1024; break;
    case 9: w.src = p.f_w_up; w.dst = p.w_up0; w.gain = p.f_norm; w.K = 1024; w.Nsrc = 5632; w.Ndst = 5632; w.mode = 1; break;
    case 10: w.src = p.f_w_up + (size_t)1024 * 5632; w.dst = p.w_up1; w.gain = p.f_norm + 1024; w.K = 1024; w.Nsrc = 5632; w.Ndst = 5632; w.mode = 1; break;
    case 11: w.src = p.f_w_down; w.dst = p.w_dn0; w.K = 2816; w.Nsrc = 1024; w.Ndst = 1024; break;
    default: w.src = p.f_w_down + (size_t)2816 * 1024; w.dst = p.w_dn1; w.K = 2816; w.Nsrc = 1024; w.Ndst = 1024; break;
  }
  return w;
}

DI void phase_prep(const Params& p, char* smem) {
  float* sT = (float*)smem;
  const int tid = threadIdx.x;
  int base = 0;
  for (int j = 0; j < 13; ++j) {
    WJob w = get_job(p, j);
    const int nkt = w.K >> 6, nnt = w.Ndst >> 6, ntile = nkt * nnt;
    int first = (int)blockIdx.x - (base % (int)gridDim.x); if (first < 0) first += gridDim.x;
    for (int t = first; t < ntile; t += gridDim.x) {
      const int kt = t % nkt, nt = t / nkt;
      const int k0 = kt << 6, n0d = nt << 6;
      int sbase = n0d;
      if (w.mode == 1) { const int tile = n0d >> 7, half = (n0d >> 6) & 1; sbase = half * FF + tile * 64; }
      __syncthreads();
#pragma unroll
      for (int i = 0; i < 4; ++i) {
        const int kk = (tid >> 4) + 16 * i, nn = (tid & 15) * 4, col = sbase + nn;
        f32x4 v = (f32x4){0.f, 0.f, 0.f, 0.f};
        if (col < w.Nsrc) v = *(const f32x4*)(w.src + (size_t)(k0 + kk) * w.Nsrc + col);
        const float g = w.gain ? w.gain[k0 + kk] : 1.0f;
        sT[kk * 65 + nn + 0] = v.x * g; sT[kk * 65 + nn + 1] = v.y * g; sT[kk * 65 + nn + 2] = v.z * g; sT[kk * 65 + nn + 3] = v.w * g;
      }
      __syncthreads();
      const int n = tid >> 2, kseg = (tid & 3) * 16;
      unsigned o[8];
#pragma unroll
      for (int q = 0; q < 8; ++q) o[q] = pack2(sT[(kseg + 2 * q) * 65 + n], sT[(kseg + 2 * q + 1) * 65 + n]);
      u32x4* dst = (u32x4*)(w.dst + a_off(n0d + n, k0 + kseg, nkt));
      dst[0] = (u32x4){o[0], o[1], o[2], o[3]}; dst[1] = (u32x4){o[4], o[5], o[6], o[7]};
    }
    base += ntile;
  }
  const int lane = tid & 63, gw = blockIdx.x * 4 + (tid >> 6), nw = gridDim.x * 4;
  for (int row = gw; row < NTOK; row += nw) {
    float ss = 0.f;
#pragma unroll
    for (int i = 0; i < 4; ++i) {
      const int col = i * 256 + lane * 4;
      f32x4 v = *(const f32x4*)(p.x + (size_t)row * 1024 + col);
      ss += v.x * v.x + v.y * v.y + v.z * v.z + v.w * v.w;
      store_bf4(p.hb + a_off(row, col, 16), v.x, v.y, v.z, v.w);
    }
#pragma unroll
    for (int o = 32; o >= 1; o >>= 1) ss += __shfl_xor(ss, o);
    if (lane < 16) p.part[(size_t)row * 16 + lane] = lane == 0 ? ss : 0.f;
  }
  if (blockIdx.x == 0) {
    for (int i = tid; i < 8 * 64; i += 256) {
      const int bg = i >> 6, d = i & 63;
      p.kcb[((size_t)bg * 512 + 511) * 64 + d] = 0;
      p.vcT[((size_t)(bg * 8 + 7) * 64 + d) * 64 + 63] = 0;
    }
  }
}

template <class AL, class EP>
DI void gemm_tile(const AL& al, const bf16_t* __restrict__ Wt, int K, int mt, int nt, const EP& ep, char* smem) {
  bf16_t* sbuf = (bf16_t*)smem;
  constexpr int STAGE = 2 * 128 * 72;
  const int tid = threadIdx.x, lane = tid & 63, wave = tid >> 6, wr = wave >> 1, wc = wave & 1, r = lane & 31, h = lane >> 5;
  const int KB = K >> 6;
  const bf16_t* wbase = Wt + (((size_t)nt * KB) << 13) + tid * 8;
  f32x16 acc[2][2];
#pragma unroll
  for (int a = 0; a < 2; ++a)
#pragma unroll
    for (int b = 0; b < 2; ++b)
#pragma unroll
      for (int i = 0; i < 16; ++i) acc[a][b][i] = 0.f;
  u32x4 xa[4], wa[4];
#define GEMM_LOAD(kb_)                                                                  \
  _Pragma("unroll") for (int i = 0; i < 4; ++i) {                                        \
    const int c = tid + 256 * i;                                                         \
    xa[i] = al(mt, c >> 3, (kb_) * 64 + (c & 7) * 8);                                    \
    wa[i] = *(const u32x4*)(wbase + ((size_t)(kb_) << 13) + 2048 * i);                   \
  }
#define GEMM_STORE(st_)                                                                 \
  _Pragma("unroll") for (int i = 0; i < 4; ++i) {                                        \
    const int c = tid + 256 * i, row = c >> 3, kc = (c & 7) * 8;                         \
    *(u32x4*)(sbuf + (st_) * STAGE + row * 72 + kc) = xa[i];                             \
    *(u32x4*)(sbuf + (st_) * STAGE + 128 * 72 + row * 72 + kc) = wa[i];                  \
  }
#define GEMM_LDF(FW, FX, st_, ks_)                                                      \
  _Pragma("unroll") for (int q = 0; q < 2; ++q) {                                        \
    FW[q] = *(const bf16x8*)(sbuf + (st_) * STAGE + 128 * 72 + (64 * wc + 32 * q + r) * 72 + 16 * (ks_) + 8 * h); \
    FX[q] = *(const bf16x8*)(sbuf + (st_) * STAGE + (64 * wr + 32 * q + r) * 72 + 16 * (ks_) + 8 * h);            \
  }
#define GEMM_MM(FW, FX)                                                                 \
  _Pragma("unroll") for (int ms = 0; ms < 2; ++ms)                                       \
    _Pragma("unroll") for (int ns = 0; ns < 2; ++ns) acc[ms][ns] = mfma32(FW[ns], FX[ms], acc[ms][ns]);
  bf16x8 faw[2], fax[2], fbw[2], fbx[2];
  __syncthreads();
  GEMM_LOAD(0)
  GEMM_STORE(0)
  if (KB > 1) { GEMM_LOAD(1) }
  __syncthreads();
  GEMM_LDF(faw, fax, 0, 0)
  for (int it = 0; it < KB; ++it) {
    const int cur = it & 1;
    if (it + 1 < KB) { GEMM_STORE(cur ^ 1) }
    if (it + 2 < KB) { GEMM_LOAD(it + 2) }
    __builtin_amdgcn_sched_barrier(0);
    GEMM_LDF(fbw, fbx, cur, 1)
    __builtin_amdgcn_sched_barrier(0);
    GEMM_MM(faw, fax)
    __builtin_amdgcn_sched_barrier(0);
    GEMM_LDF(faw, fax, cur, 2)
    __builtin_amdgcn_sched_barrier(0);
    GEMM_MM(fbw, fbx)
    __builtin_amdgcn_sched_barrier(0);
    GEMM_LDF(fbw, fbx, cur, 3)
    __builtin_amdgcn_sched_barrier(0);
    GEMM_MM(faw, fax)
    __builtin_amdgcn_sched_barrier(0);
    __syncthreads();
    if (it + 1 < KB) { GEMM_LDF(faw, fax, cur ^ 1, 0) }
    __builtin_amdgcn_sched_barrier(0);
    GEMM_MM(fbw, fbx)
    __builtin_amdgcn_sched_barrier(0);
  }
#undef GEMM_LDF
#undef GEMM_MM
#undef GEMM_LOAD
#undef GEMM_STORE
  ep(acc, mt, nt, wr, wc, lane, smem);
}

template <class AL, class EP>
DI void gemm_phase(const AL& al, const bf16_t* Wt, int K, int numM, int numN, const EP& ep, char* smem) {
  const int xcd = blockIdx.x & 7, lb = blockIdx.x >> 3, nlb = gridDim.x >> 3;
  const int mper = (numM + 7) >> 3, srows = (mper + 7) >> 3;
  const int total = srows * 8 * numN;
  for (int li = lb; li < total; li += nlb) {
    const int s = li / (8 * numN), rem = li - s * 8 * numN;
    const int nt = rem >> 3, mtl = s * 8 + (rem & 7);
    const int mt = xcd * mper + mtl;
    if (mtl >= mper || mt >= numM) continue;
    gemm_tile(al, Wt, K, mt, nt, ep, smem);
  }
}

struct ALPlain { const bf16_t* A; int KB; DI u32x4 operator()(int mt, int ml, int k) const { return *(const u32x4*)(A + (((size_t)(mt * KB + (k >> 6))) << 13) + (ml << 6) + (k & 63)); } };
struct ALFfn {
  const bf16_t* A;
  DI u32x4 operator()(int mt, int ml, int k) const {
    const int b = mt / 66, it = mt - b * 66, t = 126 * it - 2 + ml;
    if (t < 0 || t >= T_) return (u32x4){0, 0, 0, 0};
    return *(const u32x4*)(A + a_off(b * T_ + t, k, 16));
  }
};
struct ALCmp1 {
  const bf16_t* raw; const float* pe;
  DI u32x4 operator()(int mt, int ml, int k) const {
    const int m = mt * 128 + ml;
    if (m >= 4088) return (u32x4){0, 0, 0, 0};
    const int bg = m / 511, n = m - bg * 511;
    u32x4 v = *(const u32x4*)(raw + ((size_t)bg * T_ + 16 * n) * 64 + k);
    const f32x4 p0 = *(const f32x4*)(pe + k), p1 = *(const f32x4*)(pe + k + 4);
    u32x4 o;
    o.x = pack2(bf2f((bf16_t)(v.x & 0xffff)) + p0.x, bf2f((bf16_t)(v.x >> 16)) + p0.y);
    o.y = pack2(bf2f((bf16_t)(v.y & 0xffff)) + p0.z, bf2f((bf16_t)(v.y >> 16)) + p0.w);
    o.z = pack2(bf2f((bf16_t)(v.z & 0xffff)) + p1.x, bf2f((bf16_t)(v.z >> 16)) + p1.y);
    o.w = pack2(bf2f((bf16_t)(v.w & 0xffff)) + p1.z, bf2f((bf16_t)(v.w >> 16)) + p1.w);
    return o;
  }
};
struct ALCmp2 { const bf16_t* A; DI u32x4 operator()(int mt, int ml, int k) const { const int m = mt * 128 + ml; if (m >= 4088) return (u32x4){0, 0, 0, 0}; return *(const u32x4*)(A + (size_t)m * 256 + k); } };

__device__ const float ROPE_INV[8] = {1.0f, 0.19392274474868576f, 0.03760603093086393f, 0.007292664737217109f, 0.001414213562373095f, 0.0002742481756762073f, 5.318295896944988e-05f, 1.031338537721246e-05f};

template <bool ROPE>
DI void norm_store(f32x16 (&a)[2], float rs, const float* gain, int pos, bf16_t* dst, int h) {
  float ss = 0.f;
#pragma unroll
  for (int ns = 0; ns < 2; ++ns)
#pragma unroll
    for (int i = 0; i < 16; ++i) { const float v = a[ns][i] * rs; a[ns][i] = v; ss += v * v; }
  ss += __shfl_xor(ss, 32);
  const float inv = rsqrtf(ss * (1.0f / 64.0f) + 1e-6f);
#pragma unroll
  for (int ns = 0; ns < 2; ++ns)
#pragma unroll
    for (int i = 0; i < 16; ++i) a[ns][i] = a[ns][i] * inv * gain[32 * ns + crow(i, h)];
  if (ROPE) {
    const float fp = (float)pos;
#pragma unroll
    for (int ii = 0; ii < 4; ++ii) {
      const float ang = fp * ROPE_INV[4 * h + ii];
      const float c = cosf(ang), s = sinf(ang);
      const float x1 = a[0][ii], x2 = a[0][4 + ii];
      a[0][ii] = x1 * c - x2 * s; a[0][4 + ii] = x2 * c + x1 * s;
    }
  }
#pragma unroll
  for (int ns = 0; ns < 2; ++ns)
#pragma unroll
    for (int q = 0; q < 4; ++q) store_bf4(dst + 32 * ns + 8 * q + 4 * h, a[ns][4 * q], a[ns][4 * q + 1], a[ns][4 * q + 2], a[ns][4 * q + 3]);
}

struct EpiFoxIn {
  const Params& p;
  DI void operator()(f32x16 (&acc)[2][2], int mt, int nt, int wr, int wc, int lane, char*) const {
    const int r = lane & 31, h = lane >> 5, nb = nt * 128 + 64 * wc;
#pragma unroll
    for (int ms = 0; ms < 2; ++ms) {
      const int row = mt * 128 + 64 * wr + 32 * ms + r;
      const float rs = row_rstd(p.part, row);
      const int b = row >> 13, t = row & 8191;
      if (nb < 2048) {
        const bool isq = nb < 1024;
        norm_store<false>(acc[ms], rs, isq ? p.a_q_gain : p.a_k_gain, 0, (isq ? p.qb : p.kb) + ((size_t)(b * 16 + ((nb & 1023) >> 6)) * T_ + t) * 64, h);
      } else if (nb < 3072) {
        const int head = (nb - 2048) >> 6;
        bf16_t* dst = p.vT + ((size_t)((b * 16 + head) * 128 + (t >> 6))) * 4096 + (t & 63);
#pragma unroll
        for (int ns = 0; ns < 2; ++ns)
#pragma unroll
          for (int i = 0; i < 16; ++i) dst[(32 * ns + crow(i, h)) * 64] = f2bf(acc[ms][ns][i] * rs);
      } else if (nb == 3072) {
#pragma unroll
        for (int i = 0; i < 8; ++i) {
          const int head = crow(i, h);
          const float z = acc[ms][0][i] * rs + p.a_b_f[head];
          p.lf[((size_t)(b * 16 + head)) * T_ + t] = fminf(z, 0.f) - log1pf(expf(-fabsf(z)));
        }
      }
    }
  }
};

struct EpiResid {
  const float* res; float* out; bf16_t* hb; float* part;
  DI void operator()(f32x16 (&acc)[2][2], int mt, int nt, int wr, int wc, int lane, char* smem) const {
    float* sU = (float*)smem;
    const int r = lane & 31, h = lane >> 5, tid = threadIdx.x;
    __syncthreads();
#pragma unroll
    for (int ms = 0; ms < 2; ++ms) {
      const int ml = 64 * wr + 32 * ms + r;
#pragma unroll
      for (int ns = 0; ns < 2; ++ns)
#pragma unroll
        for (int i = 0; i < 16; ++i) sU[ml * 132 + 64 * wc + 32 * ns + crow(i, h)] = acc[ms][ns][i];
    }
    __syncthreads();
    const int c4 = (tid & 31) * 4, n = nt * 128 + c4;
#pragma unroll 1
    for (int hh = 0; hh < 2; ++hh) {
      f32x4 rv[8];
#pragma unroll
      for (int it = 0; it < 8; ++it) rv[it] = *(const f32x4*)(res + (size_t)(mt * 128 + (hh * 8 + it) * 8 + (tid >> 5)) * 1024 + n);
#pragma unroll
      for (int it = 0; it < 8; ++it) {
        const int rl = (hh * 8 + it) * 8 + (tid >> 5), row = mt * 128 + rl;
        const f32x4 o = rv[it] + *(const f32x4*)(sU + rl * 132 + c4);
        *(f32x4*)(out + (size_t)row * 1024 + n) = o;
        store_bf4(hb + a_off(row, n, 16), o.x, o.y, o.z, o.w);
        float ss = o.x * o.x + o.y * o.y + o.z * o.z + o.w * o.w;
        ss += __shfl_xor(ss, 1); ss += __shfl_xor(ss, 2); ss += __shfl_xor(ss, 4); ss += __shfl_xor(ss, 8); ss += __shfl_xor(ss, 16);
        if ((tid & 31) == 0) { part[(size_t)row * 16 + nt * 2] = ss; part[(size_t)row * 16 + nt * 2 + 1] = 0.f; }
      }
    }
  }
};

struct EpiFfnUp {
  const float* part; const float* cw; const float* cb; bf16_t* act;
  DI void operator()(f32x16 (&acc)[2][2], int mt, int nt, int wr, int wc, int lane, char* smem) const {
    float* sU = (float*)smem;
    const int r = lane & 31, h = lane >> 5, tid = threadIdx.x;
    const int b = mt / 66, it = mt - b * 66, tb = 126 * it - 2;
    __syncthreads();
#pragma unroll
    for (int ms = 0; ms < 2; ++ms) {
      const int ml = 64 * wr + 32 * ms + r, t = tb + ml;
      const float rs = (t >= 0 && t < T_) ? row_rstd(part, b * T_ + t) : 0.f;
#pragma unroll
      for (int ns = 0; ns < 2; ++ns)
#pragma unroll
        for (int i = 0; i < 16; ++i) sU[ml * 129 + 64 * wc + 32 * ns + crow(i, h)] = acc[ms][ns][i] * rs;
    }
    __syncthreads();
    const int jj = tid & 63, rg = tid >> 6, j = nt * 64 + jj;
    const float wg0 = cw[j], wg1 = cw[5632 + j], wg2 = cw[2 * 5632 + j], bgt = cb[j];
    const float wv0 = cw[FF + j], wv1 = cw[5632 + FF + j], wv2 = cw[2 * 5632 + FF + j], bvl = cb[FF + j];
    for (int ml = 2 + rg; ml < 128; ml += 4) {
      const int t = tb + ml;
      if (t >= T_) break;
      const float g = bgt + wg0 * sU[(ml - 2) * 129 + jj] + wg1 * sU[(ml - 1) * 129 + jj] + wg2 * sU[ml * 129 + jj];
      const float v = bvl + wv0 * sU[(ml - 2) * 129 + 64 + jj] + wv1 * sU[(ml - 1) * 129 + 64 + jj] + wv2 * sU[ml * 129 + 64 + jj];
      const float a = g / (1.0f + __expf(-g)) * v;
      act[a_off(b * T_ + t, j, 44)] = f2bf(a);
    }
  }
};

struct EpiKv {
  const Params& p;
  DI void operator()(f32x16 (&acc)[2][2], int mt, int nt, int wr, int wc, int lane, char*) const {
    const int r = lane & 31, h = lane >> 5, g = wc;
#pragma unroll
    for (int ms = 0; ms < 2; ++ms) {
      const int row = mt * 128 + 64 * wr + 32 * ms + r;
      const float rs = row_rstd(p.part, row);
      const int b = row >> 13, t = row & 8191, bg = b * 2 + g;
      if (nt < 2) {
        bf16_t* dst = p.rawc + (((size_t)(nt * 8 + bg)) * T_ + t) * 64;
#pragma unroll
        for (int ns = 0; ns < 2; ++ns)
#pragma unroll
          for (int q = 0; q < 4; ++q)
            store_bf4(dst + 32 * ns + 8 * q + 4 * h, acc[ms][ns][4 * q] * rs, acc[ms][ns][4 * q + 1] * rs, acc[ms][ns][4 * q + 2] * rs, acc[ms][ns][4 * q + 3] * rs);
      } else if (nt == 2 || nt == 4) {
        norm_store<true>(acc[ms], rs, nt == 2 ? p.ks_gain : p.kw_gain, p.pos[row], (nt == 2 ? p.ksb : p.kwb) + ((size_t)bg * T_ + t) * 64, h);
      } else if (nt == 3) {
        bf16_t* dst = p.vsT + ((size_t)bg * 128 + (t >> 6)) * 4096 + (t & 63);
#pragma unroll
        for (int ns = 0; ns < 2; ++ns)
#pragma unroll
          for (int i = 0; i < 16; ++i) dst[(32 * ns + crow(i, h)) * 64] = f2bf(acc[ms][ns][i] * rs);
      } else {
        bf16_t* dst = p.vwT + ((size_t)bg * 128 + (t >> 6)) * 4096 + (t & 63);
#pragma unroll
        for (int ns = 0; ns < 2; ++ns)
#pragma unroll
          for (int i = 0; i < 16; ++i) dst[(32 * ns + crow(i, h)) * 64] = f2bf(acc[ms][ns][i] * rs);
      }
    }
  }
};

struct EpiBIn {
  const Params& p;
  DI void operator()(f32x16 (&acc)[2][2], int mt, int nt, int wr, int wc, int lane, char*) const {
    const int r = lane & 31, h = lane >> 5, nb = nt * 128 + 64 * wc;
#pragma unroll
    for (int ms = 0; ms < 2; ++ms) {
      const int row = mt * 128 + 64 * wr + 32 * ms + r;
      const float rs = row_rstd(p.part, row);
      if (nb < 1024) {
        norm_store<true>(acc[ms], rs, p.b_q_gain, p.pos[row], p.qn + (size_t)row * 1024 + nb, h);
      } else if (nb == 1024) {
#pragma unroll
        for (int ns = 0; ns < 2; ++ns)
#pragma unroll
          for (int i = 0; i < 16; ++i) {
            const int c = 32 * ns + crow(i, h);
            if (c < 48) { const float z = acc[ms][ns][i] * rs + p.b_b_gate[c]; p.gates[(size_t)row * 48 + c] = 1.0f / (1.0f + __expf(-z)); }
          }
      }
    }
  }
};

struct EpiCmp1 {
  bf16_t* hid;
  DI void operator()(f32x16 (&acc)[2][2], int mt, int nt, int wr, int wc, int lane, char*) const {
    const int r = lane & 31, h = lane >> 5;
#pragma unroll
    for (int ms = 0; ms < 2; ++ms) {
      const int m = mt * 128 + 64 * wr + 32 * ms + r;
      if (m >= 4088) continue;
#pragma unroll
      for (int ns = 0; ns < 2; ++ns) {
        float g[16];
#pragma unroll
        for (int i = 0; i < 16; ++i) { const float x = acc[ms][ns][i]; g[i] = 0.5f * x * (1.0f + tanhf(0.7978845608028654f * (x + 0.044715f * x * x * x))); }
#pragma unroll
        for (int q = 0; q < 4; ++q) store_bf4(hid + (size_t)m * 256 + nt * 128 + 64 * wc + 32 * ns + 8 * q + 4 * h, g[4 * q], g[4 * q + 1], g[4 * q + 2], g[4 * q + 3]);
      }
    }
  }
};

struct EpiCmp2 {
  const Params& p; int sel;
  DI void operator()(f32x16 (&acc)[2][2], int mt, int nt, int wr, int wc, int lane, char*) const {
    if (wc != 0) return;
    const int r = lane & 31, h = lane >> 5;
#pragma unroll
    for (int ms = 0; ms < 2; ++ms) {
      const int m = mt * 128 + 64 * wr + 32 * ms + r;
      if (m < 4088) {
        const int bg = m / 511, n = m - bg * 511, b = bg >> 1;
        if (sel == 0) {
          norm_store<true>(acc[ms], 1.0f, p.kc_gain, p.pos[b * T_ + 16 * n + 31], p.kcb + ((size_t)bg * 512 + n) * 64, h);
        } else {
          bf16_t* dst = p.vcT + ((size_t)(bg * 8 + (n >> 6))) * 4096 + (n & 63);
#pragma unroll
          for (int ns = 0; ns < 2; ++ns)
#pragma unroll
            for (int i = 0; i < 16; ++i) dst[(32 * ns + crow(i, h)) * 64] = f2bf(acc[ms][ns][i]);
        }
      } else {
      }
    }
  }
};

DI void phase_scan(const Params& p) {
  const int lane = threadIdx.x & 63, gw = blockIdx.x * 4 + (threadIdx.x >> 6);
  if (gw >= 64) return;
  const float* src = p.lf + (size_t)gw * T_ + lane * 128;
  float* dst = p.cc + (size_t)gw * T_ + lane * 128;
  float s = 0.f;
  for (int i = 0; i < 128; i += 4) { const f32x4 v = *(const f32x4*)(src + i); s += v.x; s += v.y; s += v.z; s += v.w; }
  float inc = s;
#pragma unroll
  for (int o = 1; o < 64; o <<= 1) { const float u = __shfl_up(inc, o); if (lane >= o) inc += u; }
  float run = inc - s;
  for (int i = 0; i < 128; i += 4) {
    const f32x4 v = *(const f32x4*)(src + i); f32x4 o;
    run += v.x; o.x = run; run += v.y; o.y = run; run += v.z; o.z = run; run += v.w; o.w = run;
    *(f32x4*)(dst + i) = o;
  }
}

template <int MODE>
DI void flash_step(f32x16 (&o)[2], float& l, const bf16x8 (&qf)[4], const bf16_t* sK, const bf16_t* sV, const float* sC,
                   int kbase, int tq, float bias0, float inv_l, float* sImpRow, int lane, bool selok = true) {
  const int r = lane & 31, h = lane >> 5;
  constexpr float SC = 0.125f * 1.4426950408889634f;
  const int base_hi = (MODE == 2 || MODE == 3) ? ((tq - 31) >> 4) : tq;
#pragma unroll
  for (int sub = 0; sub < 2; ++sub) {
    f32x16 s;
#pragma unroll
    for (int i = 0; i < 16; ++i) s[i] = 0.f;
#pragma unroll
    for (int ks = 0; ks < 4; ++ks) {
      const bf16x8 a = *(const bf16x8*)(sK + (32 * sub + r) * 72 + 16 * ks + 8 * h);
      s = mfma32(a, qf[ks], s);
    }
    int hi = base_hi - kbase - 32 * sub - 4 * h;
    if (MODE == 4 && !selok) hi = -1;
    const int lo = (MODE == 1) ? hi - 511 : -1000000;
    const bool nomask = __all((hi >= 27) && (lo <= 0));
    if (MODE == 0) {
#pragma unroll
      for (int q = 0; q < 4; ++q) {
        const f32x4 c4 = *(const f32x4*)(sC + 32 * sub + 8 * q + 4 * h);
#pragma unroll
        for (int j = 0; j < 4; ++j) s[4 * q + j] = fmaf(s[4 * q + j], SC, bias0 - c4[j]);
      }
    } else {
#pragma unroll
      for (int i = 0; i < 16; ++i) s[i] = fmaf(s[i], SC, bias0);
    }
    if (!nomask) {
#pragma unroll
      for (int i = 0; i < 16; ++i) { const int cst = (i & 3) + 8 * (i >> 2); s[i] = (cst <= hi && cst >= lo) ? s[i] : -1e30f; }
    }
    float ls = 0.f;
#pragma unroll
    for (int i = 0; i < 16; ++i) { const float pv = __builtin_amdgcn_exp2f(s[i]); s[i] = pv; ls += pv; }
    l += ls;
    if (MODE == 2) continue;
    if (MODE == 3) {
#pragma unroll
      for (int q = 0; q < 4; ++q) {
        const float p3 = s[4 * q + 3] * inv_l;
        float A = (s[4 * q] + s[4 * q + 1] + s[4 * q + 2]) * inv_l + 0.5f * p3, B = 0.5f * p3;
        A += __shfl_xor(A, 1); A += __shfl_xor(A, 2); A += __shfl_xor(A, 4);
        B += __shfl_xor(B, 1); B += __shfl_xor(B, 2); B += __shfl_xor(B, 4);
        if ((r & 7) == 0) { const int j = ((kbase + 32 * sub) >> 2) + 2 * q + h; atomicAdd(&sImpRow[j], A); atomicAdd(&sImpRow[j + 1], B); }
      }
    }
#pragma unroll
    for (int st = 0; st < 2; ++st) {
      u32x4 pk;
      pk.x = pack2(s[8 * st + 0], s[8 * st + 1]); pk.y = pack2(s[8 * st + 2], s[8 * st + 3]);
      pk.z = pack2(s[8 * st + 4], s[8 * st + 5]); pk.w = pack2(s[8 * st + 6], s[8 * st + 7]);
      const bf16x8 pf = __builtin_bit_cast(bf16x8, pk);
#pragma unroll
      for (int d = 0; d < 2; ++d) {
        const bf16_t* vp = sV + (32 * d + r) * 72 + 32 * sub + 16 * st + 4 * h;
        const bf16x4 lo4 = *(const bf16x4*)vp, hi4 = *(const bf16x4*)(vp + 8);
        const bf16x8 vf = __builtin_shufflevector(lo4, hi4, 0, 1, 2, 3, 4, 5, 6, 7);
        o[d] = mfma32(vf, pf, o[d]);
      }
    }
  }
}

DI void tile_load(u32x4 (&kr)[2], u32x4 (&vr)[2], const bf16_t* kptr, int kstride, const bf16_t* vptr, int vstride, bool withV, int tid) {
#pragma unroll
  for (int i = 0; i < 2; ++i) {
    const int c = tid + 256 * i, row = c >> 3, ch = (c & 7) * 8;
    kr[i] = *(const u32x4*)(kptr + (size_t)row * kstride + ch);
    if (withV) vr[i] = *(const u32x4*)(vptr + (size_t)row * vstride + ch);
  }
}
DI void tile_store(const u32x4 (&kr)[2], const u32x4 (&vr)[2], bf16_t* sK, bf16_t* sV, bool withV, int tid) {
#pragma unroll
  for (int i = 0; i < 2; ++i) {
    const int c = tid + 256 * i, row = c >> 3, ch = (c & 7) * 8;
    *(u32x4*)(sK + row * 72 + ch) = kr[i];
    if (withV) *(u32x4*)(sV + row * 72 + ch) = vr[i];
  }
}

DI void phase_fox(const Params& p, char* smem) {
  bf16_t* sK = (bf16_t*)smem; bf16_t* sV = sK + 64 * 72; float* sC = (float*)(sV + 64 * 72);
  const int tid = threadIdx.x, lane = tid & 63, w = tid >> 6, r = lane & 31, h = lane >> 5;
  float gq = 0.f, gk = 0.f;
  for (int i = 0; i < 64; ++i) { gq = fmaxf(gq, fabsf(p.a_q_gain[i])); gk = fmaxf(gk, fabsf(p.a_k_gain[i])); }
  const float smax = 8.0f * gq * gk * 1.05f;
  const float thr = 40.0f + 2.0f * smax;
  const float negM2 = -smax * 1.4426950408889634f;
  for (int item = blockIdx.x; item < 4096; item += gridDim.x) {
    const int bh = item & 63, qt = 63 - (item >> 6), b = bh >> 4, head = bh & 15, t0 = qt * 128;
    const int tq = t0 + 32 * w + r;
    const bf16_t* qrow = p.qb + ((size_t)bh * T_ + tq) * 64;
    bf16x8 qf[4];
#pragma unroll
    for (int ks = 0; ks < 4; ++ks) qf[ks] = *(const bf16x8*)(qrow + 16 * ks + 8 * h);
    const float* cseq = p.cc + (size_t)bh * T_;
    const float cq = cseq[tq] * 1.4426950408889634f, c0 = cseq[t0];
    const bf16_t* kbp = p.kb + (size_t)bh * T_ * 64;
    const bf16_t* vbp = p.vT + (size_t)bh * 128 * 4096;
    f32x16 o[2];
#pragma unroll
    for (int d = 0; d < 2; ++d)
#pragma unroll
      for (int i = 0; i < 16; ++i) o[d][i] = 0.f;
    float l = 0.f;
    u32x4 kr[2], vr[2]; f32x4 cr = (f32x4){0.f, 0.f, 0.f, 0.f};
    int jt = 2 * qt + 1;
    tile_load(kr, vr, kbp + (size_t)jt * 4096, 64, vbp + (size_t)jt * 4096, 64, true, tid);
    if (tid < 16) cr = *(const f32x4*)(cseq + 64 * jt + 4 * tid);
    for (; jt >= 0; --jt) {
      const int kbase = 64 * jt;
      if (c0 - cseq[kbase + 63] < -thr) break;
      __syncthreads();
      tile_store(kr, vr, sK, sV, true, tid);
      if (tid < 16) *(f32x4*)(sC + 4 * tid) = cr * 1.4426950408889634f;
      __syncthreads();
      if (jt > 0) {
        tile_load(kr, vr, kbp + (size_t)(jt - 1) * 4096, 64, vbp + (size_t)(jt - 1) * 4096, 64, true, tid);
        if (tid < 16) cr = *(const f32x4*)(cseq + 64 * (jt - 1) + 4 * tid);
      }
      if (kbase <= t0 + 32 * w + 31) flash_step<0>(o, l, qf, sK, sV, sC, kbase, tq, cq + negM2, 0.f, nullptr, lane);
    }
    const float lt = l + __shfl_xor(l, 32);
    const float inv = 1.0f / lt;
    bf16_t* orow = p.ob + a_off(b * T_ + tq, head * 64, 16);
#pragma unroll
    for (int d = 0; d < 2; ++d)
#pragma unroll
      for (int q = 0; q < 4; ++q) store_bf4(orow + 32 * d + 8 * q + 4 * h, o[d][4 * q] * inv, o[d][4 * q + 1] * inv, o[d][4 * q + 2] * inv, o[d][4 * q + 3] * inv);
  }
}

DI void phase_nsa(const Params& p, char* smem) {
  bf16_t* sK = (bf16_t*)smem; bf16_t* sV = sK + 64 * 72;
  float* sImp = (float*)(sV + 64 * 72);
  float* sO = sImp + 16 * 132;
  unsigned* sMask = (unsigned*)(sO + 128 * 65);
  int* sList = (int*)(sMask + 64);
  const int tid = threadIdx.x, lane = tid & 63, w = tid >> 6, r = lane & 31, h = lane >> 5;
  float gqm = 0.f, gkm = 0.f;
  for (int i = 0; i < 64; ++i) { gqm = fmaxf(gqm, fabsf(p.b_q_gain[i])); gkm = fmaxf(gkm, fmaxf(fabsf(p.kc_gain[i]), fmaxf(fabsf(p.ks_gain[i]), fabsf(p.kw_gain[i])))); }
  const float negM2 = -8.0f * gqm * gkm * 1.05f * 1.4426950408889634f;
  for (int item = blockIdx.x; item < 4096; item += gridDim.x) {
    const int bg = item & 7, tt = 511 - (item >> 3), b = bg >> 1, g = bg & 1, t0 = tt * 16;
    const int tokl = 4 * w + (r >> 3), head = r & 7, tq = t0 + tokl;
    __syncthreads();
    for (int i = tid; i < 16 * 132; i += 256) sImp[i] = 0.f;
    bf16x8 qf[4];
    {
      const bf16_t* qrow = p.qn + ((size_t)b * T_ + tq) * 1024 + (g * 8 + head) * 64;
#pragma unroll
      for (int ks = 0; ks < 4; ++ks) qf[ks] = *(const bf16x8*)(qrow + 16 * ks + 8 * h);
    }
    const float* grow = p.gates + ((size_t)b * T_ + tq) * 48 + g * 8 + head;
    const float gate_c = grow[0], gate_w = grow[32];
    f32x16 o[2];
    float l = 0.f;
    u32x4 kr[2], vr[2];
    const int ncmp = t0 >> 4, nct = (ncmp + 63) >> 6;
    const bf16_t* kcp = p.kcb + (size_t)bg * 512 * 64;
    const bf16_t* vcp = p.vcT + (size_t)bg * 8 * 4096;
    if (nct > 0) tile_load(kr, vr, kcp, 64, vcp, 64, false, tid);
    for (int jt = 0; jt < nct; ++jt) {
      __syncthreads();
      tile_store(kr, vr, sK, sV, false, tid);
      __syncthreads();
      if (jt + 1 < nct) tile_load(kr, vr, kcp + (size_t)(jt + 1) * 4096, 64, vcp, 64, false, tid);
      flash_step<2>(o, l, qf, sK, sV, nullptr, 64 * jt, tq, negM2, 0.f, nullptr, lane);
    }
    const float lc = l + __shfl_xor(l, 32);
    const float inv_lc = lc > 0.f ? 1.0f / lc : 0.f;
#pragma unroll
    for (int d = 0; d < 2; ++d)
#pragma unroll
      for (int i = 0; i < 16; ++i) o[d][i] = 0.f;
    float l2 = 0.f;
    if (nct > 0) tile_load(kr, vr, kcp, 64, vcp, 64, true, tid);
    for (int jt = 0; jt < nct; ++jt) {
      __syncthreads();
      tile_store(kr, vr, sK, sV, true, tid);
      __syncthreads();
      if (jt + 1 < nct) tile_load(kr, vr, kcp + (size_t)(jt + 1) * 4096, 64, vcp + (size_t)(jt + 1) * 4096, 64, true, tid);
      flash_step<3>(o, l2, qf, sK, sV, nullptr, 64 * jt, tq, negM2, inv_lc, sImp + tokl * 132, lane);
    }
    {
      const float sc = gate_c * inv_lc;
      float* orow = sO + (32 * w + r) * 65;
#pragma unroll
      for (int d = 0; d < 2; ++d)
#pragma unroll
        for (int i = 0; i < 16; ++i) orow[32 * d + crow(i, h)] = o[d][i] * sc;
    }
    __syncthreads();
    const int cur = t0 >> 6;
    for (int tk = 0; tk < 4; ++tk) {
      const int tok = 4 * w + tk;
      float* sc = sImp + tok * 132;
      for (int j = lane; j <= cur; j += 64) if (j == 0 || j == cur || j == cur - 1) sc[j] = 1e6f;
    }
    __syncthreads();
    for (int tk = 0; tk < 4; ++tk) {
      const int tok = 4 * w + tk;
      const float* sc = sImp + tok * 132;
      unsigned long long mk0, mk1;
      {
        const int j = lane;
        const bool vj = j <= cur;
        const float sj = vj ? sc[j] : 0.f;
        int rank = 0;
        for (int i = 0; i <= cur; ++i) { const float si = sc[i]; rank += ((si > sj) || (si == sj && i < j)) ? 1 : 0; }
        mk0 = __ballot(vj && rank < 16);
      }
      {
        const int j = lane + 64;
        const bool vj = j <= cur;
        const float sj = vj ? sc[j] : 0.f;
        int rank = 0;
        for (int i = 0; i <= cur; ++i) { const float si = sc[i]; rank += ((si > sj) || (si == sj && i < j)) ? 1 : 0; }
        mk1 = __ballot(vj && rank < 16);
      }
      if (lane == 0) {
        sMask[tok * 4 + 0] = (unsigned)mk0; sMask[tok * 4 + 1] = (unsigned)(mk0 >> 32);
        sMask[tok * 4 + 2] = (unsigned)mk1; sMask[tok * 4 + 3] = (unsigned)(mk1 >> 32);
      }
    }
    __syncthreads();
    int n_un;
    {
      unsigned u0 = 0, u1 = 0, u2 = 0, u3 = 0;
      for (int tok = 0; tok < 16; ++tok) { u0 |= sMask[tok * 4]; u1 |= sMask[tok * 4 + 1]; u2 |= sMask[tok * 4 + 2]; u3 |= sMask[tok * 4 + 3]; }
      const int c0 = __popc(u0), c1 = __popc(u1), c2 = __popc(u2), c3 = __popc(u3);
      n_un = c0 + c1 + c2 + c3;
      if (tid < 128) {
        const int wd = tid >> 5, bit = tid & 31;
        const unsigned uw = wd == 0 ? u0 : wd == 1 ? u1 : wd == 2 ? u2 : u3;
        if ((uw >> bit) & 1u) {
          const int pre = (wd > 0 ? c0 : 0) + (wd > 1 ? c1 : 0) + (wd > 2 ? c2 : 0);
          sList[pre + __popc(uw & ((1u << bit) - 1u))] = tid;
        }
      }
    }
    __syncthreads();
#pragma unroll
    for (int d = 0; d < 2; ++d)
#pragma unroll
      for (int i = 0; i < 16; ++i) o[d][i] = 0.f;
    l = 0.f;
    {
      const bf16_t* ksp = p.ksb + (size_t)bg * T_ * 64;
      const bf16_t* vsp = p.vsT + (size_t)bg * 128 * 4096;
      {
        const int blk = sList[0];
        tile_load(kr, vr, ksp + (size_t)blk * 4096, 64, vsp + (size_t)blk * 4096, 64, true, tid);
      }
      for (int e = 0; e < n_un; ++e) {
        const int blk = sList[e];
        __syncthreads();
        tile_store(kr, vr, sK, sV, true, tid);
        __syncthreads();
        if (e + 1 < n_un) {
          const int nb = sList[e + 1];
          tile_load(kr, vr, ksp + (size_t)nb * 4096, 64, vsp + (size_t)nb * 4096, 64, true, tid);
        }
        const int wd = blk >> 5, bit = blk & 31;
        const unsigned wm = sMask[(4 * w) * 4 + wd] | sMask[(4 * w + 1) * 4 + wd] | sMask[(4 * w + 2) * 4 + wd] | sMask[(4 * w + 3) * 4 + wd];
        if ((wm >> bit) & 1u) {
          const bool selok = (sMask[tokl * 4 + wd] >> bit) & 1u;
          flash_step<4>(o, l, qf, sK, sV, nullptr, 64 * blk, tq, negM2, 0.f, nullptr, lane, selok);
        }
      }
      const float lt = l + __shfl_xor(l, 32);
      const float sc = grow[16] / lt;
      float* orow = sO + (32 * w + r) * 65;
#pragma unroll
      for (int d = 0; d < 2; ++d)
#pragma unroll
        for (int i = 0; i < 16; ++i) orow[32 * d + crow(i, h)] += o[d][i] * sc;
    }
#pragma unroll
    for (int d = 0; d < 2; ++d)
#pragma unroll
      for (int i = 0; i < 16; ++i) o[d][i] = 0.f;
    l = 0.f;
    {
      const int klo = t0 - 511 > 0 ? t0 - 511 : 0, jt0 = klo >> 6, jt1 = (t0 + 15) >> 6;
      const bf16_t* kwp = p.kwb + (size_t)bg * T_ * 64;
      const bf16_t* vwp = p.vwT + (size_t)bg * 128 * 4096;
      tile_load(kr, vr, kwp + (size_t)jt0 * 4096, 64, vwp + (size_t)jt0 * 4096, 64, true, tid);
      for (int jt = jt0; jt <= jt1; ++jt) {
        __syncthreads();
        tile_store(kr, vr, sK, sV, true, tid);
        __syncthreads();
        if (jt < jt1) tile_load(kr, vr, kwp + (size_t)(jt + 1) * 4096, 64, vwp + (size_t)(jt + 1) * 4096, 64, true, tid);
        flash_step<1>(o, l, qf, sK, sV, nullptr, 64 * jt, tq, negM2, 0.f, nullptr, lane);
      }
      const float lt = l + __shfl_xor(l, 32);
      const float sc = gate_w / lt;
      float* orow = sO + (32 * w + r) * 65;
#pragma unroll
      for (int d = 0; d < 2; ++d)
#pragma unroll
        for (int i = 0; i < 16; ++i) orow[32 * d + crow(i, h)] += o[d][i] * sc;
    }
    __syncthreads();
    for (int c = tid; c < 128 * 16; c += 256) {
      const int row = c >> 4, d4 = (c & 15) * 4, tok = row >> 3, hd = row & 7;
      const float* s = sO + row * 65 + d4;
      store_bf4(p.ob + a_off(b * T_ + t0 + tok, (g * 8 + hd) * 64 + d4, 16), s[0], s[1], s[2], s[3]);
    }
  }
}

#ifdef ONLY_PHASE
#define PH_ON(n) ((n) == ONLY_PHASE)
#else
#define PH_ON(n) true
#endif
#define REP_PHASE -1
#define PHASE(n, ...) \
  if (PH_ON(n) && ph_lo <= (n) && (n) < ph_hi) { __VA_ARGS__ } \
  if ((n) == REP_PHASE) { cg::this_grid().sync(); { __VA_ARGS__ } } \
  if (ph_lo <= (n) && (n) + 1 < ph_hi) cg::this_grid().sync();

__global__ void __launch_bounds__(256, 2) yoco_megakernel(Params p, int ph_lo, int ph_hi) {
  __shared__ __attribute__((aligned(16))) char smem[SMEM_BYTES];
  PHASE(0, phase_prep(p, smem);)
  PHASE(1, { ALPlain al{p.hb, 16}; EpiFoxIn ep{p}; gemm_phase(al, p.w_ain, 1024, 256, 25, ep, smem); })
  PHASE(2, phase_scan(p);)
  PHASE(3, phase_fox(p, smem);)
  PHASE(4, { ALPlain al{p.ob, 16}; EpiResid ep{p.x, p.out, p.hb, p.part}; gemm_phase(al, p.w_aout, 1024, 256, 8, ep, smem); })
  PHASE(5, { ALFfn al{p.hb}; EpiFfnUp ep{p.part, p.f_conv_w, p.f_conv_b, p.act}; gemm_phase(al, p.w_up0, 1024, 264, 44, ep, smem); })
  PHASE(6, { ALPlain al{p.act, 44}; EpiResid ep{p.out, p.out, p.hb, p.part}; gemm_phase(al, p.w_dn0, FF, 256, 8, ep, smem); })
  PHASE(7, {
    ALPlain al{p.hb, 16};
    { EpiKv ep{p}; gemm_phase(al, p.w_kv, 1024, 256, 6, ep, smem); }
    { EpiBIn ep{p}; gemm_phase(al, p.w_bin, 1024, 256, 9, ep, smem); }
  })
  PHASE(8, {
    { ALCmp1 al{p.rawc, p.kc_pe}; EpiCmp1 ep{p.hid}; gemm_phase(al, p.w_kc1, 2048, 32, 2, ep, smem); }
    { ALCmp1 al{p.rawc + (size_t)8 * T_ * 64, p.vc_pe}; EpiCmp1 ep{p.hid + (size_t)4096 * 256}; gemm_phase(al, p.w_vc1, 2048, 32, 2, ep, smem); }
  })
  PHASE(9, {
    { ALCmp2 al{p.hid}; EpiCmp2 ep{p, 0}; gemm_phase(al, p.w_kc2, 256, 32, 1, ep, smem); }
    { ALCmp2 al{p.hid + (size_t)4096 * 256}; EpiCmp2 ep{p, 1}; gemm_phase(al, p.w_vc2, 256, 32, 1, ep, smem); }
  })
  PHASE(10, phase_nsa(p, smem);)
  PHASE(11, { ALPlain al{p.ob, 16}; EpiResid ep{p.out, p.out, p.hb, p.part}; gemm_phase(al, p.w_bout, 1024, 256, 8, ep, smem); })
  PHASE(12, { ALFfn al{p.hb}; EpiFfnUp ep{p.part, p.f_conv_w + 3 * 5632, p.f_conv_b + 5632, p.act}; gemm_phase(al, p.w_up1, 1024, 264, 44, ep, smem); })
  PHASE(13, { ALPlain al{p.act, 44}; EpiResid ep{p.out, p.out, p.hb, p.part}; gemm_phase(al, p.w_dn1, FF, 256, 8, ep, smem); })
}

extern "C" void kernel_launch(void* const* d_in, const int* in_sizes, int n_in, void* d_out, int out_size, void* d_ws, size_t ws_size, hipStream_t stream) {
  Params p{};
  p.x = (const float*)d_in[0]; p.pos = (const int*)d_in[1];
  p.a_norm = (const float*)d_in[2]; p.a_w_in = (const float*)d_in[3]; p.a_b_f = (const float*)d_in[4]; p.a_q_gain = (const float*)d_in[5];
  p.a_k_gain = (const float*)d_in[6]; p.a_w_out = (const float*)d_in[7]; p.kv_norm = (const float*)d_in[8]; p.kv_w = (const float*)d_in[9];
  p.kc_pe = (const float*)d_in[10]; p.vc_pe = (const float*)d_in[11]; p.kc_w1 = (const float*)d_in[12]; p.kc_w2 = (const float*)d_in[13];
  p.vc_w1 = (const float*)d_in[14]; p.vc_w2 = (const float*)d_in[15]; p.kc_gain = (const float*)d_in[16]; p.ks_gain = (const float*)d_in[17];
  p.kw_gain = (const float*)d_in[18]; p.b_norm = (const float*)d_in[19]; p.b_w_in = (const float*)d_in[20]; p.b_b_gate = (const float*)d_in[21];
  p.b_q_gain = (const float*)d_in[22]; p.b_w_out = (const float*)d_in[23]; p.f_norm = (const float*)d_in[24]; p.f_w_up = (const float*)d_in[25];
  p.f_conv_w = (const float*)d_in[26]; p.f_conv_b = (const float*)d_in[27]; p.f_w_down = (const float*)d_in[28];
  p.out = (float*)d_out;
  char* ws = (char*)d_ws; size_t off = 0;
  auto take = [&](size_t bytes) { char* q = ws + off; off += (bytes + 255) & ~(size_t)255; return q; };
  p.w_ain = (bf16_t*)take((size_t)3200 * 1024 * 2); p.w_aout = (bf16_t*)take((size_t)1024 * 1024 * 2); p.w_kv = (bf16_t*)take((size_t)768 * 1024 * 2);
  p.w_kc1 = (bf16_t*)take((size_t)256 * 2048 * 2); p.w_vc1 = (bf16_t*)take((size_t)256 * 2048 * 2);
  p.w_kc2 = (bf16_t*)take((size_t)128 * 256 * 2); p.w_vc2 = (bf16_t*)take((size_t)128 * 256 * 2);
  p.w_bin = (bf16_t*)take((size_t)1152 * 1024 * 2); p.w_bout = (bf16_t*)take((size_t)1024 * 1024 * 2);
  p.w_up0 = (bf16_t*)take((size_t)5632 * 1024 * 2); p.w_up1 = (bf16_t*)take((size_t)5632 * 1024 * 2);
  p.w_dn0 = (bf16_t*)take((size_t)1024 * FF * 2); p.w_dn1 = (bf16_t*)take((size_t)1024 * FF * 2);
  p.hb = (bf16_t*)take((size_t)NTOK * 1024 * 2); p.part = (float*)take((size_t)NTOK * 16 * 4);
  p.lf = (float*)take((size_t)64 * T_ * 4); p.cc = (float*)take((size_t)64 * T_ * 4);
  p.ob = (bf16_t*)take((size_t)NTOK * 1024 * 2);
  char* R = take((size_t)NTOK * 1024 * 2 * 3);
  p.qb = (bf16_t*)R; p.kb = p.qb + (size_t)NTOK * 1024; p.vT = p.kb + (size_t)NTOK * 1024;
  p.act = (bf16_t*)R;
  {
    char* q = R;
    p.qn = (bf16_t*)q; q += (size_t)NTOK * 1024 * 2;
    p.rawc = (bf16_t*)q; q += (size_t)2 * 8 * T_ * 64 * 2;
    p.ksb = (bf16_t*)q; q += (size_t)8 * T_ * 64 * 2;
    p.vsT = (bf16_t*)q; q += (size_t)8 * T_ * 64 * 2;
    p.kwb = (bf16_t*)q; q += (size_t)8 * T_ * 64 * 2;
    p.vwT = (bf16_t*)q; q += (size_t)8 * T_ * 64 * 2;
    p.gates = (float*)q; q += (size_t)NTOK * 48 * 4;
    p.hid = (bf16_t*)q; q += (size_t)2 * 4096 * 256 * 2;
    p.kcb = (bf16_t*)q; q += (size_t)8 * 512 * 64 * 2;
    p.vcT = (bf16_t*)q; q += (size_t)8 * 64 * 512 * 2;
  }
  static int grid_blocks = 0;
  if (!grid_blocks) {
    int dev = 0, cus = 0, per_cu = 0;
    hipGetDevice(&dev);
    hipDeviceGetAttribute(&cus, hipDeviceAttributeMultiprocessorCount, dev);
    hipOccupancyMaxActiveBlocksPerMultiprocessor(&per_cu, yoco_megakernel, 256, 0);
    if (per_cu > 2) per_cu = 2;
    if (per_cu < 1) per_cu = 1;
    grid_blocks = cus * per_cu;
    grid_blocks &= ~7;
  }
#if N_LAUNCH_SPLIT
  for (int ph = 0; ph < NPHASE; ++ph) {
    int lo = ph, hi = ph + 1;
    hipLaunchKernelGGL(yoco_megakernel, dim3(grid_blocks), dim3(256), 0, stream, p, lo, hi);
  }
#else
  int lo = 0, hi = NPHASE;
  void* args[] = {&p, &lo, &hi};
  hipError_t e = hipLaunchCooperativeKernel((void*)yoco_megakernel, dim3(grid_blocks), dim3(256), args, 0, stream);
  if (e != hipSuccess) fprintf(stderr, "cooperative launch failed: %s (grid %d)\n", hipGetErrorString(e), grid_blocks);
#endif
}
```

```cpp
#include <hip/hip_runtime.h>
#include <hip/hip_cooperative_groups.h>
#include <stdint.h>
#include <cstdio>
namespace cg = cooperative_groups;

#ifndef N_LAUNCH_SPLIT
#define N_LAUNCH_SPLIT 0
#endif

#define DI __device__ __forceinline__
typedef unsigned short bf16_t;
typedef short bf16x8 __attribute__((ext_vector_type(8)));
typedef short bf16x4 __attribute__((ext_vector_type(4)));
typedef float f32x16 __attribute__((ext_vector_type(16)));
typedef float f32x4 __attribute__((ext_vector_type(4)));
typedef unsigned u32x4 __attribute__((ext_vector_type(4)));
typedef unsigned u32x2 __attribute__((ext_vector_type(2)));

constexpr int T_ = 8192;
constexpr int NTOK = 32768;
constexpr int FF = 2816;
constexpr int NPHASE = 14;
constexpr int SMEM_BYTES = 73728;

struct Params {
  const float* x; const int* pos;
  const float *a_norm, *a_w_in, *a_b_f, *a_q_gain, *a_k_gain, *a_w_out;
  const float *kv_norm, *kv_w, *kc_pe, *vc_pe, *kc_w1, *kc_w2, *vc_w1, *vc_w2, *kc_gain, *ks_gain, *kw_gain;
  const float *b_norm, *b_w_in, *b_b_gate, *b_q_gain, *b_w_out;
  const float *f_norm, *f_w_up, *f_conv_w, *f_conv_b, *f_w_down;
  float* out;
  bf16_t *w_ain, *w_aout, *w_kv, *w_kc1, *w_vc1, *w_kc2, *w_vc2, *w_bin, *w_bout, *w_up0, *w_up1, *w_dn0, *w_dn1;
  bf16_t* hb; float* part; float* lf; float* cc; bf16_t* ob;
  bf16_t *qb, *kb, *vT; bf16_t* act;
  bf16_t *rawc, *ksb, *vsT, *kwb, *vwT, *qn; float* gates; bf16_t *hid, *kcb, *vcT; float* hidp;
};

typedef __bf16 bf16v2 __attribute__((ext_vector_type(2)));
typedef float f32x2 __attribute__((ext_vector_type(2)));
struct KArgs { const void* in[29]; float* out; char* ws; };
DI void fill_params(Params& p, const KArgs& ka) {
  p.x = (const float*)ka.in[0]; p.pos = (const int*)ka.in[1];
  p.a_norm = (const float*)ka.in[2]; p.a_w_in = (const float*)ka.in[3]; p.a_b_f = (const float*)ka.in[4]; p.a_q_gain = (const float*)ka.in[5];
  p.a_k_gain = (const float*)ka.in[6]; p.a_w_out = (const float*)ka.in[7]; p.kv_norm = (const float*)ka.in[8]; p.kv_w = (const float*)ka.in[9];
  p.kc_pe = (const float*)ka.in[10]; p.vc_pe = (const float*)ka.in[11]; p.kc_w1 = (const float*)ka.in[12]; p.kc_w2 = (const float*)ka.in[13];
  p.vc_w1 = (const float*)ka.in[14]; p.vc_w2 = (const float*)ka.in[15]; p.kc_gain = (const float*)ka.in[16]; p.ks_gain = (const float*)ka.in[17];
  p.kw_gain = (const float*)ka.in[18]; p.b_norm = (const float*)ka.in[19]; p.b_w_in = (const float*)ka.in[20]; p.b_b_gate = (const float*)ka.in[21];
  p.b_q_gain = (const float*)ka.in[22]; p.b_w_out = (const float*)ka.in[23]; p.f_norm = (const float*)ka.in[24]; p.f_w_up = (const float*)ka.in[25];
  p.f_conv_w = (const float*)ka.in[26]; p.f_conv_b = (const float*)ka.in[27]; p.f_w_down = (const float*)ka.in[28];
  p.out = ka.out;
  char* wsq = ka.ws;
#define TAKE(bytes) (wsq += (((size_t)(bytes)) + 255) & ~(size_t)255, wsq - ((((size_t)(bytes)) + 255) & ~(size_t)255))
  p.w_ain = (bf16_t*)TAKE((size_t)3200 * 1024 * 2); p.w_aout = (bf16_t*)TAKE((size_t)1024 * 1024 * 2); p.w_kv = (bf16_t*)TAKE((size_t)768 * 1024 * 2);
  p.w_kc1 = (bf16_t*)TAKE((size_t)256 * 2048 * 2); p.w_vc1 = (bf16_t*)TAKE((size_t)256 * 2048 * 2);
  p.w_kc2 = (bf16_t*)TAKE((size_t)128 * 256 * 2); p.w_vc2 = (bf16_t*)TAKE((size_t)128 * 256 * 2);
  p.w_bin = (bf16_t*)TAKE((size_t)1152 * 1024 * 2); p.w_bout = (bf16_t*)TAKE((size_t)1024 * 1024 * 2);
  p.w_up0 = (bf16_t*)TAKE((size_t)5632 * 1024 * 2); p.w_up1 = (bf16_t*)TAKE((size_t)5632 * 1024 * 2);
  p.w_dn0 = (bf16_t*)TAKE((size_t)1024 * FF * 2); p.w_dn1 = (bf16_t*)TAKE((size_t)1024 * FF * 2);
  p.hb = (bf16_t*)TAKE((size_t)NTOK * 1024 * 2); p.part = (float*)TAKE((size_t)NTOK * 16 * 4);
  p.lf = (float*)TAKE((size_t)64 * T_ * 4); p.cc = (float*)TAKE((size_t)64 * T_ * 4);
  p.ob = (bf16_t*)TAKE((size_t)NTOK * 1024 * 2);
  char* R = TAKE((size_t)NTOK * 1024 * 2 * 3);
#undef TAKE
  p.qb = (bf16_t*)R; p.kb = p.qb + (size_t)NTOK * 1024; p.vT = p.kb + (size_t)NTOK * 1024;
  p.act = (bf16_t*)R;
  {
    char* q = R;
    p.qn = (bf16_t*)q; q += (size_t)NTOK * 1024 * 2;
    p.rawc = (bf16_t*)q; q += (size_t)2 * 8 * T_ * 64 * 2;
    p.ksb = (bf16_t*)q; q += (size_t)8 * T_ * 64 * 2;
    p.vsT = (bf16_t*)q; q += (size_t)8 * T_ * 64 * 2;
    p.kwb = (bf16_t*)q; q += (size_t)8 * T_ * 64 * 2;
    p.vwT = (bf16_t*)q; q += (size_t)8 * T_ * 64 * 2;
    p.gates = (float*)q; q += (size_t)NTOK * 48 * 4;
    p.hid = (bf16_t*)q; q += (size_t)2 * 4096 * 256 * 2;
    p.kcb = (bf16_t*)q; q += (size_t)8 * 512 * 64 * 2;
    p.vcT = (bf16_t*)q; q += (size_t)8 * 64 * 512 * 2;
    p.hidp = (float*)q; q += (size_t)2 * 4 * 4096 * 256 * 4;
  }
}

DI bf16_t f2bf(float x) { return __builtin_bit_cast(bf16_t, (__bf16)x); }
DI unsigned pack2(float a, float b) { f32x2 v = {a, b}; return __builtin_bit_cast(unsigned, __builtin_convertvector(v, bf16v2)); }
DI float bf2f(bf16_t v) { return __uint_as_float(((unsigned)v) << 16); }
DI int crow(int i, int h) { return (i & 3) + 8 * (i >> 2) + 4 * h; }
DI f32x16 mfma32(bf16x8 a, bf16x8 b, f32x16 c) { return __builtin_amdgcn_mfma_f32_32x32x16_bf16(a, b, c, 0, 0, 0); }
DI f32x4 mfma16(bf16x8 a, bf16x8 b, f32x4 c) { return __builtin_amdgcn_mfma_f32_16x16x32_bf16(a, b, c, 0, 0, 0); }
DI float row_rstd(const float* part, int row) {
  const f32x4* q = (const f32x4*)(part + (size_t)row * 16);
  f32x4 a = q[0], b = q[1], c = q[2], d = q[3];
  float s = ((a.x + a.y) + (a.z + a.w)) + ((b.x + b.y) + (b.z + b.w)) + ((c.x + c.y) + (c.z + c.w)) + ((d.x + d.y) + (d.z + d.w));
  return rsqrtf(s * (1.0f / 1024.0f) + 1e-6f);
}
DI size_t a_off(int row, int k, int KB) { return (((size_t)((row >> 7) * KB + (k >> 6))) << 13) + ((row & 127) << 6) + (k & 63); }
DI void store_bf4(bf16_t* dst, float a, float b, float c, float d) { u32x2 v; v.x = pack2(a, b); v.y = pack2(c, d); *(u32x2*)dst = v; }

struct WJob { const float* src; bf16_t* dst; const float* gain; int K, Nsrc, Ndst, mode; };
DI WJob get_job(const Params& p, int j) {
  WJob w; w.gain = nullptr; w.mode = 0;
  switch (j) {
    case 0: w.src = p.a_w_in; w.dst = p.w_ain; w.gain = p.a_norm; w.K = 1024; w.Nsrc = 3088; w.Ndst = 3200; break;
    case 1: w.src = p.a_w_out; w.dst = p.w_aout; w.K = 1024; w.Nsrc = 1024; w.Ndst = 1024; break;
    case 2: w.src = p.kv_w; w.dst = p.w_kv; w.gain = p.kv_norm; w.K = 1024; w.Nsrc = 768; w.Ndst = 768; break;
    case 3: w.src = p.kc_w1; w.dst = p.w_kc1; w.K = 2048; w.Nsrc = 256; w.Ndst = 256; break;
    case 4: w.src = p.vc_w1; w.dst = p.w_vc1; w.K = 2048; w.Nsrc = 256; w.Ndst = 256; break;
    case 5: w.src = p.kc_w2; w.dst = p.w_kc2; w.K = 256; w.Nsrc = 64; w.Ndst = 128; break;
    case 6: w.src = p.vc_w2; w.dst = p.w_vc2; w.K = 256; w.Nsrc = 64; w.Ndst = 128; break;
    case 7: w.src = p.b_w_in; w.dst = p.w_bin; w.gain = p.b_norm; w.K = 1024; w.Nsrc = 1072; w.Ndst = 1152; break;
    case 8: w.src = p.b_w_out; w.dst = p.w_bout; w.K = 1024; w.Nsrc = 1024; w.Ndst = 1024; break;
    case 9: w.src = p.f_w_up; w.dst = p.w_up0; w.gain = p.f_norm; w.K = 1024; w.Nsrc = 5632; w.Ndst = 5632; w.mode = 1; break;
    case 10: w.src = p.f_w_up + (size_t)1024 * 5632; w.dst = p.w_up1; w.gain = p.f_norm + 1024; w.K = 1024; w.Nsrc = 5632; w.Ndst = 5632; w.mode = 1; break;
    case 11: w.src = p.f_w_down; w.dst = p.w_dn0; w.K = 2816; w.Nsrc = 1024; w.Ndst = 1024; break;
    default: w.src = p.f_w_down + (size_t)2816 * 1024; w.dst = p.w_dn1; w.K = 2816; w.Nsrc = 1024; w.Ndst = 1024; break;
  }
  return w;
}

DI void prep_load(const WJob& w, int t, int nkt, int tid, f32x4 (&v)[4], int& k0, int& n0d) {
  const int kt = t % nkt, nt = t / nkt;
  k0 = kt << 6; n0d = nt << 6;
  int sbase = n0d;
  if (w.mode == 1) { const int tile = n0d >> 7, half = (n0d >> 6) & 1; sbase = half * FF + tile * 64; }
#pragma unroll
  for (int i = 0; i < 4; ++i) {
    const int kk = (tid >> 4) + 16 * i, col = sbase + (tid & 15) * 4;
    v[i] = (f32x4){0.f, 0.f, 0.f, 0.f};
    if (col < w.Nsrc) v[i] = *(const f32x4*)(w.src + (size_t)(k0 + kk) * w.Nsrc + col);
    const float g = w.gain ? w.gain[k0 + kk] : 1.0f;
    v[i] *= g;
  }
}
DI void prep_lds(float* sT, const f32x4 (&v)[4], int tid) {
#pragma unroll
  for (int i = 0; i < 4; ++i) {
    const int kk = (tid >> 4) + 16 * i, nn = (tid & 15) * 4;
    sT[kk * 65 + nn + 0] = v[i].x; sT[kk * 65 + nn + 1] = v[i].y; sT[kk * 65 + nn + 2] = v[i].z; sT[kk * 65 + nn + 3] = v[i].w;
  }
}
DI void prep_out(const float* sT, const WJob& w, int k0, int n0d, int nkt, int tid) {
  const int n = tid >> 2, kseg = (tid & 3) * 16;
  unsigned o[8];
#pragma unroll
  for (int q = 0; q < 8; ++q) o[q] = pack2(sT[(kseg + 2 * q) * 65 + n], sT[(kseg + 2 * q + 1) * 65 + n]);
  u32x4* dst = (u32x4*)(w.dst + a_off(n0d + n, k0 + kseg, nkt));
  dst[0] = (u32x4){o[0], o[1], o[2], o[3]}; dst[1] = (u32x4){o[4], o[5], o[6], o[7]};
}

DI void phase_prep(const Params& p, char* smem) {
  float* sT0 = (float*)smem;
  float* sT1 = sT0 + 64 * 65;
  const int tid = threadIdx.x;
  {
    const int lane = tid & 63, gw = blockIdx.x * 4 + (tid >> 6), nw = gridDim.x * 4;
    for (int row0 = gw * 4; row0 < NTOK; row0 += nw * 4) {
      f32x4 v[4][4];
#pragma unroll
      for (int rr = 0; rr < 4; ++rr)
#pragma unroll
        for (int i = 0; i < 4; ++i) v[rr][i] = *(const f32x4*)(p.x + (size_t)(row0 + rr) * 1024 + i * 256 + lane * 4);
#pragma unroll
      for (int rr = 0; rr < 4; ++rr) {
        const int row = row0 + rr;
        float ss = 0.f;
#pragma unroll
        for (int i = 0; i < 4; ++i) {
          const f32x4 x = v[rr][i];
          ss += x.x * x.x + x.y * x.y + x.z * x.z + x.w * x.w;
          store_bf4(p.hb + a_off(row, i * 256 + lane * 4, 16), x.x, x.y, x.z, x.w);
        }
#pragma unroll
        for (int o = 32; o >= 1; o >>= 1) ss += __shfl_xor(ss, o);
        if (lane < 16) p.part[(size_t)row * 16 + lane] = lane == 0 ? ss : 0.f;
      }
    }
  }
  int base = 0;
  for (int j = 0; j < 13; ++j) {
    WJob w = get_job(p, j);
    const int nkt = w.K >> 6, nnt = w.Ndst >> 6, ntile = nkt * nnt, G = gridDim.x;
    int first = (int)blockIdx.x - (base % G); if (first < 0) first += G;
    for (int t = first; t < ntile; t += 2 * G) {
      const bool hasB = (t + G) < ntile;
      f32x4 va[4], vb[4]; int k0a, n0a, k0b = 0, n0b = 0;
      prep_load(w, t, nkt, tid, va, k0a, n0a);
      if (hasB) prep_load(w, t + G, nkt, tid, vb, k0b, n0b);
      __syncthreads();
      prep_lds(sT0, va, tid);
      if (hasB) prep_lds(sT1, vb, tid);
      __syncthreads();
      prep_out(sT0, w, k0a, n0a, nkt, tid);
      if (hasB) prep_out(sT1, w, k0b, n0b, nkt, tid);
    }
    base += ntile;
  }
  if (blockIdx.x == 0) {
    for (int i = tid; i < 8 * 64; i += 256) {
      const int bg = i >> 6, d = i & 63;
      p.kcb[((size_t)bg * 512 + 511) * 64 + d] = 0;
      p.vcT[((size_t)(bg * 8 + 7) * 64 + d) * 64 + 63] = 0;
    }
  }
}

template <class AL, class EP>
DI void gemm_tile(const AL& al, const bf16_t* __restrict__ Wt, int K, int mt, int nt, const EP& ep, char* smem, int kb0 = 0, int KBn = -1) {
  bf16_t* sbuf = (bf16_t*)smem;
  constexpr int STAGE = 2 * 128 * 72;
  const int tid = threadIdx.x, lane = tid & 63, wave = tid >> 6, wr = wave >> 1, wc = wave & 1, r = lane & 31, h = lane >> 5;
  const int KBt = K >> 6, KB = KBn < 0 ? KBt : KBn;
  const bf16_t* wbase = Wt + (((size_t)nt * KBt + kb0) << 13) + tid * 8;
  f32x16 acc[2][2];
#pragma unroll
  for (int a = 0; a < 2; ++a)
#pragma unroll
    for (int b = 0; b < 2; ++b)
#pragma unroll
      for (int i = 0; i < 16; ++i) acc[a][b][i] = 0.f;
  u32x4 xa[4], wa[4];
#define GEMM_LOAD(kb_)                                                                  \
  _Pragma("unroll") for (int i = 0; i < 4; ++i) {                                        \
    const int c = tid + 256 * i;                                                         \
    xa[i] = al(mt, c >> 3, (kb0 + (kb_)) * 64 + (c & 7) * 8);                                    \
    wa[i] = *(const u32x4*)(wbase + ((size_t)(kb_) << 13) + 2048 * i);                   \
  }
#define GEMM_STORE(st_)                                                                 \
  _Pragma("unroll") for (int i = 0; i < 4; ++i) {                                        \
    const int c = tid + 256 * i, row = c >> 3, kc = (c & 7) * 8;                         \
    *(u32x4*)(sbuf + (st_) * STAGE + row * 72 + kc) = xa[i];                             \
    *(u32x4*)(sbuf + (st_) * STAGE + 128 * 72 + row * 72 + kc) = wa[i];                  \
  }
#define GEMM_LDF(FW, FX, st_, ks_)                                                      \
  _Pragma("unroll") for (int q = 0; q < 2; ++q) {                                        \
    FW[q] = *(const bf16x8*)(sbuf + (st_) * STAGE + 128 * 72 + (64 * wc + 32 * q + r) * 72 + 16 * (ks_) + 8 * h); \
    FX[q] = *(const bf16x8*)(sbuf + (st_) * STAGE + (64 * wr + 32 * q + r) * 72 + 16 * (ks_) + 8 * h);            \
  }
#define GEMM_MM(FW, FX)                                                                 \
  _Pragma("unroll") for (int ms = 0; ms < 2; ++ms)                                       \
    _Pragma("unroll") for (int ns = 0; ns < 2; ++ns) acc[ms][ns] = mfma32(FW[ns], FX[ms], acc[ms][ns]);
  bf16x8 faw[2], fax[2], fbw[2], fbx[2];
  __syncthreads();
  GEMM_LOAD(0)
  GEMM_STORE(0)
  if (KB > 1) { GEMM_LOAD(1) }
  __syncthreads();
  GEMM_LDF(faw, fax, 0, 0)
  for (int it = 0; it < KB; ++it) {
    const int cur = it & 1;
    if (it + 1 < KB) { GEMM_STORE(cur ^ 1) }
    if (it + 2 < KB) { GEMM_LOAD(it + 2) }
    __builtin_amdgcn_sched_barrier(0);
    GEMM_LDF(fbw, fbx, cur, 1)
    __builtin_amdgcn_sched_barrier(0);
    GEMM_MM(faw, fax)
    __builtin_amdgcn_sched_barrier(0);
    GEMM_LDF(faw, fax, cur, 2)
    __builtin_amdgcn_sched_barrier(0);
    GEMM_MM(fbw, fbx)
    __builtin_amdgcn_sched_barrier(0);
    GEMM_LDF(fbw, fbx, cur, 3)
    __builtin_amdgcn_sched_barrier(0);
    GEMM_MM(faw, fax)
    __builtin_amdgcn_sched_barrier(0);
    __syncthreads();
    if (it + 1 < KB) { GEMM_LDF(faw, fax, cur ^ 1, 0) }
    __builtin_amdgcn_sched_barrier(0);
    GEMM_MM(fbw, fbx)
    __builtin_amdgcn_sched_barrier(0);
  }
#undef GEMM_LDF
#undef GEMM_MM
#undef GEMM_LOAD
#undef GEMM_STORE
  ep(acc, mt, nt, wr, wc, lane, smem);
}

template <class AL, class EP>
DI void gemm_phase(const AL& al, const bf16_t* Wt, int K, int numM, int numN, const EP& ep, char* smem) {
  const int xcd = blockIdx.x & 7, lb = blockIdx.x >> 3, nlb = gridDim.x >> 3;
  const int mper = (numM + 7) >> 3, fullr = mper >> 3, mrem = mper & 7;
  const int nfull = fullr * 8 * numN, total = mper * numN;
  for (int li = lb; li < total; li += nlb) {
    int nt, mtl;
    if (li < nfull) { const int s = li / (8 * numN), rem = li - s * 8 * numN; nt = rem >> 3; mtl = s * 8 + (rem & 7); }
    else { const int rem = li - nfull; nt = rem / mrem; mtl = fullr * 8 + (rem - nt * mrem); }
    const int mt = xcd * mper + mtl;
    if (mt >= numM) continue;
    gemm_tile(al, Wt, K, mt, nt, ep, smem);
  }
}

struct ALPlain { const bf16_t* A; int KB; DI u32x4 operator()(int mt, int ml, int k) const { return *(const u32x4*)(A + (((size_t)(mt * KB + (k >> 6))) << 13) + (ml << 6) + (k & 63)); } };
struct ALFfn {
  const bf16_t* A;
  DI u32x4 operator()(int mt, int ml, int k) const {
    const int b = mt / 66, it = mt - b * 66, t = 126 * it - 2 + ml;
    if (t < 0 || t >= T_) return (u32x4){0, 0, 0, 0};
    return *(const u32x4*)(A + a_off(b * T_ + t, k, 16));
  }
};
struct ALCmp1 {
  const bf16_t* raw; const float* pe;
  DI u32x4 operator()(int mt, int ml, int k) const {
    const int m = mt * 128 + ml;
    if (m >= 4088) return (u32x4){0, 0, 0, 0};
    const int bg = m / 511, n = m - bg * 511;
    u32x4 v = *(const u32x4*)(raw + ((size_t)bg * T_ + 16 * n) * 64 + k);
    const f32x4 p0 = *(const f32x4*)(pe + k), p1 = *(const f32x4*)(pe + k + 4);
    u32x4 o;
    o.x = pack2(bf2f((bf16_t)(v.x & 0xffff)) + p0.x, bf2f((bf16_t)(v.x >> 16)) + p0.y);
    o.y = pack2(bf2f((bf16_t)(v.y & 0xffff)) + p0.z, bf2f((bf16_t)(v.y >> 16)) + p0.w);
    o.z = pack2(bf2f((bf16_t)(v.z & 0xffff)) + p1.x, bf2f((bf16_t)(v.z >> 16)) + p1.y);
    o.w = pack2(bf2f((bf16_t)(v.w & 0xffff)) + p1.z, bf2f((bf16_t)(v.w >> 16)) + p1.w);
    return o;
  }
};
struct ALCmp2 { const bf16_t* A; DI u32x4 operator()(int mt, int ml, int k) const { const int m = mt * 128 + ml; if (m >= 4088) return (u32x4){0, 0, 0, 0}; return *(const u32x4*)(A + (size_t)m * 256 + k); } };

__device__ const float ROPE_INV[8] = {1.0f, 0.19392274474868576f, 0.03760603093086393f, 0.007292664737217109f, 0.001414213562373095f, 0.0002742481756762073f, 5.318295896944988e-05f, 1.031338537721246e-05f};

template <bool ROPE>
DI void norm_store(f32x16 (&a)[2], float rs, const float* gain, int pos, bf16_t* dst, int h) {
  float ss = 0.f;
#pragma unroll
  for (int ns = 0; ns < 2; ++ns)
#pragma unroll
    for (int i = 0; i < 16; ++i) { const float v = a[ns][i] * rs; a[ns][i] = v; ss += v * v; }
  ss += __shfl_xor(ss, 32);
  const float inv = rsqrtf(ss * (1.0f / 64.0f) + 1e-6f);
#pragma unroll
  for (int ns = 0; ns < 2; ++ns)
#pragma unroll
    for (int i = 0; i < 16; ++i) a[ns][i] = a[ns][i] * inv * gain[32 * ns + crow(i, h)];
  if (ROPE) {
    const float fp = (float)pos;
#pragma unroll
    for (int ii = 0; ii < 4; ++ii) {
      const float ang = fp * ROPE_INV[4 * h + ii];
      const float c = cosf(ang), s = sinf(ang);
      const float x1 = a[0][ii], x2 = a[0][4 + ii];
      a[0][ii] = x1 * c - x2 * s; a[0][4 + ii] = x2 * c + x1 * s;
    }
  }
#pragma unroll
  for (int ns = 0; ns < 2; ++ns)
#pragma unroll
    for (int q = 0; q < 4; ++q) store_bf4(dst + 32 * ns + 8 * q + 4 * h, a[ns][4 * q], a[ns][4 * q + 1], a[ns][4 * q + 2], a[ns][4 * q + 3]);
}

struct EpiFoxIn {
  const Params& p;
  DI void operator()(f32x16 (&acc)[2][2], int mt, int nt, int wr, int wc, int lane, char*) const {
    const int r = lane & 31, h = lane >> 5, nb = nt * 128 + 64 * wc;
#pragma unroll
    for (int ms = 0; ms < 2; ++ms) {
      const int row = mt * 128 + 64 * wr + 32 * ms + r;
      const float rs = row_rstd(p.part, row);
      const int b = row >> 13, t = row & 8191;
      if (nb < 2048) {
        const bool isq = nb < 1024;
        norm_store<false>(acc[ms], rs, isq ? p.a_q_gain : p.a_k_gain, 0, (isq ? p.qb : p.kb) + ((size_t)(b * 16 + ((nb & 1023) >> 6)) * T_ + t) * 64, h);
      } else if (nb < 3072) {
        const int head = (nb - 2048) >> 6;
        bf16_t* dst = p.vT + ((size_t)((b * 16 + head) * 128 + (t >> 6))) * 4096 + (t & 63);
#pragma unroll
        for (int ns = 0; ns < 2; ++ns)
#pragma unroll
          for (int i = 0; i < 16; ++i) dst[(32 * ns + crow(i, h)) * 64] = f2bf(acc[ms][ns][i] * rs);
      } else if (nb == 3072) {
#pragma unroll
        for (int i = 0; i < 8; ++i) {
          const int head = crow(i, h);
          const float z = acc[ms][0][i] * rs + p.a_b_f[head];
          p.lf[((size_t)(b * 16 + head)) * T_ + t] = fminf(z, 0.f) - log1pf(expf(-fabsf(z)));
        }
      }
    }
  }
};

struct EpiResid {
  const float* res; float* out; bf16_t* hb; float* part;
  DI void operator()(f32x16 (&acc)[2][2], int mt, int nt, int wr, int wc, int lane, char* smem) const {
    float* sU = (float*)smem;
    const int r = lane & 31, h = lane >> 5, tid = threadIdx.x;
    __syncthreads();
#pragma unroll
    for (int ms = 0; ms < 2; ++ms) {
      const int ml = 64 * wr + 32 * ms + r;
#pragma unroll
      for (int ns = 0; ns < 2; ++ns)
#pragma unroll
        for (int i = 0; i < 16; ++i) sU[ml * 132 + 64 * wc + 32 * ns + crow(i, h)] = acc[ms][ns][i];
    }
    __syncthreads();
    const int c4 = (tid & 31) * 4, n = nt * 128 + c4;
#pragma unroll 1
    for (int hh = 0; hh < 2; ++hh) {
      f32x4 rv[8];
#pragma unroll
      for (int it = 0; it < 8; ++it) rv[it] = *(const f32x4*)(res + (size_t)(mt * 128 + (hh * 8 + it) * 8 + (tid >> 5)) * 1024 + n);
#pragma unroll
      for (int it = 0; it < 8; ++it) {
        const int rl = (hh * 8 + it) * 8 + (tid >> 5), row = mt * 128 + rl;
        const f32x4 o = rv[it] + *(const f32x4*)(sU + rl * 132 + c4);
        *(f32x4*)(out + (size_t)row * 1024 + n) = o;
        store_bf4(hb + a_off(row, n, 16), o.x, o.y, o.z, o.w);
        float ss = o.x * o.x + o.y * o.y + o.z * o.z + o.w * o.w;
        ss += __shfl_xor(ss, 1); ss += __shfl_xor(ss, 2); ss += __shfl_xor(ss, 4); ss += __shfl_xor(ss, 8); ss += __shfl_xor(ss, 16);
        if ((tid & 31) == 0) { part[(size_t)row * 16 + nt * 2] = ss; part[(size_t)row * 16 + nt * 2 + 1] = 0.f; }
      }
    }
  }
};

struct EpiFfnUp {
  const float* part; const float* cw; const float* cb; bf16_t* act;
  DI void operator()(f32x16 (&acc)[2][2], int mt, int nt, int wr, int wc, int lane, char* smem) const {
    float* sU = (float*)smem;
    const int r = lane & 31, h = lane >> 5, tid = threadIdx.x;
    const int b = mt / 66, it = mt - b * 66, tb = 126 * it - 2;
    __syncthreads();
#pragma unroll
    for (int ms = 0; ms < 2; ++ms) {
      const int ml = 64 * wr + 32 * ms + r, t = tb + ml;
      const float rs = (t >= 0 && t < T_) ? row_rstd(part, b * T_ + t) : 0.f;
#pragma unroll
      for (int ns = 0; ns < 2; ++ns)
#pragma unroll
        for (int i = 0; i < 16; ++i) sU[ml * 129 + 64 * wc + 32 * ns + crow(i, h)] = acc[ms][ns][i] * rs;
    }
    __syncthreads();
    const int jj = tid & 63, rg = tid >> 6, j = nt * 64 + jj;
    const float wg0 = cw[j], wg1 = cw[5632 + j], wg2 = cw[2 * 5632 + j], bgt = cb[j];
    const float wv0 = cw[FF + j], wv1 = cw[5632 + FF + j], wv2 = cw[2 * 5632 + FF + j], bvl = cb[FF + j];
    for (int ml = 2 + rg; ml < 128; ml += 4) {
      const int t = tb + ml;
      if (t >= T_) break;
      const float g = bgt + wg0 * sU[(ml - 2) * 129 + jj] + wg1 * sU[(ml - 1) * 129 + jj] + wg2 * sU[ml * 129 + jj];
      const float v = bvl + wv0 * sU[(ml - 2) * 129 + 64 + jj] + wv1 * sU[(ml - 1) * 129 + 64 + jj] + wv2 * sU[ml * 129 + 64 + jj];
      const float a = g / (1.0f + __expf(-g)) * v;
      act[a_off(b * T_ + t, j, 44)] = f2bf(a);
    }
  }
};

struct EpiKv {
  const Params& p;
  DI void operator()(f32x16 (&acc)[2][2], int mt, int nt, int wr, int wc, int lane, char*) const {
    const int r = lane & 31, h = lane >> 5, g = wc;
#pragma unroll
    for (int ms = 0; ms < 2; ++ms) {
      const int row = mt * 128 + 64 * wr + 32 * ms + r;
      const float rs = row_rstd(p.part, row);
      const int b = row >> 13, t = row & 8191, bg = b * 2 + g;
      if (nt < 2) {
        bf16_t* dst = p.rawc + (((size_t)(nt * 8 + bg)) * T_ + t) * 64;
#pragma unroll
        for (int ns = 0; ns < 2; ++ns)
#pragma unroll
          for (int q = 0; q < 4; ++q)
            store_bf4(dst + 32 * ns + 8 * q + 4 * h, acc[ms][ns][4 * q] * rs, acc[ms][ns][4 * q + 1] * rs, acc[ms][ns][4 * q + 2] * rs, acc[ms][ns][4 * q + 3] * rs);
      } else if (nt == 2 || nt == 4) {
        norm_store<true>(acc[ms], rs, nt == 2 ? p.ks_gain : p.kw_gain, p.pos[row], (nt == 2 ? p.ksb : p.kwb) + ((size_t)bg * T_ + t) * 64, h);
      } else if (nt == 3) {
        bf16_t* dst = p.vsT + ((size_t)bg * 128 + (t >> 6)) * 4096 + (t & 63);
#pragma unroll
        for (int ns = 0; ns < 2; ++ns)
#pragma unroll
          for (int i = 0; i < 16; ++i) dst[(32 * ns + crow(i, h)) * 64] = f2bf(acc[ms][ns][i] * rs);
      } else {
        bf16_t* dst = p.vwT + ((size_t)bg * 128 + (t >> 6)) * 4096 + (t & 63);
#pragma unroll
        for (int ns = 0; ns < 2; ++ns)
#pragma unroll
          for (int i = 0; i < 16; ++i) dst[(32 * ns + crow(i, h)) * 64] = f2bf(acc[ms][ns][i] * rs);
      }
    }
  }
};

struct EpiBIn {
  const Params& p;
  DI void operator()(f32x16 (&acc)[2][2], int mt, int nt, int wr, int wc, int lane, char*) const {
    const int r = lane & 31, h = lane >> 5, nb = nt * 128 + 64 * wc;
#pragma unroll
    for (int ms = 0; ms < 2; ++ms) {
      const int row = mt * 128 + 64 * wr + 32 * ms + r;
      const float rs = row_rstd(p.part, row);
      if (nb < 1024) {
        norm_store<true>(acc[ms], rs, p.b_q_gain, p.pos[row], p.qn + (size_t)row * 1024 + nb, h);
      } else if (nb == 1024) {
#pragma unroll
        for (int ns = 0; ns < 2; ++ns)
#pragma unroll
          for (int i = 0; i < 16; ++i) {
            const int c = 32 * ns + crow(i, h);
            if (c < 48) { const float z = acc[ms][ns][i] * rs + p.b_b_gate[c]; p.gates[(size_t)row * 48 + c] = 1.0f / (1.0f + __expf(-z)); }
          }
      }
    }
  }
};

struct EpiCmp1P {
  float* dst;
  DI void operator()(f32x16 (&acc)[2][2], int mt, int nt, int wr, int wc, int lane, char*) const {
    const int r = lane & 31, h = lane >> 5;
#pragma unroll
    for (int ms = 0; ms < 2; ++ms) {
      const int m = mt * 128 + 64 * wr + 32 * ms + r;
#pragma unroll
      for (int ns = 0; ns < 2; ++ns)
#pragma unroll
        for (int q = 0; q < 4; ++q) {
          f32x4 v = {acc[ms][ns][4 * q], acc[ms][ns][4 * q + 1], acc[ms][ns][4 * q + 2], acc[ms][ns][4 * q + 3]};
          *(f32x4*)(dst + (size_t)m * 256 + nt * 128 + 64 * wc + 32 * ns + 8 * q + 4 * h) = v;
        }
    }
  }
};
DI float gelu_tanh(float x) { return 0.5f * x * (1.0f + tanhf(0.7978845608028654f * (x + 0.044715f * x * x * x))); }
struct ALCmp2P {
  const float* P;
  DI u32x4 operator()(int mt, int ml, int k) const {
    const int m = mt * 128 + ml;
    if (m >= 4088) return (u32x4){0, 0, 0, 0};
    f32x4 a = {0.f, 0.f, 0.f, 0.f}, b = {0.f, 0.f, 0.f, 0.f};
#pragma unroll
    for (int s4 = 0; s4 < 4; ++s4) {
      const float* q = P + ((size_t)s4 * 4096 + m) * 256 + k;
      a += *(const f32x4*)q; b += *(const f32x4*)(q + 4);
    }
    u32x4 o;
    o.x = pack2(gelu_tanh(a.x), gelu_tanh(a.y)); o.y = pack2(gelu_tanh(a.z), gelu_tanh(a.w));
    o.z = pack2(gelu_tanh(b.x), gelu_tanh(b.y)); o.w = pack2(gelu_tanh(b.z), gelu_tanh(b.w));
    return o;
  }
};

struct EpiCmp1 {
  bf16_t* hid;
  DI void operator()(f32x16 (&acc)[2][2], int mt, int nt, int wr, int wc, int lane, char*) const {
    const int r = lane & 31, h = lane >> 5;
#pragma unroll
    for (int ms = 0; ms < 2; ++ms) {
      const int m = mt * 128 + 64 * wr + 32 * ms + r;
      if (m >= 4088) continue;
#pragma unroll
      for (int ns = 0; ns < 2; ++ns) {
        float g[16];
#pragma unroll
        for (int i = 0; i < 16; ++i) { const float x = acc[ms][ns][i]; g[i] = 0.5f * x * (1.0f + tanhf(0.7978845608028654f * (x + 0.044715f * x * x * x))); }
#pragma unroll
        for (int q = 0; q < 4; ++q) store_bf4(hid + (size_t)m * 256 + nt * 128 + 64 * wc + 32 * ns + 8 * q + 4 * h, g[4 * q], g[4 * q + 1], g[4 * q + 2], g[4 * q + 3]);
      }
    }
  }
};

struct EpiCmp2 {
  const Params& p; int sel;
  DI void operator()(f32x16 (&acc)[2][2], int mt, int nt, int wr, int wc, int lane, char*) const {
    if (wc != 0) return;
    const int r = lane & 31, h = lane >> 5;
#pragma unroll
    for (int ms = 0; ms < 2; ++ms) {
      const int m = mt * 128 + 64 * wr + 32 * ms + r;
      if (m < 4088) {
        const int bg = m / 511, n = m - bg * 511, b = bg >> 1;
        if (sel == 0) {
          norm_store<true>(acc[ms], 1.0f, p.kc_gain, p.pos[b * T_ + 16 * n + 31], p.kcb + ((size_t)bg * 512 + n) * 64, h);
        } else {
          bf16_t* dst = p.vcT + ((size_t)(bg * 8 + (n >> 6))) * 4096 + (n & 63);
#pragma unroll
          for (int ns = 0; ns < 2; ++ns)
#pragma unroll
            for (int i = 0; i < 16; ++i) dst[(32 * ns + crow(i, h)) * 64] = f2bf(acc[ms][ns][i]);
        }
      } else {
      }
    }
  }
};

DI void phase_scan(const Params& p, char* smem) {
  float* sW = (float*)smem;
  const int tid = threadIdx.x, lane = tid & 63, w = tid >> 6;
  for (int seq = blockIdx.x; seq < 64; seq += gridDim.x) {
    const float* src = p.lf + (size_t)seq * T_ + tid * 32;
    float* dst = p.cc + (size_t)seq * T_ + tid * 32;
    f32x4 v[8];
#pragma unroll
    for (int i = 0; i < 8; ++i) v[i] = *(const f32x4*)(src + 4 * i);
    float s = 0.f;
#pragma unroll
    for (int i = 0; i < 8; ++i) { s += v[i].x; s += v[i].y; s += v[i].z; s += v[i].w; }
    float inc = s;
#pragma unroll
    for (int o = 1; o < 64; o <<= 1) { const float u = __shfl_up(inc, o); if (lane >= o) inc += u; }
    __syncthreads();
    if (lane == 63) sW[w] = inc;
    __syncthreads();
    float run = inc - s;
    for (int q = 0; q < w; ++q) run += sW[q];
#pragma unroll
    for (int i = 0; i < 8; ++i) {
      f32x4 o;
      run += v[i].x; o.x = run; run += v[i].y; o.y = run; run += v[i].z; o.z = run; run += v[i].w; o.w = run;
      *(f32x4*)(dst + 4 * i) = o;
    }
  }
}

template <int MODE>
DI void flash_step(f32x16 (&o)[2], float& l, const bf16x8 (&qf)[4], const bf16_t* sK, const bf16_t* sV, const float* sC,
                   int kbase, int tq, float bias0, float inv_l, float* sImpRow, int lane, bool selok = true) {
  const int r = lane & 31, h = lane >> 5;
  constexpr float SC = 0.125f * 1.4426950408889634f;
  const int base_hi = (MODE == 2 || MODE == 3) ? ((tq - 31) >> 4) : tq;
#pragma unroll
  for (int sub = 0; sub < 2; ++sub) {
    f32x16 s;
#pragma unroll
    for (int i = 0; i < 16; ++i) s[i] = 0.f;
#pragma unroll
    for (int ks = 0; ks < 4; ++ks) {
      const bf16x8 a = *(const bf16x8*)(sK + (32 * sub + r) * 72 + 16 * ks + 8 * h);
      s = mfma32(a, qf[ks], s);
    }
    int hi = base_hi - kbase - 32 * sub - 4 * h;
    if (MODE == 4 && !selok) hi = -1;
    const int lo = (MODE == 1) ? hi - 511 : -1000000;
    const bool nomask = __all((hi >= 27) && (lo <= 0));
    if (MODE == 0) {
#pragma unroll
      for (int q = 0; q < 4; ++q) {
        const f32x4 c4 = *(const f32x4*)(sC + 32 * sub + 8 * q + 4 * h);
#pragma unroll
        for (int j = 0; j < 4; ++j) s[4 * q + j] = fmaf(s[4 * q + j], SC, bias0 - c4[j]);
      }
    } else {
#pragma unroll
      for (int i = 0; i < 16; ++i) s[i] = fmaf(s[i], SC, bias0);
    }
    if (!nomask) {
#pragma unroll
      for (int i = 0; i < 16; ++i) { const int cst = (i & 3) + 8 * (i >> 2); s[i] = (cst <= hi && cst >= lo) ? s[i] : -1e30f; }
    }
    float ls = 0.f;
#pragma unroll
    for (int i = 0; i < 16; ++i) { const float pv = __builtin_amdgcn_exp2f(s[i]); s[i] = pv; ls += pv; }
    l += ls;
    if (MODE == 2) continue;
    if (MODE == 3) {
#pragma unroll
      for (int q = 0; q < 4; ++q) {
        const float p3 = s[4 * q + 3] * inv_l;
        float A = (s[4 * q] + s[4 * q + 1] + s[4 * q + 2]) * inv_l + 0.5f * p3, B = 0.5f * p3;
        A += __shfl_xor(A, 1); A += __shfl_xor(A, 2); A += __shfl_xor(A, 4);
        B += __shfl_xor(B, 1); B += __shfl_xor(B, 2); B += __shfl_xor(B, 4);
        if ((r & 7) == 0) { const int j = ((kbase + 32 * sub) >> 2) + 2 * q + h; atomicAdd(&sImpRow[j], A); atomicAdd(&sImpRow[j + 1], B); }
      }
    }
#pragma unroll
    for (int st = 0; st < 2; ++st) {
      u32x4 pk;
      pk.x = pack2(s[8 * st + 0], s[8 * st + 1]); pk.y = pack2(s[8 * st + 2], s[8 * st + 3]);
      pk.z = pack2(s[8 * st + 4], s[8 * st + 5]); pk.w = pack2(s[8 * st + 6], s[8 * st + 7]);
      const bf16x8 pf = __builtin_bit_cast(bf16x8, pk);
#pragma unroll
      for (int d = 0; d < 2; ++d) {
        const bf16_t* vp = sV + (32 * d + r) * 72 + 32 * sub + 16 * st + 4 * h;
        const bf16x4 lo4 = *(const bf16x4*)vp, hi4 = *(const bf16x4*)(vp + 8);
        const bf16x8 vf = __builtin_shufflevector(lo4, hi4, 0, 1, 2, 3, 4, 5, 6, 7);
        o[d] = mfma32(vf, pf, o[d]);
      }
    }
  }
}

DI void tile_load(u32x4 (&kr)[2], u32x4 (&vr)[2], const bf16_t* kptr, int kstride, const bf16_t* vptr, int vstride, bool withV, int tid) {
#pragma unroll
  for (int i = 0; i < 2; ++i) {
    const int c = tid + 256 * i, row = c >> 3, ch = (c & 7) * 8;
    kr[i] = *(const u32x4*)(kptr + (size_t)row * kstride + ch);
    if (withV) vr[i] = *(const u32x4*)(vptr + (size_t)row * vstride + ch);
  }
}
DI void tile_store(const u32x4 (&kr)[2], const u32x4 (&vr)[2], bf16_t* sK, bf16_t* sV, bool withV, int tid) {
#pragma unroll
  for (int i = 0; i < 2; ++i) {
    const int c = tid + 256 * i, row = c >> 3, ch = (c & 7) * 8;
    *(u32x4*)(sK + row * 72 + ch) = kr[i];
    if (withV) *(u32x4*)(sV + row * 72 + ch) = vr[i];
  }
}

DI void phase_fox(const Params& p, char* smem) {
  bf16_t* sK = (bf16_t*)smem; bf16_t* sV = sK + 64 * 72; float* sC = (float*)(sV + 64 * 72);
  const int tid = threadIdx.x, lane = tid & 63, w = tid >> 6, r = lane & 31, h = lane >> 5;
  float gq = 0.f, gk = 0.f;
  for (int i = 0; i < 64; ++i) { gq = fmaxf(gq, fabsf(p.a_q_gain[i])); gk = fmaxf(gk, fabsf(p.a_k_gain[i])); }
  const float smax = 8.0f * gq * gk * 1.05f;
  const float thr = 40.0f + 2.0f * smax;
  const float negM2 = -smax * 1.4426950408889634f;
  for (int item = blockIdx.x; item < 4096; item += gridDim.x) {
    const int bh = item & 63, qt = 63 - (item >> 6), b = bh >> 4, head = bh & 15, t0 = qt * 128;
    const int tq = t0 + 32 * w + r;
    const bf16_t* qrow = p.qb + ((size_t)bh * T_ + tq) * 64;
    bf16x8 qf[4];
#pragma unroll
    for (int ks = 0; ks < 4; ++ks) qf[ks] = *(const bf16x8*)(qrow + 16 * ks + 8 * h);
    const float* cseq = p.cc + (size_t)bh * T_;
    const float cq = cseq[tq] * 1.4426950408889634f, c0 = cseq[t0];
    const bf16_t* kbp = p.kb + (size_t)bh * T_ * 64;
    const bf16_t* vbp = p.vT + (size_t)bh * 128 * 4096;
    f32x16 o[2];
#pragma unroll
    for (int d = 0; d < 2; ++d)
#pragma unroll
      for (int i = 0; i < 16; ++i) o[d][i] = 0.f;
    float l = 0.f;
    u32x4 kr[2], vr[2]; f32x4 cr = (f32x4){0.f, 0.f, 0.f, 0.f};
    int jt = 2 * qt + 1;
    tile_load(kr, vr, kbp + (size_t)jt * 4096, 64, vbp + (size_t)jt * 4096, 64, true, tid);
    if (tid < 16) cr = *(const f32x4*)(cseq + 64 * jt + 4 * tid);
    for (; jt >= 0; --jt) {
      const int kbase = 64 * jt;
      if (c0 - cseq[kbase + 63] < -thr) break;
      __syncthreads();
      tile_store(kr, vr, sK, sV, true, tid);
      if (tid < 16) *(f32x4*)(sC + 4 * tid) = cr * 1.4426950408889634f;
      __syncthreads();
      if (jt > 0) {
        tile_load(kr, vr, kbp + (size_t)(jt - 1) * 4096, 64, vbp + (size_t)(jt - 1) * 4096, 64, true, tid);
        if (tid < 16) cr = *(const f32x4*)(cseq + 64 * (jt - 1) + 4 * tid);
      }
      if (kbase <= t0 + 32 * w + 31) flash_step<0>(o, l, qf, sK, sV, sC, kbase, tq, cq + negM2, 0.f, nullptr, lane);
    }
    const float lt = l + __shfl_xor(l, 32);
    const float inv = 1.0f / lt;
    bf16_t* orow = p.ob + a_off(b * T_ + tq, head * 64, 16);
#pragma unroll
    for (int d = 0; d < 2; ++d)
#pragma unroll
      for (int q = 0; q < 4; ++q) store_bf4(orow + 32 * d + 8 * q + 4 * h, o[d][4 * q] * inv, o[d][4 * q + 1] * inv, o[d][4 * q + 2] * inv, o[d][4 * q + 3] * inv);
  }
}

DI void phase_nsa(const Params& p, char* smem) {
  bf16_t* sK = (bf16_t*)smem; bf16_t* sV = sK + 64 * 72;
  float* sImp = (float*)(sV + 64 * 72);
  float* sO = sImp + 16 * 132;
  unsigned* sMask = (unsigned*)(sO + 128 * 65);
  int* sList = (int*)(sMask + 64);
  const int tid = threadIdx.x, lane = tid & 63, w = tid >> 6, r = lane & 31, h = lane >> 5;
  float gqm = 0.f, gkm = 0.f;
  for (int i = 0; i < 64; ++i) { gqm = fmaxf(gqm, fabsf(p.b_q_gain[i])); gkm = fmaxf(gkm, fmaxf(fabsf(p.kc_gain[i]), fmaxf(fabsf(p.ks_gain[i]), fabsf(p.kw_gain[i])))); }
  const float negM2 = -8.0f * gqm * gkm * 1.05f * 1.4426950408889634f;
  for (int item = blockIdx.x; item < 4096; item += gridDim.x) {
    const int bg = item & 7, tt = 511 - (item >> 3), b = bg >> 1, g = bg & 1, t0 = tt * 16;
    const int tokl = 4 * w + (r >> 3), head = r & 7, tq = t0 + tokl;
    __syncthreads();
    for (int i = tid; i < 16 * 132; i += 256) sImp[i] = 0.f;
    bf16x8 qf[4];
    {
      const bf16_t* qrow = p.qn + ((size_t)b * T_ + tq) * 1024 + (g * 8 + head) * 64;
#pragma unroll
      for (int ks = 0; ks < 4; ++ks) qf[ks] = *(const bf16x8*)(qrow + 16 * ks + 8 * h);
    }
    const float* grow = p.gates + ((size_t)b * T_ + tq) * 48 + g * 8 + head;
    const float gate_c = grow[0], gate_w = grow[32];
    f32x16 o[2];
    float l = 0.f;
    u32x4 kr[2], vr[2];
    const int ncmp = t0 >> 4, nct = (ncmp + 63) >> 6;
    const bf16_t* kcp = p.kcb + (size_t)bg * 512 * 64;
    const bf16_t* vcp = p.vcT + (size_t)bg * 8 * 4096;
    if (nct > 0) tile_load(kr, vr, kcp, 64, vcp, 64, false, tid);
    for (int jt = 0; jt < nct; ++jt) {
      __syncthreads();
      tile_store(kr, vr, sK, sV, false, tid);
      __syncthreads();
      if (jt + 1 < nct) tile_load(kr, vr, kcp + (size_t)(jt + 1) * 4096, 64, vcp, 64, false, tid);
      flash_step<2>(o, l, qf, sK, sV, nullptr, 64 * jt, tq, negM2, 0.f, nullptr, lane);
    }
    const float lc = l + __shfl_xor(l, 32);
    const float inv_lc = lc > 0.f ? 1.0f / lc : 0.f;
#pragma unroll
    for (int d = 0; d < 2; ++d)
#pragma unroll
      for (int i = 0; i < 16; ++i) o[d][i] = 0.f;
    float l2 = 0.f;
    if (nct > 0) tile_load(kr, vr, kcp, 64, vcp, 64, true, tid);
    for (int jt = 0; jt < nct; ++jt) {
      __syncthreads();
      tile_store(kr, vr, sK, sV, true, tid);
      __syncthreads();
      if (jt + 1 < nct) tile_load(kr, vr, kcp + (size_t)(jt + 1) * 4096, 64, vcp + (size_t)(jt + 1) * 4096, 64, true, tid);
      flash_step<3>(o, l2, qf, sK, sV, nullptr, 64 * jt, tq, negM2, inv_lc, sImp + tokl * 132, lane);
    }
    {
      const float sc = gate_c * inv_lc;
      float* orow = sO + (32 * w + r) * 65;
#pragma unroll
      for (int d = 0; d < 2; ++d)
#pragma unroll
        for (int i = 0; i < 16; ++i) orow[32 * d + crow(i, h)] = o[d][i] * sc;
    }
    __syncthreads();
    const int cur = t0 >> 6;
    for (int tk = 0; tk < 4; ++tk) {
      const int tok = 4 * w + tk;
      float* sc = sImp + tok * 132;
      for (int j = lane; j <= cur; j += 64) if (j == 0 || j == cur || j == cur - 1) sc[j] = 1e6f;
    }
    __syncthreads();
    for (int tk = 0; tk < 4; ++tk) {
      const int tok = 4 * w + tk;
      const float* sc = sImp + tok * 132;
      unsigned long long mk0, mk1;
      {
        const int j = lane;
        const bool vj = j <= cur;
        const float sj = vj ? sc[j] : 0.f;
        int rank = 0;
        for (int i = 0; i <= cur; ++i) { const float si = sc[i]; rank += ((si > sj) || (si == sj && i < j)) ? 1 : 0; }
        mk0 = __ballot(vj && rank < 16);
      }
      {
        const int j = lane + 64;
        const bool vj = j <= cur;
        const float sj = vj ? sc[j] : 0.f;
        int rank = 0;
        for (int i = 0; i <= cur; ++i) { const float si = sc[i]; rank += ((si > sj) || (si == sj && i < j)) ? 1 : 0; }
        mk1 = __ballot(vj && rank < 16);
      }
      if (lane == 0) {
        sMask[tok * 4 + 0] = (unsigned)mk0; sMask[tok * 4 + 1] = (unsigned)(mk0 >> 32);
        sMask[tok * 4 + 2] = (unsigned)mk1; sMask[tok * 4 + 3] = (unsigned)(mk1 >> 32);
      }
    }
    __syncthreads();
    int n_un;
    {
      unsigned u0 = 0, u1 = 0, u2 = 0, u3 = 0;
      for (int tok = 0; tok < 16; ++tok) { u0 |= sMask[tok * 4]; u1 |= sMask[tok * 4 + 1]; u2 |= sMask[tok * 4 + 2]; u3 |= sMask[tok * 4 + 3]; }
      const int c0 = __popc(u0), c1 = __popc(u1), c2 = __popc(u2), c3 = __popc(u3);
      n_un = c0 + c1 + c2 + c3;
      if (tid < 128) {
        const int wd = tid >> 5, bit = tid & 31;
        const unsigned uw = wd == 0 ? u0 : wd == 1 ? u1 : wd == 2 ? u2 : u3;
        if ((uw >> bit) & 1u) {
          const int pre = (wd > 0 ? c0 : 0) + (wd > 1 ? c1 : 0) + (wd > 2 ? c2 : 0);
          sList[pre + __popc(uw & ((1u << bit) - 1u))] = tid;
        }
      }
    }
    __syncthreads();
#pragma unroll
    for (int d = 0; d < 2; ++d)
#pragma unroll
      for (int i = 0; i < 16; ++i) o[d][i] = 0.f;
    l = 0.f;
    {
      const bf16_t* ksp = p.ksb + (size_t)bg * T_ * 64;
      const bf16_t* vsp = p.vsT + (size_t)bg * 128 * 4096;
      {
        const int blk = sList[0];
        tile_load(kr, vr, ksp + (size_t)blk * 4096, 64, vsp + (size_t)blk * 4096, 64, true, tid);
      }
      for (int e = 0; e < n_un; ++e) {
        const int blk = sList[e];
        __syncthreads();
        tile_store(kr, vr, sK, sV, true, tid);
        __syncthreads();
        if (e + 1 < n_un) {
          const int nb = sList[e + 1];
          tile_load(kr, vr, ksp + (size_t)nb * 4096, 64, vsp + (size_t)nb * 4096, 64, true, tid);
        }
        const int wd = blk >> 5, bit = blk & 31;
        const unsigned wm = sMask[(4 * w) * 4 + wd] | sMask[(4 * w + 1) * 4 + wd] | sMask[(4 * w + 2) * 4 + wd] | sMask[(4 * w + 3) * 4 + wd];
        if ((wm >> bit) & 1u) {
          const bool selok = (sMask[tokl * 4 + wd] >> bit) & 1u;
          flash_step<4>(o, l, qf, sK, sV, nullptr, 64 * blk, tq, negM2, 0.f, nullptr, lane, selok);
        }
      }
      const float lt = l + __shfl_xor(l, 32);
      const float sc = grow[16] / lt;
      float* orow = sO + (32 * w + r) * 65;
#pragma unroll
      for (int d = 0; d < 2; ++d)
#pragma unroll
        for (int i = 0; i < 16; ++i) orow[32 * d + crow(i, h)] += o[d][i] * sc;
    }
#pragma unroll
    for (int d = 0; d < 2; ++d)
#pragma unroll
      for (int i = 0; i < 16; ++i) o[d][i] = 0.f;
    l = 0.f;
    {
      const int klo = t0 - 511 > 0 ? t0 - 511 : 0, jt0 = klo >> 6, jt1 = (t0 + 15) >> 6;
      const bf16_t* kwp = p.kwb + (size_t)bg * T_ * 64;
      const bf16_t* vwp = p.vwT + (size_t)bg * 128 * 4096;
      tile_load(kr, vr, kwp + (size_t)jt0 * 4096, 64, vwp + (size_t)jt0 * 4096, 64, true, tid);
      for (int jt = jt0; jt <= jt1; ++jt) {
        __syncthreads();
        tile_store(kr, vr, sK, sV, true, tid);
        __syncthreads();
        if (jt < jt1) tile_load(kr, vr, kwp + (size_t)(jt + 1) * 4096, 64, vwp + (size_t)(jt + 1) * 4096, 64, true, tid);
        flash_step<1>(o, l, qf, sK, sV, nullptr, 64 * jt, tq, negM2, 0.f, nullptr, lane);
      }
      const float lt = l + __shfl_xor(l, 32);
      const float sc = gate_w / lt;
      float* orow = sO + (32 * w + r) * 65;
#pragma unroll
      for (int d = 0; d < 2; ++d)
#pragma unroll
        for (int i = 0; i < 16; ++i) orow[32 * d + crow(i, h)] += o[d][i] * sc;
    }
    __syncthreads();
    for (int c = tid; c < 128 * 16; c += 256) {
      const int row = c >> 4, d4 = (c & 15) * 4, tok = row >> 3, hd = row & 7;
      const float* s = sO + row * 65 + d4;
      store_bf4(p.ob + a_off(b * T_ + t0 + tok, (g * 8 + hd) * 64 + d4, 16), s[0], s[1], s[2], s[3]);
    }
  }
}

#ifdef ONLY_PHASE
#define PH_ON(n) ((n) == ONLY_PHASE)
#else
#define PH_ON(n) true
#endif
#define REP_PHASE -1
#define PHASE(n, ...) \
  if (PH_ON(n) && ph_lo <= (n) && (n) < ph_hi) { __VA_ARGS__ } \
  if ((n) == REP_PHASE) { cg::this_grid().sync(); { __VA_ARGS__ } } \
  if (ph_lo <= (n) && (n) + 1 < ph_hi) cg::this_grid().sync();

__global__ void __launch_bounds__(256, 2) yoco_megakernel(KArgs ka, int ph_lo, int ph_hi) {
  __shared__ __attribute__((aligned(16))) char smem[SMEM_BYTES];
  Params p;
  fill_params(p, ka);
  PHASE(0, phase_prep(p, smem);)
  PHASE(1, { ALPlain al{p.hb, 16}; EpiFoxIn ep{p}; gemm_phase(al, p.w_ain, 1024, 256, 25, ep, smem); })
  PHASE(2, phase_scan(p, smem);)
  PHASE(3, phase_fox(p, smem);)
  PHASE(4, { ALPlain al{p.ob, 16}; EpiResid ep{p.x, p.out, p.hb, p.part}; gemm_phase(al, p.w_aout, 1024, 256, 8, ep, smem); })
  PHASE(5, { ALFfn al{p.hb}; EpiFfnUp ep{p.part, p.f_conv_w, p.f_conv_b, p.act}; gemm_phase(al, p.w_up0, 1024, 264, 44, ep, smem); })
  PHASE(6, { ALPlain al{p.act, 44}; EpiResid ep{p.out, p.out, p.hb, p.part}; gemm_phase(al, p.w_dn0, FF, 256, 8, ep, smem); })
  PHASE(7, {
    ALPlain al{p.hb, 16};
    { EpiKv ep{p}; gemm_phase(al, p.w_kv, 1024, 256, 6, ep, smem); }
    { EpiBIn ep{p}; gemm_phase(al, p.w_bin, 1024, 256, 9, ep, smem); }
  })
  PHASE(8, {
    for (int item = blockIdx.x; item < 512; item += gridDim.x) {
      const int sel = item & 1, ks4 = (item >> 1) & 3, nt = (item >> 3) & 1, mt = item >> 4;
      ALCmp1 al{p.rawc + (size_t)sel * 8 * T_ * 64, sel ? p.vc_pe : p.kc_pe};
      EpiCmp1P ep{p.hidp + (size_t)(sel * 4 + ks4) * 4096 * 256};
      gemm_tile(al, sel ? p.w_vc1 : p.w_kc1, 2048, mt, nt, ep, smem, ks4 * 8, 8);
    }
  })
  PHASE(9, {
    for (int item = blockIdx.x; item < 64; item += gridDim.x) {
      const int sel = item & 1, mt = item >> 1;
      ALCmp2P al{p.hidp + (size_t)sel * 4 * 4096 * 256};
      EpiCmp2 ep{p, sel};
      gemm_tile(al, sel ? p.w_vc2 : p.w_kc2, 256, mt, 0, ep, smem);
    }
  })
  PHASE(10, phase_nsa(p, smem);)
  PHASE(11, { ALPlain al{p.ob, 16}; EpiResid ep{p.out, p.out, p.hb, p.part}; gemm_phase(al, p.w_bout, 1024, 256, 8, ep, smem); })
  PHASE(12, { ALFfn al{p.hb}; EpiFfnUp ep{p.part, p.f_conv_w + 3 * 5632, p.f_conv_b + 5632, p.act}; gemm_phase(al, p.w_up1, 1024, 264, 44, ep, smem); })
  PHASE(13, { ALPlain al{p.act, 44}; EpiResid ep{p.out, p.out, p.hb, p.part}; gemm_phase(al, p.w_dn1, FF, 256, 8, ep, smem); })
}

extern "C" void kernel_launch(void* const* d_in, const int* in_sizes, int n_in, void* d_out, int out_size, void* d_ws, size_t ws_size, hipStream_t stream) {
  KArgs p{};
  for (int i = 0; i < 29; ++i) p.in[i] = d_in[i];
  p.out = (float*)d_out; p.ws = (char*)d_ws;
  static int grid_blocks = 0;
  if (!grid_blocks) {
    int dev = 0, cus = 0, per_cu = 0;
    hipGetDevice(&dev);
    hipDeviceGetAttribute(&cus, hipDeviceAttributeMultiprocessorCount, dev);
    hipOccupancyMaxActiveBlocksPerMultiprocessor(&per_cu, yoco_megakernel, 256, 0);
    if (per_cu > 2) per_cu = 2;
    if (per_cu < 1) per_cu = 1;
    grid_blocks = cus * per_cu;
    grid_blocks &= ~7;
  }
#if N_LAUNCH_SPLIT
  for (int ph = 0; ph < NPHASE; ++ph) {
    int lo = ph, hi = ph + 1;
    hipLaunchKernelGGL(yoco_megakernel, dim3(grid_blocks), dim3(256), 0, stream, p, lo, hi);
  }
#else
  int lo = 0, hi = NPHASE;
  void* args[] = {&p, &lo, &hi};
  hipError_t e = hipLaunchCooperativeKernel((void*)yoco_megakernel, dim3(grid_blocks), dim3(256), args, 0, stream);
  if (e != hipSuccess) fprintf(stderr, "cooperative launch failed: %s (grid %d)\n", hipGetErrorString(e), grid_blocks);
#endif
}
```

```cpp
#include <hip/hip_runtime.h>
#include <hip/hip_cooperative_groups.h>
#include <stdint.h>
#include <cstdio>
namespace cg = cooperative_groups;

#ifndef N_LAUNCH_SPLIT
#define N_LAUNCH_SPLIT 0
#endif

#define DI __device__ __forceinline__
typedef unsigned short bf16_t;
typedef short bf16x8 __attribute__((ext_vector_type(8)));
typedef short bf16x4 __attribute__((ext_vector_type(4)));
typedef float f32x16 __attribute__((ext_vector_type(16)));
typedef float f32x4 __attribute__((ext_vector_type(4)));
typedef unsigned u32x4 __attribute__((ext_vector_type(4)));
typedef unsigned u32x2 __attribute__((ext_vector_type(2)));

constexpr int T_ = 8192;
constexpr int NTOK = 32768;
constexpr int FF = 2816;
constexpr int NPHASE = 14;
constexpr int SMEM_BYTES = 73728;

struct Params {
  const float* x; const int* pos;
  const float *a_norm, *a_w_in, *a_b_f, *a_q_gain, *a_k_gain, *a_w_out;
  const float *kv_norm, *kv_w, *kc_pe, *vc_pe, *kc_w1, *kc_w2, *vc_w1, *vc_w2, *kc_gain, *ks_gain, *kw_gain;
  const float *b_norm, *b_w_in, *b_b_gate, *b_q_gain, *b_w_out;
  const float *f_norm, *f_w_up, *f_conv_w, *f_conv_b, *f_w_down;
  float* out;
  bf16_t *w_ain, *w_aout, *w_kv, *w_kc1, *w_vc1, *w_kc2, *w_vc2, *w_bin, *w_bout, *w_up0, *w_up1, *w_dn0, *w_dn1;
  bf16_t* hb; float* part; float* lf; float* cc; bf16_t* ob;
  bf16_t *qb, *kb, *vT; bf16_t* act;
  bf16_t *rawc, *ksb, *vsT, *kwb, *vwT, *qn; float* gates; bf16_t *hid, *kcb, *vcT; float* hidp; unsigned* bar;
};

typedef __bf16 bf16v2 __attribute__((ext_vector_type(2)));
typedef float f32x2 __attribute__((ext_vector_type(2)));
struct KArgs { const void* in[29]; float* out; char* ws; };
DI void fill_params(Params& p, const KArgs& ka) {
  p.x = (const float*)ka.in[0]; p.pos = (const int*)ka.in[1];
  p.a_norm = (const float*)ka.in[2]; p.a_w_in = (const float*)ka.in[3]; p.a_b_f = (const float*)ka.in[4]; p.a_q_gain = (const float*)ka.in[5];
  p.a_k_gain = (const float*)ka.in[6]; p.a_w_out = (const float*)ka.in[7]; p.kv_norm = (const float*)ka.in[8]; p.kv_w = (const float*)ka.in[9];
  p.kc_pe = (const float*)ka.in[10]; p.vc_pe = (const float*)ka.in[11]; p.kc_w1 = (const float*)ka.in[12]; p.kc_w2 = (const float*)ka.in[13];
  p.vc_w1 = (const float*)ka.in[14]; p.vc_w2 = (const float*)ka.in[15]; p.kc_gain = (const float*)ka.in[16]; p.ks_gain = (const float*)ka.in[17];
  p.kw_gain = (const float*)ka.in[18]; p.b_norm = (const float*)ka.in[19]; p.b_w_in = (const float*)ka.in[20]; p.b_b_gate = (const float*)ka.in[21];
  p.b_q_gain = (const float*)ka.in[22]; p.b_w_out = (const float*)ka.in[23]; p.f_norm = (const float*)ka.in[24]; p.f_w_up = (const float*)ka.in[25];
  p.f_conv_w = (const float*)ka.in[26]; p.f_conv_b = (const float*)ka.in[27]; p.f_w_down = (const float*)ka.in[28];
  p.out = ka.out;
  char* wsq = ka.ws;
#define TAKE(bytes) (wsq += (((size_t)(bytes)) + 255) & ~(size_t)255, wsq - ((((size_t)(bytes)) + 255) & ~(size_t)255))
  p.bar = (unsigned*)TAKE(16384);
  p.w_ain = (bf16_t*)TAKE((size_t)3200 * 1024 * 2); p.w_aout = (bf16_t*)TAKE((size_t)1024 * 1024 * 2); p.w_kv = (bf16_t*)TAKE((size_t)768 * 1024 * 2);
  p.w_kc1 = (bf16_t*)TAKE((size_t)256 * 2048 * 2); p.w_vc1 = (bf16_t*)TAKE((size_t)256 * 2048 * 2);
  p.w_kc2 = (bf16_t*)TAKE((size_t)128 * 256 * 2); p.w_vc2 = (bf16_t*)TAKE((size_t)128 * 256 * 2);
  p.w_bin = (bf16_t*)TAKE((size_t)1152 * 1024 * 2); p.w_bout = (bf16_t*)TAKE((size_t)1024 * 1024 * 2);
  p.w_up0 = (bf16_t*)TAKE((size_t)5632 * 1024 * 2); p.w_up1 = (bf16_t*)TAKE((size_t)5632 * 1024 * 2);
  p.w_dn0 = (bf16_t*)TAKE((size_t)1024 * FF * 2); p.w_dn1 = (bf16_t*)TAKE((size_t)1024 * FF * 2);
  p.hb = (bf16_t*)TAKE((size_t)NTOK * 1024 * 2); p.part = (float*)TAKE((size_t)NTOK * 16 * 4);
  p.lf = (float*)TAKE((size_t)64 * T_ * 4); p.cc = (float*)TAKE((size_t)64 * T_ * 4);
  p.ob = (bf16_t*)TAKE((size_t)NTOK * 1024 * 2);
  char* R = TAKE((size_t)NTOK * 1024 * 2 * 3);
#undef TAKE
  p.qb = (bf16_t*)R; p.kb = p.qb + (size_t)NTOK * 1024; p.vT = p.kb + (size_t)NTOK * 1024;
  p.act = (bf16_t*)R;
  {
    char* q = R;
    p.qn = (bf16_t*)q; q += (size_t)NTOK * 1024 * 2;
    p.rawc = (bf16_t*)q; q += (size_t)2 * 8 * T_ * 64 * 2;
    p.ksb = (bf16_t*)q; q += (size_t)8 * T_ * 64 * 2;
    p.vsT = (bf16_t*)q; q += (size_t)8 * T_ * 64 * 2;
    p.kwb = (bf16_t*)q; q += (size_t)8 * T_ * 64 * 2;
    p.vwT = (bf16_t*)q; q += (size_t)8 * T_ * 64 * 2;
    p.gates = (float*)q; q += (size_t)NTOK * 48 * 4;
    p.hid = (bf16_t*)q; q += (size_t)2 * 4096 * 256 * 2;
    p.kcb = (bf16_t*)q; q += (size_t)8 * 512 * 64 * 2;
    p.vcT = (bf16_t*)q; q += (size_t)8 * 64 * 512 * 2;
    p.hidp = (float*)q; q += (size_t)2 * 4 * 4096 * 256 * 4;
  }
}

DI bf16_t f2bf(float x) { return __builtin_bit_cast(bf16_t, (__bf16)x); }
DI unsigned pack2(float a, float b) { f32x2 v = {a, b}; return __builtin_bit_cast(unsigned, __builtin_convertvector(v, bf16v2)); }
DI float bf2f(bf16_t v) { return __uint_as_float(((unsigned)v) << 16); }
DI int crow(int i, int h) { return (i & 3) + 8 * (i >> 2) + 4 * h; }
DI f32x16 mfma32(bf16x8 a, bf16x8 b, f32x16 c) { return __builtin_amdgcn_mfma_f32_32x32x16_bf16(a, b, c, 0, 0, 0); }
DI f32x4 mfma16(bf16x8 a, bf16x8 b, f32x4 c) { return __builtin_amdgcn_mfma_f32_16x16x32_bf16(a, b, c, 0, 0, 0); }
DI float row_rstd(const float* part, int row) {
  const f32x4* q = (const f32x4*)(part + (size_t)row * 16);
  f32x4 a = q[0], b = q[1], c = q[2], d = q[3];
  float s = ((a.x + a.y) + (a.z + a.w)) + ((b.x + b.y) + (b.z + b.w)) + ((c.x + c.y) + (c.z + c.w)) + ((d.x + d.y) + (d.z + d.w));
  return rsqrtf(s * (1.0f / 1024.0f) + 1e-6f);
}
DI size_t a_off(int row, int k, int KB) { return (((size_t)((row >> 7) * KB + (k >> 6))) << 13) + ((row & 127) << 6) + (k & 63); }
DI void store_bf4(bf16_t* dst, float a, float b, float c, float d) { u32x2 v; v.x = pack2(a, b); v.y = pack2(c, d); *(u32x2*)dst = v; }

struct WJob { const float* src; bf16_t* dst; const float* gain; int K, Nsrc, Ndst, mode; };
DI WJob get_job(const Params& p, int j) {
  WJob w; w.gain = nullptr; w.mode = 0;
  switch (j) {
    case 0: w.src = p.a_w_in; w.dst = p.w_ain; w.gain = p.a_norm; w.K = 1024; w.Nsrc = 3088; w.Ndst = 3200; break;
    case 1: w.src = p.a_w_out; w.dst = p.w_aout; w.K = 1024; w.Nsrc = 1024; w.Ndst = 1024; break;
    case 2: w.src = p.kv_w; w.dst = p.w_kv; w.gain = p.kv_norm; w.K = 1024; w.Nsrc = 768; w.Ndst = 768; break;
    case 3: w.src = p.kc_w1; w.dst = p.w_kc1; w.K = 2048; w.Nsrc = 256; w.Ndst = 256; break;
    case 4: w.src = p.vc_w1; w.dst = p.w_vc1; w.K = 2048; w.Nsrc = 256; w.Ndst = 256; break;
    case 5: w.src = p.kc_w2; w.dst = p.w_kc2; w.K = 256; w.Nsrc = 64; w.Ndst = 128; break;
    case 6: w.src = p.vc_w2; w.dst = p.w_vc2; w.K = 256; w.Nsrc = 64; w.Ndst = 128; break;
    case 7: w.src = p.b_w_in; w.dst = p.w_bin; w.gain = p.b_norm; w.K = 1024; w.Nsrc = 1072; w.Ndst = 1152; break;
    case 8: w.src = p.b_w_out; w.dst = p.w_bout; w.K = 1024; w.Nsrc = 1024; w.Ndst = 1024; break;
    case 9: w.src = p.f_w_up; w.dst = p.w_up0; w.gain = p.f_norm; w.K = 1024; w.Nsrc = 5632; w.Ndst = 5632; w.mode = 1; break;
    case 10: w.src = p.f_w_up + (size_t)1024 * 5632; w.dst = p.w_up1; w.gain = p.f_norm + 1024; w.K = 1024; w.Nsrc = 5632; w.Ndst = 5632; w.mode = 1; break;
    case 11: w.src = p.f_w_down; w.dst = p.w_dn0; w.K = 2816; w.Nsrc = 1024; w.Ndst = 1024; break;
    default: w.src = p.f_w_down + (size_t)2816 * 1024; w.dst = p.w_dn1; w.K = 2816; w.Nsrc = 1024; w.Ndst = 1024; break;
  }
  return w;
}

DI void prep_load(const WJob& w, int t, int nkt, int tid, f32x4 (&v)[4], int& k0, int& n0d) {
  const int kt = t % nkt, nt = t / nkt;
  k0 = kt << 6; n0d = nt << 6;
  int sbase = n0d;
  if (w.mode == 1) { const int tile = n0d >> 7, half = (n0d >> 6) & 1; sbase = half * FF + tile * 64; }
#pragma unroll
  for (int i = 0; i < 4; ++i) {
    const int kk = (tid >> 4) + 16 * i, col = sbase + (tid & 15) * 4;
    v[i] = (f32x4){0.f, 0.f, 0.f, 0.f};
    if (col < w.Nsrc) v[i] = *(const f32x4*)(w.src + (size_t)(k0 + kk) * w.Nsrc + col);
    const float g = w.gain ? w.gain[k0 + kk] : 1.0f;
    v[i] *= g;
  }
}
DI void prep_lds(float* sT, const f32x4 (&v)[4], int tid) {
#pragma unroll
  for (int i = 0; i < 4; ++i) {
    const int kk = (tid >> 4) + 16 * i, nn = (tid & 15) * 4;
    sT[kk * 65 + nn + 0] = v[i].x; sT[kk * 65 + nn + 1] = v[i].y; sT[kk * 65 + nn + 2] = v[i].z; sT[kk * 65 + nn + 3] = v[i].w;
  }
}
DI void prep_out(const float* sT, const WJob& w, int k0, int n0d, int nkt, int tid) {
  const int n = tid >> 2, kseg = (tid & 3) * 16;
  unsigned o[8];
#pragma unroll
  for (int q = 0; q < 8; ++q) o[q] = pack2(sT[(kseg + 2 * q) * 65 + n], sT[(kseg + 2 * q + 1) * 65 + n]);
  u32x4* dst = (u32x4*)(w.dst + a_off(n0d + n, k0 + kseg, nkt));
  dst[0] = (u32x4){o[0], o[1], o[2], o[3]}; dst[1] = (u32x4){o[4], o[5], o[6], o[7]};
}

DI void phase_prep(const Params& p, char* smem) {
  float* sT0 = (float*)smem;
  float* sT1 = sT0 + 64 * 65;
  const int tid = threadIdx.x;
  {
    const int lane = tid & 63, gw = blockIdx.x * 4 + (tid >> 6), nw = gridDim.x * 4;
    for (int row0 = gw * 4; row0 < NTOK; row0 += nw * 4) {
      f32x4 v[4][4];
#pragma unroll
      for (int rr = 0; rr < 4; ++rr)
#pragma unroll
        for (int i = 0; i < 4; ++i) v[rr][i] = *(const f32x4*)(p.x + (size_t)(row0 + rr) * 1024 + i * 256 + lane * 4);
#pragma unroll
      for (int rr = 0; rr < 4; ++rr) {
        const int row = row0 + rr;
        float ss = 0.f;
#pragma unroll
        for (int i = 0; i < 4; ++i) {
          const f32x4 x = v[rr][i];
          ss += x.x * x.x + x.y * x.y + x.z * x.z + x.w * x.w;
          store_bf4(p.hb + a_off(row, i * 256 + lane * 4, 16), x.x, x.y, x.z, x.w);
        }
#pragma unroll
        for (int o = 32; o >= 1; o >>= 1) ss += __shfl_xor(ss, o);
        if (lane < 16) p.part[(size_t)row * 16 + lane] = lane == 0 ? ss : 0.f;
      }
    }
  }
  int base = 0;
  for (int j = 0; j < 13; ++j) {
    WJob w = get_job(p, j);
    const int nkt = w.K >> 6, nnt = w.Ndst >> 6, ntile = nkt * nnt, G = gridDim.x;
    int first = (int)blockIdx.x - (base % G); if (first < 0) first += G;
    for (int t = first; t < ntile; t += 2 * G) {
      const bool hasB = (t + G) < ntile;
      f32x4 va[4], vb[4]; int k0a, n0a, k0b = 0, n0b = 0;
      prep_load(w, t, nkt, tid, va, k0a, n0a);
      if (hasB) prep_load(w, t + G, nkt, tid, vb, k0b, n0b);
      __syncthreads();
      prep_lds(sT0, va, tid);
      if (hasB) prep_lds(sT1, vb, tid);
      __syncthreads();
      prep_out(sT0, w, k0a, n0a, nkt, tid);
      if (hasB) prep_out(sT1, w, k0b, n0b, nkt, tid);
    }
    base += ntile;
  }
  if (blockIdx.x == 0) {
    for (int i = tid; i < 8 * 64; i += 256) {
      const int bg = i >> 6, d = i & 63;
      p.kcb[((size_t)bg * 512 + 511) * 64 + d] = 0;
      p.vcT[((size_t)(bg * 8 + 7) * 64 + d) * 64 + 63] = 0;
    }
  }
}

template <class AL, class EP>
DI void gemm_tile(const AL& al, const bf16_t* __restrict__ Wt, int K, int mt, int nt, const EP& ep, char* smem, int kb0 = 0, int KBn = -1) {
  bf16_t* sbuf = (bf16_t*)smem;
  constexpr int STAGE = 2 * 128 * 72;
  const int tid = threadIdx.x, lane = tid & 63, wave = tid >> 6, wr = wave >> 1, wc = wave & 1, r = lane & 31, h = lane >> 5;
  const int KBt = K >> 6, KB = KBn < 0 ? KBt : KBn;
  const bf16_t* wbase = Wt + (((size_t)nt * KBt + kb0) << 13) + tid * 8;
  f32x16 acc[2][2];
#pragma unroll
  for (int a = 0; a < 2; ++a)
#pragma unroll
    for (int b = 0; b < 2; ++b)
#pragma unroll
      for (int i = 0; i < 16; ++i) acc[a][b][i] = 0.f;
  u32x4 xa[4], wa[4];
#define GEMM_LOAD(kb_)                                                                  \
  _Pragma("unroll") for (int i = 0; i < 4; ++i) {                                        \
    const int c = tid + 256 * i;                                                         \
    xa[i] = al(mt, c >> 3, (kb0 + (kb_)) * 64 + (c & 7) * 8);                                    \
    wa[i] = *(const u32x4*)(wbase + ((size_t)(kb_) << 13) + 2048 * i);                   \
  }
#define GEMM_STORE(st_)                                                                 \
  _Pragma("unroll") for (int i = 0; i < 4; ++i) {                                        \
    const int c = tid + 256 * i, row = c >> 3, kc = (c & 7) * 8;                         \
    *(u32x4*)(sbuf + (st_) * STAGE + row * 72 + kc) = xa[i];                             \
    *(u32x4*)(sbuf + (st_) * STAGE + 128 * 72 + row * 72 + kc) = wa[i];                  \
  }
#define GEMM_LDF(FW, FX, st_, ks_)                                                      \
  _Pragma("unroll") for (int q = 0; q < 2; ++q) {                                        \
    FW[q] = *(const bf16x8*)(sbuf + (st_) * STAGE + 128 * 72 + (64 * wc + 32 * q + r) * 72 + 16 * (ks_) + 8 * h); \
    FX[q] = *(const bf16x8*)(sbuf + (st_) * STAGE + (64 * wr + 32 * q + r) * 72 + 16 * (ks_) + 8 * h);            \
  }
#define GEMM_MM(FW, FX)                                                                 \
  _Pragma("unroll") for (int ms = 0; ms < 2; ++ms)                                       \
    _Pragma("unroll") for (int ns = 0; ns < 2; ++ns) acc[ms][ns] = mfma32(FW[ns], FX[ms], acc[ms][ns]);
  bf16x8 faw[2], fax[2], fbw[2], fbx[2];
  __syncthreads();
  GEMM_LOAD(0)
  GEMM_STORE(0)
  if (KB > 1) { GEMM_LOAD(1) }
  __syncthreads();
  GEMM_LDF(faw, fax, 0, 0)
  for (int it = 0; it < KB; ++it) {
    const int cur = it & 1;
    if (it + 1 < KB) { GEMM_STORE(cur ^ 1) }
    if (it + 2 < KB) { GEMM_LOAD(it + 2) }
    __builtin_amdgcn_sched_barrier(0);
    GEMM_LDF(fbw, fbx, cur, 1)
    __builtin_amdgcn_sched_barrier(0);
    GEMM_MM(faw, fax)
    __builtin_amdgcn_sched_barrier(0);
    GEMM_LDF(faw, fax, cur, 2)
    __builtin_amdgcn_sched_barrier(0);
    GEMM_MM(fbw, fbx)
    __builtin_amdgcn_sched_barrier(0);
    GEMM_LDF(fbw, fbx, cur, 3)
    __builtin_amdgcn_sched_barrier(0);
    GEMM_MM(faw, fax)
    __builtin_amdgcn_sched_barrier(0);
    __syncthreads();
    if (it + 1 < KB) { GEMM_LDF(faw, fax, cur ^ 1, 0) }
    __builtin_amdgcn_sched_barrier(0);
    GEMM_MM(fbw, fbx)
    __builtin_amdgcn_sched_barrier(0);
  }
#undef GEMM_LDF
#undef GEMM_MM
#undef GEMM_LOAD
#undef GEMM_STORE
  ep(acc, mt, nt, wr, wc, lane, smem);
}

template <class AL, class EP>
DI void gemm_phase(const AL& al, const bf16_t* Wt, int K, int numM, int numN, const EP& ep, char* smem) {
  const int xcd = blockIdx.x & 7, lb = blockIdx.x >> 3, nlb = gridDim.x >> 3;
  const int mper = (numM + 7) >> 3, fullr = mper >> 3, mrem = mper & 7;
  const int nfull = fullr * 8 * numN, total = mper * numN;
  for (int li = lb; li < total; li += nlb) {
    int nt, mtl;
    if (li < nfull) { const int s = li / (8 * numN), rem = li - s * 8 * numN; nt = rem >> 3; mtl = s * 8 + (rem & 7); }
    else { const int rem = li - nfull; nt = rem / mrem; mtl = fullr * 8 + (rem - nt * mrem); }
    const int mt = xcd * mper + mtl;
    if (mt >= numM) continue;
    gemm_tile(al, Wt, K, mt, nt, ep, smem);
  }
}

struct ALPlain { const bf16_t* A; int KB; DI u32x4 operator()(int mt, int ml, int k) const { return *(const u32x4*)(A + (((size_t)(mt * KB + (k >> 6))) << 13) + (ml << 6) + (k & 63)); } };
struct ALFfn {
  const bf16_t* A;
  DI u32x4 operator()(int mt, int ml, int k) const {
    const int b = mt / 66, it = mt - b * 66, t = 126 * it - 2 + ml;
    if (t < 0 || t >= T_) return (u32x4){0, 0, 0, 0};
    return *(const u32x4*)(A + a_off(b * T_ + t, k, 16));
  }
};
struct ALCmp1 {
  const bf16_t* raw; const float* pe;
  DI u32x4 operator()(int mt, int ml, int k) const {
    const int m = mt * 128 + ml;
    if (m >= 4088) return (u32x4){0, 0, 0, 0};
    const int bg = m / 511, n = m - bg * 511;
    u32x4 v = *(const u32x4*)(raw + ((size_t)bg * T_ + 16 * n) * 64 + k);
    const f32x4 p0 = *(const f32x4*)(pe + k), p1 = *(const f32x4*)(pe + k + 4);
    u32x4 o;
    o.x = pack2(bf2f((bf16_t)(v.x & 0xffff)) + p0.x, bf2f((bf16_t)(v.x >> 16)) + p0.y);
    o.y = pack2(bf2f((bf16_t)(v.y & 0xffff)) + p0.z, bf2f((bf16_t)(v.y >> 16)) + p0.w);
    o.z = pack2(bf2f((bf16_t)(v.z & 0xffff)) + p1.x, bf2f((bf16_t)(v.z >> 16)) + p1.y);
    o.w = pack2(bf2f((bf16_t)(v.w & 0xffff)) + p1.z, bf2f((bf16_t)(v.w >> 16)) + p1.w);
    return o;
  }
};
struct ALCmp2 { const bf16_t* A; DI u32x4 operator()(int mt, int ml, int k) const { const int m = mt * 128 + ml; if (m >= 4088) return (u32x4){0, 0, 0, 0}; return *(const u32x4*)(A + (size_t)m * 256 + k); } };

__device__ const float ROPE_INV[8] = {1.0f, 0.19392274474868576f, 0.03760603093086393f, 0.007292664737217109f, 0.001414213562373095f, 0.0002742481756762073f, 5.318295896944988e-05f, 1.031338537721246e-05f};

template <bool ROPE>
DI void norm_store(f32x16 (&a)[2], float rs, const float* gain, int pos, bf16_t* dst, int h) {
  float ss = 0.f;
#pragma unroll
  for (int ns = 0; ns < 2; ++ns)
#pragma unroll
    for (int i = 0; i < 16; ++i) { const float v = a[ns][i] * rs; a[ns][i] = v; ss += v * v; }
  ss += __shfl_xor(ss, 32);
  const float inv = rsqrtf(ss * (1.0f / 64.0f) + 1e-6f);
#pragma unroll
  for (int ns = 0; ns < 2; ++ns)
#pragma unroll
    for (int i = 0; i < 16; ++i) a[ns][i] = a[ns][i] * inv * gain[32 * ns + crow(i, h)];
  if (ROPE) {
    const float fp = (float)pos;
#pragma unroll
    for (int ii = 0; ii < 4; ++ii) {
      const float ang = fp * ROPE_INV[4 * h + ii];
      const float c = cosf(ang), s = sinf(ang);
      const float x1 = a[0][ii], x2 = a[0][4 + ii];
      a[0][ii] = x1 * c - x2 * s; a[0][4 + ii] = x2 * c + x1 * s;
    }
  }
#pragma unroll
  for (int ns = 0; ns < 2; ++ns)
#pragma unroll
    for (int q = 0; q < 4; ++q) store_bf4(dst + 32 * ns + 8 * q + 4 * h, a[ns][4 * q], a[ns][4 * q + 1], a[ns][4 * q + 2], a[ns][4 * q + 3]);
}

struct EpiFoxIn {
  const Params& p;
  DI void operator()(f32x16 (&acc)[2][2], int mt, int nt, int wr, int wc, int lane, char*) const {
    const int r = lane & 31, h = lane >> 5, nb = nt * 128 + 64 * wc;
#pragma unroll
    for (int ms = 0; ms < 2; ++ms) {
      const int row = mt * 128 + 64 * wr + 32 * ms + r;
      const float rs = row_rstd(p.part, row);
      const int b = row >> 13, t = row & 8191;
      if (nb < 2048) {
        const bool isq = nb < 1024;
        norm_store<false>(acc[ms], rs, isq ? p.a_q_gain : p.a_k_gain, 0, (isq ? p.qb : p.kb) + ((size_t)(b * 16 + ((nb & 1023) >> 6)) * T_ + t) * 64, h);
      } else if (nb < 3072) {
        const int head = (nb - 2048) >> 6;
        bf16_t* dst = p.vT + ((size_t)((b * 16 + head) * 128 + (t >> 6))) * 4096 + (t & 63);
#pragma unroll
        for (int ns = 0; ns < 2; ++ns)
#pragma unroll
          for (int i = 0; i < 16; ++i) dst[(32 * ns + crow(i, h)) * 64] = f2bf(acc[ms][ns][i] * rs);
      } else if (nb == 3072) {
#pragma unroll
        for (int i = 0; i < 8; ++i) {
          const int head = crow(i, h);
          const float z = acc[ms][0][i] * rs + p.a_b_f[head];
          p.lf[((size_t)(b * 16 + head)) * T_ + t] = fminf(z, 0.f) - log1pf(expf(-fabsf(z)));
        }
      }
    }
  }
};

struct EpiResid {
  const float* res; float* out; bf16_t* hb; float* part;
  DI void operator()(f32x16 (&acc)[2][2], int mt, int nt, int wr, int wc, int lane, char* smem) const {
    float* sU = (float*)smem;
    const int r = lane & 31, h = lane >> 5, tid = threadIdx.x;
    __syncthreads();
#pragma unroll
    for (int ms = 0; ms < 2; ++ms) {
      const int ml = 64 * wr + 32 * ms + r;
#pragma unroll
      for (int ns = 0; ns < 2; ++ns)
#pragma unroll
        for (int i = 0; i < 16; ++i) sU[ml * 132 + 64 * wc + 32 * ns + crow(i, h)] = acc[ms][ns][i];
    }
    __syncthreads();
    const int c4 = (tid & 31) * 4, n = nt * 128 + c4;
#pragma unroll 1
    for (int hh = 0; hh < 2; ++hh) {
      f32x4 rv[8];
#pragma unroll
      for (int it = 0; it < 8; ++it) rv[it] = *(const f32x4*)(res + (size_t)(mt * 128 + (hh * 8 + it) * 8 + (tid >> 5)) * 1024 + n);
#pragma unroll
      for (int it = 0; it < 8; ++it) {
        const int rl = (hh * 8 + it) * 8 + (tid >> 5), row = mt * 128 + rl;
        const f32x4 o = rv[it] + *(const f32x4*)(sU + rl * 132 + c4);
        *(f32x4*)(out + (size_t)row * 1024 + n) = o;
        store_bf4(hb + a_off(row, n, 16), o.x, o.y, o.z, o.w);
        float ss = o.x * o.x + o.y * o.y + o.z * o.z + o.w * o.w;
        ss += __shfl_xor(ss, 1); ss += __shfl_xor(ss, 2); ss += __shfl_xor(ss, 4); ss += __shfl_xor(ss, 8); ss += __shfl_xor(ss, 16);
        if ((tid & 31) == 0) { part[(size_t)row * 16 + nt * 2] = ss; part[(size_t)row * 16 + nt * 2 + 1] = 0.f; }
      }
    }
  }
};

struct EpiFfnUp {
  const float* part; const float* cw; const float* cb; bf16_t* act;
  DI void operator()(f32x16 (&acc)[2][2], int mt, int nt, int wr, int wc, int lane, char* smem) const {
    float* sU = (float*)smem;
    const int r = lane & 31, h = lane >> 5, tid = threadIdx.x;
    const int b = mt / 66, it = mt - b * 66, tb = 126 * it - 2;
    __syncthreads();
#pragma unroll
    for (int ms = 0; ms < 2; ++ms) {
      const int ml = 64 * wr + 32 * ms + r, t = tb + ml;
      const float rs = (t >= 0 && t < T_) ? row_rstd(part, b * T_ + t) : 0.f;
#pragma unroll
      for (int ns = 0; ns < 2; ++ns)
#pragma unroll
        for (int i = 0; i < 16; ++i) sU[ml * 129 + 64 * wc + 32 * ns + crow(i, h)] = acc[ms][ns][i] * rs;
    }
    __syncthreads();
    const int jj = tid & 63, rg = tid >> 6, j = nt * 64 + jj;
    const float wg0 = cw[j], wg1 = cw[5632 + j], wg2 = cw[2 * 5632 + j], bgt = cb[j];
    const float wv0 = cw[FF + j], wv1 = cw[5632 + FF + j], wv2 = cw[2 * 5632 + FF + j], bvl = cb[FF + j];
    for (int ml = 2 + rg; ml < 128; ml += 4) {
      const int t = tb + ml;
      if (t >= T_) break;
      const float g = bgt + wg0 * sU[(ml - 2) * 129 + jj] + wg1 * sU[(ml - 1) * 129 + jj] + wg2 * sU[ml * 129 + jj];
      const float v = bvl + wv0 * sU[(ml - 2) * 129 + 64 + jj] + wv1 * sU[(ml - 1) * 129 + 64 + jj] + wv2 * sU[ml * 129 + 64 + jj];
      const float a = g / (1.0f + __expf(-g)) * v;
      act[a_off(b * T_ + t, j, 44)] = f2bf(a);
    }
  }
};

struct EpiKv {
  const Params& p;
  DI void operator()(f32x16 (&acc)[2][2], int mt, int nt, int wr, int wc, int lane, char*) const {
    const int r = lane & 31, h = lane >> 5, g = wc;
#pragma unroll
    for (int ms = 0; ms < 2; ++ms) {
      const int row = mt * 128 + 64 * wr + 32 * ms + r;
      const float rs = row_rstd(p.part, row);
      const int b = row >> 13, t = row & 8191, bg = b * 2 + g;
      if (nt < 2) {
        bf16_t* dst = p.rawc + (((size_t)(nt * 8 + bg)) * T_ + t) * 64;
#pragma unroll
        for (int ns = 0; ns < 2; ++ns)
#pragma unroll
          for (int q = 0; q < 4; ++q)
            store_bf4(dst + 32 * ns + 8 * q + 4 * h, acc[ms][ns][4 * q] * rs, acc[ms][ns][4 * q + 1] * rs, acc[ms][ns][4 * q + 2] * rs, acc[ms][ns][4 * q + 3] * rs);
      } else if (nt == 2 || nt == 4) {
        norm_store<true>(acc[ms], rs, nt == 2 ? p.ks_gain : p.kw_gain, p.pos[row], (nt == 2 ? p.ksb : p.kwb) + ((size_t)bg * T_ + t) * 64, h);
      } else if (nt == 3) {
        bf16_t* dst = p.vsT + ((size_t)bg * 128 + (t >> 6)) * 4096 + (t & 63);
#pragma unroll
        for (int ns = 0; ns < 2; ++ns)
#pragma unroll
          for (int i = 0; i < 16; ++i) dst[(32 * ns + crow(i, h)) * 64] = f2bf(acc[ms][ns][i] * rs);
      } else {
        bf16_t* dst = p.vwT + ((size_t)bg * 128 + (t >> 6)) * 4096 + (t & 63);
#pragma unroll
        for (int ns = 0; ns < 2; ++ns)
#pragma unroll
          for (int i = 0; i < 16; ++i) dst[(32 * ns + crow(i, h)) * 64] = f2bf(acc[ms][ns][i] * rs);
      }
    }
  }
};

struct EpiBIn {
  const Params& p;
  DI void operator()(f32x16 (&acc)[2][2], int mt, int nt, int wr, int wc, int lane, char*) const {
    const int r = lane & 31, h = lane >> 5, nb = nt * 128 + 64 * wc;
#pragma unroll
    for (int ms = 0; ms < 2; ++ms) {
      const int row = mt * 128 + 64 * wr + 32 * ms + r;
      const float rs = row_rstd(p.part, row);
      if (nb < 1024) {
        norm_store<true>(acc[ms], rs, p.b_q_gain, p.pos[row], p.qn + (size_t)row * 1024 + nb, h);
      } else if (nb == 1024) {
#pragma unroll
        for (int ns = 0; ns < 2; ++ns)
#pragma unroll
          for (int i = 0; i < 16; ++i) {
            const int c = 32 * ns + crow(i, h);
            if (c < 48) { const float z = acc[ms][ns][i] * rs + p.b_b_gate[c]; p.gates[(size_t)row * 48 + c] = 1.0f / (1.0f + __expf(-z)); }
          }
      }
    }
  }
};

struct EpiCmp1P {
  float* dst;
  DI void operator()(f32x16 (&acc)[2][2], int mt, int nt, int wr, int wc, int lane, char*) const {
    const int r = lane & 31, h = lane >> 5;
#pragma unroll
    for (int ms = 0; ms < 2; ++ms) {
      const int m = mt * 128 + 64 * wr + 32 * ms + r;
#pragma unroll
      for (int ns = 0; ns < 2; ++ns)
#pragma unroll
        for (int q = 0; q < 4; ++q) {
          f32x4 v = {acc[ms][ns][4 * q], acc[ms][ns][4 * q + 1], acc[ms][ns][4 * q + 2], acc[ms][ns][4 * q + 3]};
          *(f32x4*)(dst + (size_t)m * 256 + nt * 128 + 64 * wc + 32 * ns + 8 * q + 4 * h) = v;
        }
    }
  }
};
DI float gelu_tanh(float x) { return 0.5f * x * (1.0f + tanhf(0.7978845608028654f * (x + 0.044715f * x * x * x))); }
struct ALCmp2P {
  const float* P;
  DI u32x4 operator()(int mt, int ml, int k) const {
    const int m = mt * 128 + ml;
    if (m >= 4088) return (u32x4){0, 0, 0, 0};
    f32x4 a = {0.f, 0.f, 0.f, 0.f}, b = {0.f, 0.f, 0.f, 0.f};
#pragma unroll
    for (int s4 = 0; s4 < 4; ++s4) {
      const float* q = P + ((size_t)s4 * 4096 + m) * 256 + k;
      a += *(const f32x4*)q; b += *(const f32x4*)(q + 4);
    }
    u32x4 o;
    o.x = pack2(gelu_tanh(a.x), gelu_tanh(a.y)); o.y = pack2(gelu_tanh(a.z), gelu_tanh(a.w));
    o.z = pack2(gelu_tanh(b.x), gelu_tanh(b.y)); o.w = pack2(gelu_tanh(b.z), gelu_tanh(b.w));
    return o;
  }
};

struct EpiCmp1 {
  bf16_t* hid;
  DI void operator()(f32x16 (&acc)[2][2], int mt, int nt, int wr, int wc, int lane, char*) const {
    const int r = lane & 31, h = lane >> 5;
#pragma unroll
    for (int ms = 0; ms < 2; ++ms) {
      const int m = mt * 128 + 64 * wr + 32 * ms + r;
      if (m >= 4088) continue;
#pragma unroll
      for (int ns = 0; ns < 2; ++ns) {
        float g[16];
#pragma unroll
        for (int i = 0; i < 16; ++i) { const float x = acc[ms][ns][i]; g[i] = 0.5f * x * (1.0f + tanhf(0.7978845608028654f * (x + 0.044715f * x * x * x))); }
#pragma unroll
        for (int q = 0; q < 4; ++q) store_bf4(hid + (size_t)m * 256 + nt * 128 + 64 * wc + 32 * ns + 8 * q + 4 * h, g[4 * q], g[4 * q + 1], g[4 * q + 2], g[4 * q + 3]);
      }
    }
  }
};

struct EpiCmp2 {
  const Params& p; int sel;
  DI void operator()(f32x16 (&acc)[2][2], int mt, int nt, int wr, int wc, int lane, char*) const {
    if (wc != 0) return;
    const int r = lane & 31, h = lane >> 5;
#pragma unroll
    for (int ms = 0; ms < 2; ++ms) {
      const int m = mt * 128 + 64 * wr + 32 * ms + r;
      if (m < 4088) {
        const int bg = m / 511, n = m - bg * 511, b = bg >> 1;
        if (sel == 0) {
          norm_store<true>(acc[ms], 1.0f, p.kc_gain, p.pos[b * T_ + 16 * n + 31], p.kcb + ((size_t)bg * 512 + n) * 64, h);
        } else {
          bf16_t* dst = p.vcT + ((size_t)(bg * 8 + (n >> 6))) * 4096 + (n & 63);
#pragma unroll
          for (int ns = 0; ns < 2; ++ns)
#pragma unroll
            for (int i = 0; i < 16; ++i) dst[(32 * ns + crow(i, h)) * 64] = f2bf(acc[ms][ns][i]);
        }
      } else {
      }
    }
  }
};

DI void phase_scan(const Params& p, char* smem) {
  float* sW = (float*)smem;
  const int tid = threadIdx.x, lane = tid & 63, w = tid >> 6;
  for (int seq = blockIdx.x; seq < 64; seq += gridDim.x) {
    const float* src = p.lf + (size_t)seq * T_ + tid * 32;
    float* dst = p.cc + (size_t)seq * T_ + tid * 32;
    f32x4 v[8];
#pragma unroll
    for (int i = 0; i < 8; ++i) v[i] = *(const f32x4*)(src + 4 * i);
    float s = 0.f;
#pragma unroll
    for (int i = 0; i < 8; ++i) { s += v[i].x; s += v[i].y; s += v[i].z; s += v[i].w; }
    float inc = s;
#pragma unroll
    for (int o = 1; o < 64; o <<= 1) { const float u = __shfl_up(inc, o); if (lane >= o) inc += u; }
    __syncthreads();
    if (lane == 63) sW[w] = inc;
    __syncthreads();
    float run = inc - s;
    for (int q = 0; q < w; ++q) run += sW[q];
#pragma unroll
    for (int i = 0; i < 8; ++i) {
      f32x4 o;
      run += v[i].x; o.x = run; run += v[i].y; o.y = run; run += v[i].z; o.z = run; run += v[i].w; o.w = run;
      *(f32x4*)(dst + 4 * i) = o;
    }
  }
}

template <int MODE>
DI void flash_step(f32x16 (&o)[2], float& l, const bf16x8 (&qf)[4], const bf16_t* sK, const bf16_t* sV, const float* sC,
                   int kbase, int tq, float bias0, float inv_l, float* sImpRow, int lane, bool selok = true) {
  const int r = lane & 31, h = lane >> 5;
  constexpr float SC = 0.125f * 1.4426950408889634f;
  const int base_hi = (MODE == 2 || MODE == 3) ? ((tq - 31) >> 4) : tq;
#pragma unroll
  for (int sub = 0; sub < 2; ++sub) {
    f32x16 s;
#pragma unroll
    for (int i = 0; i < 16; ++i) s[i] = 0.f;
#pragma unroll
    for (int ks = 0; ks < 4; ++ks) {
      const bf16x8 a = *(const bf16x8*)(sK + (32 * sub + r) * 72 + 16 * ks + 8 * h);
      s = mfma32(a, qf[ks], s);
    }
    int hi = base_hi - kbase - 32 * sub - 4 * h;
    if (MODE == 4 && !selok) hi = -1;
    const int lo = (MODE == 1) ? hi - 511 : -1000000;
    const bool nomask = __all((hi >= 27) && (lo <= 0));
    if (MODE == 0) {
#pragma unroll
      for (int q = 0; q < 4; ++q) {
        const f32x4 c4 = *(const f32x4*)(sC + 32 * sub + 8 * q + 4 * h);
#pragma unroll
        for (int j = 0; j < 4; ++j) s[4 * q + j] = fmaf(s[4 * q + j], SC, bias0 - c4[j]);
      }
    } else {
#pragma unroll
      for (int i = 0; i < 16; ++i) s[i] = fmaf(s[i], SC, bias0);
    }
    if (!nomask) {
#pragma unroll
      for (int i = 0; i < 16; ++i) { const int cst = (i & 3) + 8 * (i >> 2); s[i] = (cst <= hi && cst >= lo) ? s[i] : -1e30f; }
    }
    float ls = 0.f;
#pragma unroll
    for (int i = 0; i < 16; ++i) { const float pv = __builtin_amdgcn_exp2f(s[i]); s[i] = pv; ls += pv; }
    l += ls;
    if (MODE == 2) continue;
    if (MODE == 3) {
#pragma unroll
      for (int q = 0; q < 4; ++q) {
        const float p3 = s[4 * q + 3] * inv_l;
        float A = (s[4 * q] + s[4 * q + 1] + s[4 * q + 2]) * inv_l + 0.5f * p3, B = 0.5f * p3;
        A += __shfl_xor(A, 1); A += __shfl_xor(A, 2); A += __shfl_xor(A, 4);
        B += __shfl_xor(B, 1); B += __shfl_xor(B, 2); B += __shfl_xor(B, 4);
        if ((r & 7) == 0) { const int j = ((kbase + 32 * sub) >> 2) + 2 * q + h; atomicAdd(&sImpRow[j], A); atomicAdd(&sImpRow[j + 1], B); }
      }
    }
#pragma unroll
    for (int st = 0; st < 2; ++st) {
      u32x4 pk;
      pk.x = pack2(s[8 * st + 0], s[8 * st + 1]); pk.y = pack2(s[8 * st + 2], s[8 * st + 3]);
      pk.z = pack2(s[8 * st + 4], s[8 * st + 5]); pk.w = pack2(s[8 * st + 6], s[8 * st + 7]);
      const bf16x8 pf = __builtin_bit_cast(bf16x8, pk);
#pragma unroll
      for (int d = 0; d < 2; ++d) {
        const bf16_t* vp = sV + (32 * d + r) * 72 + 32 * sub + 16 * st + 4 * h;
        const bf16x4 lo4 = *(const bf16x4*)vp, hi4 = *(const bf16x4*)(vp + 8);
        const bf16x8 vf = __builtin_shufflevector(lo4, hi4, 0, 1, 2, 3, 4, 5, 6, 7);
        o[d] = mfma32(vf, pf, o[d]);
      }
    }
  }
}

DI void tile_load(u32x4 (&kr)[2], u32x4 (&vr)[2], const bf16_t* kptr, int kstride, const bf16_t* vptr, int vstride, bool withV, int tid) {
#pragma unroll
  for (int i = 0; i < 2; ++i) {
    const int c = tid + 256 * i, row = c >> 3, ch = (c & 7) * 8;
    kr[i] = *(const u32x4*)(kptr + (size_t)row * kstride + ch);
    if (withV) vr[i] = *(const u32x4*)(vptr + (size_t)row * vstride + ch);
  }
}
DI void tile_store(const u32x4 (&kr)[2], const u32x4 (&vr)[2], bf16_t* sK, bf16_t* sV, bool withV, int tid) {
#pragma unroll
  for (int i = 0; i < 2; ++i) {
    const int c = tid + 256 * i, row = c >> 3, ch = (c & 7) * 8;
    *(u32x4*)(sK + row * 72 + ch) = kr[i];
    if (withV) *(u32x4*)(sV + row * 72 + ch) = vr[i];
  }
}

template <class LoadF, class StoreF, class BodyF>
DI void dense_loop(int n, LoadF ld, StoreF st, BodyF body) {
  if (n <= 0) return;
  ld(0); st(0);
  if (n > 1) ld(1);
  __syncthreads();
  for (int e = 0; e < n; ++e) {
    const int cur = e & 1;
    if (e + 1 < n) st(cur ^ 1);
    if (e + 2 < n) ld(e + 2);
    body(e, cur);
    __syncthreads();
  }
}

DI void phase_fox(const Params& p, char* smem) {
  bf16_t* sKV = (bf16_t*)smem;
  float* sC = (float*)(sKV + 4 * 64 * 72);
  const int tid = threadIdx.x, lane = tid & 63, w = tid >> 6, r = lane & 31, h = lane >> 5;
  float gq = 0.f, gk = 0.f;
  for (int i = 0; i < 64; ++i) { gq = fmaxf(gq, fabsf(p.a_q_gain[i])); gk = fmaxf(gk, fabsf(p.a_k_gain[i])); }
  const float smax = 8.0f * gq * gk * 1.05f;
  const float thr = 40.0f + 2.0f * smax;
  const float negM2 = -smax * 1.4426950408889634f;
  for (int item = blockIdx.x; item < 4096; item += gridDim.x) {
    const int bh = item & 63, qt = 63 - (item >> 6), b = bh >> 4, head = bh & 15, t0 = qt * 128;
    const int tq = t0 + 32 * w + r;
    const bf16_t* qrow = p.qb + ((size_t)bh * T_ + tq) * 64;
    bf16x8 qf[4];
#pragma unroll
    for (int ks = 0; ks < 4; ++ks) qf[ks] = *(const bf16x8*)(qrow + 16 * ks + 8 * h);
    const float* cseq = p.cc + (size_t)bh * T_;
    const float cq = cseq[tq] * 1.4426950408889634f, c0 = cseq[t0];
    const bf16_t* kbp = p.kb + (size_t)bh * T_ * 64;
    const bf16_t* vbp = p.vT + (size_t)bh * 128 * 4096;
    f32x16 o[2];
#pragma unroll
    for (int d = 0; d < 2; ++d)
#pragma unroll
      for (int i = 0; i < 16; ++i) o[d][i] = 0.f;
    float l = 0.f;
    u32x4 kr[2], vr[2]; f32x4 cr = (f32x4){0.f, 0.f, 0.f, 0.f};
    const int jmax = 2 * qt + 1;
    int jmin = jmax;
    while (jmin > 0 && !(c0 - cseq[64 * (jmin - 1) + 63] < -thr)) --jmin;
    dense_loop(jmax - jmin + 1,
      [&](int e) { const int jt = jmax - e; tile_load(kr, vr, kbp + (size_t)jt * 4096, 64, vbp + (size_t)jt * 4096, 64, true, tid); if (tid < 16) cr = *(const f32x4*)(cseq + 64 * jt + 4 * tid); },
      [&](int bf) { tile_store(kr, vr, sKV + bf * 2 * 64 * 72, sKV + bf * 2 * 64 * 72 + 64 * 72, true, tid); if (tid < 16) *(f32x4*)(sC + bf * 64 + 4 * tid) = cr * 1.4426950408889634f; },
      [&](int e, int cur) {
        const int kbase = 64 * (jmax - e);
        if (kbase <= t0 + 32 * w + 31) flash_step<0>(o, l, qf, sKV + cur * 2 * 64 * 72, sKV + cur * 2 * 64 * 72 + 64 * 72, sC + cur * 64, kbase, tq, cq + negM2, 0.f, nullptr, lane);
      });
    const float lt = l + __shfl_xor(l, 32);
    const float inv = 1.0f / lt;
    bf16_t* orow = p.ob + a_off(b * T_ + tq, head * 64, 16);
#pragma unroll
    for (int d = 0; d < 2; ++d)
#pragma unroll
      for (int q = 0; q < 4; ++q) store_bf4(orow + 32 * d + 8 * q + 4 * h, o[d][4 * q] * inv, o[d][4 * q + 1] * inv, o[d][4 * q + 2] * inv, o[d][4 * q + 3] * inv);
  }
}

DI void phase_nsa(const Params& p, char* smem) {
  bf16_t* sKV = (bf16_t*)smem;
  float* sU = (float*)(sKV + 4 * 64 * 72);
  float* sImp = sU; float* sO = sU;
  unsigned* sMask = (unsigned*)(sU + 128 * 65);
  int* sList = (int*)(sMask + 64);
  const int tid = threadIdx.x, lane = tid & 63, w = tid >> 6, r = lane & 31, h = lane >> 5;
  float gqm = 0.f, gkm = 0.f;
  for (int i = 0; i < 64; ++i) { gqm = fmaxf(gqm, fabsf(p.b_q_gain[i])); gkm = fmaxf(gkm, fmaxf(fabsf(p.kc_gain[i]), fmaxf(fabsf(p.ks_gain[i]), fabsf(p.kw_gain[i])))); }
  const float negM2 = -8.0f * gqm * gkm * 1.05f * 1.4426950408889634f;
  auto stK = [&](int bf) { return sKV + bf * 2 * 64 * 72; };
  for (int item = blockIdx.x; item < 4096; item += gridDim.x) {
    const int bg = item & 7, tt = 511 - (item >> 3), b = bg >> 1, g = bg & 1, t0 = tt * 16;
    const int tokl = 4 * w + (r >> 3), head = r & 7, tq = t0 + tokl;
    __syncthreads();
    for (int i = tid; i < 16 * 132; i += 256) sImp[i] = 0.f;
    bf16x8 qf[4];
    {
      const bf16_t* qrow = p.qn + ((size_t)b * T_ + tq) * 1024 + (g * 8 + head) * 64;
#pragma unroll
      for (int ks = 0; ks < 4; ++ks) qf[ks] = *(const bf16x8*)(qrow + 16 * ks + 8 * h);
    }
    const float* grow = p.gates + ((size_t)b * T_ + tq) * 48 + g * 8 + head;
    const float gate_c = grow[0], gate_w = grow[32];
    f32x16 o[2];
    float l = 0.f;
    u32x4 kr[2], vr[2];
    const int ncmp = t0 >> 4, nct = (ncmp + 63) >> 6;
    const bf16_t* kcp = p.kcb + (size_t)bg * 512 * 64;
    const bf16_t* vcp = p.vcT + (size_t)bg * 8 * 4096;
    dense_loop(nct,
      [&](int e) { tile_load(kr, vr, kcp + (size_t)e * 4096, 64, vcp, 64, false, tid); },
      [&](int bf) { tile_store(kr, vr, stK(bf), stK(bf) + 64 * 72, false, tid); },
      [&](int e, int cur) { flash_step<2>(o, l, qf, stK(cur), stK(cur) + 64 * 72, nullptr, 64 * e, tq, negM2, 0.f, nullptr, lane); });
    const float lc = l + __shfl_xor(l, 32);
    const float inv_lc = lc > 0.f ? 1.0f / lc : 0.f;
#pragma unroll
    for (int d = 0; d < 2; ++d)
#pragma unroll
      for (int i = 0; i < 16; ++i) o[d][i] = 0.f;
    float l2 = 0.f;
    dense_loop(nct,
      [&](int e) { tile_load(kr, vr, kcp + (size_t)e * 4096, 64, vcp + (size_t)e * 4096, 64, true, tid); },
      [&](int bf) { tile_store(kr, vr, stK(bf), stK(bf) + 64 * 72, true, tid); },
      [&](int e, int cur) { flash_step<3>(o, l2, qf, stK(cur), stK(cur) + 64 * 72, nullptr, 64 * e, tq, negM2, inv_lc, sImp + tokl * 132, lane); });
    __syncthreads();
    const int cur_blk = t0 >> 6;
    for (int tk = 0; tk < 4; ++tk) {
      const int tok = 4 * w + tk;
      float* sc = sImp + tok * 132;
      for (int j = lane; j <= cur_blk; j += 64) if (j == 0 || j == cur_blk || j == cur_blk - 1) sc[j] = 1e6f;
    }
    __syncthreads();
    for (int tk = 0; tk < 4; ++tk) {
      const int tok = 4 * w + tk;
      const float* sc = sImp + tok * 132;
      unsigned long long mk0, mk1;
      {
        const int j = lane;
        const bool vj = j <= cur_blk;
        const float sj = vj ? sc[j] : 0.f;
        int rank = 0;
        for (int i = 0; i <= cur_blk; ++i) { const float si = sc[i]; rank += ((si > sj) || (si == sj && i < j)) ? 1 : 0; }
        mk0 = __ballot(vj && rank < 16);
      }
      {
        const int j = lane + 64;
        const bool vj = j <= cur_blk;
        const float sj = vj ? sc[j] : 0.f;
        int rank = 0;
        for (int i = 0; i <= cur_blk; ++i) { const float si = sc[i]; rank += ((si > sj) || (si == sj && i < j)) ? 1 : 0; }
        mk1 = __ballot(vj && rank < 16);
      }
      if (lane == 0) {
        sMask[tok * 4 + 0] = (unsigned)mk0; sMask[tok * 4 + 1] = (unsigned)(mk0 >> 32);
        sMask[tok * 4 + 2] = (unsigned)mk1; sMask[tok * 4 + 3] = (unsigned)(mk1 >> 32);
      }
    }
    __syncthreads();
    int n_un;
    {
      unsigned u0 = 0, u1 = 0, u2 = 0, u3 = 0;
      for (int tok = 0; tok < 16; ++tok) { u0 |= sMask[tok * 4]; u1 |= sMask[tok * 4 + 1]; u2 |= sMask[tok * 4 + 2]; u3 |= sMask[tok * 4 + 3]; }
      const int c0 = __popc(u0), c1 = __popc(u1), c2 = __popc(u2), c3 = __popc(u3);
      n_un = c0 + c1 + c2 + c3;
      if (tid < 128) {
        const int wd = tid >> 5, bit = tid & 31;
        const unsigned uw = wd == 0 ? u0 : wd == 1 ? u1 : wd == 2 ? u2 : u3;
        if ((uw >> bit) & 1u) {
          const int pre = (wd > 0 ? c0 : 0) + (wd > 1 ? c1 : 0) + (wd > 2 ? c2 : 0);
          sList[pre + __popc(uw & ((1u << bit) - 1u))] = tid;
        }
      }
    }
    __syncthreads();
    {
      const float sc = gate_c * inv_lc;
      float* orow = sO + (32 * w + r) * 65;
#pragma unroll
      for (int d = 0; d < 2; ++d)
#pragma unroll
        for (int i = 0; i < 16; ++i) orow[32 * d + crow(i, h)] = o[d][i] * sc;
    }
#pragma unroll
    for (int d = 0; d < 2; ++d)
#pragma unroll
      for (int i = 0; i < 16; ++i) o[d][i] = 0.f;
    l = 0.f;
    {
      const bf16_t* ksp = p.ksb + (size_t)bg * T_ * 64;
      const bf16_t* vsp = p.vsT + (size_t)bg * 128 * 4096;
      dense_loop(n_un,
        [&](int e) { const int blk = sList[e]; tile_load(kr, vr, ksp + (size_t)blk * 4096, 64, vsp + (size_t)blk * 4096, 64, true, tid); },
        [&](int bf) { tile_store(kr, vr, stK(bf), stK(bf) + 64 * 72, true, tid); },
        [&](int e, int cur) {
          const int blk = sList[e];
          const int wd = blk >> 5, bit = blk & 31;
          const unsigned wm = sMask[(4 * w) * 4 + wd] | sMask[(4 * w + 1) * 4 + wd] | sMask[(4 * w + 2) * 4 + wd] | sMask[(4 * w + 3) * 4 + wd];
          if ((wm >> bit) & 1u) {
            const bool selok = (sMask[tokl * 4 + wd] >> bit) & 1u;
            flash_step<4>(o, l, qf, stK(cur), stK(cur) + 64 * 72, nullptr, 64 * blk, tq, negM2, 0.f, nullptr, lane, selok);
          }
        });
      const float lt = l + __shfl_xor(l, 32);
      const float sc = grow[16] / lt;
      float* orow = sO + (32 * w + r) * 65;
#pragma unroll
      for (int d = 0; d < 2; ++d)
#pragma unroll
        for (int i = 0; i < 16; ++i) orow[32 * d + crow(i, h)] += o[d][i] * sc;
    }
#pragma unroll
    for (int d = 0; d < 2; ++d)
#pragma unroll
      for (int i = 0; i < 16; ++i) o[d][i] = 0.f;
    l = 0.f;
    {
      const int klo = t0 - 511 > 0 ? t0 - 511 : 0, jt0 = klo >> 6, jt1 = (t0 + 15) >> 6;
      const bf16_t* kwp = p.kwb + (size_t)bg * T_ * 64;
      const bf16_t* vwp = p.vwT + (size_t)bg * 128 * 4096;
      dense_loop(jt1 - jt0 + 1,
        [&](int e) { tile_load(kr, vr, kwp + (size_t)(jt0 + e) * 4096, 64, vwp + (size_t)(jt0 + e) * 4096, 64, true, tid); },
        [&](int bf) { tile_store(kr, vr, stK(bf), stK(bf) + 64 * 72, true, tid); },
        [&](int e, int cur) { flash_step<1>(o, l, qf, stK(cur), stK(cur) + 64 * 72, nullptr, 64 * (jt0 + e), tq, negM2, 0.f, nullptr, lane); });
      const float lt = l + __shfl_xor(l, 32);
      const float sc = gate_w / lt;
      float* orow = sO + (32 * w + r) * 65;
#pragma unroll
      for (int d = 0; d < 2; ++d)
#pragma unroll
        for (int i = 0; i < 16; ++i) orow[32 * d + crow(i, h)] += o[d][i] * sc;
    }
    __syncthreads();
    for (int c = tid; c < 128 * 16; c += 256) {
      const int row = c >> 4, d4 = (c & 15) * 4, tok = row >> 3, hd = row & 7;
      const float* s = sO + row * 65 + d4;
      store_bf4(p.ob + a_off(b * T_ + t0 + tok, (g * 8 + hd) * 64 + d4, 16), s[0], s[1], s[2], s[3]);
    }
  }
}


#define XB_TMO      128
#define XB_XCNT(j)  (256  + 64 * (j))
#define XB_XSUB(j)  (1280 + 64 * (j))
#define XB_XGEN(j)  (2304 + 64 * (j))
#define XB_TOP      3328
#define XB_TOPGEN   3392
#define XCD_BAR_WORDS 3456
#define XB_SPIN_CAP (1u << 18)
#define LAS __attribute__((address_space(3)))
DI unsigned xb_ld(unsigned* p) { return __hip_atomic_load(p, __ATOMIC_RELAXED, __HIP_MEMORY_SCOPE_AGENT); }
DI unsigned xb_add(unsigned* p, unsigned v) { return __hip_atomic_fetch_add(p, v, __ATOMIC_RELAXED, __HIP_MEMORY_SCOPE_AGENT); }
DI unsigned xb_xcc_id() { return (unsigned)__builtin_amdgcn_s_getreg((3 << 11) | 20) & 0xFu; }
#define XB_SPIN(cond, bar) do { unsigned _sp = 0; while (cond) { __builtin_amdgcn_s_sleep(1); \
    if ((++_sp & 255u) == 0u) { if (xb_ld(&(bar)[XB_TMO])) break; if (_sp > XB_SPIN_CAP) { atomicAdd(&(bar)[XB_TMO], 1u); break; } } } } while (0)
struct XcdBarrier { unsigned* bar; unsigned x; volatile LAS unsigned* st; };
DI XcdBarrier xcd_barrier_post(unsigned* bar, volatile LAS unsigned* st) {
  XcdBarrier b; b.bar = bar; b.x = xb_xcc_id(); b.st = st;
  if (threadIdx.x == 0) (void)xb_add(&bar[XB_XCNT(b.x)], 1u);
  return b;
}
DI void xcd_barrier_complete(unsigned* bar, unsigned x, unsigned& nloc, unsigned& nx) {
  const unsigned G = gridDim.x * gridDim.y * gridDim.z;
  unsigned sum, cnt, mine, sp = 0u;
  for (;;) {
    sum = 0u; cnt = 0u; mine = 0u;
#pragma unroll
    for (unsigned j = 0; j < 16; ++j) { const unsigned c = xb_ld(&bar[XB_XCNT(j)]); sum += c; cnt += (c > 0u) ? 1u : 0u; mine = (j == x) ? c : mine; }
    if (sum == G) break;
    __builtin_amdgcn_s_sleep(1);
    if ((++sp & 255u) == 0u) { if (xb_ld(&bar[XB_TMO])) break; if (sp > XB_SPIN_CAP) { atomicAdd(&bar[XB_TMO], 1u); break; } }
  }
  nloc = mine > 0u ? mine : 1u; nx = cnt > 0u ? cnt : 1u;
}
DI void xcd_barrier(const XcdBarrier& b) {
  asm volatile("s_waitcnt vmcnt(0)" ::: "memory");
  __syncthreads();
  if (threadIdx.x == 0) {
    unsigned* bar = b.bar;
    __builtin_amdgcn_s_waitcnt(0);
    unsigned nloc = b.st[0], nx = b.st[1];
    if (nloc == 0u) { xcd_barrier_complete(bar, b.x, nloc, nx); b.st[0] = nloc; b.st[1] = nx; }
    const unsigned old = xb_add(&bar[XB_XSUB(b.x)], 1u);
    const unsigned gen = old / nloc;
    if (old + 1u == (gen + 1u) * nloc) {
      __builtin_amdgcn_fence(__ATOMIC_RELEASE, "agent");
      asm volatile("s_waitcnt vmcnt(0)" ::: "memory");
      const unsigned og = xb_add(&bar[XB_TOP], 1u);
      const unsigned tg = og / nx;
      if (og + 1u == (tg + 1u) * nx) xb_add(&bar[XB_TOPGEN], 1u);
      else XB_SPIN(xb_ld(&bar[XB_TOPGEN]) == tg, bar);
      __builtin_amdgcn_fence(__ATOMIC_ACQUIRE, "agent");
      xb_add(&bar[XB_XGEN(b.x)], 1u);
      asm volatile("s_waitcnt vmcnt(0)" ::: "memory");
    } else {
      XB_SPIN(xb_ld(&bar[XB_XGEN(b.x)]) == gen, bar);
      __builtin_amdgcn_fence(__ATOMIC_ACQUIRE, "agent");
      asm volatile("s_waitcnt vmcnt(0)" ::: "memory");
    }
  }
  __syncthreads();
}

#ifdef ONLY_PHASE
#define PH_ON(n) ((n) == ONLY_PHASE)
#else
#define PH_ON(n) true
#endif
#define REP_PHASE -1
#define PHASE(n, ...) \
  if (PH_ON(n) && ph_lo <= (n) && (n) < ph_hi) { __VA_ARGS__ } \
  if ((n) == REP_PHASE) { cg::this_grid().sync(); { __VA_ARGS__ } } \
  if (ph_lo <= (n) && (n) + 1 < ph_hi) { if ((n) == 0) cg::this_grid().sync(); else xcd_barrier(xb); }

__global__ void __launch_bounds__(256, 2) yoco_megakernel(KArgs ka, int ph_lo, int ph_hi) {
  __shared__ __attribute__((aligned(16))) char smem[SMEM_BYTES];
  Params p;
  fill_params(p, ka);
  __shared__ __attribute__((aligned(16))) unsigned xb_words[4];
  if (threadIdx.x < 4) xb_words[threadIdx.x] = 0u;
  __syncthreads();
  const XcdBarrier xb = xcd_barrier_post(p.bar, (volatile LAS unsigned*)xb_words);
  PHASE(0, phase_prep(p, smem);)
  PHASE(1, { ALPlain al{p.hb, 16}; EpiFoxIn ep{p}; gemm_phase(al, p.w_ain, 1024, 256, 25, ep, smem); })
  PHASE(2, phase_scan(p, smem);)
  PHASE(3, phase_fox(p, smem);)
  PHASE(4, { ALPlain al{p.ob, 16}; EpiResid ep{p.x, p.out, p.hb, p.part}; gemm_phase(al, p.w_aout, 1024, 256, 8, ep, smem); })
  PHASE(5, { ALFfn al{p.hb}; EpiFfnUp ep{p.part, p.f_conv_w, p.f_conv_b, p.act}; gemm_phase(al, p.w_up0, 1024, 264, 44, ep, smem); })
  PHASE(6, { ALPlain al{p.act, 44}; EpiResid ep{p.out, p.out, p.hb, p.part}; gemm_phase(al, p.w_dn0, FF, 256, 8, ep, smem); })
  PHASE(7, {
    ALPlain al{p.hb, 16};
    { EpiKv ep{p}; gemm_phase(al, p.w_kv, 1024, 256, 6, ep, smem); }
    { EpiBIn ep{p}; gemm_phase(al, p.w_bin, 1024, 256, 9, ep, smem); }
  })
  PHASE(8, {
    for (int item = blockIdx.x; item < 512; item += gridDim.x) {
      const int sel = item & 1, ks4 = (item >> 1) & 3, nt = (item >> 3) & 1, mt = item >> 4;
      ALCmp1 al{p.rawc + (size_t)sel * 8 * T_ * 64, sel ? p.vc_pe : p.kc_pe};
      EpiCmp1P ep{p.hidp + (size_t)(sel * 4 + ks4) * 4096 * 256};
      gemm_tile(al, sel ? p.w_vc1 : p.w_kc1, 2048, mt, nt, ep, smem, ks4 * 8, 8);
    }
  })
  PHASE(9, {
    for (int item = blockIdx.x; item < 64; item += gridDim.x) {
      const int sel = item & 1, mt = item >> 1;
      ALCmp2P al{p.hidp + (size_t)sel * 4 * 4096 * 256};
      EpiCmp2 ep{p, sel};
      gemm_tile(al, sel ? p.w_vc2 : p.w_kc2, 256, mt, 0, ep, smem);
    }
  })
  PHASE(10, phase_nsa(p, smem);)
  PHASE(11, { ALPlain al{p.ob, 16}; EpiResid ep{p.out, p.out, p.hb, p.part}; gemm_phase(al, p.w_bout, 1024, 256, 8, ep, smem); })
  PHASE(12, { ALFfn al{p.hb}; EpiFfnUp ep{p.part, p.f_conv_w + 3 * 5632, p.f_conv_b + 5632, p.act}; gemm_phase(al, p.w_up1, 1024, 264, 44, ep, smem); })
  PHASE(13, { ALPlain al{p.act, 44}; EpiResid ep{p.out, p.out, p.hb, p.part}; gemm_phase(al, p.w_dn1, FF, 256, 8, ep, smem); })
}

extern "C" void kernel_launch(void* const* d_in, const int* in_sizes, int n_in, void* d_out, int out_size, void* d_ws, size_t ws_size, hipStream_t stream) {
  KArgs p{};
  for (int i = 0; i < 29; ++i) p.in[i] = d_in[i];
  p.out = (float*)d_out; p.ws = (char*)d_ws;
  hipMemsetAsync(d_ws, 0, 16384, stream);
  static int grid_blocks = 0;
  if (!grid_blocks) {
    int dev = 0, cus = 0, per_cu = 0;
    hipGetDevice(&dev);
    hipDeviceGetAttribute(&cus, hipDeviceAttributeMultiprocessorCount, dev);
    hipOccupancyMaxActiveBlocksPerMultiprocessor(&per_cu, yoco_megakernel, 256, 0);
    if (per_cu > 2) per_cu = 2;
    if (per_cu < 1) per_cu = 1;
    grid_blocks = cus * per_cu;
    grid_blocks &= ~7;
  }
#if N_LAUNCH_SPLIT
  for (int ph = 0; ph < NPHASE; ++ph) {
    int lo = ph, hi = ph + 1;
    hipLaunchKernelGGL(yoco_megakernel, dim3(grid_blocks), dim3(256), 0, stream, p, lo, hi);
  }
#else
  int lo = 0, hi = NPHASE;
  void* args[] = {&p, &lo, &hi};
  hipError_t e = hipLaunchCooperativeKernel((void*)yoco_megakernel, dim3(grid_blocks), dim3(256), args, 0, stream);
  if (e != hipSuccess) fprintf(stderr, "cooperative launch failed: %s (grid %d)\n", hipGetErrorString(e), grid_blocks);
#endif
}
```

```cpp
#include <hip/hip_runtime.h>
#include <hip/hip_cooperative_groups.h>
#include <stdint.h>
#include <cstdio>
namespace cg = cooperative_groups;

#ifndef N_LAUNCH_SPLIT
#define N_LAUNCH_SPLIT 0
#endif

#define DI __device__ __forceinline__
typedef unsigned short bf16_t;
typedef short bf16x8 __attribute__((ext_vector_type(8)));
typedef short bf16x4 __attribute__((ext_vector_type(4)));
typedef float f32x16 __attribute__((ext_vector_type(16)));
typedef float f32x4 __attribute__((ext_vector_type(4)));
typedef unsigned u32x4 __attribute__((ext_vector_type(4)));
typedef unsigned u32x2 __attribute__((ext_vector_type(2)));

constexpr int T_ = 8192;
constexpr int NTOK = 32768;
constexpr int FF = 2816;
constexpr int NPHASE = 14;
constexpr int SMEM_BYTES = 73728;

struct Params {
  const float* x; const int* pos;
  const float *a_norm, *a_w_in, *a_b_f, *a_q_gain, *a_k_gain, *a_w_out;
  const float *kv_norm, *kv_w, *kc_pe, *vc_pe, *kc_w1, *kc_w2, *vc_w1, *vc_w2, *kc_gain, *ks_gain, *kw_gain;
  const float *b_norm, *b_w_in, *b_b_gate, *b_q_gain, *b_w_out;
  const float *f_norm, *f_w_up, *f_conv_w, *f_conv_b, *f_w_down;
  float* out;
  bf16_t *w_ain, *w_aout, *w_kv, *w_kc1, *w_vc1, *w_kc2, *w_vc2, *w_bin, *w_bout, *w_up0, *w_up1, *w_dn0, *w_dn1;
  bf16_t* hb; float* part; float* lf; float* cc; bf16_t* ob;
  bf16_t *qb, *kb, *vT; bf16_t* act;
  bf16_t *rawc, *ksb, *vsT, *kwb, *vwT, *qn; float* gates; bf16_t *hid, *kcb, *vcT; float* hidp; unsigned* bar;
};

typedef __bf16 bf16v2 __attribute__((ext_vector_type(2)));
typedef float f32x2 __attribute__((ext_vector_type(2)));
struct KArgs { const void* in[29]; float* out; char* ws; };
DI void fill_params(Params& p, const KArgs& ka) {
  p.x = (const float*)ka.in[0]; p.pos = (const int*)ka.in[1];
  p.a_norm = (const float*)ka.in[2]; p.a_w_in = (const float*)ka.in[3]; p.a_b_f = (const float*)ka.in[4]; p.a_q_gain = (const float*)ka.in[5];
  p.a_k_gain = (const float*)ka.in[6]; p.a_w_out = (const float*)ka.in[7]; p.kv_norm = (const float*)ka.in[8]; p.kv_w = (const float*)ka.in[9];
  p.kc_pe = (const float*)ka.in[10]; p.vc_pe = (const float*)ka.in[11]; p.kc_w1 = (const float*)ka.in[12]; p.kc_w2 = (const float*)ka.in[13];
  p.vc_w1 = (const float*)ka.in[14]; p.vc_w2 = (const float*)ka.in[15]; p.kc_gain = (const float*)ka.in[16]; p.ks_gain = (const float*)ka.in[17];
  p.kw_gain = (const float*)ka.in[18]; p.b_norm = (const float*)ka.in[19]; p.b_w_in = (const float*)ka.in[20]; p.b_b_gate = (const float*)ka.in[21];
  p.b_q_gain = (const float*)ka.in[22]; p.b_w_out = (const float*)ka.in[23]; p.f_norm = (const float*)ka.in[24]; p.f_w_up = (const float*)ka.in[25];
  p.f_conv_w = (const float*)ka.in[26]; p.f_conv_b = (const float*)ka.in[27]; p.f_w_down = (const float*)ka.in[28];
  p.out = ka.out;
  char* wsq = ka.ws;
#define TAKE(bytes) (wsq += (((size_t)(bytes)) + 255) & ~(size_t)255, wsq - ((((size_t)(bytes)) + 255) & ~(size_t)255))
  p.bar = (unsigned*)TAKE(16384);
  p.w_ain = (bf16_t*)TAKE((size_t)3200 * 1024 * 2); p.w_aout = (bf16_t*)TAKE((size_t)1024 * 1024 * 2); p.w_kv = (bf16_t*)TAKE((size_t)768 * 1024 * 2);
  p.w_kc1 = (bf16_t*)TAKE((size_t)256 * 2048 * 2); p.w_vc1 = (bf16_t*)TAKE((size_t)256 * 2048 * 2);
  p.w_kc2 = (bf16_t*)TAKE((size_t)128 * 256 * 2); p.w_vc2 = (bf16_t*)TAKE((size_t)128 * 256 * 2);
  p.w_bin = (bf16_t*)TAKE((size_t)1152 * 1024 * 2); p.w_bout = (bf16_t*)TAKE((size_t)1024 * 1024 * 2);
  p.w_up0 = (bf16_t*)TAKE((size_t)5632 * 1024 * 2); p.w_up1 = (bf16_t*)TAKE((size_t)5632 * 1024 * 2);
  p.w_dn0 = (bf16_t*)TAKE((size_t)1024 * FF * 2); p.w_dn1 = (bf16_t*)TAKE((size_t)1024 * FF * 2);
  p.hb = (bf16_t*)TAKE((size_t)NTOK * 1024 * 2); p.part = (float*)TAKE((size_t)NTOK * 16 * 4);
  p.lf = (float*)TAKE((size_t)64 * T_ * 4); p.cc = (float*)TAKE((size_t)64 * T_ * 4);
  p.ob = (bf16_t*)TAKE((size_t)NTOK * 1024 * 2);
  char* R = TAKE((size_t)NTOK * 1024 * 2 * 3);
#undef TAKE
  p.qb = (bf16_t*)R; p.kb = p.qb + (size_t)NTOK * 1024; p.vT = p.kb + (size_t)NTOK * 1024;
  p.act = (bf16_t*)R;
  {
    char* q = R;
    p.qn = (bf16_t*)q; q += (size_t)NTOK * 1024 * 2;
    p.rawc = (bf16_t*)q; q += (size_t)2 * 8 * T_ * 64 * 2;
    p.ksb = (bf16_t*)q; q += (size_t)8 * T_ * 64 * 2;
    p.vsT = (bf16_t*)q; q += (size_t)8 * T_ * 64 * 2;
    p.kwb = (bf16_t*)q; q += (size_t)8 * T_ * 64 * 2;
    p.vwT = (bf16_t*)q; q += (size_t)8 * T_ * 64 * 2;
    p.gates = (float*)q; q += (size_t)NTOK * 48 * 4;
    p.hid = (bf16_t*)q; q += (size_t)2 * 4096 * 256 * 2;
    p.kcb = (bf16_t*)q; q += (size_t)8 * 512 * 64 * 2;
    p.vcT = (bf16_t*)q; q += (size_t)8 * 64 * 512 * 2;
    p.hidp = (float*)q; q += (size_t)2 * 4 * 4096 * 256 * 4;
  }
}

DI bf16_t f2bf(float x) { return __builtin_bit_cast(bf16_t, (__bf16)x); }
DI unsigned pack2(float a, float b) { f32x2 v = {a, b}; return __builtin_bit_cast(unsigned, __builtin_convertvector(v, bf16v2)); }
DI float bf2f(bf16_t v) { return __uint_as_float(((unsigned)v) << 16); }
DI int crow(int i, int h) { return (i & 3) + 8 * (i >> 2) + 4 * h; }
DI f32x16 mfma32(bf16x8 a, bf16x8 b, f32x16 c) { return __builtin_amdgcn_mfma_f32_32x32x16_bf16(a, b, c, 0, 0, 0); }
DI f32x4 mfma16(bf16x8 a, bf16x8 b, f32x4 c) { return __builtin_amdgcn_mfma_f32_16x16x32_bf16(a, b, c, 0, 0, 0); }
DI float row_rstd(const float* part, int row) {
  const f32x4* q = (const f32x4*)(part + (size_t)row * 16);
  f32x4 a = q[0], b = q[1], c = q[2], d = q[3];
  float s = ((a.x + a.y) + (a.z + a.w)) + ((b.x + b.y) + (b.z + b.w)) + ((c.x + c.y) + (c.z + c.w)) + ((d.x + d.y) + (d.z + d.w));
  return rsqrtf(s * (1.0f / 1024.0f) + 1e-6f);
}
DI size_t a_off(int row, int k, int KB) { return (((size_t)((row >> 7) * KB + (k >> 6))) << 13) + ((row & 127) << 6) + (k & 63); }
DI void store_bf4(bf16_t* dst, float a, float b, float c, float d) { u32x2 v; v.x = pack2(a, b); v.y = pack2(c, d); *(u32x2*)dst = v; }

struct WJob { const float* src; bf16_t* dst; const float* gain; int K, Nsrc, Ndst, mode; };
DI WJob get_job(const Params& p, int j) {
  WJob w; w.gain = nullptr; w.mode = 0;
  switch (j) {
    case 0: w.src = p.a_w_in; w.dst = p.w_ain; w.gain = p.a_norm; w.K = 1024; w.Nsrc = 3088; w.Ndst = 3200; break;
    case 1: w.src = p.a_w_out; w.dst = p.w_aout; w.K = 1024; w.Nsrc = 1024; w.Ndst = 1024; break;
    case 2: w.src = p.kv_w; w.dst = p.w_kv; w.gain = p.kv_norm; w.K = 1024; w.Nsrc = 768; w.Ndst = 768; break;
    case 3: w.src = p.kc_w1; w.dst = p.w_kc1; w.K = 2048; w.Nsrc = 256; w.Ndst = 256; break;
    case 4: w.src = p.vc_w1; w.dst = p.w_vc1; w.K = 2048; w.Nsrc = 256; w.Ndst = 256; break;
    case 5: w.src = p.kc_w2; w.dst = p.w_kc2; w.K = 256; w.Nsrc = 64; w.Ndst = 128; break;
    case 6: w.src = p.vc_w2; w.dst = p.w_vc2; w.K = 256; w.Nsrc = 64; w.Ndst = 128; break;
    case 7: w.src = p.b_w_in; w.dst = p.w_bin; w.gain = p.b_norm; w.K = 1024; w.Nsrc = 1072; w.Ndst = 1152; break;
    case 8: w.src = p.b_w_out; w.dst = p.w_bout; w.K = 1024; w.Nsrc = 1024; w.Ndst = 1024; break;
    case 9: w.src = p.f_w_up; w.dst = p.w_up0; w.gain = p.f_norm; w.K = 1024; w.Nsrc = 5632; w.Ndst = 5632; w.mode = 1; break;
    case 10: w.src = p.f_w_up + (size_t)1024 * 5632; w.dst = p.w_up1; w.gain = p.f_norm + 1024; w.K = 1024; w.Nsrc = 5632; w.Ndst = 5632; w.mode = 1; break;
    case 11: w.src = p.f_w_down; w.dst = p.w_dn0; w.K = 2816; w.Nsrc = 1024; w.Ndst = 1024; break;
    default: w.src = p.f_w_down + (size_t)2816 * 1024; w.dst = p.w_dn1; w.K = 2816; w.Nsrc = 1024; w.Ndst = 1024; break;
  }
  return w;
}

DI void prep_load(const WJob& w, int t, int nkt, int tid, f32x4 (&v)[4], int& k0, int& n0d) {
  const int kt = t % nkt, nt = t / nkt;
  k0 = kt << 6; n0d = nt << 6;
  int sbase = n0d;
  if (w.mode == 1) { const int tile = n0d >> 7, half = (n0d >> 6) & 1; sbase = half * FF + tile * 64; }
#pragma unroll
  for (int i = 0; i < 4; ++i) {
    const int kk = (tid >> 4) + 16 * i, col = sbase + (tid & 15) * 4;
    v[i] = (f32x4){0.f, 0.f, 0.f, 0.f};
    if (col < w.Nsrc) v[i] = *(const f32x4*)(w.src + (size_t)(k0 + kk) * w.Nsrc + col);
    const float g = w.gain ? w.gain[k0 + kk] : 1.0f;
    v[i] *= g;
  }
}
DI void prep_lds(float* sT, const f32x4 (&v)[4], int tid) {
#pragma unroll
  for (int i = 0; i < 4; ++i) {
    const int kk = (tid >> 4) + 16 * i, nn = (tid & 15) * 4;
    sT[kk * 65 + nn + 0] = v[i].x; sT[kk * 65 + nn + 1] = v[i].y; sT[kk * 65 + nn + 2] = v[i].z; sT[kk * 65 + nn + 3] = v[i].w;
  }
}
DI void prep_out(const float* sT, const WJob& w, int k0, int n0d, int nkt, int tid) {
  const int n = tid >> 2, kseg = (tid & 3) * 16;
  unsigned o[8];
#pragma unroll
  for (int q = 0; q < 8; ++q) o[q] = pack2(sT[(kseg + 2 * q) * 65 + n], sT[(kseg + 2 * q + 1) * 65 + n]);
  u32x4* dst = (u32x4*)(w.dst + a_off(n0d + n, k0 + kseg, nkt));
  dst[0] = (u32x4){o[0], o[1], o[2], o[3]}; dst[1] = (u32x4){o[4], o[5], o[6], o[7]};
}

DI void phase_prep(const Params& p, char* smem) {
  float* sT0 = (float*)smem;
  float* sT1 = sT0 + 64 * 65;
  const int tid = threadIdx.x;
  {
    const int lane = tid & 63, gw = blockIdx.x * 4 + (tid >> 6), nw = gridDim.x * 4;
    for (int row0 = gw * 4; row0 < NTOK; row0 += nw * 4) {
      f32x4 v[4][4];
#pragma unroll
      for (int rr = 0; rr < 4; ++rr)
#pragma unroll
        for (int i = 0; i < 4; ++i) v[rr][i] = *(const f32x4*)(p.x + (size_t)(row0 + rr) * 1024 + i * 256 + lane * 4);
#pragma unroll
      for (int rr = 0; rr < 4; ++rr) {
        const int row = row0 + rr;
        float ss = 0.f;
#pragma unroll
        for (int i = 0; i < 4; ++i) {
          const f32x4 x = v[rr][i];
          ss += x.x * x.x + x.y * x.y + x.z * x.z + x.w * x.w;
          store_bf4(p.hb + a_off(row, i * 256 + lane * 4, 16), x.x, x.y, x.z, x.w);
        }
#pragma unroll
        for (int o = 32; o >= 1; o >>= 1) ss += __shfl_xor(ss, o);
        if (lane < 16) p.part[(size_t)row * 16 + lane] = lane == 0 ? ss : 0.f;
      }
    }
  }
  int base = 0;
  for (int j = 0; j < 13; ++j) {
    WJob w = get_job(p, j);
    const int nkt = w.K >> 6, nnt = w.Ndst >> 6, ntile = nkt * nnt, G = gridDim.x;
    int first = (int)blockIdx.x - (base % G); if (first < 0) first += G;
    for (int t = first; t < ntile; t += 2 * G) {
      const bool hasB = (t + G) < ntile;
      f32x4 va[4], vb[4]; int k0a, n0a, k0b = 0, n0b = 0;
      prep_load(w, t, nkt, tid, va, k0a, n0a);
      if (hasB) prep_load(w, t + G, nkt, tid, vb, k0b, n0b);
      __syncthreads();
      prep_lds(sT0, va, tid);
      if (hasB) prep_lds(sT1, vb, tid);
      __syncthreads();
      prep_out(sT0, w, k0a, n0a, nkt, tid);
      if (hasB) prep_out(sT1, w, k0b, n0b, nkt, tid);
    }
    base += ntile;
  }
  if (blockIdx.x == 0) {
    for (int i = tid; i < 8 * 64; i += 256) {
      const int bg = i >> 6, d = i & 63;
      p.kcb[((size_t)bg * 512 + 511) * 64 + d] = 0;
      p.vcT[((size_t)(bg * 8 + 7) * 64 + d) * 64 + 63] = 0;
    }
  }
}

template <class AL, class EP>
DI void gemm_tile(const AL& al, const bf16_t* __restrict__ Wt, int K, int mt, int nt, const EP& ep, char* smem, int kb0 = 0, int KBn = -1) {
  bf16_t* sbuf = (bf16_t*)smem;
  constexpr int STAGE = 2 * 128 * 72;
  const int tid = threadIdx.x, lane = tid & 63, wave = tid >> 6, wr = wave >> 1, wc = wave & 1, r = lane & 31, h = lane >> 5;
  const int KBt = K >> 6, KB = KBn < 0 ? KBt : KBn;
  const bf16_t* wbase = Wt + (((size_t)nt * KBt + kb0) << 13) + tid * 8;
  f32x16 acc[2][2];
#pragma unroll
  for (int a = 0; a < 2; ++a)
#pragma unroll
    for (int b = 0; b < 2; ++b)
#pragma unroll
      for (int i = 0; i < 16; ++i) acc[a][b][i] = 0.f;
  u32x4 xa[4], wa[4];
#define GEMM_LOAD(kb_)                                                                  \
  _Pragma("unroll") for (int i = 0; i < 4; ++i) {                                        \
    const int c = tid + 256 * i;                                                         \
    xa[i] = al(mt, c >> 3, (kb0 + (kb_)) * 64 + (c & 7) * 8);                                    \
    wa[i] = *(const u32x4*)(wbase + ((size_t)(kb_) << 13) + 2048 * i);                   \
  }
#define GEMM_STORE(st_)                                                                 \
  _Pragma("unroll") for (int i = 0; i < 4; ++i) {                                        \
    const int c = tid + 256 * i, row = c >> 3, kc = (c & 7) * 8;                         \
    *(u32x4*)(sbuf + (st_) * STAGE + row * 72 + kc) = xa[i];                             \
    *(u32x4*)(sbuf + (st_) * STAGE + 128 * 72 + row * 72 + kc) = wa[i];                  \
  }
#define GEMM_LDF(FW, FX, st_, ks_)                                                      \
  _Pragma("unroll") for (int q = 0; q < 2; ++q) {                                        \
    FW[q] = *(const bf16x8*)(sbuf + (st_) * STAGE + 128 * 72 + (64 * wc + 32 * q + r) * 72 + 16 * (ks_) + 8 * h); \
    FX[q] = *(const bf16x8*)(sbuf + (st_) * STAGE + (64 * wr + 32 * q + r) * 72 + 16 * (ks_) + 8 * h);            \
  }
#define GEMM_MM(FW, FX)                                                                 \
  _Pragma("unroll") for (int ms = 0; ms < 2; ++ms)                                       \
    _Pragma("unroll") for (int ns = 0; ns < 2; ++ns) acc[ms][ns] = mfma32(FW[ns], FX[ms], acc[ms][ns]);
  bf16x8 faw[2], fax[2], fbw[2], fbx[2];
  __syncthreads();
  GEMM_LOAD(0)
  GEMM_STORE(0)
  if (KB > 1) { GEMM_LOAD(1) }
  __syncthreads();
  GEMM_LDF(faw, fax, 0, 0)
  for (int it = 0; it < KB; ++it) {
    const int cur = it & 1;
    if (it + 1 < KB) { GEMM_STORE(cur ^ 1) }
    if (it + 2 < KB) { GEMM_LOAD(it + 2) }
    __builtin_amdgcn_sched_barrier(0);
    GEMM_LDF(fbw, fbx, cur, 1)
    __builtin_amdgcn_sched_barrier(0);
    GEMM_MM(faw, fax)
    __builtin_amdgcn_sched_barrier(0);
    GEMM_LDF(faw, fax, cur, 2)
    __builtin_amdgcn_sched_barrier(0);
    GEMM_MM(fbw, fbx)
    __builtin_amdgcn_sched_barrier(0);
    GEMM_LDF(fbw, fbx, cur, 3)
    __builtin_amdgcn_sched_barrier(0);
    GEMM_MM(faw, fax)
    __builtin_amdgcn_sched_barrier(0);
    __syncthreads();
    if (it + 1 < KB) { GEMM_LDF(faw, fax, cur ^ 1, 0) }
    __builtin_amdgcn_sched_barrier(0);
    GEMM_MM(fbw, fbx)
    __builtin_amdgcn_sched_barrier(0);
  }
#undef GEMM_LDF
#undef GEMM_MM
#undef GEMM_LOAD
#undef GEMM_STORE
  ep(acc, mt, nt, wr, wc, lane, smem);
}

template <class AL, class EP>
DI void gemm_phase(const AL& al, const bf16_t* Wt, int K, int numM, int numN, const EP& ep, char* smem) {
  const int xcd = blockIdx.x & 7, lb = blockIdx.x >> 3, nlb = gridDim.x >> 3;
  const int mper = (numM + 7) >> 3, fullr = mper >> 3, mrem = mper & 7;
  const int nfull = fullr * 8 * numN, total = mper * numN;
  for (int li = lb; li < total; li += nlb) {
    int nt, mtl;
    if (li < nfull) { const int s = li / (8 * numN), rem = li - s * 8 * numN; nt = rem >> 3; mtl = s * 8 + (rem & 7); }
    else { const int rem = li - nfull; nt = rem / mrem; mtl = fullr * 8 + (rem - nt * mrem); }
    const int mt = xcd * mper + mtl;
    if (mt >= numM) continue;
    gemm_tile(al, Wt, K, mt, nt, ep, smem);
  }
}

struct ALPlain { const bf16_t* A; int KB; DI u32x4 operator()(int mt, int ml, int k) const { return *(const u32x4*)(A + (((size_t)(mt * KB + (k >> 6))) << 13) + (ml << 6) + (k & 63)); } };
struct ALFfn {
  const bf16_t* A;
  DI u32x4 operator()(int mt, int ml, int k) const {
    const int b = mt / 66, it = mt - b * 66, t = 126 * it - 2 + ml;
    if (t < 0 || t >= T_) return (u32x4){0, 0, 0, 0};
    return *(const u32x4*)(A + a_off(b * T_ + t, k, 16));
  }
};
struct ALCmp1 {
  const bf16_t* raw; const float* pe;
  DI u32x4 operator()(int mt, int ml, int k) const {
    const int m = mt * 128 + ml;
    if (m >= 4088) return (u32x4){0, 0, 0, 0};
    const int bg = m / 511, n = m - bg * 511;
    u32x4 v = *(const u32x4*)(raw + ((size_t)bg * T_ + 16 * n) * 64 + k);
    const f32x4 p0 = *(const f32x4*)(pe + k), p1 = *(const f32x4*)(pe + k + 4);
    u32x4 o;
    o.x = pack2(bf2f((bf16_t)(v.x & 0xffff)) + p0.x, bf2f((bf16_t)(v.x >> 16)) + p0.y);
    o.y = pack2(bf2f((bf16_t)(v.y & 0xffff)) + p0.z, bf2f((bf16_t)(v.y >> 16)) + p0.w);
    o.z = pack2(bf2f((bf16_t)(v.z & 0xffff)) + p1.x, bf2f((bf16_t)(v.z >> 16)) + p1.y);
    o.w = pack2(bf2f((bf16_t)(v.w & 0xffff)) + p1.z, bf2f((bf16_t)(v.w >> 16)) + p1.w);
    return o;
  }
};
struct ALCmp2 { const bf16_t* A; DI u32x4 operator()(int mt, int ml, int k) const { const int m = mt * 128 + ml; if (m >= 4088) return (u32x4){0, 0, 0, 0}; return *(const u32x4*)(A + (size_t)m * 256 + k); } };

__device__ const float ROPE_INV[8] = {1.0f, 0.19392274474868576f, 0.03760603093086393f, 0.007292664737217109f, 0.001414213562373095f, 0.0002742481756762073f, 5.318295896944988e-05f, 1.031338537721246e-05f};

template <bool ROPE>
DI void norm_store(f32x16 (&a)[2], float rs, const float* gain, int pos, bf16_t* dst, int h) {
  float ss = 0.f;
#pragma unroll
  for (int ns = 0; ns < 2; ++ns)
#pragma unroll
    for (int i = 0; i < 16; ++i) { const float v = a[ns][i] * rs; a[ns][i] = v; ss += v * v; }
  ss += __shfl_xor(ss, 32);
  const float inv = rsqrtf(ss * (1.0f / 64.0f) + 1e-6f);
#pragma unroll
  for (int ns = 0; ns < 2; ++ns)
#pragma unroll
    for (int i = 0; i < 16; ++i) a[ns][i] = a[ns][i] * inv * gain[32 * ns + crow(i, h)];
  if (ROPE) {
    const float fp = (float)pos;
#pragma unroll
    for (int ii = 0; ii < 4; ++ii) {
      const float ang = fp * ROPE_INV[4 * h + ii];
      const float c = cosf(ang), s = sinf(ang);
      const float x1 = a[0][ii], x2 = a[0][4 + ii];
      a[0][ii] = x1 * c - x2 * s; a[0][4 + ii] = x2 * c + x1 * s;
    }
  }
#pragma unroll
  for (int ns = 0; ns < 2; ++ns)
#pragma unroll
    for (int q = 0; q < 4; ++q) store_bf4(dst + 32 * ns + 8 * q + 4 * h, a[ns][4 * q], a[ns][4 * q + 1], a[ns][4 * q + 2], a[ns][4 * q + 3]);
}

struct EpiFoxIn {
  const Params& p;
  DI void operator()(f32x16 (&acc)[2][2], int mt, int nt, int wr, int wc, int lane, char*) const {
    const int r = lane & 31, h = lane >> 5, nb = nt * 128 + 64 * wc;
#pragma unroll
    for (int ms = 0; ms < 2; ++ms) {
      const int row = mt * 128 + 64 * wr + 32 * ms + r;
      const float rs = row_rstd(p.part, row);
      const int b = row >> 13, t = row & 8191;
      if (nb < 2048) {
        const bool isq = nb < 1024;
        norm_store<false>(acc[ms], rs, isq ? p.a_q_gain : p.a_k_gain, 0, (isq ? p.qb : p.kb) + ((size_t)(b * 16 + ((nb & 1023) >> 6)) * T_ + t) * 64, h);
      } else if (nb < 3072) {
        const int head = (nb - 2048) >> 6;
        bf16_t* dst = p.vT + ((size_t)((b * 16 + head) * 128 + (t >> 6))) * 4096 + (t & 63);
#pragma unroll
        for (int ns = 0; ns < 2; ++ns)
#pragma unroll
          for (int i = 0; i < 16; ++i) dst[(32 * ns + crow(i, h)) * 64] = f2bf(acc[ms][ns][i] * rs);
      } else if (nb == 3072) {
#pragma unroll
        for (int i = 0; i < 8; ++i) {
          const int head = crow(i, h);
          const float z = acc[ms][0][i] * rs + p.a_b_f[head];
          p.lf[((size_t)(b * 16 + head)) * T_ + t] = fminf(z, 0.f) - log1pf(expf(-fabsf(z)));
        }
      }
    }
  }
};

template <int MODE>
struct EpiResid {
  const float* res; float* out; bf16_t* hb; float* part;
  DI void operator()(f32x16 (&acc)[2][2], int mt, int nt, int wr, int wc, int lane, char* smem) const {
    float* sU = (float*)smem;
    const int r = lane & 31, h = lane >> 5, tid = threadIdx.x;
    __syncthreads();
#pragma unroll
    for (int ms = 0; ms < 2; ++ms) {
      const int ml = 64 * wr + 32 * ms + r;
#pragma unroll
      for (int ns = 0; ns < 2; ++ns)
#pragma unroll
        for (int i = 0; i < 16; ++i) sU[ml * 132 + 64 * wc + 32 * ns + crow(i, h)] = acc[ms][ns][i];
    }
    __syncthreads();
    const int c4 = (tid & 31) * 4, n = nt * 128 + c4;
#pragma unroll 1
    for (int hh = 0; hh < 2; ++hh) {
      f32x4 rv[8];
#pragma unroll
      for (int it = 0; it < 8; ++it) {
        const int row = mt * 128 + (hh * 8 + it) * 8 + (tid >> 5);
        if (MODE == 0) rv[it] = *(const f32x4*)(res + (size_t)row * 1024 + n);
        else {
          const u32x2 v = *(const u32x2*)(hb + a_off(row, n, 16));
          rv[it] = (f32x4){bf2f((bf16_t)(v.x & 0xffff)), bf2f((bf16_t)(v.x >> 16)), bf2f((bf16_t)(v.y & 0xffff)), bf2f((bf16_t)(v.y >> 16))};
        }
      }
#pragma unroll
      for (int it = 0; it < 8; ++it) {
        const int rl = (hh * 8 + it) * 8 + (tid >> 5), row = mt * 128 + rl;
        const f32x4 o = rv[it] + *(const f32x4*)(sU + rl * 132 + c4);
        if (MODE == 2) *(f32x4*)(out + (size_t)row * 1024 + n) = o;
        else {
          store_bf4(hb + a_off(row, n, 16), o.x, o.y, o.z, o.w);
          float ss = o.x * o.x + o.y * o.y + o.z * o.z + o.w * o.w;
          ss += __shfl_xor(ss, 1); ss += __shfl_xor(ss, 2); ss += __shfl_xor(ss, 4); ss += __shfl_xor(ss, 8); ss += __shfl_xor(ss, 16);
          if ((tid & 31) == 0) { part[(size_t)row * 16 + nt * 2] = ss; part[(size_t)row * 16 + nt * 2 + 1] = 0.f; }
        }
      }
    }
  }
};

struct EpiFfnUp {
  const float* part; const float* cw; const float* cb; bf16_t* act;
  DI void operator()(f32x16 (&acc)[2][2], int mt, int nt, int wr, int wc, int lane, char* smem) const {
    float* sU = (float*)smem;
    const int r = lane & 31, h = lane >> 5, tid = threadIdx.x;
    const int b = mt / 66, it = mt - b * 66, tb = 126 * it - 2;
    __syncthreads();
#pragma unroll
    for (int ms = 0; ms < 2; ++ms) {
      const int ml = 64 * wr + 32 * ms + r, t = tb + ml;
      const float rs = (t >= 0 && t < T_) ? row_rstd(part, b * T_ + t) : 0.f;
#pragma unroll
      for (int ns = 0; ns < 2; ++ns)
#pragma unroll
        for (int i = 0; i < 16; ++i) sU[ml * 129 + 64 * wc + 32 * ns + crow(i, h)] = acc[ms][ns][i] * rs;
    }
    __syncthreads();
    const int jj = tid & 63, rg = tid >> 6, j = nt * 64 + jj;
    const float wg0 = cw[j], wg1 = cw[5632 + j], wg2 = cw[2 * 5632 + j], bgt = cb[j];
    const float wv0 = cw[FF + j], wv1 = cw[5632 + FF + j], wv2 = cw[2 * 5632 + FF + j], bvl = cb[FF + j];
    for (int ml = 2 + rg; ml < 128; ml += 4) {
      const int t = tb + ml;
      if (t >= T_) break;
      const float g = bgt + wg0 * sU[(ml - 2) * 129 + jj] + wg1 * sU[(ml - 1) * 129 + jj] + wg2 * sU[ml * 129 + jj];
      const float v = bvl + wv0 * sU[(ml - 2) * 129 + 64 + jj] + wv1 * sU[(ml - 1) * 129 + 64 + jj] + wv2 * sU[ml * 129 + 64 + jj];
      const float a = g / (1.0f + __expf(-g)) * v;
      act[a_off(b * T_ + t, j, 44)] = f2bf(a);
    }
  }
};

struct EpiKv {
  const Params& p;
  DI void operator()(f32x16 (&acc)[2][2], int mt, int nt, int wr, int wc, int lane, char*) const {
    const int r = lane & 31, h = lane >> 5, g = wc;
#pragma unroll
    for (int ms = 0; ms < 2; ++ms) {
      const int row = mt * 128 + 64 * wr + 32 * ms + r;
      const float rs = row_rstd(p.part, row);
      const int b = row >> 13, t = row & 8191, bg = b * 2 + g;
      if (nt < 2) {
        bf16_t* dst = p.rawc + (((size_t)(nt * 8 + bg)) * T_ + t) * 64;
#pragma unroll
        for (int ns = 0; ns < 2; ++ns)
#pragma unroll
          for (int q = 0; q < 4; ++q)
            store_bf4(dst + 32 * ns + 8 * q + 4 * h, acc[ms][ns][4 * q] * rs, acc[ms][ns][4 * q + 1] * rs, acc[ms][ns][4 * q + 2] * rs, acc[ms][ns][4 * q + 3] * rs);
      } else if (nt == 2 || nt == 4) {
        norm_store<true>(acc[ms], rs, nt == 2 ? p.ks_gain : p.kw_gain, p.pos[row], (nt == 2 ? p.ksb : p.kwb) + ((size_t)bg * T_ + t) * 64, h);
      } else if (nt == 3) {
        bf16_t* dst = p.vsT + ((size_t)bg * 128 + (t >> 6)) * 4096 + (t & 63);
#pragma unroll
        for (int ns = 0; ns < 2; ++ns)
#pragma unroll
          for (int i = 0; i < 16; ++i) dst[(32 * ns + crow(i, h)) * 64] = f2bf(acc[ms][ns][i] * rs);
      } else {
        bf16_t* dst = p.vwT + ((size_t)bg * 128 + (t >> 6)) * 4096 + (t & 63);
#pragma unroll
        for (int ns = 0; ns < 2; ++ns)
#pragma unroll
          for (int i = 0; i < 16; ++i) dst[(32 * ns + crow(i, h)) * 64] = f2bf(acc[ms][ns][i] * rs);
      }
    }
  }
};

struct EpiBIn {
  const Params& p;
  DI void operator()(f32x16 (&acc)[2][2], int mt, int nt, int wr, int wc, int lane, char*) const {
    const int r = lane & 31, h = lane >> 5, nb = nt * 128 + 64 * wc;
#pragma unroll
    for (int ms = 0; ms < 2; ++ms) {
      const int row = mt * 128 + 64 * wr + 32 * ms + r;
      const float rs = row_rstd(p.part, row);
      if (nb < 1024) {
        norm_store<true>(acc[ms], rs, p.b_q_gain, p.pos[row], p.qn + (size_t)row * 1024 + nb, h);
      } else if (nb == 1024) {
#pragma unroll
        for (int ns = 0; ns < 2; ++ns)
#pragma unroll
          for (int i = 0; i < 16; ++i) {
            const int c = 32 * ns + crow(i, h);
            if (c < 48) { const float z = acc[ms][ns][i] * rs + p.b_b_gate[c]; p.gates[(size_t)row * 48 + c] = 1.0f / (1.0f + __expf(-z)); }
          }
      }
    }
  }
};

struct EpiCmp1P {
  float* dst;
  DI void operator()(f32x16 (&acc)[2][2], int mt, int nt, int wr, int wc, int lane, char*) const {
    const int r = lane & 31, h = lane >> 5;
#pragma unroll
    for (int ms = 0; ms < 2; ++ms) {
      const int m = mt * 128 + 64 * wr + 32 * ms + r;
#pragma unroll
      for (int ns = 0; ns < 2; ++ns)
#pragma unroll
        for (int q = 0; q < 4; ++q) {
          f32x4 v = {acc[ms][ns][4 * q], acc[ms][ns][4 * q + 1], acc[ms][ns][4 * q + 2], acc[ms][ns][4 * q + 3]};
          *(f32x4*)(dst + (size_t)m * 256 + nt * 128 + 64 * wc + 32 * ns + 8 * q + 4 * h) = v;
        }
    }
  }
};
DI float gelu_tanh(float x) { return 0.5f * x * (1.0f + tanhf(0.7978845608028654f * (x + 0.044715f * x * x * x))); }
struct ALCmp2P {
  const float* P;
  DI u32x4 operator()(int mt, int ml, int k) const {
    const int m = mt * 128 + ml;
    if (m >= 4088) return (u32x4){0, 0, 0, 0};
    f32x4 a = {0.f, 0.f, 0.f, 0.f}, b = {0.f, 0.f, 0.f, 0.f};
#pragma unroll
    for (int s4 = 0; s4 < 4; ++s4) {
      const float* q = P + ((size_t)s4 * 4096 + m) * 256 + k;
      a += *(const f32x4*)q; b += *(const f32x4*)(q + 4);
    }
    u32x4 o;
    o.x = pack2(gelu_tanh(a.x), gelu_tanh(a.y)); o.y = pack2(gelu_tanh(a.z), gelu_tanh(a.w));
    o.z = pack2(gelu_tanh(b.x), gelu_tanh(b.y)); o.w = pack2(gelu_tanh(b.z), gelu_tanh(b.w));
    return o;
  }
};

struct EpiCmp1 {
  bf16_t* hid;
  DI void operator()(f32x16 (&acc)[2][2], int mt, int nt, int wr, int wc, int lane, char*) const {
    const int r = lane & 31, h = lane >> 5;
#pragma unroll
    for (int ms = 0; ms < 2; ++ms) {
      const int m = mt * 128 + 64 * wr + 32 * ms + r;
      if (m >= 4088) continue;
#pragma unroll
      for (int ns = 0; ns < 2; ++ns) {
        float g[16];
#pragma unroll
        for (int i = 0; i < 16; ++i) { const float x = acc[ms][ns][i]; g[i] = 0.5f * x * (1.0f + tanhf(0.7978845608028654f * (x + 0.044715f * x * x * x))); }
#pragma unroll
        for (int q = 0; q < 4; ++q) store_bf4(hid + (size_t)m * 256 + nt * 128 + 64 * wc + 32 * ns + 8 * q + 4 * h, g[4 * q], g[4 * q + 1], g[4 * q + 2], g[4 * q + 3]);
      }
    }
  }
};

struct EpiCmp2 {
  const Params& p; int sel;
  DI void operator()(f32x16 (&acc)[2][2], int mt, int nt, int wr, int wc, int lane, char*) const {
    if (wc != 0) return;
    const int r = lane & 31, h = lane >> 5;
#pragma unroll
    for (int ms = 0; ms < 2; ++ms) {
      const int m = mt * 128 + 64 * wr + 32 * ms + r;
      if (m < 4088) {
        const int bg = m / 511, n = m - bg * 511, b = bg >> 1;
        if (sel == 0) {
          norm_store<true>(acc[ms], 1.0f, p.kc_gain, p.pos[b * T_ + 16 * n + 31], p.kcb + ((size_t)bg * 512 + n) * 64, h);
        } else {
          bf16_t* dst = p.vcT + ((size_t)(bg * 8 + (n >> 6))) * 4096 + (n & 63);
#pragma unroll
          for (int ns = 0; ns < 2; ++ns)
#pragma unroll
            for (int i = 0; i < 16; ++i) dst[(32 * ns + crow(i, h)) * 64] = f2bf(acc[ms][ns][i]);
        }
      } else {
      }
    }
  }
};

DI void phase_scan(const Params& p, char* smem) {
  float* sW = (float*)smem;
  const int tid = threadIdx.x, lane = tid & 63, w = tid >> 6;
  for (int seq = blockIdx.x; seq < 64; seq += gridDim.x) {
    const float* src = p.lf + (size_t)seq * T_ + tid * 32;
    float* dst = p.cc + (size_t)seq * T_ + tid * 32;
    f32x4 v[8];
#pragma unroll
    for (int i = 0; i < 8; ++i) v[i] = *(const f32x4*)(src + 4 * i);
    float s = 0.f;
#pragma unroll
    for (int i = 0; i < 8; ++i) { s += v[i].x; s += v[i].y; s += v[i].z; s += v[i].w; }
    float inc = s;
#pragma unroll
    for (int o = 1; o < 64; o <<= 1) { const float u = __shfl_up(inc, o); if (lane >= o) inc += u; }
    __syncthreads();
    if (lane == 63) sW[w] = inc;
    __syncthreads();
    float run = inc - s;
    for (int q = 0; q < w; ++q) run += sW[q];
#pragma unroll
    for (int i = 0; i < 8; ++i) {
      f32x4 o;
      run += v[i].x; o.x = run; run += v[i].y; o.y = run; run += v[i].z; o.z = run; run += v[i].w; o.w = run;
      *(f32x4*)(dst + 4 * i) = o;
    }
  }
}

template <int MODE>
DI void flash_step(f32x16 (&o)[2], float& l, const bf16x8 (&qf)[4], const bf16_t* sK, const bf16_t* sV, const float* sC,
                   int kbase, int tq, float bias0, float inv_l, float* sImpRow, int lane, bool selok = true) {
  const int r = lane & 31, h = lane >> 5;
  constexpr float SC = 0.125f * 1.4426950408889634f;
  const int base_hi = (MODE == 2 || MODE == 3) ? ((tq - 31) >> 4) : tq;
#pragma unroll
  for (int sub = 0; sub < 2; ++sub) {
    f32x16 s;
#pragma unroll
    for (int i = 0; i < 16; ++i) s[i] = 0.f;
#pragma unroll
    for (int ks = 0; ks < 4; ++ks) {
      const bf16x8 a = *(const bf16x8*)(sK + (32 * sub + r) * 72 + 16 * ks + 8 * h);
      s = mfma32(a, qf[ks], s);
    }
    int hi = base_hi - kbase - 32 * sub - 4 * h;
    if (MODE == 4 && !selok) hi = -1;
    const int lo = (MODE == 1) ? hi - 511 : -1000000;
    const bool nomask = __all((hi >= 27) && (lo <= 0));
    if (MODE == 0) {
#pragma unroll
      for (int q = 0; q < 4; ++q) {
        const f32x4 c4 = *(const f32x4*)(sC + 32 * sub + 8 * q + 4 * h);
#pragma unroll
        for (int j = 0; j < 4; ++j) s[4 * q + j] = fmaf(s[4 * q + j], SC, bias0 - c4[j]);
      }
    } else {
#pragma unroll
      for (int i = 0; i < 16; ++i) s[i] = fmaf(s[i], SC, bias0);
    }
    if (!nomask) {
#pragma unroll
      for (int i = 0; i < 16; ++i) { const int cst = (i & 3) + 8 * (i >> 2); s[i] = (cst <= hi && cst >= lo) ? s[i] : -1e30f; }
    }
    float ls = 0.f;
#pragma unroll
    for (int i = 0; i < 16; ++i) { const float pv = __builtin_amdgcn_exp2f(s[i]); s[i] = pv; ls += pv; }
    l += ls;
    if (MODE == 2) continue;
    if (MODE == 3) {
#pragma unroll
      for (int q = 0; q < 4; ++q) {
        const float p3 = s[4 * q + 3] * inv_l;
        float A = (s[4 * q] + s[4 * q + 1] + s[4 * q + 2]) * inv_l + 0.5f * p3, B = 0.5f * p3;
        A += __shfl_xor(A, 1); A += __shfl_xor(A, 2); A += __shfl_xor(A, 4);
        B += __shfl_xor(B, 1); B += __shfl_xor(B, 2); B += __shfl_xor(B, 4);
        if ((r & 7) == 0) { const int j = ((kbase + 32 * sub) >> 2) + 2 * q + h; atomicAdd(&sImpRow[j], A); atomicAdd(&sImpRow[j + 1], B); }
      }
    }
#pragma unroll
    for (int st = 0; st < 2; ++st) {
      u32x4 pk;
      pk.x = pack2(s[8 * st + 0], s[8 * st + 1]); pk.y = pack2(s[8 * st + 2], s[8 * st + 3]);
      pk.z = pack2(s[8 * st + 4], s[8 * st + 5]); pk.w = pack2(s[8 * st + 6], s[8 * st + 7]);
      const bf16x8 pf = __builtin_bit_cast(bf16x8, pk);
#pragma unroll
      for (int d = 0; d < 2; ++d) {
        const bf16_t* vp = sV + (32 * d + r) * 72 + 32 * sub + 16 * st + 4 * h;
        const bf16x4 lo4 = *(const bf16x4*)vp, hi4 = *(const bf16x4*)(vp + 8);
        const bf16x8 vf = __builtin_shufflevector(lo4, hi4, 0, 1, 2, 3, 4, 5, 6, 7);
        o[d] = mfma32(vf, pf, o[d]);
      }
    }
  }
}

DI void tile_load(u32x4 (&kr)[2], u32x4 (&vr)[2], const bf16_t* kptr, int kstride, const bf16_t* vptr, int vstride, bool withV, int tid) {
#pragma unroll
  for (int i = 0; i < 2; ++i) {
    const int c = tid + 256 * i, row = c >> 3, ch = (c & 7) * 8;
    kr[i] = *(const u32x4*)(kptr + (size_t)row * kstride + ch);
    if (withV) vr[i] = *(const u32x4*)(vptr + (size_t)row * vstride + ch);
  }
}
DI void tile_store(const u32x4 (&kr)[2], const u32x4 (&vr)[2], bf16_t* sK, bf16_t* sV, bool withV, int tid) {
#pragma unroll
  for (int i = 0; i < 2; ++i) {
    const int c = tid + 256 * i, row = c >> 3, ch = (c & 7) * 8;
    *(u32x4*)(sK + row * 72 + ch) = kr[i];
    if (withV) *(u32x4*)(sV + row * 72 + ch) = vr[i];
  }
}

template <class LoadF, class StoreF, class BodyF>
DI void dense_loop(int n, LoadF ld, StoreF st, BodyF body) {
  if (n <= 0) return;
  ld(0); st(0);
  if (n > 1) ld(1);
  __syncthreads();
  for (int e = 0; e < n; ++e) {
    const int cur = e & 1;
    if (e + 1 < n) st(cur ^ 1);
    if (e + 2 < n) ld(e + 2);
    body(e, cur);
    __syncthreads();
  }
}

DI void phase_fox(const Params& p, char* smem) {
  bf16_t* sKV = (bf16_t*)smem;
  float* sC = (float*)(sKV + 4 * 64 * 72);
  const int tid = threadIdx.x, lane = tid & 63, w = tid >> 6, r = lane & 31, h = lane >> 5;
  float gq = 0.f, gk = 0.f;
  for (int i = 0; i < 64; ++i) { gq = fmaxf(gq, fabsf(p.a_q_gain[i])); gk = fmaxf(gk, fabsf(p.a_k_gain[i])); }
  const float smax = 8.0f * gq * gk * 1.05f;
  const float thr = 40.0f + 2.0f * smax;
  const float negM2 = -smax * 1.4426950408889634f;
  for (int item = blockIdx.x; item < 4096; item += gridDim.x) {
    const int bh = item & 63, qt = 63 - (item >> 6), b = bh >> 4, head = bh & 15, t0 = qt * 128;
    const int tq = t0 + 32 * w + r;
    const bf16_t* qrow = p.qb + ((size_t)bh * T_ + tq) * 64;
    bf16x8 qf[4];
#pragma unroll
    for (int ks = 0; ks < 4; ++ks) qf[ks] = *(const bf16x8*)(qrow + 16 * ks + 8 * h);
    const float* cseq = p.cc + (size_t)bh * T_;
    const float cq = cseq[tq] * 1.4426950408889634f, c0 = cseq[t0];
    const bf16_t* kbp = p.kb + (size_t)bh * T_ * 64;
    const bf16_t* vbp = p.vT + (size_t)bh * 128 * 4096;
    f32x16 o[2];
#pragma unroll
    for (int d = 0; d < 2; ++d)
#pragma unroll
      for (int i = 0; i < 16; ++i) o[d][i] = 0.f;
    float l = 0.f;
    u32x4 kr[2], vr[2]; f32x4 cr = (f32x4){0.f, 0.f, 0.f, 0.f};
    const int jmax = 2 * qt + 1;
    int jmin = jmax;
    while (jmin > 0 && !(c0 - cseq[64 * (jmin - 1) + 63] < -thr)) --jmin;
    dense_loop(jmax - jmin + 1,
      [&](int e) { const int jt = jmax - e; tile_load(kr, vr, kbp + (size_t)jt * 4096, 64, vbp + (size_t)jt * 4096, 64, true, tid); if (tid < 16) cr = *(const f32x4*)(cseq + 64 * jt + 4 * tid); },
      [&](int bf) { tile_store(kr, vr, sKV + bf * 2 * 64 * 72, sKV + bf * 2 * 64 * 72 + 64 * 72, true, tid); if (tid < 16) *(f32x4*)(sC + bf * 64 + 4 * tid) = cr * 1.4426950408889634f; },
      [&](int e, int cur) {
        const int kbase = 64 * (jmax - e);
        if (kbase <= t0 + 32 * w + 31) flash_step<0>(o, l, qf, sKV + cur * 2 * 64 * 72, sKV + cur * 2 * 64 * 72 + 64 * 72, sC + cur * 64, kbase, tq, cq + negM2, 0.f, nullptr, lane);
      });
    const float lt = l + __shfl_xor(l, 32);
    const float inv = 1.0f / lt;
    bf16_t* orow = p.ob + a_off(b * T_ + tq, head * 64, 16);
#pragma unroll
    for (int d = 0; d < 2; ++d)
#pragma unroll
      for (int q = 0; q < 4; ++q) store_bf4(orow + 32 * d + 8 * q + 4 * h, o[d][4 * q] * inv, o[d][4 * q + 1] * inv, o[d][4 * q + 2] * inv, o[d][4 * q + 3] * inv);
  }
}

DI void phase_nsa(const Params& p, char* smem) {
  bf16_t* sKV = (bf16_t*)smem;
  float* sU = (float*)(sKV + 4 * 64 * 72);
  float* sImp = sU; float* sO = sU;
  unsigned* sMask = (unsigned*)(sU + 128 * 65);
  int* sList = (int*)(sMask + 64);
  const int tid = threadIdx.x, lane = tid & 63, w = tid >> 6, r = lane & 31, h = lane >> 5;
  float gqm = 0.f, gkm = 0.f;
  for (int i = 0; i < 64; ++i) { gqm = fmaxf(gqm, fabsf(p.b_q_gain[i])); gkm = fmaxf(gkm, fmaxf(fabsf(p.kc_gain[i]), fmaxf(fabsf(p.ks_gain[i]), fabsf(p.kw_gain[i])))); }
  const float negM2 = -8.0f * gqm * gkm * 1.05f * 1.4426950408889634f;
  auto stK = [&](int bf) { return sKV + bf * 2 * 64 * 72; };
  for (int item = blockIdx.x; item < 4096; item += gridDim.x) {
    const int bg = item & 7, tt = 511 - (item >> 3), b = bg >> 1, g = bg & 1, t0 = tt * 16;
    const int tokl = 4 * w + (r >> 3), head = r & 7, tq = t0 + tokl;
    __syncthreads();
    for (int i = tid; i < 16 * 132; i += 256) sImp[i] = 0.f;
    bf16x8 qf[4];
    {
      const bf16_t* qrow = p.qn + ((size_t)b * T_ + tq) * 1024 + (g * 8 + head) * 64;
#pragma unroll
      for (int ks = 0; ks < 4; ++ks) qf[ks] = *(const bf16x8*)(qrow + 16 * ks + 8 * h);
    }
    const float* grow = p.gates + ((size_t)b * T_ + tq) * 48 + g * 8 + head;
    const float gate_c = grow[0], gate_w = grow[32];
    f32x16 o[2];
    float l = 0.f;
    u32x4 kr[2], vr[2];
    const int ncmp = t0 >> 4, nct = (ncmp + 63) >> 6;
    const bf16_t* kcp = p.kcb + (size_t)bg * 512 * 64;
    const bf16_t* vcp = p.vcT + (size_t)bg * 8 * 4096;
    dense_loop(nct,
      [&](int e) { tile_load(kr, vr, kcp + (size_t)e * 4096, 64, vcp, 64, false, tid); },
      [&](int bf) { tile_store(kr, vr, stK(bf), stK(bf) + 64 * 72, false, tid); },
      [&](int e, int cur) { flash_step<2>(o, l, qf, stK(cur), stK(cur) + 64 * 72, nullptr, 64 * e, tq, negM2, 0.f, nullptr, lane); });
    const float lc = l + __shfl_xor(l, 32);
    const float inv_lc = lc > 0.f ? 1.0f / lc : 0.f;
#pragma unroll
    for (int d = 0; d < 2; ++d)
#pragma unroll
      for (int i = 0; i < 16; ++i) o[d][i] = 0.f;
    float l2 = 0.f;
    dense_loop(nct,
      [&](int e) { tile_load(kr, vr, kcp + (size_t)e * 4096, 64, vcp + (size_t)e * 4096, 64, true, tid); },
      [&](int bf) { tile_store(kr, vr, stK(bf), stK(bf) + 64 * 72, true, tid); },
      [&](int e, int cur) { flash_step<3>(o, l2, qf, stK(cur), stK(cur) + 64 * 72, nullptr, 64 * e, tq, negM2, inv_lc, sImp + tokl * 132, lane); });
    __syncthreads();
    const int cur_blk = t0 >> 6;
    for (int tk = 0; tk < 4; ++tk) {
      const int tok = 4 * w + tk;
      float* sc = sImp + tok * 132;
      for (int j = lane; j <= cur_blk; j += 64) if (j == 0 || j == cur_blk || j == cur_blk - 1) sc[j] = 1e6f;
    }
    __syncthreads();
    for (int tk = 0; tk < 4; ++tk) {
      const int tok = 4 * w + tk;
      const float* sc = sImp + tok * 132;
      unsigned long long mk0, mk1;
      {
        const int j = lane;
        const bool vj = j <= cur_blk;
        const float sj = vj ? sc[j] : 0.f;
        int rank = 0;
        for (int i = 0; i <= cur_blk; ++i) { const float si = sc[i]; rank += ((si > sj) || (si == sj && i < j)) ? 1 : 0; }
        mk0 = __ballot(vj && rank < 16);
      }
      {
        const int j = lane + 64;
        const bool vj = j <= cur_blk;
        const float sj = vj ? sc[j] : 0.f;
        int rank = 0;
        for (int i = 0; i <= cur_blk; ++i) { const float si = sc[i]; rank += ((si > sj) || (si == sj && i < j)) ? 1 : 0; }
        mk1 = __ballot(vj && rank < 16);
      }
      if (lane == 0) {
        sMask[tok * 4 + 0] = (unsigned)mk0; sMask[tok * 4 + 1] = (unsigned)(mk0 >> 32);
        sMask[tok * 4 + 2] = (unsigned)mk1; sMask[tok * 4 + 3] = (unsigned)(mk1 >> 32);
      }
    }
    __syncthreads();
    int n_un;
    {
      unsigned u0 = 0, u1 = 0, u2 = 0, u3 = 0;
      for (int tok = 0; tok < 16; ++tok) { u0 |= sMask[tok * 4]; u1 |= sMask[tok * 4 + 1]; u2 |= sMask[tok * 4 + 2]; u3 |= sMask[tok * 4 + 3]; }
      const int c0 = __popc(u0), c1 = __popc(u1), c2 = __popc(u2), c3 = __popc(u3);
      n_un = c0 + c1 + c2 + c3;
      if (tid < 128) {
        const int wd = tid >> 5, bit = tid & 31;
        const unsigned uw = wd == 0 ? u0 : wd == 1 ? u1 : wd == 2 ? u2 : u3;
        if ((uw >> bit) & 1u) {
          const int pre = (wd > 0 ? c0 : 0) + (wd > 1 ? c1 : 0) + (wd > 2 ? c2 : 0);
          sList[pre + __popc(uw & ((1u << bit) - 1u))] = tid;
        }
      }
    }
    __syncthreads();
    {
      const float sc = gate_c * inv_lc;
      float* orow = sO + (32 * w + r) * 65;
#pragma unroll
      for (int d = 0; d < 2; ++d)
#pragma unroll
        for (int i = 0; i < 16; ++i) orow[32 * d + crow(i, h)] = o[d][i] * sc;
    }
#pragma unroll
    for (int d = 0; d < 2; ++d)
#pragma unroll
      for (int i = 0; i < 16; ++i) o[d][i] = 0.f;
    l = 0.f;
    {
      const bf16_t* ksp = p.ksb + (size_t)bg * T_ * 64;
      const bf16_t* vsp = p.vsT + (size_t)bg * 128 * 4096;
      dense_loop(n_un,
        [&](int e) { const int blk = sList[e]; tile_load(kr, vr, ksp + (size_t)blk * 4096, 64, vsp + (size_t)blk * 4096, 64, true, tid); },
        [&](int bf) { tile_store(kr, vr, stK(bf), stK(bf) + 64 * 72, true, tid); },
        [&](int e, int cur) {
          const int blk = sList[e];
          const int wd = blk >> 5, bit = blk & 31;
          const unsigned wm = sMask[(4 * w) * 4 + wd] | sMask[(4 * w + 1) * 4 + wd] | sMask[(4 * w + 2) * 4 + wd] | sMask[(4 * w + 3) * 4 + wd];
          if ((wm >> bit) & 1u) {
            const bool selok = (sMask[tokl * 4 + wd] >> bit) & 1u;
            flash_step<4>(o, l, qf, stK(cur), stK(cur) + 64 * 72, nullptr, 64 * blk, tq, negM2, 0.f, nullptr, lane, selok);
          }
        });
      const float lt = l + __shfl_xor(l, 32);
      const float sc = grow[16] / lt;
      float* orow = sO + (32 * w + r) * 65;
#pragma unroll
      for (int d = 0; d < 2; ++d)
#pragma unroll
        for (int i = 0; i < 16; ++i) orow[32 * d + crow(i, h)] += o[d][i] * sc;
    }
#pragma unroll
    for (int d = 0; d < 2; ++d)
#pragma unroll
      for (int i = 0; i < 16; ++i) o[d][i] = 0.f;
    l = 0.f;
    {
      const int klo = t0 - 511 > 0 ? t0 - 511 : 0, jt0 = klo >> 6, jt1 = (t0 + 15) >> 6;
      const bf16_t* kwp = p.kwb + (size_t)bg * T_ * 64;
      const bf16_t* vwp = p.vwT + (size_t)bg * 128 * 4096;
      dense_loop(jt1 - jt0 + 1,
        [&](int e) { tile_load(kr, vr, kwp + (size_t)(jt0 + e) * 4096, 64, vwp + (size_t)(jt0 + e) * 4096, 64, true, tid); },
        [&](int bf) { tile_store(kr, vr, stK(bf), stK(bf) + 64 * 72, true, tid); },
        [&](int e, int cur) { flash_step<1>(o, l, qf, stK(cur), stK(cur) + 64 * 72, nullptr, 64 * (jt0 + e), tq, negM2, 0.f, nullptr, lane); });
      const float lt = l + __shfl_xor(l, 32);
      const float sc = gate_w / lt;
      float* orow = sO + (32 * w + r) * 65;
#pragma unroll
      for (int d = 0; d < 2; ++d)
#pragma unroll
        for (int i = 0; i < 16; ++i) orow[32 * d + crow(i, h)] += o[d][i] * sc;
    }
    __syncthreads();
    for (int c = tid; c < 128 * 16; c += 256) {
      const int row = c >> 4, d4 = (c & 15) * 4, tok = row >> 3, hd = row & 7;
      const float* s = sO + row * 65 + d4;
      store_bf4(p.ob + a_off(b * T_ + t0 + tok, (g * 8 + hd) * 64 + d4, 16), s[0], s[1], s[2], s[3]);
    }
  }
}


#define XB_TMO      128
#define XB_XCNT(j)  (256  + 64 * (j))
#define XB_XSUB(j)  (1280 + 64 * (j))
#define XB_XGEN(j)  (2304 + 64 * (j))
#define XB_TOP      3328
#define XB_TOPGEN   3392
#define XCD_BAR_WORDS 3456
#define XB_SPIN_CAP (1u << 18)
#define LAS __attribute__((address_space(3)))
DI unsigned xb_ld(unsigned* p) { return __hip_atomic_load(p, __ATOMIC_RELAXED, __HIP_MEMORY_SCOPE_AGENT); }
DI unsigned xb_add(unsigned* p, unsigned v) { return __hip_atomic_fetch_add(p, v, __ATOMIC_RELAXED, __HIP_MEMORY_SCOPE_AGENT); }
DI unsigned xb_xcc_id() { return (unsigned)__builtin_amdgcn_s_getreg((3 << 11) | 20) & 0xFu; }
#define XB_SPIN(cond, bar) do { unsigned _sp = 0; while (cond) { __builtin_amdgcn_s_sleep(1); \
    if ((++_sp & 255u) == 0u) { if (xb_ld(&(bar)[XB_TMO])) break; if (_sp > XB_SPIN_CAP) { atomicAdd(&(bar)[XB_TMO], 1u); break; } } } } while (0)
struct XcdBarrier { unsigned* bar; unsigned x; volatile LAS unsigned* st; };
DI XcdBarrier xcd_barrier_post(unsigned* bar, volatile LAS unsigned* st) {
  XcdBarrier b; b.bar = bar; b.x = xb_xcc_id(); b.st = st;
  if (threadIdx.x == 0) (void)xb_add(&bar[XB_XCNT(b.x)], 1u);
  return b;
}
DI void xcd_barrier_complete(unsigned* bar, unsigned x, unsigned& nloc, unsigned& nx) {
  const unsigned G = gridDim.x * gridDim.y * gridDim.z;
  unsigned sum, cnt, mine, sp = 0u;
  for (;;) {
    sum = 0u; cnt = 0u; mine = 0u;
#pragma unroll
    for (unsigned j = 0; j < 16; ++j) { const unsigned c = xb_ld(&bar[XB_XCNT(j)]); sum += c; cnt += (c > 0u) ? 1u : 0u; mine = (j == x) ? c : mine; }
    if (sum == G) break;
    __builtin_amdgcn_s_sleep(1);
    if ((++sp & 255u) == 0u) { if (xb_ld(&bar[XB_TMO])) break; if (sp > XB_SPIN_CAP) { atomicAdd(&bar[XB_TMO], 1u); break; } }
  }
  nloc = mine > 0u ? mine : 1u; nx = cnt > 0u ? cnt : 1u;
}
DI void xcd_barrier(const XcdBarrier& b) {
  asm volatile("s_waitcnt vmcnt(0)" ::: "memory");
  __syncthreads();
  if (threadIdx.x == 0) {
    unsigned* bar = b.bar;
    __builtin_amdgcn_s_waitcnt(0);
    unsigned nloc = b.st[0], nx = b.st[1];
    if (nloc == 0u) { xcd_barrier_complete(bar, b.x, nloc, nx); b.st[0] = nloc; b.st[1] = nx; }
    const unsigned old = xb_add(&bar[XB_XSUB(b.x)], 1u);
    const unsigned gen = old / nloc;
    if (old + 1u == (gen + 1u) * nloc) {
      __builtin_amdgcn_fence(__ATOMIC_RELEASE, "agent");
      asm volatile("s_waitcnt vmcnt(0)" ::: "memory");
      const unsigned og = xb_add(&bar[XB_TOP], 1u);
      const unsigned tg = og / nx;
      if (og + 1u == (tg + 1u) * nx) xb_add(&bar[XB_TOPGEN], 1u);
      else XB_SPIN(xb_ld(&bar[XB_TOPGEN]) == tg, bar);
      __builtin_amdgcn_fence(__ATOMIC_ACQUIRE, "agent");
      xb_add(&bar[XB_XGEN(b.x)], 1u);
      asm volatile("s_waitcnt vmcnt(0)" ::: "memory");
    } else {
      XB_SPIN(xb_ld(&bar[XB_XGEN(b.x)]) == gen, bar);
      __builtin_amdgcn_fence(__ATOMIC_ACQUIRE, "agent");
      asm volatile("s_waitcnt vmcnt(0)" ::: "memory");
    }
  }
  __syncthreads();
}

#ifdef ONLY_PHASE
#define PH_ON(n) ((n) == ONLY_PHASE)
#else
#define PH_ON(n) true
#endif
#define REP_PHASE -1
#define PHASE(n, ...) \
  if (PH_ON(n) && ph_lo <= (n) && (n) < ph_hi) { __VA_ARGS__ } \
  if ((n) == REP_PHASE) { cg::this_grid().sync(); { __VA_ARGS__ } } \
  if (ph_lo <= (n) && (n) + 1 < ph_hi) { if (ph_hi > 1000) cg::this_grid().sync(); else xcd_barrier(xb); }

__global__ void __launch_bounds__(256, 2) yoco_megakernel(KArgs ka, int ph_lo, int ph_hi) {
  __shared__ __attribute__((aligned(16))) char smem[SMEM_BYTES];
  Params p;
  fill_params(p, ka);
  __shared__ __attribute__((aligned(16))) unsigned xb_words[4];
  if (threadIdx.x < 4) xb_words[threadIdx.x] = 0u;
  __syncthreads();
  const XcdBarrier xb = xcd_barrier_post(p.bar, (volatile LAS unsigned*)xb_words);
  PHASE(0, phase_prep(p, smem);)
  PHASE(1, { ALPlain al{p.hb, 16}; EpiFoxIn ep{p}; gemm_phase(al, p.w_ain, 1024, 256, 25, ep, smem); })
  PHASE(2, phase_scan(p, smem);)
  PHASE(3, phase_fox(p, smem);)
  PHASE(4, { ALPlain al{p.ob, 16}; EpiResid<0> ep{p.x, p.out, p.hb, p.part}; gemm_phase(al, p.w_aout, 1024, 256, 8, ep, smem); })
  PHASE(5, { ALFfn al{p.hb}; EpiFfnUp ep{p.part, p.f_conv_w, p.f_conv_b, p.act}; gemm_phase(al, p.w_up0, 1024, 264, 44, ep, smem); })
  PHASE(6, { ALPlain al{p.act, 44}; EpiResid<1> ep{p.out, p.out, p.hb, p.part}; gemm_phase(al, p.w_dn0, FF, 256, 8, ep, smem); })
  PHASE(7, {
    ALPlain al{p.hb, 16};
    { EpiKv ep{p}; gemm_phase(al, p.w_kv, 1024, 256, 6, ep, smem); }
    { EpiBIn ep{p}; gemm_phase(al, p.w_bin, 1024, 256, 9, ep, smem); }
  })
  PHASE(8, {
    for (int item = blockIdx.x; item < 512; item += gridDim.x) {
      const int sel = item & 1, ks4 = (item >> 1) & 3, nt = (item >> 3) & 1, mt = item >> 4;
      ALCmp1 al{p.rawc + (size_t)sel * 8 * T_ * 64, sel ? p.vc_pe : p.kc_pe};
      EpiCmp1P ep{p.hidp + (size_t)(sel * 4 + ks4) * 4096 * 256};
      gemm_tile(al, sel ? p.w_vc1 : p.w_kc1, 2048, mt, nt, ep, smem, ks4 * 8, 8);
    }
  })
  PHASE(9, {
    for (int item = blockIdx.x; item < 64; item += gridDim.x) {
      const int sel = item & 1, mt = item >> 1;
      ALCmp2P al{p.hidp + (size_t)sel * 4 * 4096 * 256};
      EpiCmp2 ep{p, sel};
      gemm_tile(al, sel ? p.w_vc2 : p.w_kc2, 256, mt, 0, ep, smem);
    }
  })
  PHASE(10, phase_nsa(p, smem);)
  PHASE(11, { ALPlain al{p.ob, 16}; EpiResid<1> ep{p.out, p.out, p.hb, p.part}; gemm_phase(al, p.w_bout, 1024, 256, 8, ep, smem); })
  PHASE(12, { ALFfn al{p.hb}; EpiFfnUp ep{p.part, p.f_conv_w + 3 * 5632, p.f_conv_b + 5632, p.act}; gemm_phase(al, p.w_up1, 1024, 264, 44, ep, smem); })
  PHASE(13, { ALPlain al{p.act, 44}; EpiResid<2> ep{p.out, p.out, p.hb, p.part}; gemm_phase(al, p.w_dn1, FF, 256, 8, ep, smem); })
}

extern "C" void kernel_launch(void* const* d_in, const int* in_sizes, int n_in, void* d_out, int out_size, void* d_ws, size_t ws_size, hipStream_t stream) {
  KArgs p{};
  for (int i = 0; i < 29; ++i) p.in[i] = d_in[i];
  p.out = (float*)d_out; p.ws = (char*)d_ws;
  hipMemsetAsync(d_ws, 0, 16384, stream);
  static int grid_blocks = 0;
  if (!grid_blocks) {
    int dev = 0, cus = 0, per_cu = 0;
    hipGetDevice(&dev);
    hipDeviceGetAttribute(&cus, hipDeviceAttributeMultiprocessorCount, dev);
    hipOccupancyMaxActiveBlocksPerMultiprocessor(&per_cu, yoco_megakernel, 256, 0);
    if (per_cu > 2) per_cu = 2;
    if (per_cu < 1) per_cu = 1;
    grid_blocks = cus * per_cu;
    grid_blocks &= ~7;
  }
#if N_LAUNCH_SPLIT
  for (int ph = 0; ph < NPHASE; ++ph) {
    int lo = ph, hi = ph + 1;
    hipLaunchKernelGGL(yoco_megakernel, dim3(grid_blocks), dim3(256), 0, stream, p, lo, hi);
  }
#else
  int lo = 0, hi = NPHASE;
  void* args[] = {&p, &lo, &hi};
  hipError_t e = hipLaunchCooperativeKernel((void*)yoco_megakernel, dim3(grid_blocks), dim3(256), args, 0, stream);
  if (e != hipSuccess) fprintf(stderr, "cooperative launch failed: %s (grid %d)\n", hipGetErrorString(e), grid_blocks);
#endif
}
```

```cpp
#include <hip/hip_runtime.h>
#include <hip/hip_cooperative_groups.h>
#include <stdint.h>
#include <cstdio>
namespace cg = cooperative_groups;

#ifndef N_LAUNCH_SPLIT
#define N_LAUNCH_SPLIT 0
#endif

#define DI __device__ __forceinline__
typedef unsigned short bf16_t;
typedef short bf16x8 __attribute__((ext_vector_type(8)));
typedef short bf16x4 __attribute__((ext_vector_type(4)));
typedef float f32x16 __attribute__((ext_vector_type(16)));
typedef float f32x4 __attribute__((ext_vector_type(4)));
typedef unsigned u32x4 __attribute__((ext_vector_type(4)));
typedef unsigned u32x2 __attribute__((ext_vector_type(2)));

constexpr int T_ = 8192;
constexpr int NTOK = 32768;
constexpr int FF = 2816;
constexpr int NPHASE = 14;
constexpr int SMEM_BYTES = 73728;

struct Params {
  const float* x; const int* pos;
  const float *a_norm, *a_w_in, *a_b_f, *a_q_gain, *a_k_gain, *a_w_out;
  const float *kv_norm, *kv_w, *kc_pe, *vc_pe, *kc_w1, *kc_w2, *vc_w1, *vc_w2, *kc_gain, *ks_gain, *kw_gain;
  const float *b_norm, *b_w_in, *b_b_gate, *b_q_gain, *b_w_out;
  const float *f_norm, *f_w_up, *f_conv_w, *f_conv_b, *f_w_down;
  float* out;
  bf16_t *w_ain, *w_aout, *w_kv, *w_kc1, *w_vc1, *w_kc2, *w_vc2, *w_bin, *w_bout, *w_up0, *w_up1, *w_dn0, *w_dn1;
  bf16_t* hb; float* part; float* lf; float* cc; bf16_t* ob;
  bf16_t *qb, *kb, *vT; bf16_t* act;
  bf16_t *rawc, *ksb, *vsT, *kwb, *vwT, *qn; float* gates; bf16_t *hid, *kcb, *vcT; float* hidp; unsigned* bar;
};

typedef __bf16 bf16v2 __attribute__((ext_vector_type(2)));
typedef float f32x2 __attribute__((ext_vector_type(2)));
struct KArgs { const void* in[29]; float* out; char* ws; };
DI void fill_params(Params& p, const KArgs& ka) {
  p.x = (const float*)ka.in[0]; p.pos = (const int*)ka.in[1];
  p.a_norm = (const float*)ka.in[2]; p.a_w_in = (const float*)ka.in[3]; p.a_b_f = (const float*)ka.in[4]; p.a_q_gain = (const float*)ka.in[5];
  p.a_k_gain = (const float*)ka.in[6]; p.a_w_out = (const float*)ka.in[7]; p.kv_norm = (const float*)ka.in[8]; p.kv_w = (const float*)ka.in[9];
  p.kc_pe = (const float*)ka.in[10]; p.vc_pe = (const float*)ka.in[11]; p.kc_w1 = (const float*)ka.in[12]; p.kc_w2 = (const float*)ka.in[13];
  p.vc_w1 = (const float*)ka.in[14]; p.vc_w2 = (const float*)ka.in[15]; p.kc_gain = (const float*)ka.in[16]; p.ks_gain = (const float*)ka.in[17];
  p.kw_gain = (const float*)ka.in[18]; p.b_norm = (const float*)ka.in[19]; p.b_w_in = (const float*)ka.in[20]; p.b_b_gate = (const float*)ka.in[21];
  p.b_q_gain = (const float*)ka.in[22]; p.b_w_out = (const float*)ka.in[23]; p.f_norm = (const float*)ka.in[24]; p.f_w_up = (const float*)ka.in[25];
  p.f_conv_w = (const float*)ka.in[26]; p.f_conv_b = (const float*)ka.in[27]; p.f_w_down = (const float*)ka.in[28];
  p.out = ka.out;
  char* wsq = ka.ws;
#define TAKE(bytes) (wsq += (((size_t)(bytes)) + 255) & ~(size_t)255, wsq - ((((size_t)(bytes)) + 255) & ~(size_t)255))
  p.bar = (unsigned*)TAKE(16384);
  p.w_ain = (bf16_t*)TAKE((size_t)3200 * 1024 * 2); p.w_aout = (bf16_t*)TAKE((size_t)1024 * 1024 * 2); p.w_kv = (bf16_t*)TAKE((size_t)768 * 1024 * 2);
  p.w_kc1 = (bf16_t*)TAKE((size_t)256 * 2048 * 2); p.w_vc1 = (bf16_t*)TAKE((size_t)256 * 2048 * 2);
  p.w_kc2 = (bf16_t*)TAKE((size_t)128 * 256 * 2); p.w_vc2 = (bf16_t*)TAKE((size_t)128 * 256 * 2);
  p.w_bin = (bf16_t*)TAKE((size_t)1152 * 1024 * 2); p.w_bout = (bf16_t*)TAKE((size_t)1024 * 1024 * 2);
  p.w_up0 = (bf16_t*)TAKE((size_t)5632 * 1024 * 2); p.w_up1 = (bf16_t*)TAKE((size_t)5632 * 1024 * 2);
  p.w_dn0 = (bf16_t*)TAKE((size_t)1024 * FF * 2); p.w_dn1 = (bf16_t*)TAKE((size_t)1024 * FF * 2);
  p.hb = (bf16_t*)TAKE((size_t)NTOK * 1024 * 2); p.part = (float*)TAKE((size_t)NTOK * 16 * 4);
  p.lf = (float*)TAKE((size_t)64 * T_ * 4); p.cc = (float*)TAKE((size_t)64 * T_ * 4);
  p.ob = (bf16_t*)TAKE((size_t)NTOK * 1024 * 2);
  char* R = TAKE((size_t)NTOK * 1024 * 2 * 3);
#undef TAKE
  p.qb = (bf16_t*)R; p.kb = p.qb + (size_t)NTOK * 1024; p.vT = p.kb + (size_t)NTOK * 1024;
  p.act = (bf16_t*)R;
  {
    char* q = R;
    p.qn = (bf16_t*)q; q += (size_t)NTOK * 1024 * 2;
    p.rawc = (bf16_t*)q; q += (size_t)2 * 8 * T_ * 64 * 2;
    p.ksb = (bf16_t*)q; q += (size_t)8 * T_ * 64 * 2;
    p.vsT = (bf16_t*)q; q += (size_t)8 * T_ * 64 * 2;
    p.kwb = (bf16_t*)q; q += (size_t)8 * T_ * 64 * 2;
    p.vwT = (bf16_t*)q; q += (size_t)8 * T_ * 64 * 2;
    p.gates = (float*)q; q += (size_t)NTOK * 48 * 4;
    p.hid = (bf16_t*)q; q += (size_t)2 * 4096 * 256 * 2;
    p.kcb = (bf16_t*)q; q += (size_t)8 * 512 * 64 * 2;
    p.vcT = (bf16_t*)q; q += (size_t)8 * 64 * 512 * 2;
    p.hidp = (float*)q; q += (size_t)2 * 4 * 4096 * 256 * 4;
  }
}

DI bf16_t f2bf(float x) { return __builtin_bit_cast(bf16_t, (__bf16)x); }
DI unsigned pack2(float a, float b) { f32x2 v = {a, b}; return __builtin_bit_cast(unsigned, __builtin_convertvector(v, bf16v2)); }
DI float bf2f(bf16_t v) { return __uint_as_float(((unsigned)v) << 16); }
DI int crow(int i, int h) { return (i & 3) + 8 * (i >> 2) + 4 * h; }
DI f32x16 mfma32(bf16x8 a, bf16x8 b, f32x16 c) { return __builtin_amdgcn_mfma_f32_32x32x16_bf16(a, b, c, 0, 0, 0); }
DI f32x4 mfma16(bf16x8 a, bf16x8 b, f32x4 c) { return __builtin_amdgcn_mfma_f32_16x16x32_bf16(a, b, c, 0, 0, 0); }
DI float row_rstd(const float* part, int row) {
  const f32x4* q = (const f32x4*)(part + (size_t)row * 16);
  f32x4 a = q[0], b = q[1], c = q[2], d = q[3];
  float s = ((a.x + a.y) + (a.z + a.w)) + ((b.x + b.y) + (b.z + b.w)) + ((c.x + c.y) + (c.z + c.w)) + ((d.x + d.y) + (d.z + d.w));
  return rsqrtf(s * (1.0f / 1024.0f) + 1e-6f);
}
DI size_t a_off(int row, int k, int KB) { return (((size_t)((row >> 7) * KB + (k >> 6))) << 13) + ((row & 127) << 6) + (k & 63); }
DI void store_bf4(bf16_t* dst, float a, float b, float c, float d) { u32x2 v; v.x = pack2(a, b); v.y = pack2(c, d); *(u32x2*)dst = v; }

struct WJob { const float* src; bf16_t* dst; const float* gain; int K, Nsrc, Ndst, mode; };
DI WJob get_job(const Params& p, int j) {
  WJob w; w.gain = nullptr; w.mode = 0;
  switch (j) {
    case 0: w.src = p.a_w_in; w.dst = p.w_ain; w.gain = p.a_norm; w.K = 1024; w.Nsrc = 3088; w.Ndst = 3200; break;
    case 1: w.src = p.a_w_out; w.dst = p.w_aout; w.K = 1024; w.Nsrc = 1024; w.Ndst = 1024; break;
    case 2: w.src = p.kv_w; w.dst = p.w_kv; w.gain = p.kv_norm; w.K = 1024; w.Nsrc = 768; w.Ndst = 768; break;
    case 3: w.src = p.kc_w1; w.dst = p.w_kc1; w.K = 2048; w.Nsrc = 256; w.Ndst = 256; break;
    case 4: w.src = p.vc_w1; w.dst = p.w_vc1; w.K = 2048; w.Nsrc = 256; w.Ndst = 256; break;
    case 5: w.src = p.kc_w2; w.dst = p.w_kc2; w.K = 256; w.Nsrc = 64; w.Ndst = 128; break;
    case 6: w.src = p.vc_w2; w.dst = p.w_vc2; w.K = 256; w.Nsrc = 64; w.Ndst = 128; break;
    case 7: w.src = p.b_w_in; w.dst = p.w_bin; w.gain = p.b_norm; w.K = 1024; w.Nsrc = 1072; w.Ndst = 1152; break;
    case 8: w.src = p.b_w_out; w.dst = p.w_bout; w.K = 1024; w.Nsrc = 1024; w.Ndst = 1024; break;
    case 9: w.src = p.f_w_up; w.dst = p.w_up0; w.gain = p.f_norm; w.K = 1024; w.Nsrc = 5632; w.Ndst = 5632; w.mode = 1; break;
    case 10: w.src = p.f_w_up + (size_t)1024 * 5632; w.dst = p.w_up1; w.gain = p.f_norm + 1024; w.K = 1024; w.Nsrc = 5632; w.Ndst = 5632; w.mode = 1; break;
    case 11: w.src = p.f_w_down; w.dst = p.w_dn0; w.K = 2816; w.Nsrc = 1024; w.Ndst = 1024; break;
    default: w.src = p.f_w_down + (size_t)2816 * 1024; w.dst = p.w_dn1; w.K = 2816; w.Nsrc = 1024; w.Ndst = 1024; break;
  }
  return w;
}

DI void prep_load(const WJob& w, int t, int nkt, int tid, f32x4 (&v)[4], int& k0, int& n0d) {
  const int kt = t % nkt, nt = t / nkt;
  k0 = kt << 6; n0d = nt << 6;
  int sbase = n0d;
  if (w.mode == 1) { const int tile = n0d >> 7, half = (n0d >> 6) & 1; sbase = half * FF + tile * 64; }
#pragma unroll
  for (int i = 0; i < 4; ++i) {
    const int kk = (tid >> 4) + 16 * i, col = sbase + (tid & 15) * 4;
    v[i] = (f32x4){0.f, 0.f, 0.f, 0.f};
    if (col < w.Nsrc) v[i] = *(const f32x4*)(w.src + (size_t)(k0 + kk) * w.Nsrc + col);
    const float g = w.gain ? w.gain[k0 + kk] : 1.0f;
    v[i] *= g;
  }
}
DI void prep_lds(float* sT, const f32x4 (&v)[4], int tid) {
#pragma unroll
  for (int i = 0; i < 4; ++i) {
    const int kk = (tid >> 4) + 16 * i, nn = (tid & 15) * 4;
    sT[kk * 65 + nn + 0] = v[i].x; sT[kk * 65 + nn + 1] = v[i].y; sT[kk * 65 + nn + 2] = v[i].z; sT[kk * 65 + nn + 3] = v[i].w;
  }
}
DI void prep_out(const float* sT, const WJob& w, int k0, int n0d, int nkt, int tid) {
  const int n = tid >> 2, kseg = (tid & 3) * 16;
  unsigned o[8];
#pragma unroll
  for (int q = 0; q < 8; ++q) o[q] = pack2(sT[(kseg + 2 * q) * 65 + n], sT[(kseg + 2 * q + 1) * 65 + n]);
  u32x4* dst = (u32x4*)(w.dst + a_off(n0d + n, k0 + kseg, nkt));
  dst[0] = (u32x4){o[0], o[1], o[2], o[3]}; dst[1] = (u32x4){o[4], o[5], o[6], o[7]};
}

DI void phase_prep(const Params& p, char* smem) {
  float* sT0 = (float*)smem;
  float* sT1 = sT0 + 64 * 65;
  const int tid = threadIdx.x;
  {
    const int lane = tid & 63, gw = blockIdx.x * 4 + (tid >> 6), nw = gridDim.x * 4;
    for (int row0 = gw * 4; row0 < NTOK; row0 += nw * 4) {
      f32x4 v[4][4];
#pragma unroll
      for (int rr = 0; rr < 4; ++rr)
#pragma unroll
        for (int i = 0; i < 4; ++i) v[rr][i] = *(const f32x4*)(p.x + (size_t)(row0 + rr) * 1024 + i * 256 + lane * 4);
#pragma unroll
      for (int rr = 0; rr < 4; ++rr) {
        const int row = row0 + rr;
        float ss = 0.f;
#pragma unroll
        for (int i = 0; i < 4; ++i) {
          const f32x4 x = v[rr][i];
          ss += x.x * x.x + x.y * x.y + x.z * x.z + x.w * x.w;
          store_bf4(p.hb + a_off(row, i * 256 + lane * 4, 16), x.x, x.y, x.z, x.w);
        }
#pragma unroll
        for (int o = 32; o >= 1; o >>= 1) ss += __shfl_xor(ss, o);
        if (lane < 16) p.part[(size_t)row * 16 + lane] = lane == 0 ? ss : 0.f;
      }
    }
  }
  int base = 0;
  for (int j = 0; j < 13; ++j) {
    WJob w = get_job(p, j);
    const int nkt = w.K >> 6, nnt = w.Ndst >> 6, ntile = nkt * nnt, G = gridDim.x;
    int first = (int)blockIdx.x - (base % G); if (first < 0) first += G;
    for (int t = first; t < ntile; t += 2 * G) {
      const bool hasB = (t + G) < ntile;
      f32x4 va[4], vb[4]; int k0a, n0a, k0b = 0, n0b = 0;
      prep_load(w, t, nkt, tid, va, k0a, n0a);
      if (hasB) prep_load(w, t + G, nkt, tid, vb, k0b, n0b);
      __syncthreads();
      prep_lds(sT0, va, tid);
      if (hasB) prep_lds(sT1, vb, tid);
      __syncthreads();
      prep_out(sT0, w, k0a, n0a, nkt, tid);
      if (hasB) prep_out(sT1, w, k0b, n0b, nkt, tid);
    }
    base += ntile;
  }
  if (blockIdx.x == 0) {
    for (int i = tid; i < 8 * 64; i += 256) {
      const int bg = i >> 6, d = i & 63;
      p.kcb[((size_t)bg * 512 + 511) * 64 + d] = 0;
      p.vcT[((size_t)(bg * 8 + 7) * 64 + d) * 64 + 63] = 0;
    }
  }
}

template <class AL, class EP>
DI void gemm_tile(const AL& al, const bf16_t* __restrict__ Wt, int K, int mt, int nt, const EP& ep, char* smem, int kb0 = 0, int KBn = -1) {
  bf16_t* sbuf = (bf16_t*)smem;
  constexpr int STAGE = 2 * 128 * 72;
  const int tid = threadIdx.x, lane = tid & 63, wave = tid >> 6, wr = wave >> 1, wc = wave & 1, r = lane & 31, h = lane >> 5;
  const int KBt = K >> 6, KB = KBn < 0 ? KBt : KBn;
  const bf16_t* wbase = Wt + (((size_t)nt * KBt + kb0) << 13) + tid * 8;
  f32x16 acc[2][2];
#pragma unroll
  for (int a = 0; a < 2; ++a)
#pragma unroll
    for (int b = 0; b < 2; ++b)
#pragma unroll
      for (int i = 0; i < 16; ++i) acc[a][b][i] = 0.f;
  u32x4 xa[4], wa[4];
#define GEMM_LOAD(kb_)                                                                  \
  _Pragma("unroll") for (int i = 0; i < 4; ++i) {                                        \
    const int c = tid + 256 * i;                                                         \
    xa[i] = al(mt, c >> 3, (kb0 + (kb_)) * 64 + (c & 7) * 8);                                    \
    wa[i] = *(const u32x4*)(wbase + ((size_t)(kb_) << 13) + 2048 * i);                   \
  }
#define GEMM_STORE(st_)                                                                 \
  _Pragma("unroll") for (int i = 0; i < 4; ++i) {                                        \
    const int c = tid + 256 * i, row = c >> 3, kc = (c & 7) * 8;                         \
    *(u32x4*)(sbuf + (st_) * STAGE + row * 72 + kc) = xa[i];                             \
    *(u32x4*)(sbuf + (st_) * STAGE + 128 * 72 + row * 72 + kc) = wa[i];                  \
  }
#define GEMM_LDF(FW, FX, st_, ks_)                                                      \
  _Pragma("unroll") for (int q = 0; q < 2; ++q) {                                        \
    FW[q] = *(const bf16x8*)(sbuf + (st_) * STAGE + 128 * 72 + (64 * wc + 32 * q + r) * 72 + 16 * (ks_) + 8 * h); \
    FX[q] = *(const bf16x8*)(sbuf + (st_) * STAGE + (64 * wr + 32 * q + r) * 72 + 16 * (ks_) + 8 * h);            \
  }
#define GEMM_MM(FW, FX)                                                                 \
  _Pragma("unroll") for (int ms = 0; ms < 2; ++ms)                                       \
    _Pragma("unroll") for (int ns = 0; ns < 2; ++ns) acc[ms][ns] = mfma32(FW[ns], FX[ms], acc[ms][ns]);
  bf16x8 faw[2], fax[2], fbw[2], fbx[2];
  __syncthreads();
  GEMM_LOAD(0)
  GEMM_STORE(0)
  if (KB > 1) { GEMM_LOAD(1) }
  __syncthreads();
  GEMM_LDF(faw, fax, 0, 0)
  for (int it = 0; it < KB; ++it) {
    const int cur = it & 1;
    if (it + 1 < KB) { GEMM_STORE(cur ^ 1) }
    if (it + 2 < KB) { GEMM_LOAD(it + 2) }
    __builtin_amdgcn_sched_barrier(0);
    GEMM_LDF(fbw, fbx, cur, 1)
    __builtin_amdgcn_sched_barrier(0);
    GEMM_MM(faw, fax)
    __builtin_amdgcn_sched_barrier(0);
    GEMM_LDF(faw, fax, cur, 2)
    __builtin_amdgcn_sched_barrier(0);
    GEMM_MM(fbw, fbx)
    __builtin_amdgcn_sched_barrier(0);
    GEMM_LDF(fbw, fbx, cur, 3)
    __builtin_amdgcn_sched_barrier(0);
    GEMM_MM(faw, fax)
    __builtin_amdgcn_sched_barrier(0);
    __syncthreads();
    if (it + 1 < KB) { GEMM_LDF(faw, fax, cur ^ 1, 0) }
    __builtin_amdgcn_sched_barrier(0);
    GEMM_MM(fbw, fbx)
    __builtin_amdgcn_sched_barrier(0);
  }
#undef GEMM_LDF
#undef GEMM_MM
#undef GEMM_LOAD
#undef GEMM_STORE
  ep(acc, mt, nt, wr, wc, lane, smem);
}

template <class AL, class EP>
DI void gemm_phase(const AL& al, const bf16_t* Wt, int K, int numM, int numN, const EP& ep, char* smem) {
  const int xcd = blockIdx.x & 7, lb = blockIdx.x >> 3, nlb = gridDim.x >> 3;
  const int mper = (numM + 7) >> 3, fullr = mper >> 3, mrem = mper & 7;
  const int nfull = fullr * 8 * numN, total = mper * numN;
  for (int li = lb; li < total; li += nlb) {
    int nt, mtl;
    if (li < nfull) { const int s = li / (8 * numN), rem = li - s * 8 * numN; nt = rem >> 3; mtl = s * 8 + (rem & 7); }
    else { const int rem = li - nfull; nt = rem / mrem; mtl = fullr * 8 + (rem - nt * mrem); }
    const int mt = xcd * mper + mtl;
    if (mt >= numM) continue;
    gemm_tile(al, Wt, K, mt, nt, ep, smem);
  }
}

struct ALPlain { const bf16_t* A; int KB; DI u32x4 operator()(int mt, int ml, int k) const { return *(const u32x4*)(A + (((size_t)(mt * KB + (k >> 6))) << 13) + (ml << 6) + (k & 63)); } };
struct ALFfn {
  const bf16_t* A;
  DI u32x4 operator()(int mt, int ml, int k) const {
    const int b = mt / 66, it = mt - b * 66, t = 126 * it - 2 + ml;
    if (t < 0 || t >= T_) return (u32x4){0, 0, 0, 0};
    return *(const u32x4*)(A + a_off(b * T_ + t, k, 16));
  }
};
struct ALCmp1 {
  const bf16_t* raw; const float* pe;
  DI u32x4 operator()(int mt, int ml, int k) const {
    const int m = mt * 128 + ml;
    if (m >= 4088) return (u32x4){0, 0, 0, 0};
    const int bg = m / 511, n = m - bg * 511;
    u32x4 v = *(const u32x4*)(raw + ((size_t)bg * T_ + 16 * n) * 64 + k);
    const f32x4 p0 = *(const f32x4*)(pe + k), p1 = *(const f32x4*)(pe + k + 4);
    u32x4 o;
    o.x = pack2(bf2f((bf16_t)(v.x & 0xffff)) + p0.x, bf2f((bf16_t)(v.x >> 16)) + p0.y);
    o.y = pack2(bf2f((bf16_t)(v.y & 0xffff)) + p0.z, bf2f((bf16_t)(v.y >> 16)) + p0.w);
    o.z = pack2(bf2f((bf16_t)(v.z & 0xffff)) + p1.x, bf2f((bf16_t)(v.z >> 16)) + p1.y);
    o.w = pack2(bf2f((bf16_t)(v.w & 0xffff)) + p1.z, bf2f((bf16_t)(v.w >> 16)) + p1.w);
    return o;
  }
};
struct ALCmp2 { const bf16_t* A; DI u32x4 operator()(int mt, int ml, int k) const { const int m = mt * 128 + ml; if (m >= 4088) return (u32x4){0, 0, 0, 0}; return *(const u32x4*)(A + (size_t)m * 256 + k); } };

__device__ const float ROPE_INV[8] = {1.0f, 0.19392274474868576f, 0.03760603093086393f, 0.007292664737217109f, 0.001414213562373095f, 0.0002742481756762073f, 5.318295896944988e-05f, 1.031338537721246e-05f};

template <bool ROPE>
DI void norm_store(f32x16 (&a)[2], float rs, const float* gain, int pos, bf16_t* dst, int h) {
  float ss = 0.f;
#pragma unroll
  for (int ns = 0; ns < 2; ++ns)
#pragma unroll
    for (int i = 0; i < 16; ++i) { const float v = a[ns][i] * rs; a[ns][i] = v; ss += v * v; }
  ss += __shfl_xor(ss, 32);
  const float inv = rsqrtf(ss * (1.0f / 64.0f) + 1e-6f);
#pragma unroll
  for (int ns = 0; ns < 2; ++ns)
#pragma unroll
    for (int i = 0; i < 16; ++i) a[ns][i] = a[ns][i] * inv * gain[32 * ns + crow(i, h)];
  if (ROPE) {
    const float fp = (float)pos;
#pragma unroll
    for (int ii = 0; ii < 4; ++ii) {
      const float ang = fp * ROPE_INV[4 * h + ii];
      const float c = cosf(ang), s = sinf(ang);
      const float x1 = a[0][ii], x2 = a[0][4 + ii];
      a[0][ii] = x1 * c - x2 * s; a[0][4 + ii] = x2 * c + x1 * s;
    }
  }
#pragma unroll
  for (int ns = 0; ns < 2; ++ns)
#pragma unroll
    for (int q = 0; q < 4; ++q) store_bf4(dst + 32 * ns + 8 * q + 4 * h, a[ns][4 * q], a[ns][4 * q + 1], a[ns][4 * q + 2], a[ns][4 * q + 3]);
}

struct EpiFoxIn {
  const Params& p;
  DI void operator()(f32x16 (&acc)[2][2], int mt, int nt, int wr, int wc, int lane, char*) const {
    const int r = lane & 31, h = lane >> 5, nb = nt * 128 + 64 * wc;
#pragma unroll
    for (int ms = 0; ms < 2; ++ms) {
      const int row = mt * 128 + 64 * wr + 32 * ms + r;
      const float rs = row_rstd(p.part, row);
      const int b = row >> 13, t = row & 8191;
      if (nb < 2048) {
        const bool isq = nb < 1024;
        norm_store<false>(acc[ms], rs, isq ? p.a_q_gain : p.a_k_gain, 0, (isq ? p.qb : p.kb) + ((size_t)(b * 16 + ((nb & 1023) >> 6)) * T_ + t) * 64, h);
      } else if (nb < 3072) {
        const int head = (nb - 2048) >> 6;
        bf16_t* dst = p.vT + ((size_t)((b * 16 + head) * 128 + (t >> 6))) * 4096 + (t & 63);
#pragma unroll
        for (int ns = 0; ns < 2; ++ns)
#pragma unroll
          for (int i = 0; i < 16; ++i) dst[(32 * ns + crow(i, h)) * 64] = f2bf(acc[ms][ns][i] * rs);
      } else if (nb == 3072) {
#pragma unroll
        for (int i = 0; i < 8; ++i) {
          const int head = crow(i, h);
          const float z = acc[ms][0][i] * rs + p.a_b_f[head];
          p.lf[((size_t)(b * 16 + head)) * T_ + t] = fminf(z, 0.f) - log1pf(expf(-fabsf(z)));
        }
      }
    }
  }
};

template <int MODE>
struct EpiResid {
  const float* res; float* out; bf16_t* hb; float* part;
  DI void operator()(f32x16 (&acc)[2][2], int mt, int nt, int wr, int wc, int lane, char* smem) const {
    float* sU = (float*)smem;
    const int r = lane & 31, h = lane >> 5, tid = threadIdx.x;
    __syncthreads();
#pragma unroll
    for (int ms = 0; ms < 2; ++ms) {
      const int ml = 64 * wr + 32 * ms + r;
#pragma unroll
      for (int ns = 0; ns < 2; ++ns)
#pragma unroll
        for (int i = 0; i < 16; ++i) sU[ml * 132 + 64 * wc + 32 * ns + crow(i, h)] = acc[ms][ns][i];
    }
    __syncthreads();
    const int c4 = (tid & 31) * 4, n = nt * 128 + c4;
#pragma unroll 1
    for (int hh = 0; hh < 2; ++hh) {
      f32x4 rv[8];
#pragma unroll
      for (int it = 0; it < 8; ++it) {
        const int row = mt * 128 + (hh * 8 + it) * 8 + (tid >> 5);
        if (MODE == 0) rv[it] = *(const f32x4*)(res + (size_t)row * 1024 + n);
        else {
          const u32x2 v = *(const u32x2*)(hb + a_off(row, n, 16));
          rv[it] = (f32x4){bf2f((bf16_t)(v.x & 0xffff)), bf2f((bf16_t)(v.x >> 16)), bf2f((bf16_t)(v.y & 0xffff)), bf2f((bf16_t)(v.y >> 16))};
        }
      }
#pragma unroll
      for (int it = 0; it < 8; ++it) {
        const int rl = (hh * 8 + it) * 8 + (tid >> 5), row = mt * 128 + rl;
        const f32x4 o = rv[it] + *(const f32x4*)(sU + rl * 132 + c4);
        if (MODE == 2) *(f32x4*)(out + (size_t)row * 1024 + n) = o;
        else {
          store_bf4(hb + a_off(row, n, 16), o.x, o.y, o.z, o.w);
          float ss = o.x * o.x + o.y * o.y + o.z * o.z + o.w * o.w;
          ss += __shfl_xor(ss, 1); ss += __shfl_xor(ss, 2); ss += __shfl_xor(ss, 4); ss += __shfl_xor(ss, 8); ss += __shfl_xor(ss, 16);
          if ((tid & 31) == 0) { part[(size_t)row * 16 + nt * 2] = ss; part[(size_t)row * 16 + nt * 2 + 1] = 0.f; }
        }
      }
    }
  }
};

struct EpiFfnUp {
  const float* part; const float* cw; const float* cb; bf16_t* act;
  DI void operator()(f32x16 (&acc)[2][2], int mt, int nt, int wr, int wc, int lane, char* smem) const {
    float* sU = (float*)smem;
    const int r = lane & 31, h = lane >> 5, tid = threadIdx.x;
    const int b = mt / 66, it = mt - b * 66, tb = 126 * it - 2;
    __syncthreads();
#pragma unroll
    for (int ms = 0; ms < 2; ++ms) {
      const int ml = 64 * wr + 32 * ms + r, t = tb + ml;
      const float rs = (t >= 0 && t < T_) ? row_rstd(part, b * T_ + t) : 0.f;
#pragma unroll
      for (int ns = 0; ns < 2; ++ns)
#pragma unroll
        for (int i = 0; i < 16; ++i) sU[ml * 129 + 64 * wc + 32 * ns + crow(i, h)] = acc[ms][ns][i] * rs;
    }
    __syncthreads();
    const int jj = tid & 63, rg = tid >> 6, j = nt * 64 + jj;
    const float wg0 = cw[j], wg1 = cw[5632 + j], wg2 = cw[2 * 5632 + j], bgt = cb[j];
    const float wv0 = cw[FF + j], wv1 = cw[5632 + FF + j], wv2 = cw[2 * 5632 + FF + j], bvl = cb[FF + j];
    for (int ml = 2 + rg; ml < 128; ml += 4) {
      const int t = tb + ml;
      if (t >= T_) break;
      const float g = bgt + wg0 * sU[(ml - 2) * 129 + jj] + wg1 * sU[(ml - 1) * 129 + jj] + wg2 * sU[ml * 129 + jj];
      const float v = bvl + wv0 * sU[(ml - 2) * 129 + 64 + jj] + wv1 * sU[(ml - 1) * 129 + 64 + jj] + wv2 * sU[ml * 129 + 64 + jj];
      const float a = g / (1.0f + __expf(-g)) * v;
      act[a_off(b * T_ + t, j, 44)] = f2bf(a);
    }
  }
};

struct EpiKv {
  const Params& p;
  DI void operator()(f32x16 (&acc)[2][2], int mt, int nt, int wr, int wc, int lane, char*) const {
    const int r = lane & 31, h = lane >> 5, g = wc;
#pragma unroll
    for (int ms = 0; ms < 2; ++ms) {
      const int row = mt * 128 + 64 * wr + 32 * ms + r;
      const float rs = row_rstd(p.part, row);
      const int b = row >> 13, t = row & 8191, bg = b * 2 + g;
      if (nt < 2) {
        bf16_t* dst = p.rawc + (((size_t)(nt * 8 + bg)) * T_ + t) * 64;
#pragma unroll
        for (int ns = 0; ns < 2; ++ns)
#pragma unroll
          for (int q = 0; q < 4; ++q)
            store_bf4(dst + 32 * ns + 8 * q + 4 * h, acc[ms][ns][4 * q] * rs, acc[ms][ns][4 * q + 1] * rs, acc[ms][ns][4 * q + 2] * rs, acc[ms][ns][4 * q + 3] * rs);
      } else if (nt == 2 || nt == 4) {
        norm_store<true>(acc[ms], rs, nt == 2 ? p.ks_gain : p.kw_gain, p.pos[row], (nt == 2 ? p.ksb : p.kwb) + ((size_t)bg * T_ + t) * 64, h);
      } else if (nt == 3) {
        bf16_t* dst = p.vsT + ((size_t)bg * 128 + (t >> 6)) * 4096 + (t & 63);
#pragma unroll
        for (int ns = 0; ns < 2; ++ns)
#pragma unroll
          for (int i = 0; i < 16; ++i) dst[(32 * ns + crow(i, h)) * 64] = f2bf(acc[ms][ns][i] * rs);
      } else {
        bf16_t* dst = p.vwT + ((size_t)bg * 128 + (t >> 6)) * 4096 + (t & 63);
#pragma unroll
        for (int ns = 0; ns < 2; ++ns)
#pragma unroll
          for (int i = 0; i < 16; ++i) dst[(32 * ns + crow(i, h)) * 64] = f2bf(acc[ms][ns][i] * rs);
      }
    }
  }
};

struct EpiBIn {
  const Params& p;
  DI void operator()(f32x16 (&acc)[2][2], int mt, int nt, int wr, int wc, int lane, char*) const {
    const int r = lane & 31, h = lane >> 5, nb = nt * 128 + 64 * wc;
#pragma unroll
    for (int ms = 0; ms < 2; ++ms) {
      const int row = mt * 128 + 64 * wr + 32 * ms + r;
      const float rs = row_rstd(p.part, row);
      if (nb < 1024) {
        norm_store<true>(acc[ms], rs, p.b_q_gain, p.pos[row], p.qn + (size_t)row * 1024 + nb, h);
      } else if (nb == 1024) {
#pragma unroll
        for (int ns = 0; ns < 2; ++ns)
#pragma unroll
          for (int i = 0; i < 16; ++i) {
            const int c = 32 * ns + crow(i, h);
            if (c < 48) { const float z = acc[ms][ns][i] * rs + p.b_b_gate[c]; p.gates[(size_t)row * 48 + c] = 1.0f / (1.0f + __expf(-z)); }
          }
      }
    }
  }
};

struct EpiCmp1P {
  float* dst;
  DI void operator()(f32x16 (&acc)[2][2], int mt, int nt, int wr, int wc, int lane, char*) const {
    const int r = lane & 31, h = lane >> 5;
#pragma unroll
    for (int ms = 0; ms < 2; ++ms) {
      const int m = mt * 128 + 64 * wr + 32 * ms + r;
#pragma unroll
      for (int ns = 0; ns < 2; ++ns)
#pragma unroll
        for (int q = 0; q < 4; ++q) {
          f32x4 v = {acc[ms][ns][4 * q], acc[ms][ns][4 * q + 1], acc[ms][ns][4 * q + 2], acc[ms][ns][4 * q + 3]};
          *(f32x4*)(dst + (size_t)m * 256 + nt * 128 + 64 * wc + 32 * ns + 8 * q + 4 * h) = v;
        }
    }
  }
};
DI float gelu_tanh(float x) { return 0.5f * x * (1.0f + tanhf(0.7978845608028654f * (x + 0.044715f * x * x * x))); }
struct ALCmp2P {
  const float* P;
  DI u32x4 operator()(int mt, int ml, int k) const {
    const int m = mt * 128 + ml;
    if (m >= 4088) return (u32x4){0, 0, 0, 0};
    f32x4 a = {0.f, 0.f, 0.f, 0.f}, b = {0.f, 0.f, 0.f, 0.f};
#pragma unroll
    for (int s4 = 0; s4 < 4; ++s4) {
      const float* q = P + ((size_t)s4 * 4096 + m) * 256 + k;
      a += *(const f32x4*)q; b += *(const f32x4*)(q + 4);
    }
    u32x4 o;
    o.x = pack2(gelu_tanh(a.x), gelu_tanh(a.y)); o.y = pack2(gelu_tanh(a.z), gelu_tanh(a.w));
    o.z = pack2(gelu_tanh(b.x), gelu_tanh(b.y)); o.w = pack2(gelu_tanh(b.z), gelu_tanh(b.w));
    return o;
  }
};

struct EpiCmp1 {
  bf16_t* hid;
  DI void operator()(f32x16 (&acc)[2][2], int mt, int nt, int wr, int wc, int lane, char*) const {
    const int r = lane & 31, h = lane >> 5;
#pragma unroll
    for (int ms = 0; ms < 2; ++ms) {
      const int m = mt * 128 + 64 * wr + 32 * ms + r;
      if (m >= 4088) continue;
#pragma unroll
      for (int ns = 0; ns < 2; ++ns) {
        float g[16];
#pragma unroll
        for (int i = 0; i < 16; ++i) { const float x = acc[ms][ns][i]; g[i] = 0.5f * x * (1.0f + tanhf(0.7978845608028654f * (x + 0.044715f * x * x * x))); }
#pragma unroll
        for (int q = 0; q < 4; ++q) store_bf4(hid + (size_t)m * 256 + nt * 128 + 64 * wc + 32 * ns + 8 * q + 4 * h, g[4 * q], g[4 * q + 1], g[4 * q + 2], g[4 * q + 3]);
      }
    }
  }
};

struct EpiCmp2 {
  const Params& p; int sel;
  DI void operator()(f32x16 (&acc)[2][2], int mt, int nt, int wr, int wc, int lane, char*) const {
    if (wc != 0) return;
    const int r = lane & 31, h = lane >> 5;
#pragma unroll
    for (int ms = 0; ms < 2; ++ms) {
      const int m = mt * 128 + 64 * wr + 32 * ms + r;
      if (m < 4088) {
        const int bg = m / 511, n = m - bg * 511, b = bg >> 1;
        if (sel == 0) {
          norm_store<true>(acc[ms], 1.0f, p.kc_gain, p.pos[b * T_ + 16 * n + 31], p.kcb + ((size_t)bg * 512 + n) * 64, h);
        } else {
          bf16_t* dst = p.vcT + ((size_t)(bg * 8 + (n >> 6))) * 4096 + (n & 63);
#pragma unroll
          for (int ns = 0; ns < 2; ++ns)
#pragma unroll
            for (int i = 0; i < 16; ++i) dst[(32 * ns + crow(i, h)) * 64] = f2bf(acc[ms][ns][i]);
        }
      } else {
      }
    }
  }
};

DI void phase_scan(const Params& p, char* smem) {
  float* sW = (float*)smem;
  const int tid = threadIdx.x, lane = tid & 63, w = tid >> 6;
  for (int seq = blockIdx.x; seq < 64; seq += gridDim.x) {
    const float* src = p.lf + (size_t)seq * T_ + tid * 32;
    float* dst = p.cc + (size_t)seq * T_ + tid * 32;
    f32x4 v[8];
#pragma unroll
    for (int i = 0; i < 8; ++i) v[i] = *(const f32x4*)(src + 4 * i);
    float s = 0.f;
#pragma unroll
    for (int i = 0; i < 8; ++i) { s += v[i].x; s += v[i].y; s += v[i].z; s += v[i].w; }
    float inc = s;
#pragma unroll
    for (int o = 1; o < 64; o <<= 1) { const float u = __shfl_up(inc, o); if (lane >= o) inc += u; }
    __syncthreads();
    if (lane == 63) sW[w] = inc;
    __syncthreads();
    float run = inc - s;
    for (int q = 0; q < w; ++q) run += sW[q];
#pragma unroll
    for (int i = 0; i < 8; ++i) {
      f32x4 o;
      run += v[i].x; o.x = run; run += v[i].y; o.y = run; run += v[i].z; o.z = run; run += v[i].w; o.w = run;
      *(f32x4*)(dst + 4 * i) = o;
    }
  }
}

template <int MODE>
DI void flash_step(f32x16 (&o)[2], float& l, const bf16x8 (&qf)[4], const bf16_t* sK, const bf16_t* sV, const float* sC,
                   int kbase, int tq, float bias0, float inv_l, float* sImpRow, int lane, bool selok = true) {
  const int r = lane & 31, h = lane >> 5;
  constexpr float SC = 0.125f * 1.4426950408889634f;
  const int base_hi = (MODE == 2 || MODE == 3) ? ((tq - 31) >> 4) : tq;
  const float bsel = (MODE == 4 && !selok) ? -1e30f : bias0;
#pragma unroll
  for (int sub = 0; sub < 2; ++sub) {
    f32x16 s;
#pragma unroll
    for (int i = 0; i < 16; ++i) s[i] = 0.f;
#pragma unroll
    for (int ks = 0; ks < 4; ++ks) {
      const bf16x8 a = *(const bf16x8*)(sK + (32 * sub + r) * 72 + 16 * ks + 8 * h);
      s = mfma32(a, qf[ks], s);
    }
    const int hi = base_hi - kbase - 32 * sub - 4 * h;
    const int lo = (MODE == 1) ? hi - 511 : -1000000;
    const bool nomask = __all((hi >= 27) && (lo <= 0));
    if (MODE == 0) {
#pragma unroll
      for (int q = 0; q < 4; ++q) {
        const f32x4 c4 = *(const f32x4*)(sC + 32 * sub + 8 * q + 4 * h);
#pragma unroll
        for (int j = 0; j < 4; ++j) s[4 * q + j] = fmaf(s[4 * q + j], SC, bias0 - c4[j]);
      }
    } else {
#pragma unroll
      for (int i = 0; i < 16; ++i) s[i] = fmaf(s[i], SC, bsel);
    }
    if (!nomask) {
#pragma unroll
      for (int i = 0; i < 16; ++i) { const int cst = (i & 3) + 8 * (i >> 2); s[i] = (cst <= hi && cst >= lo) ? s[i] : -1e30f; }
    }
    float ls = 0.f;
#pragma unroll
    for (int i = 0; i < 16; ++i) { const float pv = __builtin_amdgcn_exp2f(s[i]); s[i] = pv; ls += pv; }
    l += ls;
    if (MODE == 2) continue;
    if (MODE == 3) {
#pragma unroll
      for (int q = 0; q < 4; ++q) {
        const float p3 = s[4 * q + 3] * inv_l;
        float A = (s[4 * q] + s[4 * q + 1] + s[4 * q + 2]) * inv_l + 0.5f * p3, B = 0.5f * p3;
        A += __shfl_xor(A, 1); A += __shfl_xor(A, 2); A += __shfl_xor(A, 4);
        B += __shfl_xor(B, 1); B += __shfl_xor(B, 2); B += __shfl_xor(B, 4);
        if ((r & 7) == 0) { const int j = ((kbase + 32 * sub) >> 2) + 2 * q + h; atomicAdd(&sImpRow[j], A); atomicAdd(&sImpRow[j + 1], B); }
      }
    }
#pragma unroll
    for (int st = 0; st < 2; ++st) {
      u32x4 pk;
      pk.x = pack2(s[8 * st + 0], s[8 * st + 1]); pk.y = pack2(s[8 * st + 2], s[8 * st + 3]);
      pk.z = pack2(s[8 * st + 4], s[8 * st + 5]); pk.w = pack2(s[8 * st + 6], s[8 * st + 7]);
      const bf16x8 pf = __builtin_bit_cast(bf16x8, pk);
#pragma unroll
      for (int d = 0; d < 2; ++d) {
        const bf16_t* vp = sV + (32 * d + r) * 72 + 32 * sub + 16 * st + 4 * h;
        const bf16x4 lo4 = *(const bf16x4*)vp, hi4 = *(const bf16x4*)(vp + 8);
        const bf16x8 vf = __builtin_shufflevector(lo4, hi4, 0, 1, 2, 3, 4, 5, 6, 7);
        o[d] = mfma32(vf, pf, o[d]);
      }
    }
  }
}

DI void tile_load(u32x4 (&kr)[2], u32x4 (&vr)[2], const bf16_t* kptr, int kstride, const bf16_t* vptr, int vstride, bool withV, int tid) {
#pragma unroll
  for (int i = 0; i < 2; ++i) {
    const int c = tid + 256 * i, row = c >> 3, ch = (c & 7) * 8;
    kr[i] = *(const u32x4*)(kptr + (size_t)row * kstride + ch);
    if (withV) vr[i] = *(const u32x4*)(vptr + (size_t)row * vstride + ch);
  }
}
DI void tile_store(const u32x4 (&kr)[2], const u32x4 (&vr)[2], bf16_t* sK, bf16_t* sV, bool withV, int tid) {
#pragma unroll
  for (int i = 0; i < 2; ++i) {
    const int c = tid + 256 * i, row = c >> 3, ch = (c & 7) * 8;
    *(u32x4*)(sK + row * 72 + ch) = kr[i];
    if (withV) *(u32x4*)(sV + row * 72 + ch) = vr[i];
  }
}

template <class LoadF, class StoreF, class BodyF>
DI void dense_loop(int n, LoadF ld, StoreF st, BodyF body) {
  if (n <= 0) return;
  ld(0); st(0);
  if (n > 1) ld(1);
  __syncthreads();
  for (int e = 0; e < n; ++e) {
    const int cur = e & 1;
    if (e + 1 < n) st(cur ^ 1);
    if (e + 2 < n) ld(e + 2);
    body(e, cur);
    __syncthreads();
  }
}

DI void phase_fox(const Params& p, char* smem) {
  bf16_t* sKV = (bf16_t*)smem;
  float* sC = (float*)(sKV + 4 * 64 * 72);
  const int tid = threadIdx.x, lane = tid & 63, w = tid >> 6, r = lane & 31, h = lane >> 5;
  float gq = 0.f, gk = 0.f;
  for (int i = 0; i < 64; ++i) { gq = fmaxf(gq, fabsf(p.a_q_gain[i])); gk = fmaxf(gk, fabsf(p.a_k_gain[i])); }
  const float smax = 8.0f * gq * gk * 1.05f;
  const float thr = 40.0f + 2.0f * smax;
  const float negM2 = -smax * 1.4426950408889634f;
  for (int item = blockIdx.x; item < 4096; item += gridDim.x) {
    const int bh = item & 63, qt = 63 - (item >> 6), b = bh >> 4, head = bh & 15, t0 = qt * 128;
    const int tq = t0 + 32 * w + r;
    const bf16_t* qrow = p.qb + ((size_t)bh * T_ + tq) * 64;
    bf16x8 qf[4];
#pragma unroll
    for (int ks = 0; ks < 4; ++ks) qf[ks] = *(const bf16x8*)(qrow + 16 * ks + 8 * h);
    const float* cseq = p.cc + (size_t)bh * T_;
    const float cq = cseq[tq] * 1.4426950408889634f, c0 = cseq[t0];
    const bf16_t* kbp = p.kb + (size_t)bh * T_ * 64;
    const bf16_t* vbp = p.vT + (size_t)bh * 128 * 4096;
    f32x16 o[2];
#pragma unroll
    for (int d = 0; d < 2; ++d)
#pragma unroll
      for (int i = 0; i < 16; ++i) o[d][i] = 0.f;
    float l = 0.f;
    u32x4 kr[2], vr[2]; f32x4 cr = (f32x4){0.f, 0.f, 0.f, 0.f};
    const int jmax = 2 * qt + 1;
    int jmin = jmax;
    while (jmin > 0 && !(c0 - cseq[64 * (jmin - 1) + 63] < -thr)) --jmin;
    dense_loop(jmax - jmin + 1,
      [&](int e) { const int jt = jmax - e; tile_load(kr, vr, kbp + (size_t)jt * 4096, 64, vbp + (size_t)jt * 4096, 64, true, tid); if (tid < 16) cr = *(const f32x4*)(cseq + 64 * jt + 4 * tid); },
      [&](int bf) { tile_store(kr, vr, sKV + bf * 2 * 64 * 72, sKV + bf * 2 * 64 * 72 + 64 * 72, true, tid); if (tid < 16) *(f32x4*)(sC + bf * 64 + 4 * tid) = cr * 1.4426950408889634f; },
      [&](int e, int cur) {
        const int kbase = 64 * (jmax - e);
        if (kbase <= t0 + 32 * w + 31) flash_step<0>(o, l, qf, sKV + cur * 2 * 64 * 72, sKV + cur * 2 * 64 * 72 + 64 * 72, sC + cur * 64, kbase, tq, cq + negM2, 0.f, nullptr, lane);
      });
    const float lt = l + __shfl_xor(l, 32);
    const float inv = 1.0f / lt;
    bf16_t* orow = p.ob + a_off(b * T_ + tq, head * 64, 16);
#pragma unroll
    for (int d = 0; d < 2; ++d)
#pragma unroll
      for (int q = 0; q < 4; ++q) store_bf4(orow + 32 * d + 8 * q + 4 * h, o[d][4 * q] * inv, o[d][4 * q + 1] * inv, o[d][4 * q + 2] * inv, o[d][4 * q + 3] * inv);
  }
}

DI void phase_nsa(const Params& p, char* smem) {
  bf16_t* sKV = (bf16_t*)smem;
  float* sU = (float*)(sKV + 4 * 64 * 72);
  float* sImp = sU; float* sO = sU;
  unsigned* sMask = (unsigned*)(sU + 128 * 65);
  int* sList = (int*)(sMask + 64);
  const int tid = threadIdx.x, lane = tid & 63, w = tid >> 6, r = lane & 31, h = lane >> 5;
  float gqm = 0.f, gkm = 0.f;
  for (int i = 0; i < 64; ++i) { gqm = fmaxf(gqm, fabsf(p.b_q_gain[i])); gkm = fmaxf(gkm, fmaxf(fabsf(p.kc_gain[i]), fmaxf(fabsf(p.ks_gain[i]), fabsf(p.kw_gain[i])))); }
  const float negM2 = -8.0f * gqm * gkm * 1.05f * 1.4426950408889634f;
  auto stK = [&](int bf) { return sKV + bf * 2 * 64 * 72; };
  for (int item = blockIdx.x; item < 4096; item += gridDim.x) {
    const int bg = item & 7, tt = 511 - (item >> 3), b = bg >> 1, g = bg & 1, t0 = tt * 16;
    const int tokl = 4 * w + (r >> 3), head = r & 7, tq = t0 + tokl;
    __syncthreads();
    for (int i = tid; i < 16 * 132; i += 256) sImp[i] = 0.f;
    bf16x8 qf[4];
    {
      const bf16_t* qrow = p.qn + ((size_t)b * T_ + tq) * 1024 + (g * 8 + head) * 64;
#pragma unroll
      for (int ks = 0; ks < 4; ++ks) qf[ks] = *(const bf16x8*)(qrow + 16 * ks + 8 * h);
    }
    const float* grow = p.gates + ((size_t)b * T_ + tq) * 48 + g * 8 + head;
    const float gate_c = grow[0], gate_w = grow[32];
    f32x16 o[2];
    float l = 0.f;
    u32x4 kr[2], vr[2];
    const int ncmp = t0 >> 4, nct = (ncmp + 63) >> 6;
    const bf16_t* kcp = p.kcb + (size_t)bg * 512 * 64;
    const bf16_t* vcp = p.vcT + (size_t)bg * 8 * 4096;
    dense_loop(nct,
      [&](int e) { tile_load(kr, vr, kcp + (size_t)e * 4096, 64, vcp, 64, false, tid); },
      [&](int bf) { tile_store(kr, vr, stK(bf), stK(bf) + 64 * 72, false, tid); },
      [&](int e, int cur) { flash_step<2>(o, l, qf, stK(cur), stK(cur) + 64 * 72, nullptr, 64 * e, tq, negM2, 0.f, nullptr, lane); });
    const float lc = l + __shfl_xor(l, 32);
    const float inv_lc = lc > 0.f ? 1.0f / lc : 0.f;
#pragma unroll
    for (int d = 0; d < 2; ++d)
#pragma unroll
      for (int i = 0; i < 16; ++i) o[d][i] = 0.f;
    float l2 = 0.f;
    dense_loop(nct,
      [&](int e) { tile_load(kr, vr, kcp + (size_t)e * 4096, 64, vcp + (size_t)e * 4096, 64, true, tid); },
      [&](int bf) { tile_store(kr, vr, stK(bf), stK(bf) + 64 * 72, true, tid); },
      [&](int e, int cur) { flash_step<3>(o, l2, qf, stK(cur), stK(cur) + 64 * 72, nullptr, 64 * e, tq, negM2, inv_lc, sImp + tokl * 132, lane); });
    __syncthreads();
    const int cur_blk = t0 >> 6;
    for (int tk = 0; tk < 4; ++tk) {
      const int tok = 4 * w + tk;
      float* sc = sImp + tok * 132;
      for (int j = lane; j <= cur_blk; j += 64) if (j == 0 || j == cur_blk || j == cur_blk - 1) sc[j] = 1e6f;
    }
    __syncthreads();
    for (int tk = 0; tk < 4; ++tk) {
      const int tok = 4 * w + tk;
      const float* sc = sImp + tok * 132;
      unsigned long long mk0, mk1;
      {
        const int j = lane;
        const bool vj = j <= cur_blk;
        const float sj = vj ? sc[j] : 0.f;
        int rank = 0;
        for (int i = 0; i <= cur_blk; ++i) { const float si = sc[i]; rank += ((si > sj) || (si == sj && i < j)) ? 1 : 0; }
        mk0 = __ballot(vj && rank < 16);
      }
      {
        const int j = lane + 64;
        const bool vj = j <= cur_blk;
        const float sj = vj ? sc[j] : 0.f;
        int rank = 0;
        for (int i = 0; i <= cur_blk; ++i) { const float si = sc[i]; rank += ((si > sj) || (si == sj && i < j)) ? 1 : 0; }
        mk1 = __ballot(vj && rank < 16);
      }
      if (lane == 0) {
        sMask[tok * 4 + 0] = (unsigned)mk0; sMask[tok * 4 + 1] = (unsigned)(mk0 >> 32);
        sMask[tok * 4 + 2] = (unsigned)mk1; sMask[tok * 4 + 3] = (unsigned)(mk1 >> 32);
      }
    }
    __syncthreads();
    int n_un;
    {
      unsigned u0 = 0, u1 = 0, u2 = 0, u3 = 0;
      for (int tok = 0; tok < 16; ++tok) { u0 |= sMask[tok * 4]; u1 |= sMask[tok * 4 + 1]; u2 |= sMask[tok * 4 + 2]; u3 |= sMask[tok * 4 + 3]; }
      const int c0 = __popc(u0), c1 = __popc(u1), c2 = __popc(u2), c3 = __popc(u3);
      n_un = c0 + c1 + c2 + c3;
      if (tid < 128) {
        const int wd = tid >> 5, bit = tid & 31;
        const unsigned uw = wd == 0 ? u0 : wd == 1 ? u1 : wd == 2 ? u2 : u3;
        if ((uw >> bit) & 1u) {
          const int pre = (wd > 0 ? c0 : 0) + (wd > 1 ? c1 : 0) + (wd > 2 ? c2 : 0);
          sList[pre + __popc(uw & ((1u << bit) - 1u))] = tid;
        }
      }
    }
    __syncthreads();
    {
      const float sc = gate_c * inv_lc;
      float* orow = sO + (32 * w + r) * 65;
#pragma unroll
      for (int d = 0; d < 2; ++d)
#pragma unroll
        for (int i = 0; i < 16; ++i) orow[32 * d + crow(i, h)] = o[d][i] * sc;
    }
#pragma unroll
    for (int d = 0; d < 2; ++d)
#pragma unroll
      for (int i = 0; i < 16; ++i) o[d][i] = 0.f;
    l = 0.f;
    {
      const bf16_t* ksp = p.ksb + (size_t)bg * T_ * 64;
      const bf16_t* vsp = p.vsT + (size_t)bg * 128 * 4096;
      dense_loop(n_un,
        [&](int e) { const int blk = sList[e]; tile_load(kr, vr, ksp + (size_t)blk * 4096, 64, vsp + (size_t)blk * 4096, 64, true, tid); },
        [&](int bf) { tile_store(kr, vr, stK(bf), stK(bf) + 64 * 72, true, tid); },
        [&](int e, int cur) {
          const int blk = sList[e];
          const int wd = blk >> 5, bit = blk & 31;
          const unsigned wm = sMask[(4 * w) * 4 + wd] | sMask[(4 * w + 1) * 4 + wd] | sMask[(4 * w + 2) * 4 + wd] | sMask[(4 * w + 3) * 4 + wd];
          if ((wm >> bit) & 1u) {
            const bool selok = (sMask[tokl * 4 + wd] >> bit) & 1u;
            flash_step<4>(o, l, qf, stK(cur), stK(cur) + 64 * 72, nullptr, 64 * blk, tq, negM2, 0.f, nullptr, lane, selok);
          }
        });
      const float lt = l + __shfl_xor(l, 32);
      const float sc = grow[16] / lt;
      float* orow = sO + (32 * w + r) * 65;
#pragma unroll
      for (int d = 0; d < 2; ++d)
#pragma unroll
        for (int i = 0; i < 16; ++i) orow[32 * d + crow(i, h)] += o[d][i] * sc;
    }
#pragma unroll
    for (int d = 0; d < 2; ++d)
#pragma unroll
      for (int i = 0; i < 16; ++i) o[d][i] = 0.f;
    l = 0.f;
    {
      const int klo = t0 - 511 > 0 ? t0 - 511 : 0, jt0 = klo >> 6, jt1 = (t0 + 15) >> 6;
      const bf16_t* kwp = p.kwb + (size_t)bg * T_ * 64;
      const bf16_t* vwp = p.vwT + (size_t)bg * 128 * 4096;
      dense_loop(jt1 - jt0 + 1,
        [&](int e) { tile_load(kr, vr, kwp + (size_t)(jt0 + e) * 4096, 64, vwp + (size_t)(jt0 + e) * 4096, 64, true, tid); },
        [&](int bf) { tile_store(kr, vr, stK(bf), stK(bf) + 64 * 72, true, tid); },
        [&](int e, int cur) { flash_step<1>(o, l, qf, stK(cur), stK(cur) + 64 * 72, nullptr, 64 * (jt0 + e), tq, negM2, 0.f, nullptr, lane); });
      const float lt = l + __shfl_xor(l, 32);
      const float sc = gate_w / lt;
      float* orow = sO + (32 * w + r) * 65;
#pragma unroll
      for (int d = 0; d < 2; ++d)
#pragma unroll
        for (int i = 0; i < 16; ++i) orow[32 * d + crow(i, h)] += o[d][i] * sc;
    }
    __syncthreads();
    for (int c = tid; c < 128 * 16; c += 256) {
      const int row = c >> 4, d4 = (c & 15) * 4, tok = row >> 3, hd = row & 7;
      const float* s = sO + row * 65 + d4;
      store_bf4(p.ob + a_off(b * T_ + t0 + tok, (g * 8 + hd) * 64 + d4, 16), s[0], s[1], s[2], s[3]);
    }
  }
}


#define XB_TMO      128
#define XB_XCNT(j)  (256  + 64 * (j))
#define XB_XSUB(j)  (1280 + 64 * (j))
#define XB_XGEN(j)  (2304 + 64 * (j))
#define XB_TOP      3328
#define XB_TOPGEN   3392
#define XCD_BAR_WORDS 3456
#define XB_SPIN_CAP (1u << 18)
#define LAS __attribute__((address_space(3)))
DI unsigned xb_ld(unsigned* p) { return __hip_atomic_load(p, __ATOMIC_RELAXED, __HIP_MEMORY_SCOPE_AGENT); }
DI unsigned xb_add(unsigned* p, unsigned v) { return __hip_atomic_fetch_add(p, v, __ATOMIC_RELAXED, __HIP_MEMORY_SCOPE_AGENT); }
DI unsigned xb_xcc_id() { return (unsigned)__builtin_amdgcn_s_getreg((3 << 11) | 20) & 0xFu; }
#define XB_SPIN(cond, bar) do { unsigned _sp = 0; while (cond) { __builtin_amdgcn_s_sleep(1); \
    if ((++_sp & 255u) == 0u) { if (xb_ld(&(bar)[XB_TMO])) break; if (_sp > XB_SPIN_CAP) { atomicAdd(&(bar)[XB_TMO], 1u); break; } } } } while (0)
struct XcdBarrier { unsigned* bar; unsigned x; volatile LAS unsigned* st; };
DI XcdBarrier xcd_barrier_post(unsigned* bar, volatile LAS unsigned* st) {
  XcdBarrier b; b.bar = bar; b.x = xb_xcc_id(); b.st = st;
  if (threadIdx.x == 0) (void)xb_add(&bar[XB_XCNT(b.x)], 1u);
  return b;
}
DI void xcd_barrier_complete(unsigned* bar, unsigned x, unsigned& nloc, unsigned& nx) {
  const unsigned G = gridDim.x * gridDim.y * gridDim.z;
  unsigned sum, cnt, mine, sp = 0u;
  for (;;) {
    sum = 0u; cnt = 0u; mine = 0u;
#pragma unroll
    for (unsigned j = 0; j < 16; ++j) { const unsigned c = xb_ld(&bar[XB_XCNT(j)]); sum += c; cnt += (c > 0u) ? 1u : 0u; mine = (j == x) ? c : mine; }
    if (sum == G) break;
    __builtin_amdgcn_s_sleep(1);
    if ((++sp & 255u) == 0u) { if (xb_ld(&bar[XB_TMO])) break; if (sp > XB_SPIN_CAP) { atomicAdd(&bar[XB_TMO], 1u); break; } }
  }
  nloc = mine > 0u ? mine : 1u; nx = cnt > 0u ? cnt : 1u;
}
DI void xcd_barrier(const XcdBarrier& b) {
  asm volatile("s_waitcnt vmcnt(0)" ::: "memory");
  __syncthreads();
  if (threadIdx.x == 0) {
    unsigned* bar = b.bar;
    __builtin_amdgcn_s_waitcnt(0);
    unsigned nloc = b.st[0], nx = b.st[1];
    if (nloc == 0u) { xcd_barrier_complete(bar, b.x, nloc, nx); b.st[0] = nloc; b.st[1] = nx; }
    const unsigned old = xb_add(&bar[XB_XSUB(b.x)], 1u);
    const unsigned gen = old / nloc;
    if (old + 1u == (gen + 1u) * nloc) {
      __builtin_amdgcn_fence(__ATOMIC_RELEASE, "agent");
      asm volatile("s_waitcnt vmcnt(0)" ::: "memory");
      const unsigned og = xb_add(&bar[XB_TOP], 1u);
      const unsigned tg = og / nx;
      if (og + 1u == (tg + 1u) * nx) xb_add(&bar[XB_TOPGEN], 1u);
      else XB_SPIN(xb_ld(&bar[XB_TOPGEN]) == tg, bar);
      __builtin_amdgcn_fence(__ATOMIC_ACQUIRE, "agent");
      xb_add(&bar[XB_XGEN(b.x)], 1u);
      asm volatile("s_waitcnt vmcnt(0)" ::: "memory");
    } else {
      XB_SPIN(xb_ld(&bar[XB_XGEN(b.x)]) == gen, bar);
      __builtin_amdgcn_fence(__ATOMIC_ACQUIRE, "agent");
      asm volatile("s_waitcnt vmcnt(0)" ::: "memory");
    }
  }
  __syncthreads();
}

#ifdef ONLY_PHASE
#define PH_ON(n) ((n) == ONLY_PHASE)
#else
#define PH_ON(n) true
#endif
#define REP_PHASE -1
#define PHASE(n, ...) \
  if (PH_ON(n) && ph_lo <= (n) && (n) < ph_hi) { __VA_ARGS__ } \
  if ((n) == REP_PHASE) { cg::this_grid().sync(); { __VA_ARGS__ } } \
  if (ph_lo <= (n) && (n) + 1 < ph_hi) { if (ph_hi > 1000) cg::this_grid().sync(); else xcd_barrier(xb); }

__global__ void __launch_bounds__(256, 2) yoco_megakernel(KArgs ka, int ph_lo, int ph_hi) {
  __shared__ __attribute__((aligned(16))) char smem[SMEM_BYTES];
  Params p;
  fill_params(p, ka);
  __shared__ __attribute__((aligned(16))) unsigned xb_words[4];
  if (threadIdx.x < 4) xb_words[threadIdx.x] = 0u;
  __syncthreads();
  const XcdBarrier xb = xcd_barrier_post(p.bar, (volatile LAS unsigned*)xb_words);
  PHASE(0, phase_prep(p, smem);)
  PHASE(1, { ALPlain al{p.hb, 16}; EpiFoxIn ep{p}; gemm_phase(al, p.w_ain, 1024, 256, 25, ep, smem); })
  PHASE(2, phase_scan(p, smem);)
  PHASE(3, phase_fox(p, smem);)
  PHASE(4, { ALPlain al{p.ob, 16}; EpiResid<0> ep{p.x, p.out, p.hb, p.part}; gemm_phase(al, p.w_aout, 1024, 256, 8, ep, smem); })
  PHASE(5, { ALFfn al{p.hb}; EpiFfnUp ep{p.part, p.f_conv_w, p.f_conv_b, p.act}; gemm_phase(al, p.w_up0, 1024, 264, 44, ep, smem); })
  PHASE(6, { ALPlain al{p.act, 44}; EpiResid<1> ep{p.out, p.out, p.hb, p.part}; gemm_phase(al, p.w_dn0, FF, 256, 8, ep, smem); })
  PHASE(7, {
    ALPlain al{p.hb, 16};
    { EpiKv ep{p}; gemm_phase(al, p.w_kv, 1024, 256, 6, ep, smem); }
    { EpiBIn ep{p}; gemm_phase(al, p.w_bin, 1024, 256, 9, ep, smem); }
  })
  PHASE(8, {
    for (int item = blockIdx.x; item < 512; item += gridDim.x) {
      const int sel = item & 1, ks4 = (item >> 1) & 3, nt = (item >> 3) & 1, mt = item >> 4;
      ALCmp1 al{p.rawc + (size_t)sel * 8 * T_ * 64, sel ? p.vc_pe : p.kc_pe};
      EpiCmp1P ep{p.hidp + (size_t)(sel * 4 + ks4) * 4096 * 256};
      gemm_tile(al, sel ? p.w_vc1 : p.w_kc1, 2048, mt, nt, ep, smem, ks4 * 8, 8);
    }
  })
  PHASE(9, {
    for (int item = blockIdx.x; item < 64; item += gridDim.x) {
      const int sel = item & 1, mt = item >> 1;
      ALCmp2P al{p.hidp + (size_t)sel * 4 * 4096 * 256};
      EpiCmp2 ep{p, sel};
      gemm_tile(al, sel ? p.w_vc2 : p.w_kc2, 256, mt, 0, ep, smem);
    }
  })
  PHASE(10, phase_nsa(p, smem);)
  PHASE(11, { ALPlain al{p.ob, 16}; EpiResid<1> ep{p.out, p.out, p.hb, p.part}; gemm_phase(al, p.w_bout, 1024, 256, 8, ep, smem); })
  PHASE(12, { ALFfn al{p.hb}; EpiFfnUp ep{p.part, p.f_conv_w + 3 * 5632, p.f_conv_b + 5632, p.act}; gemm_phase(al, p.w_up1, 1024, 264, 44, ep, smem); })
  PHASE(13, { ALPlain al{p.act, 44}; EpiResid<2> ep{p.out, p.out, p.hb, p.part}; gemm_phase(al, p.w_dn1, FF, 256, 8, ep, smem); })
}

extern "C" void kernel_launch(void* const* d_in, const int* in_sizes, int n_in, void* d_out, int out_size, void* d_ws, size_t ws_size, hipStream_t stream) {
  KArgs p{};
  for (int i = 0; i < 29; ++i) p.in[i] = d_in[i];
  p.out = (float*)d_out; p.ws = (char*)d_ws;
  hipMemsetAsync(d_ws, 0, 16384, stream);
  static int grid_blocks = 0;
  if (!grid_blocks) {
    int dev = 0, cus = 0, per_cu = 0;
    hipGetDevice(&dev);
    hipDeviceGetAttribute(&cus, hipDeviceAttributeMultiprocessorCount, dev);
    hipOccupancyMaxActiveBlocksPerMultiprocessor(&per_cu, yoco_megakernel, 256, 0);
    if (per_cu > 2) per_cu = 2;
    if (per_cu < 1) per_cu = 1;
    grid_blocks = cus * per_cu;
    grid_blocks &= ~7;
  }
#if N_LAUNCH_SPLIT
  for (int ph = 0; ph < NPHASE; ++ph) {
    int lo = ph, hi = ph + 1;
    hipLaunchKernelGGL(yoco_megakernel, dim3(grid_blocks), dim3(256), 0, stream, p, lo, hi);
  }
#else
  int lo = 0, hi = NPHASE;
  void* args[] = {&p, &lo, &hi};
  hipError_t e = hipLaunchCooperativeKernel((void*)yoco_megakernel, dim3(grid_blocks), dim3(256), args, 0, stream);
  if (e != hipSuccess) fprintf(stderr, "cooperative launch failed: %s (grid %d)\n", hipGetErrorString(e), grid_blocks);
#endif
}
```

```cpp
#include <hip/hip_runtime.h>
#include <hip/hip_cooperative_groups.h>
#include <stdint.h>
#include <cstdio>
namespace cg = cooperative_groups;

#ifndef N_LAUNCH_SPLIT
#define N_LAUNCH_SPLIT 0
#endif

#define DI __device__ __forceinline__
typedef unsigned short bf16_t;
typedef short bf16x8 __attribute__((ext_vector_type(8)));
typedef short bf16x4 __attribute__((ext_vector_type(4)));
typedef float f32x16 __attribute__((ext_vector_type(16)));
typedef float f32x4 __attribute__((ext_vector_type(4)));
typedef unsigned u32x4 __attribute__((ext_vector_type(4)));
typedef unsigned u32x2 __attribute__((ext_vector_type(2)));

constexpr int T_ = 8192;
constexpr int NTOK = 32768;
constexpr int FF = 2816;
constexpr int NPHASE = 14;
constexpr int SMEM_BYTES = 73728;

struct Params {
  const float* x; const int* pos;
  const float *a_norm, *a_w_in, *a_b_f, *a_q_gain, *a_k_gain, *a_w_out;
  const float *kv_norm, *kv_w, *kc_pe, *vc_pe, *kc_w1, *kc_w2, *vc_w1, *vc_w2, *kc_gain, *ks_gain, *kw_gain;
  const float *b_norm, *b_w_in, *b_b_gate, *b_q_gain, *b_w_out;
  const float *f_norm, *f_w_up, *f_conv_w, *f_conv_b, *f_w_down;
  float* out;
  bf16_t *w_ain, *w_aout, *w_kv, *w_kc1, *w_vc1, *w_kc2, *w_vc2, *w_bin, *w_bout, *w_up0, *w_up1, *w_dn0, *w_dn1;
  bf16_t* hb; float* part; float* lf; float* cc; bf16_t* ob;
  bf16_t *qb, *kb, *vT; bf16_t* act;
  bf16_t *rawc, *ksb, *vsT, *kwb, *vwT, *qn; float* gates; bf16_t *hid, *kcb, *vcT; float* hidp; unsigned* bar;
};

typedef __bf16 bf16v2 __attribute__((ext_vector_type(2)));
typedef float f32x2 __attribute__((ext_vector_type(2)));
struct KArgs { const void* in[29]; float* out; char* ws; };
DI void fill_params(Params& p, const KArgs& ka) {
  p.x = (const float*)ka.in[0]; p.pos = (const int*)ka.in[1];
  p.a_norm = (const float*)ka.in[2]; p.a_w_in = (const float*)ka.in[3]; p.a_b_f = (const float*)ka.in[4]; p.a_q_gain = (const float*)ka.in[5];
  p.a_k_gain = (const float*)ka.in[6]; p.a_w_out = (const float*)ka.in[7]; p.kv_norm = (const float*)ka.in[8]; p.kv_w = (const float*)ka.in[9];
  p.kc_pe = (const float*)ka.in[10]; p.vc_pe = (const float*)ka.in[11]; p.kc_w1 = (const float*)ka.in[12]; p.kc_w2 = (const float*)ka.in[13];
  p.vc_w1 = (const float*)ka.in[14]; p.vc_w2 = (const float*)ka.in[15]; p.kc_gain = (const float*)ka.in[16]; p.ks_gain = (const float*)ka.in[17];
  p.kw_gain = (const float*)ka.in[18]; p.b_norm = (const float*)ka.in[19]; p.b_w_in = (const float*)ka.in[20]; p.b_b_gate = (const float*)ka.in[21];
  p.b_q_gain = (const float*)ka.in[22]; p.b_w_out = (const float*)ka.in[23]; p.f_norm = (const float*)ka.in[24]; p.f_w_up = (const float*)ka.in[25];
  p.f_conv_w = (const float*)ka.in[26]; p.f_conv_b = (const float*)ka.in[27]; p.f_w_down = (const float*)ka.in[28];
  p.out = ka.out;
  char* wsq = ka.ws;
#define TAKE(bytes) (wsq += (((size_t)(bytes)) + 255) & ~(size_t)255, wsq - ((((size_t)(bytes)) + 255) & ~(size_t)255))
  p.bar = (unsigned*)TAKE(16384);
  p.w_ain = (bf16_t*)TAKE((size_t)3200 * 1024 * 2); p.w_aout = (bf16_t*)TAKE((size_t)1024 * 1024 * 2); p.w_kv = (bf16_t*)TAKE((size_t)768 * 1024 * 2);
  p.w_kc1 = (bf16_t*)TAKE((size_t)256 * 2048 * 2); p.w_vc1 = (bf16_t*)TAKE((size_t)256 * 2048 * 2);
  p.w_kc2 = (bf16_t*)TAKE((size_t)128 * 256 * 2); p.w_vc2 = (bf16_t*)TAKE((size_t)128 * 256 * 2);
  p.w_bin = (bf16_t*)TAKE((size_t)1152 * 1024 * 2); p.w_bout = (bf16_t*)TAKE((size_t)1024 * 1024 * 2);
  p.w_up0 = (bf16_t*)TAKE((size_t)5632 * 1024 * 2); p.w_up1 = (bf16_t*)TAKE((size_t)5632 * 1024 * 2);
  p.w_dn0 = (bf16_t*)TAKE((size_t)1024 * FF * 2); p.w_dn1 = (bf16_t*)TAKE((size_t)1024 * FF * 2);
  p.hb = (bf16_t*)TAKE((size_t)NTOK * 1024 * 2); p.part = (float*)TAKE((size_t)NTOK * 16 * 4);
  p.lf = (float*)TAKE((size_t)64 * T_ * 4); p.cc = (float*)TAKE((size_t)64 * T_ * 4);
  p.ob = (bf16_t*)TAKE((size_t)NTOK * 1024 * 2);
  char* R = TAKE((size_t)NTOK * 1024 * 2 * 3);
#undef TAKE
  p.qb = (bf16_t*)R; p.kb = p.qb + (size_t)NTOK * 1024; p.vT = p.kb + (size_t)NTOK * 1024;
  p.act = (bf16_t*)R;
  {
    char* q = R;
    p.qn = (bf16_t*)q; q += (size_t)NTOK * 1024 * 2;
    p.rawc = (bf16_t*)q; q += (size_t)2 * 8 * T_ * 64 * 2;
    p.ksb = (bf16_t*)q; q += (size_t)8 * T_ * 64 * 2;
    p.vsT = (bf16_t*)q; q += (size_t)8 * T_ * 64 * 2;
    p.kwb = (bf16_t*)q; q += (size_t)8 * T_ * 64 * 2;
    p.vwT = (bf16_t*)q; q += (size_t)8 * T_ * 64 * 2;
    p.gates = (float*)q; q += (size_t)NTOK * 48 * 4;
    p.hid = (bf16_t*)q; q += (size_t)2 * 4096 * 256 * 2;
    p.kcb = (bf16_t*)q; q += (size_t)8 * 512 * 64 * 2;
    p.vcT = (bf16_t*)q; q += (size_t)8 * 64 * 512 * 2;
    p.hidp = (float*)q; q += (size_t)2 * 4 * 4096 * 256 * 4;
  }
}

DI bf16_t f2bf(float x) { return __builtin_bit_cast(bf16_t, (__bf16)x); }
DI unsigned pack2(float a, float b) { f32x2 v = {a, b}; return __builtin_bit_cast(unsigned, __builtin_convertvector(v, bf16v2)); }
DI float bf2f(bf16_t v) { return __uint_as_float(((unsigned)v) << 16); }
DI int crow(int i, int h) { return (i & 3) + 8 * (i >> 2) + 4 * h; }
DI f32x16 mfma32(bf16x8 a, bf16x8 b, f32x16 c) { return __builtin_amdgcn_mfma_f32_32x32x16_bf16(a, b, c, 0, 0, 0); }
DI f32x4 mfma16(bf16x8 a, bf16x8 b, f32x4 c) { return __builtin_amdgcn_mfma_f32_16x16x32_bf16(a, b, c, 0, 0, 0); }
DI float row_rstd(const float* part, int row) {
  const f32x4* q = (const f32x4*)(part + (size_t)row * 16);
  f32x4 a = q[0], b = q[1], c = q[2], d = q[3];
  float s = ((a.x + a.y) + (a.z + a.w)) + ((b.x + b.y) + (b.z + b.w)) + ((c.x + c.y) + (c.z + c.w)) + ((d.x + d.y) + (d.z + d.w));
  return rsqrtf(s * (1.0f / 1024.0f) + 1e-6f);
}
DI size_t a_off(int row, int k, int KB) { return (((size_t)((row >> 7) * KB + (k >> 6))) << 13) + ((row & 127) << 6) + (k & 63); }
DI void store_bf4(bf16_t* dst, float a, float b, float c, float d) { u32x2 v; v.x = pack2(a, b); v.y = pack2(c, d); *(u32x2*)dst = v; }

struct WJob { const float* src; bf16_t* dst; const float* gain; int K, Nsrc, Ndst, mode; };
DI WJob get_job(const Params& p, int j) {
  WJob w; w.gain = nullptr; w.mode = 0;
  switch (j) {
    case 0: w.src = p.a_w_in; w.dst = p.w_ain; w.gain = p.a_norm; w.K = 1024; w.Nsrc = 3088; w.Ndst = 3200; break;
    case 1: w.src = p.a_w_out; w.dst = p.w_aout; w.K = 1024; w.Nsrc = 1024; w.Ndst = 1024; break;
    case 2: w.src = p.kv_w; w.dst = p.w_kv; w.gain = p.kv_norm; w.K = 1024; w.Nsrc = 768; w.Ndst = 768; break;
    case 3: w.src = p.kc_w1; w.dst = p.w_kc1; w.K = 2048; w.Nsrc = 256; w.Ndst = 256; break;
    case 4: w.src = p.vc_w1; w.dst = p.w_vc1; w.K = 2048; w.Nsrc = 256; w.Ndst = 256; break;
    case 5: w.src = p.kc_w2; w.dst = p.w_kc2; w.K = 256; w.Nsrc = 64; w.Ndst = 128; break;
    case 6: w.src = p.vc_w2; w.dst = p.w_vc2; w.K = 256; w.Nsrc = 64; w.Ndst = 128; break;
    case 7: w.src = p.b_w_in; w.dst = p.w_bin; w.gain = p.b_norm; w.K = 1024; w.Nsrc = 1072; w.Ndst = 1152; break;
    case 8: w.src = p.b_w_out; w.dst = p.w_bout; w.K = 1024; w.Nsrc = 1024; w.Ndst = 1024; break;
    case 9: w.src = p.f_w_up; w.dst = p.w_up0; w.gain = p.f_norm; w.K = 1024; w.Nsrc = 5632; w.Ndst = 5632; w.mode = 1; break;
    case 10: w.src = p.f_w_up + (size_t)1024 * 5632; w.dst = p.w_up1; w.gain = p.f_norm + 1024; w.K = 1024; w.Nsrc = 5632; w.Ndst = 5632; w.mode = 1; break;
    case 11: w.src = p.f_w_down; w.dst = p.w_dn0; w.K = 2816; w.Nsrc = 1024; w.Ndst = 1024; break;
    default: w.src = p.f_w_down + (size_t)2816 * 1024; w.dst = p.w_dn1; w.K = 2816; w.Nsrc = 1024; w.Ndst = 1024; break;
  }
  return w;
}

DI void prep_load(const WJob& w, int t, int nkt, int tid, f32x4 (&v)[4], int& k0, int& n0d) {
  const int kt = t % nkt, nt = t / nkt;
  k0 = kt << 6; n0d = nt << 6;
  int sbase = n0d;
  if (w.mode == 1) { const int tile = n0d >> 7, half = (n0d >> 6) & 1; sbase = half * FF + tile * 64; }
#pragma unroll
  for (int i = 0; i < 4; ++i) {
    const int kk = (tid >> 4) + 16 * i, col = sbase + (tid & 15) * 4;
    v[i] = (f32x4){0.f, 0.f, 0.f, 0.f};
    if (col < w.Nsrc) v[i] = *(const f32x4*)(w.src + (size_t)(k0 + kk) * w.Nsrc + col);
    const float g = w.gain ? w.gain[k0 + kk] : 1.0f;
    v[i] *= g;
  }
}
DI void prep_lds(float* sT, const f32x4 (&v)[4], int tid) {
#pragma unroll
  for (int i = 0; i < 4; ++i) {
    const int kk = (tid >> 4) + 16 * i, nn = (tid & 15) * 4;
    sT[kk * 65 + nn + 0] = v[i].x; sT[kk * 65 + nn + 1] = v[i].y; sT[kk * 65 + nn + 2] = v[i].z; sT[kk * 65 + nn + 3] = v[i].w;
  }
}
DI void prep_out(const float* sT, const WJob& w, int k0, int n0d, int nkt, int tid) {
  const int n = tid >> 2, kseg = (tid & 3) * 16;
  unsigned o[8];
#pragma unroll
  for (int q = 0; q < 8; ++q) o[q] = pack2(sT[(kseg + 2 * q) * 65 + n], sT[(kseg + 2 * q + 1) * 65 + n]);
  u32x4* dst = (u32x4*)(w.dst + a_off(n0d + n, k0 + kseg, nkt));
  dst[0] = (u32x4){o[0], o[1], o[2], o[3]}; dst[1] = (u32x4){o[4], o[5], o[6], o[7]};
}

DI void phase_prep(const Params& p, char* smem) {
  float* sT0 = (float*)smem;
  float* sT1 = sT0 + 64 * 65;
  const int tid = threadIdx.x;
  {
    const int lane = tid & 63, gw = blockIdx.x * 4 + (tid >> 6), nw = gridDim.x * 4;
    for (int row0 = gw * 4; row0 < NTOK; row0 += nw * 4) {
      f32x4 v[4][4];
#pragma unroll
      for (int rr = 0; rr < 4; ++rr)
#pragma unroll
        for (int i = 0; i < 4; ++i) v[rr][i] = *(const f32x4*)(p.x + (size_t)(row0 + rr) * 1024 + i * 256 + lane * 4);
#pragma unroll
      for (int rr = 0; rr < 4; ++rr) {
        const int row = row0 + rr;
        float ss = 0.f;
#pragma unroll
        for (int i = 0; i < 4; ++i) {
          const f32x4 x = v[rr][i];
          ss += x.x * x.x + x.y * x.y + x.z * x.z + x.w * x.w;
          store_bf4(p.hb + a_off(row, i * 256 + lane * 4, 16), x.x, x.y, x.z, x.w);
        }
#pragma unroll
        for (int o = 32; o >= 1; o >>= 1) ss += __shfl_xor(ss, o);
        if (lane < 16) p.part[(size_t)row * 16 + lane] = lane == 0 ? ss : 0.f;
      }
    }
  }
  int base = 0;
  for (int j = 0; j < 13; ++j) {
    WJob w = get_job(p, j);
    const int nkt = w.K >> 6, nnt = w.Ndst >> 6, ntile = nkt * nnt, G = gridDim.x;
    int first = (int)blockIdx.x - (base % G); if (first < 0) first += G;
    for (int t = first; t < ntile; t += 2 * G) {
      const bool hasB = (t + G) < ntile;
      f32x4 va[4], vb[4]; int k0a, n0a, k0b = 0, n0b = 0;
      prep_load(w, t, nkt, tid, va, k0a, n0a);
      if (hasB) prep_load(w, t + G, nkt, tid, vb, k0b, n0b);
      __syncthreads();
      prep_lds(sT0, va, tid);
      if (hasB) prep_lds(sT1, vb, tid);
      __syncthreads();
      prep_out(sT0, w, k0a, n0a, nkt, tid);
      if (hasB) prep_out(sT1, w, k0b, n0b, nkt, tid);
    }
    base += ntile;
  }
  if (blockIdx.x == 0) {
    for (int i = tid; i < 8 * 64; i += 256) {
      const int bg = i >> 6, d = i & 63;
      p.kcb[((size_t)bg * 512 + 511) * 64 + d] = 0;
      p.vcT[((size_t)(bg * 8 + 7) * 64 + d) * 64 + 63] = 0;
    }
  }
}

template <class AL, class EP>
DI void gemm_tile(const AL& al, const bf16_t* __restrict__ Wt, int K, int mt, int nt, const EP& ep, char* smem, int kb0 = 0, int KBn = -1) {
  bf16_t* sbuf = (bf16_t*)smem;
  constexpr int STAGE = 2 * 128 * 72;
  const int tid = threadIdx.x, lane = tid & 63, wave = tid >> 6, wr = wave >> 1, wc = wave & 1, r = lane & 31, h = lane >> 5;
  const int KBt = K >> 6, KB = KBn < 0 ? KBt : KBn;
  const bf16_t* wbase = Wt + (((size_t)nt * KBt + kb0) << 13) + tid * 8;
  f32x16 acc[2][2];
#pragma unroll
  for (int a = 0; a < 2; ++a)
#pragma unroll
    for (int b = 0; b < 2; ++b)
#pragma unroll
      for (int i = 0; i < 16; ++i) acc[a][b][i] = 0.f;
  u32x4 xa[4], wa[4];
#define GEMM_LOAD(kb_)                                                                  \
  _Pragma("unroll") for (int i = 0; i < 4; ++i) {                                        \
    const int c = tid + 256 * i;                                                         \
    xa[i] = al(mt, c >> 3, (kb0 + (kb_)) * 64 + (c & 7) * 8);                                    \
    wa[i] = *(const u32x4*)(wbase + ((size_t)(kb_) << 13) + 2048 * i);                   \
  }
#define GEMM_STORE(st_)                                                                 \
  _Pragma("unroll") for (int i = 0; i < 4; ++i) {                                        \
    const int c = tid + 256 * i, row = c >> 3, kc = (c & 7) * 8;                         \
    *(u32x4*)(sbuf + (st_) * STAGE + row * 72 + kc) = xa[i];                             \
    *(u32x4*)(sbuf + (st_) * STAGE + 128 * 72 + row * 72 + kc) = wa[i];                  \
  }
#define GEMM_LDF(FW, FX, st_, ks_)                                                      \
  _Pragma("unroll") for (int q = 0; q < 2; ++q) {                                        \
    FW[q] = *(const bf16x8*)(sbuf + (st_) * STAGE + 128 * 72 + (64 * wc + 32 * q + r) * 72 + 16 * (ks_) + 8 * h); \
    FX[q] = *(const bf16x8*)(sbuf + (st_) * STAGE + (64 * wr + 32 * q + r) * 72 + 16 * (ks_) + 8 * h);            \
  }
#define GEMM_MM(FW, FX)                                                                 \
  _Pragma("unroll") for (int ms = 0; ms < 2; ++ms)                                       \
    _Pragma("unroll") for (int ns = 0; ns < 2; ++ns) acc[ms][ns] = mfma32(FW[ns], FX[ms], acc[ms][ns]);
  bf16x8 faw[2], fax[2], fbw[2], fbx[2];
  __syncthreads();
  GEMM_LOAD(0)
  GEMM_STORE(0)
  if (KB > 1) { GEMM_LOAD(1) }
  __syncthreads();
  GEMM_LDF(faw, fax, 0, 0)
  for (int it = 0; it < KB; ++it) {
    const int cur = it & 1;
    if (it + 1 < KB) { GEMM_STORE(cur ^ 1) }
    if (it + 2 < KB) { GEMM_LOAD(it + 2) }
    __builtin_amdgcn_sched_barrier(0);
    GEMM_LDF(fbw, fbx, cur, 1)
    __builtin_amdgcn_sched_barrier(0);
    GEMM_MM(faw, fax)
    __builtin_amdgcn_sched_barrier(0);
    GEMM_LDF(faw, fax, cur, 2)
    __builtin_amdgcn_sched_barrier(0);
    GEMM_MM(fbw, fbx)
    __builtin_amdgcn_sched_barrier(0);
    GEMM_LDF(fbw, fbx, cur, 3)
    __builtin_amdgcn_sched_barrier(0);
    GEMM_MM(faw, fax)
    __builtin_amdgcn_sched_barrier(0);
    __syncthreads();
    if (it + 1 < KB) { GEMM_LDF(faw, fax, cur ^ 1, 0) }
    __builtin_amdgcn_sched_barrier(0);
    GEMM_MM(fbw, fbx)
    __builtin_amdgcn_sched_barrier(0);
  }
#undef GEMM_LDF
#undef GEMM_MM
#undef GEMM_LOAD
#undef GEMM_STORE
  ep(acc, mt, nt, wr, wc, lane, smem);
}

template <class AL, class EP>
DI void gemm_phase(const AL& al, const bf16_t* Wt, int K, int numM, int numN, const EP& ep, char* smem) {
  const int xcd = blockIdx.x & 7, lb = blockIdx.x >> 3, nlb = gridDim.x >> 3;
  const int mper = (numM + 7) >> 3, fullr = mper >> 3, mrem = mper & 7;
  const int nfull = fullr * 8 * numN, total = mper * numN;
  for (int li = lb; li < total; li += nlb) {
    int nt, mtl;
    if (li < nfull) { const int s = li / (8 * numN), rem = li - s * 8 * numN; nt = rem >> 3; mtl = s * 8 + (rem & 7); }
    else { const int rem = li - nfull; nt = rem / mrem; mtl = fullr * 8 + (rem - nt * mrem); }
    const int mt = xcd * mper + mtl;
    if (mt >= numM) continue;
    gemm_tile(al, Wt, K, mt, nt, ep, smem);
  }
}

struct ALPlain { const bf16_t* A; int KB; DI u32x4 operator()(int mt, int ml, int k) const { return *(const u32x4*)(A + (((size_t)(mt * KB + (k >> 6))) << 13) + (ml << 6) + (k & 63)); } };
struct ALFfn {
  const bf16_t* A;
  DI u32x4 operator()(int mt, int ml, int k) const {
    const int b = mt / 66, it = mt - b * 66, t = 126 * it - 2 + ml;
    if (t < 0 || t >= T_) return (u32x4){0, 0, 0, 0};
    return *(const u32x4*)(A + a_off(b * T_ + t, k, 16));
  }
};
struct ALCmp1 {
  const bf16_t* raw; const float* pe;
  DI u32x4 operator()(int mt, int ml, int k) const {
    const int m = mt * 128 + ml;
    if (m >= 4088) return (u32x4){0, 0, 0, 0};
    const int bg = m / 511, n = m - bg * 511;
    u32x4 v = *(const u32x4*)(raw + ((size_t)bg * T_ + 16 * n) * 64 + k);
    const f32x4 p0 = *(const f32x4*)(pe + k), p1 = *(const f32x4*)(pe + k + 4);
    u32x4 o;
    o.x = pack2(bf2f((bf16_t)(v.x & 0xffff)) + p0.x, bf2f((bf16_t)(v.x >> 16)) + p0.y);
    o.y = pack2(bf2f((bf16_t)(v.y & 0xffff)) + p0.z, bf2f((bf16_t)(v.y >> 16)) + p0.w);
    o.z = pack2(bf2f((bf16_t)(v.z & 0xffff)) + p1.x, bf2f((bf16_t)(v.z >> 16)) + p1.y);
    o.w = pack2(bf2f((bf16_t)(v.w & 0xffff)) + p1.z, bf2f((bf16_t)(v.w >> 16)) + p1.w);
    return o;
  }
};
struct ALCmp2 { const bf16_t* A; DI u32x4 operator()(int mt, int ml, int k) const { const int m = mt * 128 + ml; if (m >= 4088) return (u32x4){0, 0, 0, 0}; return *(const u32x4*)(A + (size_t)m * 256 + k); } };

__device__ const float ROPE_INV[8] = {1.0f, 0.19392274474868576f, 0.03760603093086393f, 0.007292664737217109f, 0.001414213562373095f, 0.0002742481756762073f, 5.318295896944988e-05f, 1.031338537721246e-05f};

template <bool ROPE>
DI void norm_store(f32x16 (&a)[2], float rs, const float* gain, int pos, bf16_t* dst, int h) {
  float ss = 0.f;
#pragma unroll
  for (int ns = 0; ns < 2; ++ns)
#pragma unroll
    for (int i = 0; i < 16; ++i) { const float v = a[ns][i] * rs; a[ns][i] = v; ss += v * v; }
  ss += __shfl_xor(ss, 32);
  const float inv = rsqrtf(ss * (1.0f / 64.0f) + 1e-6f);
#pragma unroll
  for (int ns = 0; ns < 2; ++ns)
#pragma unroll
    for (int i = 0; i < 16; ++i) a[ns][i] = a[ns][i] * inv * gain[32 * ns + crow(i, h)];
  if (ROPE) {
    const float fp = (float)pos;
#pragma unroll
    for (int ii = 0; ii < 4; ++ii) {
      const float ang = fp * ROPE_INV[4 * h + ii];
      const float c = cosf(ang), s = sinf(ang);
      const float x1 = a[0][ii], x2 = a[0][4 + ii];
      a[0][ii] = x1 * c - x2 * s; a[0][4 + ii] = x2 * c + x1 * s;
    }
  }
#pragma unroll
  for (int ns = 0; ns < 2; ++ns)
#pragma unroll
    for (int q = 0; q < 4; ++q) store_bf4(dst + 32 * ns + 8 * q + 4 * h, a[ns][4 * q], a[ns][4 * q + 1], a[ns][4 * q + 2], a[ns][4 * q + 3]);
}

struct EpiFoxIn {
  const Params& p;
  DI void operator()(f32x16 (&acc)[2][2], int mt, int nt, int wr, int wc, int lane, char*) const {
    const int r = lane & 31, h = lane >> 5, nb = nt * 128 + 64 * wc;
#pragma unroll
    for (int ms = 0; ms < 2; ++ms) {
      const int row = mt * 128 + 64 * wr + 32 * ms + r;
      const float rs = row_rstd(p.part, row);
      const int b = row >> 13, t = row & 8191;
      if (nb < 2048) {
        const bool isq = nb < 1024;
        norm_store<false>(acc[ms], rs, isq ? p.a_q_gain : p.a_k_gain, 0, (isq ? p.qb : p.kb) + ((size_t)(b * 16 + ((nb & 1023) >> 6)) * T_ + t) * 64, h);
      } else if (nb < 3072) {
        const int head = (nb - 2048) >> 6;
        bf16_t* dst = p.vT + ((size_t)((b * 16 + head) * 128 + (t >> 6))) * 4096 + (t & 63);
#pragma unroll
        for (int ns = 0; ns < 2; ++ns)
#pragma unroll
          for (int i = 0; i < 16; ++i) dst[(32 * ns + crow(i, h)) * 64] = f2bf(acc[ms][ns][i] * rs);
      } else if (nb == 3072) {
#pragma unroll
        for (int i = 0; i < 8; ++i) {
          const int head = crow(i, h);
          const float z = acc[ms][0][i] * rs + p.a_b_f[head];
          p.lf[((size_t)(b * 16 + head)) * T_ + t] = fminf(z, 0.f) - log1pf(expf(-fabsf(z)));
        }
      }
    }
  }
};

template <int MODE>
struct EpiResid {
  const float* res; float* out; bf16_t* hb; float* part;
  DI void operator()(f32x16 (&acc)[2][2], int mt, int nt, int wr, int wc, int lane, char* smem) const {
    float* sU = (float*)smem;
    const int r = lane & 31, h = lane >> 5, tid = threadIdx.x;
    __syncthreads();
#pragma unroll
    for (int ms = 0; ms < 2; ++ms) {
      const int ml = 64 * wr + 32 * ms + r;
#pragma unroll
      for (int ns = 0; ns < 2; ++ns)
#pragma unroll
        for (int i = 0; i < 16; ++i) sU[ml * 132 + 64 * wc + 32 * ns + crow(i, h)] = acc[ms][ns][i];
    }
    __syncthreads();
    const int c4 = (tid & 31) * 4, n = nt * 128 + c4;
#pragma unroll 1
    for (int hh = 0; hh < 2; ++hh) {
      f32x4 rv[8];
#pragma unroll
      for (int it = 0; it < 8; ++it) {
        const int row = mt * 128 + (hh * 8 + it) * 8 + (tid >> 5);
        if (MODE == 0) rv[it] = *(const f32x4*)(res + (size_t)row * 1024 + n);
        else {
          const u32x2 v = *(const u32x2*)(hb + a_off(row, n, 16));
          rv[it] = (f32x4){bf2f((bf16_t)(v.x & 0xffff)), bf2f((bf16_t)(v.x >> 16)), bf2f((bf16_t)(v.y & 0xffff)), bf2f((bf16_t)(v.y >> 16))};
        }
      }
#pragma unroll
      for (int it = 0; it < 8; ++it) {
        const int rl = (hh * 8 + it) * 8 + (tid >> 5), row = mt * 128 + rl;
        const f32x4 o = rv[it] + *(const f32x4*)(sU + rl * 132 + c4);
        if (MODE == 2) *(f32x4*)(out + (size_t)row * 1024 + n) = o;
        else {
          store_bf4(hb + a_off(row, n, 16), o.x, o.y, o.z, o.w);
          float ss = o.x * o.x + o.y * o.y + o.z * o.z + o.w * o.w;
          ss += __shfl_xor(ss, 1); ss += __shfl_xor(ss, 2); ss += __shfl_xor(ss, 4); ss += __shfl_xor(ss, 8); ss += __shfl_xor(ss, 16);
          if ((tid & 31) == 0) { part[(size_t)row * 16 + nt * 2] = ss; part[(size_t)row * 16 + nt * 2 + 1] = 0.f; }
        }
      }
    }
  }
};

struct EpiFfnUp {
  const float* part; const float* cw; const float* cb; bf16_t* act;
  DI void operator()(f32x16 (&acc)[2][2], int mt, int nt, int wr, int wc, int lane, char* smem) const {
    float* sU = (float*)smem;
    const int r = lane & 31, h = lane >> 5, tid = threadIdx.x;
    const int b = mt / 66, it = mt - b * 66, tb = 126 * it - 2;
    __syncthreads();
#pragma unroll
    for (int ms = 0; ms < 2; ++ms) {
      const int ml = 64 * wr + 32 * ms + r, t = tb + ml;
      const float rs = (t >= 0 && t < T_) ? row_rstd(part, b * T_ + t) : 0.f;
#pragma unroll
      for (int ns = 0; ns < 2; ++ns)
#pragma unroll
        for (int i = 0; i < 16; ++i) sU[ml * 129 + 64 * wc + 32 * ns + crow(i, h)] = acc[ms][ns][i] * rs;
    }
    __syncthreads();
    const int jj = tid & 63, rg = tid >> 6, j = nt * 64 + jj;
    const float wg0 = cw[j], wg1 = cw[5632 + j], wg2 = cw[2 * 5632 + j], bgt = cb[j];
    const float wv0 = cw[FF + j], wv1 = cw[5632 + FF + j], wv2 = cw[2 * 5632 + FF + j], bvl = cb[FF + j];
    {
      const int m_lo = rg == 0 ? 2 : 32 * rg, m_hi = 32 * rg + 32;
      float g0 = sU[(m_lo - 2) * 129 + jj], g1 = sU[(m_lo - 1) * 129 + jj];
      float v0 = sU[(m_lo - 2) * 129 + 64 + jj], v1 = sU[(m_lo - 1) * 129 + 64 + jj];
      for (int ml = m_lo; ml < m_hi; ++ml) {
        const int t = tb + ml;
        if (t >= T_) break;
        const float g2 = sU[ml * 129 + jj], v2 = sU[ml * 129 + 64 + jj];
        const float g = bgt + wg0 * g0 + wg1 * g1 + wg2 * g2;
        const float v = bvl + wv0 * v0 + wv1 * v1 + wv2 * v2;
        const float a = g * __builtin_amdgcn_rcpf(1.0f + __expf(-g)) * v;
        act[a_off(b * T_ + t, j, 44)] = f2bf(a);
        g0 = g1; g1 = g2; v0 = v1; v1 = v2;
      }
    }
  }
};

struct EpiKv {
  const Params& p;
  DI void operator()(f32x16 (&acc)[2][2], int mt, int nt, int wr, int wc, int lane, char*) const {
    const int r = lane & 31, h = lane >> 5, g = wc;
#pragma unroll
    for (int ms = 0; ms < 2; ++ms) {
      const int row = mt * 128 + 64 * wr + 32 * ms + r;
      const float rs = row_rstd(p.part, row);
      const int b = row >> 13, t = row & 8191, bg = b * 2 + g;
      if (nt < 2) {
        bf16_t* dst = p.rawc + (((size_t)(nt * 8 + bg)) * T_ + t) * 64;
#pragma unroll
        for (int ns = 0; ns < 2; ++ns)
#pragma unroll
          for (int q = 0; q < 4; ++q)
            store_bf4(dst + 32 * ns + 8 * q + 4 * h, acc[ms][ns][4 * q] * rs, acc[ms][ns][4 * q + 1] * rs, acc[ms][ns][4 * q + 2] * rs, acc[ms][ns][4 * q + 3] * rs);
      } else if (nt == 2 || nt == 4) {
        norm_store<true>(acc[ms], rs, nt == 2 ? p.ks_gain : p.kw_gain, p.pos[row], (nt == 2 ? p.ksb : p.kwb) + ((size_t)bg * T_ + t) * 64, h);
      } else if (nt == 3) {
        bf16_t* dst = p.vsT + ((size_t)bg * 128 + (t >> 6)) * 4096 + (t & 63);
#pragma unroll
        for (int ns = 0; ns < 2; ++ns)
#pragma unroll
          for (int i = 0; i < 16; ++i) dst[(32 * ns + crow(i, h)) * 64] = f2bf(acc[ms][ns][i] * rs);
      } else {
        bf16_t* dst = p.vwT + ((size_t)bg * 128 + (t >> 6)) * 4096 + (t & 63);
#pragma unroll
        for (int ns = 0; ns < 2; ++ns)
#pragma unroll
          for (int i = 0; i < 16; ++i) dst[(32 * ns + crow(i, h)) * 64] = f2bf(acc[ms][ns][i] * rs);
      }
    }
  }
};

struct EpiBIn {
  const Params& p;
  DI void operator()(f32x16 (&acc)[2][2], int mt, int nt, int wr, int wc, int lane, char*) const {
    const int r = lane & 31, h = lane >> 5, nb = nt * 128 + 64 * wc;
#pragma unroll
    for (int ms = 0; ms < 2; ++ms) {
      const int row = mt * 128 + 64 * wr + 32 * ms + r;
      const float rs = row_rstd(p.part, row);
      if (nb < 1024) {
        norm_store<true>(acc[ms], rs, p.b_q_gain, p.pos[row], p.qn + (size_t)row * 1024 + nb, h);
      } else if (nb == 1024) {
#pragma unroll
        for (int ns = 0; ns < 2; ++ns)
#pragma unroll
          for (int i = 0; i < 16; ++i) {
            const int c = 32 * ns + crow(i, h);
            if (c < 48) { const float z = acc[ms][ns][i] * rs + p.b_b_gate[c]; p.gates[(size_t)row * 48 + c] = 1.0f / (1.0f + __expf(-z)); }
          }
      }
    }
  }
};

struct EpiCmp1P {
  float* dst;
  DI void operator()(f32x16 (&acc)[2][2], int mt, int nt, int wr, int wc, int lane, char*) const {
    const int r = lane & 31, h = lane >> 5;
#pragma unroll
    for (int ms = 0; ms < 2; ++ms) {
      const int m = mt * 128 + 64 * wr + 32 * ms + r;
#pragma unroll
      for (int ns = 0; ns < 2; ++ns)
#pragma unroll
        for (int q = 0; q < 4; ++q) {
          f32x4 v = {acc[ms][ns][4 * q], acc[ms][ns][4 * q + 1], acc[ms][ns][4 * q + 2], acc[ms][ns][4 * q + 3]};
          *(f32x4*)(dst + (size_t)m * 256 + nt * 128 + 64 * wc + 32 * ns + 8 * q + 4 * h) = v;
        }
    }
  }
};
DI float gelu_tanh(float x) { return 0.5f * x * (1.0f + tanhf(0.7978845608028654f * (x + 0.044715f * x * x * x))); }
struct ALCmp2P {
  const float* P;
  DI u32x4 operator()(int mt, int ml, int k) const {
    const int m = mt * 128 + ml;
    if (m >= 4088) return (u32x4){0, 0, 0, 0};
    f32x4 a = {0.f, 0.f, 0.f, 0.f}, b = {0.f, 0.f, 0.f, 0.f};
#pragma unroll
    for (int s4 = 0; s4 < 4; ++s4) {
      const float* q = P + ((size_t)s4 * 4096 + m) * 256 + k;
      a += *(const f32x4*)q; b += *(const f32x4*)(q + 4);
    }
    u32x4 o;
    o.x = pack2(gelu_tanh(a.x), gelu_tanh(a.y)); o.y = pack2(gelu_tanh(a.z), gelu_tanh(a.w));
    o.z = pack2(gelu_tanh(b.x), gelu_tanh(b.y)); o.w = pack2(gelu_tanh(b.z), gelu_tanh(b.w));
    return o;
  }
};

struct EpiCmp1 {
  bf16_t* hid;
  DI void operator()(f32x16 (&acc)[2][2], int mt, int nt, int wr, int wc, int lane, char*) const {
    const int r = lane & 31, h = lane >> 5;
#pragma unroll
    for (int ms = 0; ms < 2; ++ms) {
      const int m = mt * 128 + 64 * wr + 32 * ms + r;
      if (m >= 4088) continue;
#pragma unroll
      for (int ns = 0; ns < 2; ++ns) {
        float g[16];
#pragma unroll
        for (int i = 0; i < 16; ++i) { const float x = acc[ms][ns][i]; g[i] = 0.5f * x * (1.0f + tanhf(0.7978845608028654f * (x + 0.044715f * x * x * x))); }
#pragma unroll
        for (int q = 0; q < 4; ++q) store_bf4(hid + (size_t)m * 256 + nt * 128 + 64 * wc + 32 * ns + 8 * q + 4 * h, g[4 * q], g[4 * q + 1], g[4 * q + 2], g[4 * q + 3]);
      }
    }
  }
};

struct EpiCmp2 {
  const Params& p; int sel;
  DI void operator()(f32x16 (&acc)[2][2], int mt, int nt, int wr, int wc, int lane, char*) const {
    if (wc != 0) return;
    const int r = lane & 31, h = lane >> 5;
#pragma unroll
    for (int ms = 0; ms < 2; ++ms) {
      const int m = mt * 128 + 64 * wr + 32 * ms + r;
      if (m < 4088) {
        const int bg = m / 511, n = m - bg * 511, b = bg >> 1;
        if (sel == 0) {
          norm_store<true>(acc[ms], 1.0f, p.kc_gain, p.pos[b * T_ + 16 * n + 31], p.kcb + ((size_t)bg * 512 + n) * 64, h);
        } else {
          bf16_t* dst = p.vcT + ((size_t)(bg * 8 + (n >> 6))) * 4096 + (n & 63);
#pragma unroll
          for (int ns = 0; ns < 2; ++ns)
#pragma unroll
            for (int i = 0; i < 16; ++i) dst[(32 * ns + crow(i, h)) * 64] = f2bf(acc[ms][ns][i]);
        }
      } else {
      }
    }
  }
};

DI void phase_scan(const Params& p, char* smem) {
  float* sW = (float*)smem;
  const int tid = threadIdx.x, lane = tid & 63, w = tid >> 6;
  for (int seq = blockIdx.x; seq < 64; seq += gridDim.x) {
    const float* src = p.lf + (size_t)seq * T_ + tid * 32;
    float* dst = p.cc + (size_t)seq * T_ + tid * 32;
    f32x4 v[8];
#pragma unroll
    for (int i = 0; i < 8; ++i) v[i] = *(const f32x4*)(src + 4 * i);
    float s = 0.f;
#pragma unroll
    for (int i = 0; i < 8; ++i) { s += v[i].x; s += v[i].y; s += v[i].z; s += v[i].w; }
    float inc = s;
#pragma unroll
    for (int o = 1; o < 64; o <<= 1) { const float u = __shfl_up(inc, o); if (lane >= o) inc += u; }
    __syncthreads();
    if (lane == 63) sW[w] = inc;
    __syncthreads();
    float run = inc - s;
    for (int q = 0; q < w; ++q) run += sW[q];
#pragma unroll
    for (int i = 0; i < 8; ++i) {
      f32x4 o;
      run += v[i].x; o.x = run; run += v[i].y; o.y = run; run += v[i].z; o.z = run; run += v[i].w; o.w = run;
      *(f32x4*)(dst + 4 * i) = o;
    }
  }
}

template <int MODE>
DI void flash_step(f32x16 (&o)[2], float& l, const bf16x8 (&qf)[4], const bf16_t* sK, const bf16_t* sV, const float* sC,
                   int kbase, int tq, float bias0, float inv_l, float* sImpRow, int lane, bool selok = true) {
  const int r = lane & 31, h = lane >> 5;
  constexpr float SC = 0.125f * 1.4426950408889634f;
  const int base_hi = (MODE == 2 || MODE == 3) ? ((tq - 31) >> 4) : tq;
  const float bsel = (MODE == 4 && !selok) ? -1e30f : bias0;
#pragma unroll
  for (int sub = 0; sub < 2; ++sub) {
    f32x16 s;
#pragma unroll
    for (int i = 0; i < 16; ++i) s[i] = 0.f;
#pragma unroll
    for (int ks = 0; ks < 4; ++ks) {
      const bf16x8 a = *(const bf16x8*)(sK + (32 * sub + r) * 72 + 16 * ks + 8 * h);
      s = mfma32(a, qf[ks], s);
    }
    const int hi = base_hi - kbase - 32 * sub - 4 * h;
    const int lo = (MODE == 1) ? hi - 511 : -1000000;
    const bool nomask = __all((hi >= 27) && (lo <= 0));
    if (MODE == 0) {
#pragma unroll
      for (int q = 0; q < 4; ++q) {
        const f32x4 c4 = *(const f32x4*)(sC + 32 * sub + 8 * q + 4 * h);
#pragma unroll
        for (int j = 0; j < 4; ++j) s[4 * q + j] = fmaf(s[4 * q + j], SC, bias0 - c4[j]);
      }
    } else {
#pragma unroll
      for (int i = 0; i < 16; ++i) s[i] = fmaf(s[i], SC, bsel);
    }
    if (!nomask) {
#pragma unroll
      for (int i = 0; i < 16; ++i) { const int cst = (i & 3) + 8 * (i >> 2); s[i] = (cst <= hi && cst >= lo) ? s[i] : -1e30f; }
    }
    float ls = 0.f;
#pragma unroll
    for (int i = 0; i < 16; ++i) { const float pv = __builtin_amdgcn_exp2f(s[i]); s[i] = pv; ls += pv; }
    l += ls;
    if (MODE == 2) continue;
    if (MODE == 3) {
#pragma unroll
      for (int q = 0; q < 4; ++q) {
        const float p3 = s[4 * q + 3] * inv_l;
        float A = (s[4 * q] + s[4 * q + 1] + s[4 * q + 2]) * inv_l + 0.5f * p3, B = 0.5f * p3;
        A += __shfl_xor(A, 1); A += __shfl_xor(A, 2); A += __shfl_xor(A, 4);
        B += __shfl_xor(B, 1); B += __shfl_xor(B, 2); B += __shfl_xor(B, 4);
        if ((r & 7) == 0) { const int j = ((kbase + 32 * sub) >> 2) + 2 * q + h; atomicAdd(&sImpRow[j], A); atomicAdd(&sImpRow[j + 1], B); }
      }
    }
#pragma unroll
    for (int st = 0; st < 2; ++st) {
      u32x4 pk;
      pk.x = pack2(s[8 * st + 0], s[8 * st + 1]); pk.y = pack2(s[8 * st + 2], s[8 * st + 3]);
      pk.z = pack2(s[8 * st + 4], s[8 * st + 5]); pk.w = pack2(s[8 * st + 6], s[8 * st + 7]);
      const bf16x8 pf = __builtin_bit_cast(bf16x8, pk);
#pragma unroll
      for (int d = 0; d < 2; ++d) {
        const bf16_t* vp = sV + (32 * d + r) * 72 + 32 * sub + 16 * st + 4 * h;
        const bf16x4 lo4 = *(const bf16x4*)vp, hi4 = *(const bf16x4*)(vp + 8);
        const bf16x8 vf = __builtin_shufflevector(lo4, hi4, 0, 1, 2, 3, 4, 5, 6, 7);
        o[d] = mfma32(vf, pf, o[d]);
      }
    }
  }
}

DI void tile_load(u32x4 (&kr)[2], u32x4 (&vr)[2], const bf16_t* kptr, int kstride, const bf16_t* vptr, int vstride, bool withV, int tid) {
#pragma unroll
  for (int i = 0; i < 2; ++i) {
    const int c = tid + 256 * i, row = c >> 3, ch = (c & 7) * 8;
    kr[i] = *(const u32x4*)(kptr + (size_t)row * kstride + ch);
    if (withV) vr[i] = *(const u32x4*)(vptr + (size_t)row * vstride + ch);
  }
}
DI void tile_store(const u32x4 (&kr)[2], const u32x4 (&vr)[2], bf16_t* sK, bf16_t* sV, bool withV, int tid) {
#pragma unroll
  for (int i = 0; i < 2; ++i) {
    const int c = tid + 256 * i, row = c >> 3, ch = (c & 7) * 8;
    *(u32x4*)(sK + row * 72 + ch) = kr[i];
    if (withV) *(u32x4*)(sV + row * 72 + ch) = vr[i];
  }
}

template <class LoadF, class StoreF, class BodyF>
DI void dense_loop(int n, LoadF ld, StoreF st, BodyF body) {
  if (n <= 0) return;
  ld(0); st(0);
  if (n > 1) ld(1);
  __syncthreads();
  for (int e = 0; e < n; ++e) {
    const int cur = e & 1;
    if (e + 1 < n) st(cur ^ 1);
    if (e + 2 < n) ld(e + 2);
    body(e, cur);
    __syncthreads();
  }
}

DI void phase_fox(const Params& p, char* smem) {
  bf16_t* sKV = (bf16_t*)smem;
  float* sC = (float*)(sKV + 4 * 64 * 72);
  const int tid = threadIdx.x, lane = tid & 63, w = tid >> 6, r = lane & 31, h = lane >> 5;
  float gq = 0.f, gk = 0.f;
  for (int i = 0; i < 64; ++i) { gq = fmaxf(gq, fabsf(p.a_q_gain[i])); gk = fmaxf(gk, fabsf(p.a_k_gain[i])); }
  const float smax = 8.0f * gq * gk * 1.05f;
  const float thr = 40.0f + 2.0f * smax;
  const float negM2 = -smax * 1.4426950408889634f;
  for (int item = blockIdx.x; item < 4096; item += gridDim.x) {
    const int bh = item & 63, qt = 63 - (item >> 6), b = bh >> 4, head = bh & 15, t0 = qt * 128;
    const int tq = t0 + 32 * w + r;
    const bf16_t* qrow = p.qb + ((size_t)bh * T_ + tq) * 64;
    bf16x8 qf[4];
#pragma unroll
    for (int ks = 0; ks < 4; ++ks) qf[ks] = *(const bf16x8*)(qrow + 16 * ks + 8 * h);
    const float* cseq = p.cc + (size_t)bh * T_;
    const float cq = cseq[tq] * 1.4426950408889634f, c0 = cseq[t0];
    const bf16_t* kbp = p.kb + (size_t)bh * T_ * 64;
    const bf16_t* vbp = p.vT + (size_t)bh * 128 * 4096;
    f32x16 o[2];
#pragma unroll
    for (int d = 0; d < 2; ++d)
#pragma unroll
      for (int i = 0; i < 16; ++i) o[d][i] = 0.f;
    float l = 0.f;
    u32x4 kr[2], vr[2]; f32x4 cr = (f32x4){0.f, 0.f, 0.f, 0.f};
    const int jmax = 2 * qt + 1;
    int jmin = jmax;
    while (jmin > 0 && !(c0 - cseq[64 * (jmin - 1) + 63] < -thr)) --jmin;
    dense_loop(jmax - jmin + 1,
      [&](int e) { const int jt = jmax - e; tile_load(kr, vr, kbp + (size_t)jt * 4096, 64, vbp + (size_t)jt * 4096, 64, true, tid); if (tid < 16) cr = *(const f32x4*)(cseq + 64 * jt + 4 * tid); },
      [&](int bf) { tile_store(kr, vr, sKV + bf * 2 * 64 * 72, sKV + bf * 2 * 64 * 72 + 64 * 72, true, tid); if (tid < 16) *(f32x4*)(sC + bf * 64 + 4 * tid) = cr * 1.4426950408889634f; },
      [&](int e, int cur) {
        const int kbase = 64 * (jmax - e);
        if (kbase <= t0 + 32 * w + 31) flash_step<0>(o, l, qf, sKV + cur * 2 * 64 * 72, sKV + cur * 2 * 64 * 72 + 64 * 72, sC + cur * 64, kbase, tq, cq + negM2, 0.f, nullptr, lane);
      });
    const float lt = l + __shfl_xor(l, 32);
    const float inv = 1.0f / lt;
    bf16_t* orow = p.ob + a_off(b * T_ + tq, head * 64, 16);
#pragma unroll
    for (int d = 0; d < 2; ++d)
#pragma unroll
      for (int q = 0; q < 4; ++q) store_bf4(orow + 32 * d + 8 * q + 4 * h, o[d][4 * q] * inv, o[d][4 * q + 1] * inv, o[d][4 * q + 2] * inv, o[d][4 * q + 3] * inv);
  }
}

DI void phase_nsa(const Params& p, char* smem) {
  bf16_t* sKV = (bf16_t*)smem;
  float* sU = (float*)(sKV + 4 * 64 * 72);
  float* sImp = sU; float* sO = sU;
  unsigned* sMask = (unsigned*)(sU + 128 * 65);
  int* sList = (int*)(sMask + 64);
  const int tid = threadIdx.x, lane = tid & 63, w = tid >> 6, r = lane & 31, h = lane >> 5;
  float gqm = 0.f, gkm = 0.f;
  for (int i = 0; i < 64; ++i) { gqm = fmaxf(gqm, fabsf(p.b_q_gain[i])); gkm = fmaxf(gkm, fmaxf(fabsf(p.kc_gain[i]), fmaxf(fabsf(p.ks_gain[i]), fabsf(p.kw_gain[i])))); }
  const float negM2 = -8.0f * gqm * gkm * 1.05f * 1.4426950408889634f;
  auto stK = [&](int bf) { return sKV + bf * 2 * 64 * 72; };
  for (int item = blockIdx.x; item < 4096; item += gridDim.x) {
    const int bg = item & 7, tt = 511 - (item >> 3), b = bg >> 1, g = bg & 1, t0 = tt * 16;
    const int tokl = 4 * w + (r >> 3), head = r & 7, tq = t0 + tokl;
    __syncthreads();
    for (int i = tid; i < 16 * 132; i += 256) sImp[i] = 0.f;
    bf16x8 qf[4];
    {
      const bf16_t* qrow = p.qn + ((size_t)b * T_ + tq) * 1024 + (g * 8 + head) * 64;
#pragma unroll
      for (int ks = 0; ks < 4; ++ks) qf[ks] = *(const bf16x8*)(qrow + 16 * ks + 8 * h);
    }
    const float* grow = p.gates + ((size_t)b * T_ + tq) * 48 + g * 8 + head;
    const float gate_c = grow[0], gate_w = grow[32];
    f32x16 o[2];
    float l = 0.f;
    u32x4 kr[2], vr[2];
    const int ncmp = t0 >> 4, nct = (ncmp + 63) >> 6;
    const bf16_t* kcp = p.kcb + (size_t)bg * 512 * 64;
    const bf16_t* vcp = p.vcT + (size_t)bg * 8 * 4096;
    dense_loop(nct,
      [&](int e) { tile_load(kr, vr, kcp + (size_t)e * 4096, 64, vcp, 64, false, tid); },
      [&](int bf) { tile_store(kr, vr, stK(bf), stK(bf) + 64 * 72, false, tid); },
      [&](int e, int cur) { flash_step<2>(o, l, qf, stK(cur), stK(cur) + 64 * 72, nullptr, 64 * e, tq, negM2, 0.f, nullptr, lane); });
    const float lc = l + __shfl_xor(l, 32);
    const float inv_lc = lc > 0.f ? 1.0f / lc : 0.f;
#pragma unroll
    for (int d = 0; d < 2; ++d)
#pragma unroll
      for (int i = 0; i < 16; ++i) o[d][i] = 0.f;
    float l2 = 0.f;
    dense_loop(nct,
      [&](int e) { tile_load(kr, vr, kcp + (size_t)e * 4096, 64, vcp + (size_t)e * 4096, 64, true, tid); },
      [&](int bf) { tile_store(kr, vr, stK(bf), stK(bf) + 64 * 72, true, tid); },
      [&](int e, int cur) { flash_step<3>(o, l2, qf, stK(cur), stK(cur) + 64 * 72, nullptr, 64 * e, tq, negM2, inv_lc, sImp + tokl * 132, lane); });
    __syncthreads();
    const int cur_blk = t0 >> 6;
    for (int tk = 0; tk < 4; ++tk) {
      const int tok = 4 * w + tk;
      float* sc = sImp + tok * 132;
      for (int j = lane; j <= cur_blk; j += 64) if (j == 0 || j == cur_blk || j == cur_blk - 1) sc[j] = 1e6f;
    }
    __syncthreads();
    for (int tk = 0; tk < 4; ++tk) {
      const int tok = 4 * w + tk;
      const float* sc = sImp + tok * 132;
      const bool v0 = lane <= cur_blk, v1 = lane + 64 <= cur_blk;
      const float s0 = v0 ? sc[lane] : -1e30f, s1 = v1 ? sc[lane + 64] : -1e30f;
      int r0 = 0, r1 = 0;
      const int n0 = cur_blk < 63 ? cur_blk + 1 : 64;
      for (int i = 0; i < n0; ++i) {
        const float si = __builtin_bit_cast(float, __builtin_amdgcn_readlane(__builtin_bit_cast(int, s0), i));
        r0 += ((si > s0) || (si == s0 && i < lane)) ? 1 : 0;
        r1 += (si >= s1) ? 1 : 0;
      }
      for (int i = 64; i <= cur_blk; ++i) {
        const float si = __builtin_bit_cast(float, __builtin_amdgcn_readlane(__builtin_bit_cast(int, s1), i - 64));
        r0 += (si > s0) ? 1 : 0;
        r1 += ((si > s1) || (si == s1 && i - 64 < lane)) ? 1 : 0;
      }
      const unsigned long long mk0 = __ballot(v0 && r0 < 16), mk1 = __ballot(v1 && r1 < 16);
      if (lane == 0) {
        sMask[tok * 4 + 0] = (unsigned)mk0; sMask[tok * 4 + 1] = (unsigned)(mk0 >> 32);
        sMask[tok * 4 + 2] = (unsigned)mk1; sMask[tok * 4 + 3] = (unsigned)(mk1 >> 32);
      }
    }
    __syncthreads();
    int n_un;
    {
      unsigned u0 = 0, u1 = 0, u2 = 0, u3 = 0;
      for (int tok = 0; tok < 16; ++tok) { u0 |= sMask[tok * 4]; u1 |= sMask[tok * 4 + 1]; u2 |= sMask[tok * 4 + 2]; u3 |= sMask[tok * 4 + 3]; }
      const int c0 = __popc(u0), c1 = __popc(u1), c2 = __popc(u2), c3 = __popc(u3);
      n_un = c0 + c1 + c2 + c3;
      if (tid < 128) {
        const int wd = tid >> 5, bit = tid & 31;
        const unsigned uw = wd == 0 ? u0 : wd == 1 ? u1 : wd == 2 ? u2 : u3;
        if ((uw >> bit) & 1u) {
          const int pre = (wd > 0 ? c0 : 0) + (wd > 1 ? c1 : 0) + (wd > 2 ? c2 : 0);
          sList[pre + __popc(uw & ((1u << bit) - 1u))] = tid;
        }
      }
    }
    __syncthreads();
    {
      const float sc = gate_c * inv_lc;
      float* orow = sO + (32 * w + r) * 65;
#pragma unroll
      for (int d = 0; d < 2; ++d)
#pragma unroll
        for (int i = 0; i < 16; ++i) orow[32 * d + crow(i, h)] = o[d][i] * sc;
    }
#pragma unroll
    for (int d = 0; d < 2; ++d)
#pragma unroll
      for (int i = 0; i < 16; ++i) o[d][i] = 0.f;
    l = 0.f;
    {
      const bf16_t* ksp = p.ksb + (size_t)bg * T_ * 64;
      const bf16_t* vsp = p.vsT + (size_t)bg * 128 * 4096;
      dense_loop(n_un,
        [&](int e) { const int blk = sList[e]; tile_load(kr, vr, ksp + (size_t)blk * 4096, 64, vsp + (size_t)blk * 4096, 64, true, tid); },
        [&](int bf) { tile_store(kr, vr, stK(bf), stK(bf) + 64 * 72, true, tid); },
        [&](int e, int cur) {
          const int blk = sList[e];
          const int wd = blk >> 5, bit = blk & 31;
          const unsigned wm = sMask[(4 * w) * 4 + wd] | sMask[(4 * w + 1) * 4 + wd] | sMask[(4 * w + 2) * 4 + wd] | sMask[(4 * w + 3) * 4 + wd];
          if ((wm >> bit) & 1u) {
            const bool selok = (sMask[tokl * 4 + wd] >> bit) & 1u;
            flash_step<4>(o, l, qf, stK(cur), stK(cur) + 64 * 72, nullptr, 64 * blk, tq, negM2, 0.f, nullptr, lane, selok);
          }
        });
      const float lt = l + __shfl_xor(l, 32);
      const float sc = grow[16] / lt;
      float* orow = sO + (32 * w + r) * 65;
#pragma unroll
      for (int d = 0; d < 2; ++d)
#pragma unroll
        for (int i = 0; i < 16; ++i) orow[32 * d + crow(i, h)] += o[d][i] * sc;
    }
#pragma unroll
    for (int d = 0; d < 2; ++d)
#pragma unroll
      for (int i = 0; i < 16; ++i) o[d][i] = 0.f;
    l = 0.f;
    {
      const int klo = t0 - 511 > 0 ? t0 - 511 : 0, jt0 = klo >> 6, jt1 = (t0 + 15) >> 6;
      const bf16_t* kwp = p.kwb + (size_t)bg * T_ * 64;
      const bf16_t* vwp = p.vwT + (size_t)bg * 128 * 4096;
      dense_loop(jt1 - jt0 + 1,
        [&](int e) { tile_load(kr, vr, kwp + (size_t)(jt0 + e) * 4096, 64, vwp + (size_t)(jt0 + e) * 4096, 64, true, tid); },
        [&](int bf) { tile_store(kr, vr, stK(bf), stK(bf) + 64 * 72, true, tid); },
        [&](int e, int cur) { flash_step<1>(o, l, qf, stK(cur), stK(cur) + 64 * 72, nullptr, 64 * (jt0 + e), tq, negM2, 0.f, nullptr, lane); });
      const float lt = l + __shfl_xor(l, 32);
      const float sc = gate_w / lt;
      float* orow = sO + (32 * w + r) * 65;
#pragma unroll
      for (int d = 0; d < 2; ++d)
#pragma unroll
        for (int i = 0; i < 16; ++i) orow[32 * d + crow(i, h)] += o[d][i] * sc;
    }
    __syncthreads();
    for (int c = tid; c < 128 * 16; c += 256) {
      const int row = c >> 4, d4 = (c & 15) * 4, tok = row >> 3, hd = row & 7;
      const float* s = sO + row * 65 + d4;
      store_bf4(p.ob + a_off(b * T_ + t0 + tok, (g * 8 + hd) * 64 + d4, 16), s[0], s[1], s[2], s[3]);
    }
  }
}


#define XB_TMO      128
#define XB_XCNT(j)  (256  + 64 * (j))
#define XB_XSUB(j)  (1280 + 64 * (j))
#define XB_XGEN(j)  (2304 + 64 * (j))
#define XB_TOP      3328
#define XB_TOPGEN   3392
#define XCD_BAR_WORDS 3456
#define XB_SPIN_CAP (1u << 18)
#define LAS __attribute__((address_space(3)))
DI unsigned xb_ld(unsigned* p) { return __hip_atomic_load(p, __ATOMIC_RELAXED, __HIP_MEMORY_SCOPE_AGENT); }
DI unsigned xb_add(unsigned* p, unsigned v) { return __hip_atomic_fetch_add(p, v, __ATOMIC_RELAXED, __HIP_MEMORY_SCOPE_AGENT); }
DI unsigned xb_xcc_id() { return (unsigned)__builtin_amdgcn_s_getreg((3 << 11) | 20) & 0xFu; }
#define XB_SPIN(cond, bar) do { unsigned _sp = 0; while (cond) { __builtin_amdgcn_s_sleep(1); \
    if ((++_sp & 255u) == 0u) { if (xb_ld(&(bar)[XB_TMO])) break; if (_sp > XB_SPIN_CAP) { atomicAdd(&(bar)[XB_TMO], 1u); break; } } } } while (0)
struct XcdBarrier { unsigned* bar; unsigned x; volatile LAS unsigned* st; };
DI XcdBarrier xcd_barrier_post(unsigned* bar, volatile LAS unsigned* st) {
  XcdBarrier b; b.bar = bar; b.x = xb_xcc_id(); b.st = st;
  if (threadIdx.x == 0) (void)xb_add(&bar[XB_XCNT(b.x)], 1u);
  return b;
}
DI void xcd_barrier_complete(unsigned* bar, unsigned x, unsigned& nloc, unsigned& nx) {
  const unsigned G = gridDim.x * gridDim.y * gridDim.z;
  unsigned sum, cnt, mine, sp = 0u;
  for (;;) {
    sum = 0u; cnt = 0u; mine = 0u;
#pragma unroll
    for (unsigned j = 0; j < 16; ++j) { const unsigned c = xb_ld(&bar[XB_XCNT(j)]); sum += c; cnt += (c > 0u) ? 1u : 0u; mine = (j == x) ? c : mine; }
    if (sum == G) break;
    __builtin_amdgcn_s_sleep(1);
    if ((++sp & 255u) == 0u) { if (xb_ld(&bar[XB_TMO])) break; if (sp > XB_SPIN_CAP) { atomicAdd(&bar[XB_TMO], 1u); break; } }
  }
  nloc = mine > 0u ? mine : 1u; nx = cnt > 0u ? cnt : 1u;
}
DI void xcd_barrier(const XcdBarrier& b) {
  asm volatile("s_waitcnt vmcnt(0)" ::: "memory");
  __syncthreads();
  if (threadIdx.x == 0) {
    unsigned* bar = b.bar;
    __builtin_amdgcn_s_waitcnt(0);
    unsigned nloc = b.st[0], nx = b.st[1];
    if (nloc == 0u) { xcd_barrier_complete(bar, b.x, nloc, nx); b.st[0] = nloc; b.st[1] = nx; }
    const unsigned old = xb_add(&bar[XB_XSUB(b.x)], 1u);
    const unsigned gen = old / nloc;
    if (old + 1u == (gen + 1u) * nloc) {
      __builtin_amdgcn_fence(__ATOMIC_RELEASE, "agent");
      asm volatile("s_waitcnt vmcnt(0)" ::: "memory");
      const unsigned og = xb_add(&bar[XB_TOP], 1u);
      const unsigned tg = og / nx;
      if (og + 1u == (tg + 1u) * nx) xb_add(&bar[XB_TOPGEN], 1u);
      else XB_SPIN(xb_ld(&bar[XB_TOPGEN]) == tg, bar);
      __builtin_amdgcn_fence(__ATOMIC_ACQUIRE, "agent");
      xb_add(&bar[XB_XGEN(b.x)], 1u);
      asm volatile("s_waitcnt vmcnt(0)" ::: "memory");
    } else {
      XB_SPIN(xb_ld(&bar[XB_XGEN(b.x)]) == gen, bar);
      __builtin_amdgcn_fence(__ATOMIC_ACQUIRE, "agent");
      asm volatile("s_waitcnt vmcnt(0)" ::: "memory");
    }
  }
  __syncthreads();
}

#ifdef ONLY_PHASE
#define PH_ON(n) ((n) == ONLY_PHASE)
#else
#define PH_ON(n) true
#endif
#define REP_PHASE -1
#define PHASE(n, ...) \
  if (PH_ON(n) && ph_lo <= (n) && (n) < ph_hi) { __VA_ARGS__ } \
  if ((n) == REP_PHASE) { cg::this_grid().sync(); { __VA_ARGS__ } } \
  if (ph_lo <= (n) && (n) + 1 < ph_hi) { if (ph_hi > 1000) cg::this_grid().sync(); else xcd_barrier(xb); }

__global__ void __launch_bounds__(256, 2) yoco_megakernel(KArgs ka, int ph_lo, int ph_hi) {
  __shared__ __attribute__((aligned(16))) char smem[SMEM_BYTES];
  Params p;
  fill_params(p, ka);
  __shared__ __attribute__((aligned(16))) unsigned xb_words[4];
  if (threadIdx.x < 4) xb_words[threadIdx.x] = 0u;
  __syncthreads();
  const XcdBarrier xb = xcd_barrier_post(p.bar, (volatile LAS unsigned*)xb_words);
  PHASE(0, phase_prep(p, smem);)
  PHASE(1, { ALPlain al{p.hb, 16}; EpiFoxIn ep{p}; gemm_phase(al, p.w_ain, 1024, 256, 25, ep, smem); })
  PHASE(2, phase_scan(p, smem);)
  PHASE(3, phase_fox(p, smem);)
  PHASE(4, { ALPlain al{p.ob, 16}; EpiResid<0> ep{p.x, p.out, p.hb, p.part}; gemm_phase(al, p.w_aout, 1024, 256, 8, ep, smem); })
  PHASE(5, { ALFfn al{p.hb}; EpiFfnUp ep{p.part, p.f_conv_w, p.f_conv_b, p.act}; gemm_phase(al, p.w_up0, 1024, 264, 44, ep, smem); })
  PHASE(6, { ALPlain al{p.act, 44}; EpiResid<1> ep{p.out, p.out, p.hb, p.part}; gemm_phase(al, p.w_dn0, FF, 256, 8, ep, smem); })
  PHASE(7, {
    ALPlain al{p.hb, 16};
    { EpiKv ep{p}; gemm_phase(al, p.w_kv, 1024, 256, 6, ep, smem); }
    { EpiBIn ep{p}; gemm_phase(al, p.w_bin, 1024, 256, 9, ep, smem); }
  })
  PHASE(8, {
    for (int item = blockIdx.x; item < 512; item += gridDim.x) {
      const int sel = item & 1, ks4 = (item >> 1) & 3, nt = (item >> 3) & 1, mt = item >> 4;
      ALCmp1 al{p.rawc + (size_t)sel * 8 * T_ * 64, sel ? p.vc_pe : p.kc_pe};
      EpiCmp1P ep{p.hidp + (size_t)(sel * 4 + ks4) * 4096 * 256};
      gemm_tile(al, sel ? p.w_vc1 : p.w_kc1, 2048, mt, nt, ep, smem, ks4 * 8, 8);
    }
  })
  PHASE(9, {
    for (int item = blockIdx.x; item < 64; item += gridDim.x) {
      const int sel = item & 1, mt = item >> 1;
      ALCmp2P al{p.hidp + (size_t)sel * 4 * 4096 * 256};
      EpiCmp2 ep{p, sel};
      gemm_tile(al, sel ? p.w_vc2 : p.w_kc2, 256, mt, 0, ep, smem);
    }
  })
  PHASE(10, phase_nsa(p, smem);)
  PHASE(11, { ALPlain al{p.ob, 16}; EpiResid<1> ep{p.out, p.out, p.hb, p.part}; gemm_phase(al, p.w_bout, 1024, 256, 8, ep, smem); })
  PHASE(12, { ALFfn al{p.hb}; EpiFfnUp ep{p.part, p.f_conv_w + 3 * 5632, p.f_conv_b + 5632, p.act}; gemm_phase(al, p.w_up1, 1024, 264, 44, ep, smem); })
  PHASE(13, { ALPlain al{p.act, 44}; EpiResid<2> ep{p.out, p.out, p.hb, p.part}; gemm_phase(al, p.w_dn1, FF, 256, 8, ep, smem); })
}

extern "C" void kernel_launch(void* const* d_in, const int* in_sizes, int n_in, void* d_out, int out_size, void* d_ws, size_t ws_size, hipStream_t stream) {
  KArgs p{};
  for (int i = 0; i < 29; ++i) p.in[i] = d_in[i];
  p.out = (float*)d_out; p.ws = (char*)d_ws;
  hipMemsetAsync(d_ws, 0, 16384, stream);
  static int grid_blocks = 0;
  if (!grid_blocks) {
    int dev = 0, cus = 0, per_cu = 0;
    hipGetDevice(&dev);
    hipDeviceGetAttribute(&cus, hipDeviceAttributeMultiprocessorCount, dev);
    hipOccupancyMaxActiveBlocksPerMultiprocessor(&per_cu, yoco_megakernel, 256, 0);
    if (per_cu > 2) per_cu = 2;
    if (per_cu < 1) per_cu = 1;
    grid_blocks = cus * per_cu;
    grid_blocks &= ~7;
  }
#if N_LAUNCH_SPLIT
  for (int ph = 0; ph < NPHASE; ++ph) {
    int lo = ph, hi = ph + 1;
    hipLaunchKernelGGL(yoco_megakernel, dim3(grid_blocks), dim3(256), 0, stream, p, lo, hi);
  }
#else
  int lo = 0, hi = NPHASE;
  void* args[] = {&p, &lo, &hi};
  hipError_t e = hipLaunchCooperativeKernel((void*)yoco_megakernel, dim3(grid_blocks), dim3(256), args, 0, stream);
  if (e != hipSuccess) fprintf(stderr, "cooperative launch failed: %s (grid %d)\n", hipGetErrorString(e), grid_blocks);
#endif
}
```

```cpp
#include <hip/hip_runtime.h>
#include <hip/hip_cooperative_groups.h>
#include <stdint.h>
#include <cstdio>
namespace cg = cooperative_groups;

#ifndef N_LAUNCH_SPLIT
#define N_LAUNCH_SPLIT 0
#endif

#define DI __device__ __forceinline__
typedef unsigned short bf16_t;
typedef short bf16x8 __attribute__((ext_vector_type(8)));
typedef short bf16x4 __attribute__((ext_vector_type(4)));
typedef float f32x16 __attribute__((ext_vector_type(16)));
typedef float f32x4 __attribute__((ext_vector_type(4)));
typedef unsigned u32x4 __attribute__((ext_vector_type(4)));
typedef unsigned u32x2 __attribute__((ext_vector_type(2)));

constexpr int T_ = 8192;
constexpr int NTOK = 32768;
constexpr int FF = 2816;
constexpr int NPHASE = 14;
constexpr int SMEM_BYTES = 73728;

struct Params {
  const float* x; const int* pos;
  const float *a_norm, *a_w_in, *a_b_f, *a_q_gain, *a_k_gain, *a_w_out;
  const float *kv_norm, *kv_w, *kc_pe, *vc_pe, *kc_w1, *kc_w2, *vc_w1, *vc_w2, *kc_gain, *ks_gain, *kw_gain;
  const float *b_norm, *b_w_in, *b_b_gate, *b_q_gain, *b_w_out;
  const float *f_norm, *f_w_up, *f_conv_w, *f_conv_b, *f_w_down;
  float* out;
  bf16_t *w_ain, *w_aout, *w_kv, *w_kc1, *w_vc1, *w_kc2, *w_vc2, *w_bin, *w_bout, *w_up0, *w_up1, *w_dn0, *w_dn1;
  bf16_t* hb; float* part; float* lf; float* cc; bf16_t* ob;
  bf16_t *qb, *kb, *vT; bf16_t* act;
  bf16_t *rawc, *ksb, *vsT, *kwb, *vwT, *qn; float* gates; bf16_t *hid, *kcb, *vcT; float* hidp; unsigned* bar;
};

typedef __bf16 bf16v2 __attribute__((ext_vector_type(2)));
typedef float f32x2 __attribute__((ext_vector_type(2)));
struct KArgs { const void* in[29]; float* out; char* ws; };
DI void fill_params(Params& p, const KArgs& ka) {
  p.x = (const float*)ka.in[0]; p.pos = (const int*)ka.in[1];
  p.a_norm = (const float*)ka.in[2]; p.a_w_in = (const float*)ka.in[3]; p.a_b_f = (const float*)ka.in[4]; p.a_q_gain = (const float*)ka.in[5];
  p.a_k_gain = (const float*)ka.in[6]; p.a_w_out = (const float*)ka.in[7]; p.kv_norm = (const float*)ka.in[8]; p.kv_w = (const float*)ka.in[9];
  p.kc_pe = (const float*)ka.in[10]; p.vc_pe = (const float*)ka.in[11]; p.kc_w1 = (const float*)ka.in[12]; p.kc_w2 = (const float*)ka.in[13];
  p.vc_w1 = (const float*)ka.in[14]; p.vc_w2 = (const float*)ka.in[15]; p.kc_gain = (const float*)ka.in[16]; p.ks_gain = (const float*)ka.in[17];
  p.kw_gain = (const float*)ka.in[18]; p.b_norm = (const float*)ka.in[19]; p.b_w_in = (const float*)ka.in[20]; p.b_b_gate = (const float*)ka.in[21];
  p.b_q_gain = (const float*)ka.in[22]; p.b_w_out = (const float*)ka.in[23]; p.f_norm = (const float*)ka.in[24]; p.f_w_up = (const float*)ka.in[25];
  p.f_conv_w = (const float*)ka.in[26]; p.f_conv_b = (const float*)ka.in[27]; p.f_w_down = (const float*)ka.in[28];
  p.out = ka.out;
  char* wsq = ka.ws;
#define TAKE(bytes) (wsq += (((size_t)(bytes)) + 255) & ~(size_t)255, wsq - ((((size_t)(bytes)) + 255) & ~(size_t)255))
  p.bar = (unsigned*)TAKE(16384);
  p.w_ain = (bf16_t*)TAKE((size_t)3200 * 1024 * 2); p.w_aout = (bf16_t*)TAKE((size_t)1024 * 1024 * 2); p.w_kv = (bf16_t*)TAKE((size_t)768 * 1024 * 2);
  p.w_kc1 = (bf16_t*)TAKE((size_t)256 * 2048 * 2); p.w_vc1 = (bf16_t*)TAKE((size_t)256 * 2048 * 2);
  p.w_kc2 = (bf16_t*)TAKE((size_t)128 * 256 * 2); p.w_vc2 = (bf16_t*)TAKE((size_t)128 * 256 * 2);
  p.w_bin = (bf16_t*)TAKE((size_t)1152 * 1024 * 2); p.w_bout = (bf16_t*)TAKE((size_t)1024 * 1024 * 2);
  p.w_up0 = (bf16_t*)TAKE((size_t)5632 * 1024 * 2); p.w_up1 = (bf16_t*)TAKE((size_t)5632 * 1024 * 2);
  p.w_dn0 = (bf16_t*)TAKE((size_t)1024 * FF * 2); p.w_dn1 = (bf16_t*)TAKE((size_t)1024 * FF * 2);
  p.hb = (bf16_t*)TAKE((size_t)NTOK * 1024 * 2); p.part = (float*)TAKE((size_t)NTOK * 16 * 4);
  p.lf = (float*)TAKE((size_t)64 * T_ * 4); p.cc = (float*)TAKE((size_t)64 * T_ * 4);
  p.ob = (bf16_t*)TAKE((size_t)NTOK * 1024 * 2);
  char* R = TAKE((size_t)NTOK * 1024 * 2 * 3);
#undef TAKE
  p.qb = (bf16_t*)R; p.kb = p.qb + (size_t)NTOK * 1024; p.vT = p.kb + (size_t)NTOK * 1024;
  p.act = (bf16_t*)R;
  {
    char* q = R;
    p.qn = (bf16_t*)q; q += (size_t)NTOK * 1024 * 2;
    p.rawc = (bf16_t*)q; q += (size_t)2 * 8 * T_ * 64 * 2;
    p.ksb = (bf16_t*)q; q += (size_t)8 * T_ * 64 * 2;
    p.vsT = (bf16_t*)q; q += (size_t)8 * T_ * 64 * 2;
    p.kwb = (bf16_t*)q; q += (size_t)8 * T_ * 64 * 2;
    p.vwT = (bf16_t*)q; q += (size_t)8 * T_ * 64 * 2;
    p.gates = (float*)q; q += (size_t)NTOK * 48 * 4;
    p.hid = (bf16_t*)q; q += (size_t)2 * 4096 * 256 * 2;
    p.kcb = (bf16_t*)q; q += (size_t)8 * 512 * 64 * 2;
    p.vcT = (bf16_t*)q; q += (size_t)8 * 64 * 512 * 2;
    p.hidp = (float*)q; q += (size_t)2 * 4 * 4096 * 256 * 4;
  }
}

DI bf16_t f2bf(float x) { return __builtin_bit_cast(bf16_t, (__bf16)x); }
DI unsigned pack2(float a, float b) { f32x2 v = {a, b}; return __builtin_bit_cast(unsigned, __builtin_convertvector(v, bf16v2)); }
DI float bf2f(bf16_t v) { return __uint_as_float(((unsigned)v) << 16); }
DI int crow(int i, int h) { return (i & 3) + 8 * (i >> 2) + 4 * h; }
DI f32x16 mfma32(bf16x8 a, bf16x8 b, f32x16 c) { return __builtin_amdgcn_mfma_f32_32x32x16_bf16(a, b, c, 0, 0, 0); }
DI f32x4 mfma16(bf16x8 a, bf16x8 b, f32x4 c) { return __builtin_amdgcn_mfma_f32_16x16x32_bf16(a, b, c, 0, 0, 0); }
DI float row_rstd(const float* part, int row) {
  const f32x4* q = (const f32x4*)(part + (size_t)row * 16);
  f32x4 a = q[0], b = q[1], c = q[2], d = q[3];
  float s = ((a.x + a.y) + (a.z + a.w)) + ((b.x + b.y) + (b.z + b.w)) + ((c.x + c.y) + (c.z + c.w)) + ((d.x + d.y) + (d.z + d.w));
  return rsqrtf(s * (1.0f / 1024.0f) + 1e-6f);
}
DI size_t a_off(int row, int k, int KB) { return (((size_t)((row >> 7) * KB + (k >> 6))) << 13) + ((row & 127) << 6) + (k & 63); }
DI void store_bf4(bf16_t* dst, float a, float b, float c, float d) { u32x2 v; v.x = pack2(a, b); v.y = pack2(c, d); *(u32x2*)dst = v; }

struct WJob { const float* src; bf16_t* dst; const float* gain; int K, Nsrc, Ndst, mode; };
DI WJob get_job(const Params& p, int j) {
  WJob w; w.gain = nullptr; w.mode = 0;
  switch (j) {
    case 0: w.src = p.a_w_in; w.dst = p.w_ain; w.gain = p.a_norm; w.K = 1024; w.Nsrc = 3088; w.Ndst = 3200; break;
    case 1: w.src = p.a_w_out; w.dst = p.w_aout; w.K = 1024; w.Nsrc = 1024; w.Ndst = 1024; break;
    case 2: w.src = p.kv_w; w.dst = p.w_kv; w.gain = p.kv_norm; w.K = 1024; w.Nsrc = 768; w.Ndst = 768; break;
    case 3: w.src = p.kc_w1; w.dst = p.w_kc1; w.K = 2048; w.Nsrc = 256; w.Ndst = 256; break;
    case 4: w.src = p.vc_w1; w.dst = p.w_vc1; w.K = 2048; w.Nsrc = 256; w.Ndst = 256; break;
    case 5: w.src = p.kc_w2; w.dst = p.w_kc2; w.K = 256; w.Nsrc = 64; w.Ndst = 128; break;
    case 6: w.src = p.vc_w2; w.dst = p.w_vc2; w.K = 256; w.Nsrc = 64; w.Ndst = 128; break;
    case 7: w.src = p.b_w_in; w.dst = p.w_bin; w.gain = p.b_norm; w.K = 1024; w.Nsrc = 1072; w.Ndst = 1152; break;
    case 8: w.src = p.b_w_out; w.dst = p.w_bout; w.K = 1024; w.Nsrc = 1024; w.Ndst = 1024; break;
    case 9: w.src = p.f_w_up; w.dst = p.w_up0; w.gain = p.f_norm; w.K = 1024; w.Nsrc = 5632; w.Ndst = 5632; w.mode = 1; break;
    case 10: w.src = p.f_w_up + (size_t)1024 * 5632; w.dst = p.w_up1; w.gain = p.f_norm + 1024; w.K = 1024; w.Nsrc = 5632; w.Ndst = 5632; w.mode = 1; break;
    case 11: w.src = p.f_w_down; w.dst = p.w_dn0; w.K = 2816; w.Nsrc = 1024; w.Ndst = 1024; break;
    default: w.src = p.f_w_down + (size_t)2816 * 1024; w.dst = p.w_dn1; w.K = 2816; w.Nsrc = 1024; w.Ndst = 1024; break;
  }
  return w;
}

DI void prep_load(const WJob& w, int t, int nkt, int tid, f32x4 (&v)[4], int& k0, int& n0d) {
  const int kt = t % nkt, nt = t / nkt;
  k0 = kt << 6; n0d = nt << 6;
  int sbase = n0d;
  if (w.mode == 1) { const int tile = n0d >> 7, half = (n0d >> 6) & 1; sbase = half * FF + tile * 64; }
#pragma unroll
  for (int i = 0; i < 4; ++i) {
    const int kk = (tid >> 4) + 16 * i, col = sbase + (tid & 15) * 4;
    v[i] = (f32x4){0.f, 0.f, 0.f, 0.f};
    if (col < w.Nsrc) v[i] = *(const f32x4*)(w.src + (size_t)(k0 + kk) * w.Nsrc + col);
    const float g = w.gain ? w.gain[k0 + kk] : 1.0f;
    v[i] *= g;
  }
}
DI void prep_lds(float* sT, const f32x4 (&v)[4], int tid) {
#pragma unroll
  for (int i = 0; i < 4; ++i) {
    const int kk = (tid >> 4) + 16 * i, nn = (tid & 15) * 4;
    sT[kk * 65 + nn + 0] = v[i].x; sT[kk * 65 + nn + 1] = v[i].y; sT[kk * 65 + nn + 2] = v[i].z; sT[kk * 65 + nn + 3] = v[i].w;
  }
}
DI void prep_out(const float* sT, const WJob& w, int k0, int n0d, int nkt, int tid) {
  const int n = tid >> 2, kseg = (tid & 3) * 16;
  unsigned o[8];
#pragma unroll
  for (int q = 0; q < 8; ++q) o[q] = pack2(sT[(kseg + 2 * q) * 65 + n], sT[(kseg + 2 * q + 1) * 65 + n]);
  u32x4* dst = (u32x4*)(w.dst + a_off(n0d + n, k0 + kseg, nkt));
  dst[0] = (u32x4){o[0], o[1], o[2], o[3]}; dst[1] = (u32x4){o[4], o[5], o[6], o[7]};
}

DI void phase_prep(const Params& p, char* smem) {
  float* sT0 = (float*)smem;
  float* sT1 = sT0 + 64 * 65;
  const int tid = threadIdx.x;
  {
    const int lane = tid & 63, gw = blockIdx.x * 4 + (tid >> 6), nw = gridDim.x * 4;
    for (int row0 = gw * 4; row0 < NTOK; row0 += nw * 4) {
      f32x4 v[4][4];
#pragma unroll
      for (int rr = 0; rr < 4; ++rr)
#pragma unroll
        for (int i = 0; i < 4; ++i) v[rr][i] = *(const f32x4*)(p.x + (size_t)(row0 + rr) * 1024 + i * 256 + lane * 4);
#pragma unroll
      for (int rr = 0; rr < 4; ++rr) {
        const int row = row0 + rr;
        float ss = 0.f;
#pragma unroll
        for (int i = 0; i < 4; ++i) {
          const f32x4 x = v[rr][i];
          ss += x.x * x.x + x.y * x.y + x.z * x.z + x.w * x.w;
          store_bf4(p.hb + a_off(row, i * 256 + lane * 4, 16), x.x, x.y, x.z, x.w);
        }
#pragma unroll
        for (int o = 32; o >= 1; o >>= 1) ss += __shfl_xor(ss, o);
        if (lane < 16) p.part[(size_t)row * 16 + lane] = lane == 0 ? ss : 0.f;
      }
    }
  }
  {
    int tstart[14];
    tstart[0] = 0;
#pragma unroll
    for (int j = 0; j < 13; ++j) { const WJob w = get_job(p, j); tstart[j + 1] = tstart[j] + (w.K >> 6) * (w.Ndst >> 6); }
    const int total = tstart[13], G = gridDim.x;
    auto find_job = [&](int g) { int j = 0;
#pragma unroll
      for (int q = 1; q < 13; ++q) j += (g >= tstart[q]) ? 1 : 0;
      return j; };
    auto job_base = [&](int j) { int r = 0;
#pragma unroll
      for (int q = 0; q < 13; ++q) r = (q == j) ? tstart[q] : r;
      return r; };
    f32x4 va[4], vb[4]; int k0a = 0, n0a = 0, k0b = 0, n0b = 0, ja = 0, jb = 0;
    int g = blockIdx.x;
    if (g < total) { ja = find_job(g); const WJob w = get_job(p, ja); prep_load(w, g - job_base(ja), w.K >> 6, tid, va, k0a, n0a); }
    for (; g < total; g += G) {
      const int gn = g + G;
      if (gn < total) { jb = find_job(gn); const WJob w = get_job(p, jb); prep_load(w, gn - job_base(jb), w.K >> 6, tid, vb, k0b, n0b); }
      __syncthreads();
      prep_lds(sT0, va, tid);
      __syncthreads();
      { const WJob w = get_job(p, ja); prep_out(sT0, w, k0a, n0a, w.K >> 6, tid); }
#pragma unroll
      for (int i = 0; i < 4; ++i) va[i] = vb[i];
      k0a = k0b; n0a = n0b; ja = jb;
    }
  }
  if (blockIdx.x == 0) {
    for (int i = tid; i < 8 * 64; i += 256) {
      const int bg = i >> 6, d = i & 63;
      p.kcb[((size_t)bg * 512 + 511) * 64 + d] = 0;
      p.vcT[((size_t)(bg * 8 + 7) * 64 + d) * 64 + 63] = 0;
    }
  }
}

template <class AL, class EP>
DI void gemm_tile(const AL& al, const bf16_t* __restrict__ Wt, int K, int mt, int nt, const EP& ep, char* smem, int kb0 = 0, int KBn = -1) {
  bf16_t* sbuf = (bf16_t*)smem;
  constexpr int STAGE = 2 * 128 * 72;
  const int tid = threadIdx.x, lane = tid & 63, wave = tid >> 6, wr = wave >> 1, wc = wave & 1, r = lane & 31, h = lane >> 5;
  const int KBt = K >> 6, KB = KBn < 0 ? KBt : KBn;
  const bf16_t* wbase = Wt + (((size_t)nt * KBt + kb0) << 13) + tid * 8;
  f32x16 acc[2][2];
#pragma unroll
  for (int a = 0; a < 2; ++a)
#pragma unroll
    for (int b = 0; b < 2; ++b)
#pragma unroll
      for (int i = 0; i < 16; ++i) acc[a][b][i] = 0.f;
  u32x4 xa[4], wa[4];
#define GEMM_LOAD(kb_)                                                                  \
  _Pragma("unroll") for (int i = 0; i < 4; ++i) {                                        \
    const int c = tid + 256 * i;                                                         \
    xa[i] = al(mt, c >> 3, (kb0 + (kb_)) * 64 + (c & 7) * 8);                                    \
    wa[i] = *(const u32x4*)(wbase + ((size_t)(kb_) << 13) + 2048 * i);                   \
  }
#define GEMM_STORE(st_)                                                                 \
  _Pragma("unroll") for (int i = 0; i < 4; ++i) {                                        \
    const int c = tid + 256 * i, row = c >> 3, kc = (c & 7) * 8;                         \
    *(u32x4*)(sbuf + (st_) * STAGE + row * 72 + kc) = xa[i];                             \
    *(u32x4*)(sbuf + (st_) * STAGE + 128 * 72 + row * 72 + kc) = wa[i];                  \
  }
#define GEMM_LDF(FW, FX, st_, ks_)                                                      \
  _Pragma("unroll") for (int q = 0; q < 2; ++q) {                                        \
    FW[q] = *(const bf16x8*)(sbuf + (st_) * STAGE + 128 * 72 + (64 * wc + 32 * q + r) * 72 + 16 * (ks_) + 8 * h); \
    FX[q] = *(const bf16x8*)(sbuf + (st_) * STAGE + (64 * wr + 32 * q + r) * 72 + 16 * (ks_) + 8 * h);            \
  }
#define GEMM_MM(FW, FX)                                                                 \
  _Pragma("unroll") for (int ms = 0; ms < 2; ++ms)                                       \
    _Pragma("unroll") for (int ns = 0; ns < 2; ++ns) acc[ms][ns] = mfma32(FW[ns], FX[ms], acc[ms][ns]);
  bf16x8 faw[2], fax[2], fbw[2], fbx[2];
  __syncthreads();
  GEMM_LOAD(0)
  GEMM_STORE(0)
  if (KB > 1) { GEMM_LOAD(1) }
  __syncthreads();
  GEMM_LDF(faw, fax, 0, 0)
  for (int it = 0; it < KB; ++it) {
    const int cur = it & 1;
    if (it + 1 < KB) { GEMM_STORE(cur ^ 1) }
    if (it + 2 < KB) { GEMM_LOAD(it + 2) }
    __builtin_amdgcn_sched_barrier(0);
    GEMM_LDF(fbw, fbx, cur, 1)
    __builtin_amdgcn_sched_barrier(0);
    GEMM_MM(faw, fax)
    __builtin_amdgcn_sched_barrier(0);
    GEMM_LDF(faw, fax, cur, 2)
    __builtin_amdgcn_sched_barrier(0);
    GEMM_MM(fbw, fbx)
    __builtin_amdgcn_sched_barrier(0);
    GEMM_LDF(fbw, fbx, cur, 3)
    __builtin_amdgcn_sched_barrier(0);
    GEMM_MM(faw, fax)
    __builtin_amdgcn_sched_barrier(0);
    __syncthreads();
    if (it + 1 < KB) { GEMM_LDF(faw, fax, cur ^ 1, 0) }
    __builtin_amdgcn_sched_barrier(0);
    GEMM_MM(fbw, fbx)
    __builtin_amdgcn_sched_barrier(0);
  }
#undef GEMM_LDF
#undef GEMM_MM
#undef GEMM_LOAD
#undef GEMM_STORE
  ep(acc, mt, nt, wr, wc, lane, smem);
}

template <class AL, class EP>
DI void gemm_phase(const AL& al, const bf16_t* Wt, int K, int numM, int numN, const EP& ep, char* smem) {
  const int xcd = blockIdx.x & 7, lb = blockIdx.x >> 3, nlb = gridDim.x >> 3;
  const int mper = (numM + 7) >> 3, fullr = mper >> 3, mrem = mper & 7;
  const int nfull = fullr * 8 * numN, total = mper * numN;
  for (int li = lb; li < total; li += nlb) {
    int nt, mtl;
    if (li < nfull) { const int s = li / (8 * numN), rem = li - s * 8 * numN; nt = rem >> 3; mtl = s * 8 + (rem & 7); }
    else { const int rem = li - nfull; nt = rem / mrem; mtl = fullr * 8 + (rem - nt * mrem); }
    const int mt = xcd * mper + mtl;
    if (mt >= numM) continue;
    gemm_tile(al, Wt, K, mt, nt, ep, smem);
  }
}

struct ALPlain { const bf16_t* A; int KB; DI u32x4 operator()(int mt, int ml, int k) const { return *(const u32x4*)(A + (((size_t)(mt * KB + (k >> 6))) << 13) + (ml << 6) + (k & 63)); } };
struct ALFfn {
  const bf16_t* A;
  DI u32x4 operator()(int mt, int ml, int k) const {
    const int b = mt / 66, it = mt - b * 66, t = 126 * it - 2 + ml;
    if (t < 0 || t >= T_) return (u32x4){0, 0, 0, 0};
    return *(const u32x4*)(A + a_off(b * T_ + t, k, 16));
  }
};
struct ALCmp1 {
  const bf16_t* raw; const float* pe;
  DI u32x4 operator()(int mt, int ml, int k) const {
    const int m = mt * 128 + ml;
    if (m >= 4088) return (u32x4){0, 0, 0, 0};
    const int bg = m / 511, n = m - bg * 511;
    u32x4 v = *(const u32x4*)(raw + ((size_t)bg * T_ + 16 * n) * 64 + k);
    const f32x4 p0 = *(const f32x4*)(pe + k), p1 = *(const f32x4*)(pe + k + 4);
    u32x4 o;
    o.x = pack2(bf2f((bf16_t)(v.x & 0xffff)) + p0.x, bf2f((bf16_t)(v.x >> 16)) + p0.y);
    o.y = pack2(bf2f((bf16_t)(v.y & 0xffff)) + p0.z, bf2f((bf16_t)(v.y >> 16)) + p0.w);
    o.z = pack2(bf2f((bf16_t)(v.z & 0xffff)) + p1.x, bf2f((bf16_t)(v.z >> 16)) + p1.y);
    o.w = pack2(bf2f((bf16_t)(v.w & 0xffff)) + p1.z, bf2f((bf16_t)(v.w >> 16)) + p1.w);
    return o;
  }
};
struct ALCmp2 { const bf16_t* A; DI u32x4 operator()(int mt, int ml, int k) const { const int m = mt * 128 + ml; if (m >= 4088) return (u32x4){0, 0, 0, 0}; return *(const u32x4*)(A + (size_t)m * 256 + k); } };

__device__ const float ROPE_INV[8] = {1.0f, 0.19392274474868576f, 0.03760603093086393f, 0.007292664737217109f, 0.001414213562373095f, 0.0002742481756762073f, 5.318295896944988e-05f, 1.031338537721246e-05f};

template <bool ROPE>
DI void norm_store(f32x16 (&a)[2], float rs, const float* gain, int pos, bf16_t* dst, int h) {
  float ss = 0.f;
#pragma unroll
  for (int ns = 0; ns < 2; ++ns)
#pragma unroll
    for (int i = 0; i < 16; ++i) { const float v = a[ns][i] * rs; a[ns][i] = v; ss += v * v; }
  ss += __shfl_xor(ss, 32);
  const float inv = rsqrtf(ss * (1.0f / 64.0f) + 1e-6f);
#pragma unroll
  for (int ns = 0; ns < 2; ++ns)
#pragma unroll
    for (int i = 0; i < 16; ++i) a[ns][i] = a[ns][i] * inv * gain[32 * ns + crow(i, h)];
  if (ROPE) {
    const float fp = (float)pos;
#pragma unroll
    for (int ii = 0; ii < 4; ++ii) {
      const float ang = fp * ROPE_INV[4 * h + ii];
      const float c = cosf(ang), s = sinf(ang);
      const float x1 = a[0][ii], x2 = a[0][4 + ii];
      a[0][ii] = x1 * c - x2 * s; a[0][4 + ii] = x2 * c + x1 * s;
    }
  }
#pragma unroll
  for (int ns = 0; ns < 2; ++ns)
#pragma unroll
    for (int q = 0; q < 4; ++q) store_bf4(dst + 32 * ns + 8 * q + 4 * h, a[ns][4 * q], a[ns][4 * q + 1], a[ns][4 * q + 2], a[ns][4 * q + 3]);
}

struct EpiFoxIn {
  const Params& p;
  DI void operator()(f32x16 (&acc)[2][2], int mt, int nt, int wr, int wc, int lane, char*) const {
    const int r = lane & 31, h = lane >> 5, nb = nt * 128 + 64 * wc;
#pragma unroll
    for (int ms = 0; ms < 2; ++ms) {
      const int row = mt * 128 + 64 * wr + 32 * ms + r;
      const float rs = row_rstd(p.part, row);
      const int b = row >> 13, t = row & 8191;
      if (nb < 2048) {
        const bool isq = nb < 1024;
        norm_store<false>(acc[ms], rs, isq ? p.a_q_gain : p.a_k_gain, 0, (isq ? p.qb : p.kb) + ((size_t)(b * 16 + ((nb & 1023) >> 6)) * T_ + t) * 64, h);
      } else if (nb < 3072) {
        const int head = (nb - 2048) >> 6;
        bf16_t* dst = p.vT + ((size_t)((b * 16 + head) * 128 + (t >> 6))) * 4096 + (t & 63);
#pragma unroll
        for (int ns = 0; ns < 2; ++ns)
#pragma unroll
          for (int i = 0; i < 16; ++i) dst[(32 * ns + crow(i, h)) * 64] = f2bf(acc[ms][ns][i] * rs);
      } else if (nb == 3072) {
#pragma unroll
        for (int i = 0; i < 8; ++i) {
          const int head = crow(i, h);
          const float z = acc[ms][0][i] * rs + p.a_b_f[head];
          p.lf[((size_t)(b * 16 + head)) * T_ + t] = fminf(z, 0.f) - log1pf(expf(-fabsf(z)));
        }
      }
    }
  }
};

template <int MODE>
struct EpiResid {
  const float* res; float* out; bf16_t* hb; float* part;
  DI void operator()(f32x16 (&acc)[2][2], int mt, int nt, int wr, int wc, int lane, char* smem) const {
    float* sU = (float*)smem;
    const int r = lane & 31, h = lane >> 5, tid = threadIdx.x;
    __syncthreads();
#pragma unroll
    for (int ms = 0; ms < 2; ++ms) {
      const int ml = 64 * wr + 32 * ms + r;
#pragma unroll
      for (int ns = 0; ns < 2; ++ns)
#pragma unroll
        for (int i = 0; i < 16; ++i) sU[ml * 132 + 64 * wc + 32 * ns + crow(i, h)] = acc[ms][ns][i];
    }
    __syncthreads();
    const int c4 = (tid & 31) * 4, n = nt * 128 + c4;
#pragma unroll 1
    for (int hh = 0; hh < 2; ++hh) {
      f32x4 rv[8];
#pragma unroll
      for (int it = 0; it < 8; ++it) {
        const int row = mt * 128 + (hh * 8 + it) * 8 + (tid >> 5);
        if (MODE == 0) rv[it] = *(const f32x4*)(res + (size_t)row * 1024 + n);
        else {
          const u32x2 v = *(const u32x2*)(hb + a_off(row, n, 16));
          rv[it] = (f32x4){bf2f((bf16_t)(v.x & 0xffff)), bf2f((bf16_t)(v.x >> 16)), bf2f((bf16_t)(v.y & 0xffff)), bf2f((bf16_t)(v.y >> 16))};
        }
      }
#pragma unroll
      for (int it = 0; it < 8; ++it) {
        const int rl = (hh * 8 + it) * 8 + (tid >> 5), row = mt * 128 + rl;
        const f32x4 o = rv[it] + *(const f32x4*)(sU + rl * 132 + c4);
        if (MODE == 2) *(f32x4*)(out + (size_t)row * 1024 + n) = o;
        else {
          store_bf4(hb + a_off(row, n, 16), o.x, o.y, o.z, o.w);
          float ss = o.x * o.x + o.y * o.y + o.z * o.z + o.w * o.w;
          ss += __shfl_xor(ss, 1); ss += __shfl_xor(ss, 2); ss += __shfl_xor(ss, 4); ss += __shfl_xor(ss, 8); ss += __shfl_xor(ss, 16);
          if ((tid & 31) == 0) { part[(size_t)row * 16 + nt * 2] = ss; part[(size_t)row * 16 + nt * 2 + 1] = 0.f; }
        }
      }
    }
  }
};

struct EpiFfnUp {
  const float* part; const float* cw; const float* cb; bf16_t* act;
  DI void operator()(f32x16 (&acc)[2][2], int mt, int nt, int wr, int wc, int lane, char* smem) const {
    float* sU = (float*)smem;
    const int r = lane & 31, h = lane >> 5, tid = threadIdx.x;
    const int b = mt / 66, it = mt - b * 66, tb = 126 * it - 2;
    __syncthreads();
#pragma unroll
    for (int ms = 0; ms < 2; ++ms) {
      const int ml = 64 * wr + 32 * ms + r, t = tb + ml;
      const float rs = (t >= 0 && t < T_) ? row_rstd(part, b * T_ + t) : 0.f;
#pragma unroll
      for (int ns = 0; ns < 2; ++ns)
#pragma unroll
        for (int i = 0; i < 16; ++i) sU[ml * 129 + 64 * wc + 32 * ns + crow(i, h)] = acc[ms][ns][i] * rs;
    }
    __syncthreads();
    const int jj = tid & 63, rg = tid >> 6, j = nt * 64 + jj;
    const float wg0 = cw[j], wg1 = cw[5632 + j], wg2 = cw[2 * 5632 + j], bgt = cb[j];
    const float wv0 = cw[FF + j], wv1 = cw[5632 + FF + j], wv2 = cw[2 * 5632 + FF + j], bvl = cb[FF + j];
    {
      const int m_lo = rg == 0 ? 2 : 32 * rg, m_hi = 32 * rg + 32;
      float g0 = sU[(m_lo - 2) * 129 + jj], g1 = sU[(m_lo - 1) * 129 + jj];
      float v0 = sU[(m_lo - 2) * 129 + 64 + jj], v1 = sU[(m_lo - 1) * 129 + 64 + jj];
      for (int ml = m_lo; ml < m_hi; ++ml) {
        const int t = tb + ml;
        if (t >= T_) break;
        const float g2 = sU[ml * 129 + jj], v2 = sU[ml * 129 + 64 + jj];
        const float g = bgt + wg0 * g0 + wg1 * g1 + wg2 * g2;
        const float v = bvl + wv0 * v0 + wv1 * v1 + wv2 * v2;
        const float a = g * __builtin_amdgcn_rcpf(1.0f + __expf(-g)) * v;
        act[a_off(b * T_ + t, j, 44)] = f2bf(a);
        g0 = g1; g1 = g2; v0 = v1; v1 = v2;
      }
    }
  }
};

struct EpiKv {
  const Params& p;
  DI void operator()(f32x16 (&acc)[2][2], int mt, int nt, int wr, int wc, int lane, char*) const {
    const int r = lane & 31, h = lane >> 5, g = wc;
#pragma unroll
    for (int ms = 0; ms < 2; ++ms) {
      const int row = mt * 128 + 64 * wr + 32 * ms + r;
      const float rs = row_rstd(p.part, row);
      const int b = row >> 13, t = row & 8191, bg = b * 2 + g;
      if (nt < 2) {
        bf16_t* dst = p.rawc + (((size_t)(nt * 8 + bg)) * T_ + t) * 64;
#pragma unroll
        for (int ns = 0; ns < 2; ++ns)
#pragma unroll
          for (int q = 0; q < 4; ++q)
            store_bf4(dst + 32 * ns + 8 * q + 4 * h, acc[ms][ns][4 * q] * rs, acc[ms][ns][4 * q + 1] * rs, acc[ms][ns][4 * q + 2] * rs, acc[ms][ns][4 * q + 3] * rs);
      } else if (nt == 2 || nt == 4) {
        norm_store<true>(acc[ms], rs, nt == 2 ? p.ks_gain : p.kw_gain, p.pos[row], (nt == 2 ? p.ksb : p.kwb) + ((size_t)bg * T_ + t) * 64, h);
      } else if (nt == 3) {
        bf16_t* dst = p.vsT + ((size_t)bg * 128 + (t >> 6)) * 4096 + (t & 63);
#pragma unroll
        for (int ns = 0; ns < 2; ++ns)
#pragma unroll
          for (int i = 0; i < 16; ++i) dst[(32 * ns + crow(i, h)) * 64] = f2bf(acc[ms][ns][i] * rs);
      } else {
        bf16_t* dst = p.vwT + ((size_t)bg * 128 + (t >> 6)) * 4096 + (t & 63);
#pragma unroll
        for (int ns = 0; ns < 2; ++ns)
#pragma unroll
          for (int i = 0; i < 16; ++i) dst[(32 * ns + crow(i, h)) * 64] = f2bf(acc[ms][ns][i] * rs);
      }
    }
  }
};

struct EpiBIn {
  const Params& p;
  DI void operator()(f32x16 (&acc)[2][2], int mt, int nt, int wr, int wc, int lane, char*) const {
    const int r = lane & 31, h = lane >> 5, nb = nt * 128 + 64 * wc;
#pragma unroll
    for (int ms = 0; ms < 2; ++ms) {
      const int row = mt * 128 + 64 * wr + 32 * ms + r;
      const float rs = row_rstd(p.part, row);
      if (nb < 1024) {
        norm_store<true>(acc[ms], rs, p.b_q_gain, p.pos[row], p.qn + (size_t)row * 1024 + nb, h);
      } else if (nb == 1024) {
#pragma unroll
        for (int ns = 0; ns < 2; ++ns)
#pragma unroll
          for (int i = 0; i < 16; ++i) {
            const int c = 32 * ns + crow(i, h);
            if (c < 48) { const float z = acc[ms][ns][i] * rs + p.b_b_gate[c]; p.gates[(size_t)row * 48 + c] = 1.0f / (1.0f + __expf(-z)); }
          }
      }
    }
  }
};

struct EpiCmp1P {
  float* dst;
  DI void operator()(f32x16 (&acc)[2][2], int mt, int nt, int wr, int wc, int lane, char*) const {
    const int r = lane & 31, h = lane >> 5;
#pragma unroll
    for (int ms = 0; ms < 2; ++ms) {
      const int m = mt * 128 + 64 * wr + 32 * ms + r;
#pragma unroll
      for (int ns = 0; ns < 2; ++ns)
#pragma unroll
        for (int q = 0; q < 4; ++q) {
          f32x4 v = {acc[ms][ns][4 * q], acc[ms][ns][4 * q + 1], acc[ms][ns][4 * q + 2], acc[ms][ns][4 * q + 3]};
          *(f32x4*)(dst + (size_t)m * 256 + nt * 128 + 64 * wc + 32 * ns + 8 * q + 4 * h) = v;
        }
    }
  }
};
DI float gelu_tanh(float x) { return 0.5f * x * (1.0f + tanhf(0.7978845608028654f * (x + 0.044715f * x * x * x))); }
struct ALCmp2P {
  const float* P;
  DI u32x4 operator()(int mt, int ml, int k) const {
    const int m = mt * 128 + ml;
    if (m >= 4088) return (u32x4){0, 0, 0, 0};
    f32x4 a = {0.f, 0.f, 0.f, 0.f}, b = {0.f, 0.f, 0.f, 0.f};
#pragma unroll
    for (int s4 = 0; s4 < 4; ++s4) {
      const float* q = P + ((size_t)s4 * 4096 + m) * 256 + k;
      a += *(const f32x4*)q; b += *(const f32x4*)(q + 4);
    }
    u32x4 o;
    o.x = pack2(gelu_tanh(a.x), gelu_tanh(a.y)); o.y = pack2(gelu_tanh(a.z), gelu_tanh(a.w));
    o.z = pack2(gelu_tanh(b.x), gelu_tanh(b.y)); o.w = pack2(gelu_tanh(b.z), gelu_tanh(b.w));
    return o;
  }
};

struct EpiCmp1 {
  bf16_t* hid;
  DI void operator()(f32x16 (&acc)[2][2], int mt, int nt, int wr, int wc, int lane, char*) const {
    const int r = lane & 31, h = lane >> 5;
#pragma unroll
    for (int ms = 0; ms < 2; ++ms) {
      const int m = mt * 128 + 64 * wr + 32 * ms + r;
      if (m >= 4088) continue;
#pragma unroll
      for (int ns = 0; ns < 2; ++ns) {
        float g[16];
#pragma unroll
        for (int i = 0; i < 16; ++i) { const float x = acc[ms][ns][i]; g[i] = 0.5f * x * (1.0f + tanhf(0.7978845608028654f * (x + 0.044715f * x * x * x))); }
#pragma unroll
        for (int q = 0; q < 4; ++q) store_bf4(hid + (size_t)m * 256 + nt * 128 + 64 * wc + 32 * ns + 8 * q + 4 * h, g[4 * q], g[4 * q + 1], g[4 * q + 2], g[4 * q + 3]);
      }
    }
  }
};

struct EpiCmp2 {
  const Params& p; int sel;
  DI void operator()(f32x16 (&acc)[2][2], int mt, int nt, int wr, int wc, int lane, char*) const {
    if (wc != 0) return;
    const int r = lane & 31, h = lane >> 5;
#pragma unroll
    for (int ms = 0; ms < 2; ++ms) {
      const int m = mt * 128 + 64 * wr + 32 * ms + r;
      if (m < 4088) {
        const int bg = m / 511, n = m - bg * 511, b = bg >> 1;
        if (sel == 0) {
          norm_store<true>(acc[ms], 1.0f, p.kc_gain, p.pos[b * T_ + 16 * n + 31], p.kcb + ((size_t)bg * 512 + n) * 64, h);
        } else {
          bf16_t* dst = p.vcT + ((size_t)(bg * 8 + (n >> 6))) * 4096 + (n & 63);
#pragma unroll
          for (int ns = 0; ns < 2; ++ns)
#pragma unroll
            for (int i = 0; i < 16; ++i) dst[(32 * ns + crow(i, h)) * 64] = f2bf(acc[ms][ns][i]);
        }
      } else {
      }
    }
  }
};

DI void phase_scan(const Params& p, char* smem) {
  float* sW = (float*)smem;
  const int tid = threadIdx.x, lane = tid & 63, w = tid >> 6;
  for (int seq = blockIdx.x; seq < 64; seq += gridDim.x) {
    const float* src = p.lf + (size_t)seq * T_ + tid * 32;
    float* dst = p.cc + (size_t)seq * T_ + tid * 32;
    f32x4 v[8];
#pragma unroll
    for (int i = 0; i < 8; ++i) v[i] = *(const f32x4*)(src + 4 * i);
    float s = 0.f;
#pragma unroll
    for (int i = 0; i < 8; ++i) { s += v[i].x; s += v[i].y; s += v[i].z; s += v[i].w; }
    float inc = s;
#pragma unroll
    for (int o = 1; o < 64; o <<= 1) { const float u = __shfl_up(inc, o); if (lane >= o) inc += u; }
    __syncthreads();
    if (lane == 63) sW[w] = inc;
    __syncthreads();
    float run = inc - s;
    for (int q = 0; q < w; ++q) run += sW[q];
#pragma unroll
    for (int i = 0; i < 8; ++i) {
      f32x4 o;
      run += v[i].x; o.x = run; run += v[i].y; o.y = run; run += v[i].z; o.z = run; run += v[i].w; o.w = run;
      *(f32x4*)(dst + 4 * i) = o;
    }
  }
}

template <int MODE>
DI void flash_step(f32x16 (&o)[2], float& l, const bf16x8 (&qf)[4], const bf16_t* sK, const bf16_t* sV, const float* sC,
                   int kbase, int tq, float bias0, float inv_l, float* sImpRow, int lane, bool selok = true) {
  const int r = lane & 31, h = lane >> 5;
  constexpr float SC = 0.125f * 1.4426950408889634f;
  const int base_hi = (MODE == 2 || MODE == 3) ? ((tq - 31) >> 4) : tq;
  const float bsel = (MODE == 4 && !selok) ? -1e30f : bias0;
#pragma unroll
  for (int sub = 0; sub < 2; ++sub) {
    f32x16 s;
#pragma unroll
    for (int i = 0; i < 16; ++i) s[i] = 0.f;
#pragma unroll
    for (int ks = 0; ks < 4; ++ks) {
      const bf16x8 a = *(const bf16x8*)(sK + (32 * sub + r) * 72 + 16 * ks + 8 * h);
      s = mfma32(a, qf[ks], s);
    }
    const int hi = base_hi - kbase - 32 * sub - 4 * h;
    const int lo = (MODE == 1) ? hi - 511 : -1000000;
    const bool nomask = __all((hi >= 27) && (lo <= 0));
    if (MODE == 0) {
#pragma unroll
      for (int q = 0; q < 4; ++q) {
        const f32x4 c4 = *(const f32x4*)(sC + 32 * sub + 8 * q + 4 * h);
#pragma unroll
        for (int j = 0; j < 4; ++j) s[4 * q + j] = fmaf(s[4 * q + j], SC, bias0 - c4[j]);
      }
    } else {
#pragma unroll
      for (int i = 0; i < 16; ++i) s[i] = fmaf(s[i], SC, bsel);
    }
    if (!nomask) {
#pragma unroll
      for (int i = 0; i < 16; ++i) { const int cst = (i & 3) + 8 * (i >> 2); s[i] = (cst <= hi && cst >= lo) ? s[i] : -1e30f; }
    }
    float ls = 0.f;
#pragma unroll
    for (int i = 0; i < 16; ++i) { const float pv = __builtin_amdgcn_exp2f(s[i]); s[i] = pv; ls += pv; }
    l += ls;
    if (MODE == 2) continue;
    if (MODE == 3) {
#pragma unroll
      for (int q = 0; q < 4; ++q) {
        const float p3 = s[4 * q + 3] * inv_l;
        float A = (s[4 * q] + s[4 * q + 1] + s[4 * q + 2]) * inv_l + 0.5f * p3, B = 0.5f * p3;
        A += __shfl_xor(A, 1); A += __shfl_xor(A, 2); A += __shfl_xor(A, 4);
        B += __shfl_xor(B, 1); B += __shfl_xor(B, 2); B += __shfl_xor(B, 4);
        if ((r & 7) == 0) { const int j = ((kbase + 32 * sub) >> 2) + 2 * q + h; atomicAdd(&sImpRow[j], A); atomicAdd(&sImpRow[j + 1], B); }
      }
    }
#pragma unroll
    for (int st = 0; st < 2; ++st) {
      u32x4 pk;
      pk.x = pack2(s[8 * st + 0], s[8 * st + 1]); pk.y = pack2(s[8 * st + 2], s[8 * st + 3]);
      pk.z = pack2(s[8 * st + 4], s[8 * st + 5]); pk.w = pack2(s[8 * st + 6], s[8 * st + 7]);
      const bf16x8 pf = __builtin_bit_cast(bf16x8, pk);
#pragma unroll
      for (int d = 0; d < 2; ++d) {
        const bf16_t* vp = sV + (32 * d + r) * 72 + 32 * sub + 16 * st + 4 * h;
        const bf16x4 lo4 = *(const bf16x4*)vp, hi4 = *(const bf16x4*)(vp + 8);
        const bf16x8 vf = __builtin_shufflevector(lo4, hi4, 0, 1, 2, 3, 4, 5, 6, 7);
        o[d] = mfma32(vf, pf, o[d]);
      }
    }
  }
}

DI void tile_load(u32x4 (&kr)[2], u32x4 (&vr)[2], const bf16_t* kptr, int kstride, const bf16_t* vptr, int vstride, bool withV, int tid) {
#pragma unroll
  for (int i = 0; i < 2; ++i) {
    const int c = tid + 256 * i, row = c >> 3, ch = (c & 7) * 8;
    kr[i] = *(const u32x4*)(kptr + (size_t)row * kstride + ch);
    if (withV) vr[i] = *(const u32x4*)(vptr + (size_t)row * vstride + ch);
  }
}
DI void tile_store(const u32x4 (&kr)[2], const u32x4 (&vr)[2], bf16_t* sK, bf16_t* sV, bool withV, int tid) {
#pragma unroll
  for (int i = 0; i < 2; ++i) {
    const int c = tid + 256 * i, row = c >> 3, ch = (c & 7) * 8;
    *(u32x4*)(sK + row * 72 + ch) = kr[i];
    if (withV) *(u32x4*)(sV + row * 72 + ch) = vr[i];
  }
}

template <class LoadF, class StoreF, class BodyF>
DI void dense_loop(int n, LoadF ld, StoreF st, BodyF body) {
  if (n <= 0) return;
  ld(0); st(0);
  if (n > 1) ld(1);
  __syncthreads();
  for (int e = 0; e < n; ++e) {
    const int cur = e & 1;
    if (e + 1 < n) st(cur ^ 1);
    if (e + 2 < n) ld(e + 2);
    body(e, cur);
    __syncthreads();
  }
}

DI void phase_fox(const Params& p, char* smem) {
  bf16_t* sKV = (bf16_t*)smem;
  float* sC = (float*)(sKV + 4 * 64 * 72);
  const int tid = threadIdx.x, lane = tid & 63, w = tid >> 6, r = lane & 31, h = lane >> 5;
  float gq = 0.f, gk = 0.f;
  for (int i = 0; i < 64; ++i) { gq = fmaxf(gq, fabsf(p.a_q_gain[i])); gk = fmaxf(gk, fabsf(p.a_k_gain[i])); }
  const float smax = 8.0f * gq * gk * 1.05f;
  const float thr = 40.0f + 2.0f * smax;
  const float negM2 = -smax * 1.4426950408889634f;
  for (int item = blockIdx.x; item < 4096; item += gridDim.x) {
    const int bh = item & 63, qt = 63 - (item >> 6), b = bh >> 4, head = bh & 15, t0 = qt * 128;
    const int tq = t0 + 32 * w + r;
    const bf16_t* qrow = p.qb + ((size_t)bh * T_ + tq) * 64;
    bf16x8 qf[4];
#pragma unroll
    for (int ks = 0; ks < 4; ++ks) qf[ks] = *(const bf16x8*)(qrow + 16 * ks + 8 * h);
    const float* cseq = p.cc + (size_t)bh * T_;
    const float cq = cseq[tq] * 1.4426950408889634f, c0 = cseq[t0];
    const bf16_t* kbp = p.kb + (size_t)bh * T_ * 64;
    const bf16_t* vbp = p.vT + (size_t)bh * 128 * 4096;
    f32x16 o[2];
#pragma unroll
    for (int d = 0; d < 2; ++d)
#pragma unroll
      for (int i = 0; i < 16; ++i) o[d][i] = 0.f;
    float l = 0.f;
    u32x4 kr[2], vr[2]; f32x4 cr = (f32x4){0.f, 0.f, 0.f, 0.f};
    const int jmax = 2 * qt + 1;
    int jmin = jmax;
    while (jmin > 0 && !(c0 - cseq[64 * (jmin - 1) + 63] < -thr)) --jmin;
    dense_loop(jmax - jmin + 1,
      [&](int e) { const int jt = jmax - e; tile_load(kr, vr, kbp + (size_t)jt * 4096, 64, vbp + (size_t)jt * 4096, 64, true, tid); if (tid < 16) cr = *(const f32x4*)(cseq + 64 * jt + 4 * tid); },
      [&](int bf) { tile_store(kr, vr, sKV + bf * 2 * 64 * 72, sKV + bf * 2 * 64 * 72 + 64 * 72, true, tid); if (tid < 16) *(f32x4*)(sC + bf * 64 + 4 * tid) = cr * 1.4426950408889634f; },
      [&](int e, int cur) {
        const int kbase = 64 * (jmax - e);
        if (kbase <= t0 + 32 * w + 31) flash_step<0>(o, l, qf, sKV + cur * 2 * 64 * 72, sKV + cur * 2 * 64 * 72 + 64 * 72, sC + cur * 64, kbase, tq, cq + negM2, 0.f, nullptr, lane);
      });
    const float lt = l + __shfl_xor(l, 32);
    const float inv = 1.0f / lt;
    bf16_t* orow = p.ob + a_off(b * T_ + tq, head * 64, 16);
#pragma unroll
    for (int d = 0; d < 2; ++d)
#pragma unroll
      for (int q = 0; q < 4; ++q) store_bf4(orow + 32 * d + 8 * q + 4 * h, o[d][4 * q] * inv, o[d][4 * q + 1] * inv, o[d][4 * q + 2] * inv, o[d][4 * q + 3] * inv);
  }
}

DI void phase_nsa(const Params& p, char* smem) {
  bf16_t* sKV = (bf16_t*)smem;
  float* sU = (float*)(sKV + 4 * 64 * 72);
  float* sImp = sU; float* sO = sU;
  unsigned* sMask = (unsigned*)(sU + 128 * 65);
  int* sList = (int*)(sMask + 64);
  const int tid = threadIdx.x, lane = tid & 63, w = tid >> 6, r = lane & 31, h = lane >> 5;
  float gqm = 0.f, gkm = 0.f;
  for (int i = 0; i < 64; ++i) { gqm = fmaxf(gqm, fabsf(p.b_q_gain[i])); gkm = fmaxf(gkm, fmaxf(fabsf(p.kc_gain[i]), fmaxf(fabsf(p.ks_gain[i]), fabsf(p.kw_gain[i])))); }
  const float negM2 = -8.0f * gqm * gkm * 1.05f * 1.4426950408889634f;
  auto stK = [&](int bf) { return sKV + bf * 2 * 64 * 72; };
  for (int item = blockIdx.x; item < 4096; item += gridDim.x) {
    const int bg = item & 7, tt = 511 - (item >> 3), b = bg >> 1, g = bg & 1, t0 = tt * 16;
    const int tokl = 4 * w + (r >> 3), head = r & 7, tq = t0 + tokl;
    __syncthreads();
    for (int i = tid; i < 16 * 132; i += 256) sImp[i] = 0.f;
    bf16x8 qf[4];
    {
      const bf16_t* qrow = p.qn + ((size_t)b * T_ + tq) * 1024 + (g * 8 + head) * 64;
#pragma unroll
      for (int ks = 0; ks < 4; ++ks) qf[ks] = *(const bf16x8*)(qrow + 16 * ks + 8 * h);
    }
    const float* grow = p.gates + ((size_t)b * T_ + tq) * 48 + g * 8 + head;
    const float gate_c = grow[0], gate_w = grow[32];
    f32x16 o[2];
    float l = 0.f;
    u32x4 kr[2], vr[2];
    const int ncmp = t0 >> 4, nct = (ncmp + 63) >> 6;
    const bf16_t* kcp = p.kcb + (size_t)bg * 512 * 64;
    const bf16_t* vcp = p.vcT + (size_t)bg * 8 * 4096;
    dense_loop(nct,
      [&](int e) { tile_load(kr, vr, kcp + (size_t)e * 4096, 64, vcp, 64, false, tid); },
      [&](int bf) { tile_store(kr, vr, stK(bf), stK(bf) + 64 * 72, false, tid); },
      [&](int e, int cur) { flash_step<2>(o, l, qf, stK(cur), stK(cur) + 64 * 72, nullptr, 64 * e, tq, negM2, 0.f, nullptr, lane); });
    const float lc = l + __shfl_xor(l, 32);
    const float inv_lc = lc > 0.f ? 1.0f / lc : 0.f;
#pragma unroll
    for (int d = 0; d < 2; ++d)
#pragma unroll
      for (int i = 0; i < 16; ++i) o[d][i] = 0.f;
    float l2 = 0.f;
    dense_loop(nct,
      [&](int e) { tile_load(kr, vr, kcp + (size_t)e * 4096, 64, vcp + (size_t)e * 4096, 64, true, tid); },
      [&](int bf) { tile_store(kr, vr, stK(bf), stK(bf) + 64 * 72, true, tid); },
      [&](int e, int cur) { flash_step<3>(o, l2, qf, stK(cur), stK(cur) + 64 * 72, nullptr, 64 * e, tq, negM2, inv_lc, sImp + tokl * 132, lane); });
    __syncthreads();
    const int cur_blk = t0 >> 6;
    for (int tk = 0; tk < 4; ++tk) {
      const int tok = 4 * w + tk;
      float* sc = sImp + tok * 132;
      for (int j = lane; j <= cur_blk; j += 64) if (j == 0 || j == cur_blk || j == cur_blk - 1) sc[j] = 1e6f;
    }
    __syncthreads();
    for (int tk = 0; tk < 4; ++tk) {
      const int tok = 4 * w + tk;
      const float* sc = sImp + tok * 132;
      const bool v0 = lane <= cur_blk, v1 = lane + 64 <= cur_blk;
      const float s0 = v0 ? sc[lane] : -1e30f, s1 = v1 ? sc[lane + 64] : -1e30f;
      int r0 = 0, r1 = 0;
      const int n0 = cur_blk < 63 ? cur_blk + 1 : 64;
      for (int i = 0; i < n0; ++i) {
        const float si = __builtin_bit_cast(float, __builtin_amdgcn_readlane(__builtin_bit_cast(int, s0), i));
        r0 += ((si > s0) || (si == s0 && i < lane)) ? 1 : 0;
        r1 += (si >= s1) ? 1 : 0;
      }
      for (int i = 64; i <= cur_blk; ++i) {
        const float si = __builtin_bit_cast(float, __builtin_amdgcn_readlane(__builtin_bit_cast(int, s1), i - 64));
        r0 += (si > s0) ? 1 : 0;
        r1 += ((si > s1) || (si == s1 && i - 64 < lane)) ? 1 : 0;
      }
      const unsigned long long mk0 = __ballot(v0 && r0 < 16), mk1 = __ballot(v1 && r1 < 16);
      if (lane == 0) {
        sMask[tok * 4 + 0] = (unsigned)mk0; sMask[tok * 4 + 1] = (unsigned)(mk0 >> 32);
        sMask[tok * 4 + 2] = (unsigned)mk1; sMask[tok * 4 + 3] = (unsigned)(mk1 >> 32);
      }
    }
    __syncthreads();
    int n_un;
    {
      unsigned u0 = 0, u1 = 0, u2 = 0, u3 = 0;
      for (int tok = 0; tok < 16; ++tok) { u0 |= sMask[tok * 4]; u1 |= sMask[tok * 4 + 1]; u2 |= sMask[tok * 4 + 2]; u3 |= sMask[tok * 4 + 3]; }
      const int c0 = __popc(u0), c1 = __popc(u1), c2 = __popc(u2), c3 = __popc(u3);
      n_un = c0 + c1 + c2 + c3;
      if (tid < 128) {
        const int wd = tid >> 5, bit = tid & 31;
        const unsigned uw = wd == 0 ? u0 : wd == 1 ? u1 : wd == 2 ? u2 : u3;
        if ((uw >> bit) & 1u) {
          const int pre = (wd > 0 ? c0 : 0) + (wd > 1 ? c1 : 0) + (wd > 2 ? c2 : 0);
          sList[pre + __popc(uw & ((1u << bit) - 1u))] = tid;
        }
      }
    }
    __syncthreads();
    {
      const float sc = gate_c * inv_lc;
      float* orow = sO + (32 * w + r) * 65;
#pragma unroll
      for (int d = 0; d < 2; ++d)
#pragma unroll
        for (int i = 0; i < 16; ++i) orow[32 * d + crow(i, h)] = o[d][i] * sc;
    }
#pragma unroll
    for (int d = 0; d < 2; ++d)
#pragma unroll
      for (int i = 0; i < 16; ++i) o[d][i] = 0.f;
    l = 0.f;
    {
      const bf16_t* ksp = p.ksb + (size_t)bg * T_ * 64;
      const bf16_t* vsp = p.vsT + (size_t)bg * 128 * 4096;
      dense_loop(n_un,
        [&](int e) { const int blk = sList[e]; tile_load(kr, vr, ksp + (size_t)blk * 4096, 64, vsp + (size_t)blk * 4096, 64, true, tid); },
        [&](int bf) { tile_store(kr, vr, stK(bf), stK(bf) + 64 * 72, true, tid); },
        [&](int e, int cur) {
          const int blk = sList[e];
          const int wd = blk >> 5, bit = blk & 31;
          const unsigned wm = sMask[(4 * w) * 4 + wd] | sMask[(4 * w + 1) * 4 + wd] | sMask[(4 * w + 2) * 4 + wd] | sMask[(4 * w + 3) * 4 + wd];
          if ((wm >> bit) & 1u) {
            const bool selok = (sMask[tokl * 4 + wd] >> bit) & 1u;
            flash_step<4>(o, l, qf, stK(cur), stK(cur) + 64 * 72, nullptr, 64 * blk, tq, negM2, 0.f, nullptr, lane, selok);
          }
        });
      const float lt = l + __shfl_xor(l, 32);
      const float sc = grow[16] / lt;
      float* orow = sO + (32 * w + r) * 65;
#pragma unroll
      for (int d = 0; d < 2; ++d)
#pragma unroll
        for (int i = 0; i < 16; ++i) orow[32 * d + crow(i, h)] += o[d][i] * sc;
    }
#pragma unroll
    for (int d = 0; d < 2; ++d)
#pragma unroll
      for (int i = 0; i < 16; ++i) o[d][i] = 0.f;
    l = 0.f;
    {
      const int klo = t0 - 511 > 0 ? t0 - 511 : 0, jt0 = klo >> 6, jt1 = (t0 + 15) >> 6;
      const bf16_t* kwp = p.kwb + (size_t)bg * T_ * 64;
      const bf16_t* vwp = p.vwT + (size_t)bg * 128 * 4096;
      dense_loop(jt1 - jt0 + 1,
        [&](int e) { tile_load(kr, vr, kwp + (size_t)(jt0 + e) * 4096, 64, vwp + (size_t)(jt0 + e) * 4096, 64, true, tid); },
        [&](int bf) { tile_store(kr, vr, stK(bf), stK(bf) + 64 * 72, true, tid); },
        [&](int e, int cur) { flash_step<1>(o, l, qf, stK(cur), stK(cur) + 64 * 72, nullptr, 64 * (jt0 + e), tq, negM2, 0.f, nullptr, lane); });
      const float lt = l + __shfl_xor(l, 32);
      const float sc = gate_w / lt;
      float* orow = sO + (32 * w + r) * 65;
#pragma unroll
      for (int d = 0; d < 2; ++d)
#pragma unroll
        for (int i = 0; i < 16; ++i) orow[32 * d + crow(i, h)] += o[d][i] * sc;
    }
    __syncthreads();
    for (int c = tid; c < 128 * 16; c += 256) {
      const int row = c >> 4, d4 = (c & 15) * 4, tok = row >> 3, hd = row & 7;
      const float* s = sO + row * 65 + d4;
      store_bf4(p.ob + a_off(b * T_ + t0 + tok, (g * 8 + hd) * 64 + d4, 16), s[0], s[1], s[2], s[3]);
    }
  }
}


#define XB_TMO      128
#define XB_XCNT(j)  (256  + 64 * (j))
#define XB_XSUB(j)  (1280 + 64 * (j))
#define XB_XGEN(j)  (2304 + 64 * (j))
#define XB_TOP      3328
#define XB_TOPGEN   3392
#define XCD_BAR_WORDS 3456
#define XB_SPIN_CAP (1u << 18)
#define LAS __attribute__((address_space(3)))
DI unsigned xb_ld(unsigned* p) { return __hip_atomic_load(p, __ATOMIC_RELAXED, __HIP_MEMORY_SCOPE_AGENT); }
DI unsigned xb_add(unsigned* p, unsigned v) { return __hip_atomic_fetch_add(p, v, __ATOMIC_RELAXED, __HIP_MEMORY_SCOPE_AGENT); }
DI unsigned xb_xcc_id() { return (unsigned)__builtin_amdgcn_s_getreg((3 << 11) | 20) & 0xFu; }
#define XB_SPIN(cond, bar) do { unsigned _sp = 0; while (cond) { __builtin_amdgcn_s_sleep(1); \
    if ((++_sp & 255u) == 0u) { if (xb_ld(&(bar)[XB_TMO])) break; if (_sp > XB_SPIN_CAP) { atomicAdd(&(bar)[XB_TMO], 1u); break; } } } } while (0)
struct XcdBarrier { unsigned* bar; unsigned x; volatile LAS unsigned* st; };
DI XcdBarrier xcd_barrier_post(unsigned* bar, volatile LAS unsigned* st) {
  XcdBarrier b; b.bar = bar; b.x = xb_xcc_id(); b.st = st;
  if (threadIdx.x == 0) (void)xb_add(&bar[XB_XCNT(b.x)], 1u);
  return b;
}
DI void xcd_barrier_complete(unsigned* bar, unsigned x, unsigned& nloc, unsigned& nx) {
  const unsigned G = gridDim.x * gridDim.y * gridDim.z;
  unsigned sum, cnt, mine, sp = 0u;
  for (;;) {
    sum = 0u; cnt = 0u; mine = 0u;
#pragma unroll
    for (unsigned j = 0; j < 16; ++j) { const unsigned c = xb_ld(&bar[XB_XCNT(j)]); sum += c; cnt += (c > 0u) ? 1u : 0u; mine = (j == x) ? c : mine; }
    if (sum == G) break;
    __builtin_amdgcn_s_sleep(1);
    if ((++sp & 255u) == 0u) { if (xb_ld(&bar[XB_TMO])) break; if (sp > XB_SPIN_CAP) { atomicAdd(&bar[XB_TMO], 1u); break; } }
  }
  nloc = mine > 0u ? mine : 1u; nx = cnt > 0u ? cnt : 1u;
}
DI void xcd_barrier(const XcdBarrier& b) {
  asm volatile("s_waitcnt vmcnt(0)" ::: "memory");
  __syncthreads();
  if (threadIdx.x == 0) {
    unsigned* bar = b.bar;
    __builtin_amdgcn_s_waitcnt(0);
    unsigned nloc = b.st[0], nx = b.st[1];
    if (nloc == 0u) { xcd_barrier_complete(bar, b.x, nloc, nx); b.st[0] = nloc; b.st[1] = nx; }
    const unsigned old = xb_add(&bar[XB_XSUB(b.x)], 1u);
    const unsigned gen = old / nloc;
    if (old + 1u == (gen + 1u) * nloc) {
      __builtin_amdgcn_fence(__ATOMIC_RELEASE, "agent");
      asm volatile("s_waitcnt vmcnt(0)" ::: "memory");
      const unsigned og = xb_add(&bar[XB_TOP], 1u);
      const unsigned tg = og / nx;
      if (og + 1u == (tg + 1u) * nx) xb_add(&bar[XB_TOPGEN], 1u);
      else XB_SPIN(xb_ld(&bar[XB_TOPGEN]) == tg, bar);
      __builtin_amdgcn_fence(__ATOMIC_ACQUIRE, "agent");
      xb_add(&bar[XB_XGEN(b.x)], 1u);
      asm volatile("s_waitcnt vmcnt(0)" ::: "memory");
    } else {
      XB_SPIN(xb_ld(&bar[XB_XGEN(b.x)]) == gen, bar);
      __builtin_amdgcn_fence(__ATOMIC_ACQUIRE, "agent");
      asm volatile("s_waitcnt vmcnt(0)" ::: "memory");
    }
  }
  __syncthreads();
}

#ifdef ONLY_PHASE
#define PH_ON(n) ((n) == ONLY_PHASE)
#else
#define PH_ON(n) true
#endif
#define REP_PHASE -1
#define PHASE(n, ...) \
  if (PH_ON(n) && ph_lo <= (n) && (n) < ph_hi) { __VA_ARGS__ } \
  if ((n) == REP_PHASE) { cg::this_grid().sync(); { __VA_ARGS__ } } \
  if (ph_lo <= (n) && (n) + 1 < ph_hi) { if (ph_hi > 1000) cg::this_grid().sync(); else xcd_barrier(xb); }

__global__ void __launch_bounds__(256, 2) yoco_megakernel(KArgs ka, int ph_lo, int ph_hi) {
  __shared__ __attribute__((aligned(16))) char smem[SMEM_BYTES];
  Params p;
  fill_params(p, ka);
  __shared__ __attribute__((aligned(16))) unsigned xb_words[4];
  if (threadIdx.x < 4) xb_words[threadIdx.x] = 0u;
  __syncthreads();
  const XcdBarrier xb = xcd_barrier_post(p.bar, (volatile LAS unsigned*)xb_words);
  PHASE(0, phase_prep(p, smem);)
  PHASE(1, { ALPlain al{p.hb, 16}; EpiFoxIn ep{p}; gemm_phase(al, p.w_ain, 1024, 256, 25, ep, smem); })
  PHASE(2, phase_scan(p, smem);)
  PHASE(3, phase_fox(p, smem);)
  PHASE(4, { ALPlain al{p.ob, 16}; EpiResid<0> ep{p.x, p.out, p.hb, p.part}; gemm_phase(al, p.w_aout, 1024, 256, 8, ep, smem); })
  PHASE(5, { ALFfn al{p.hb}; EpiFfnUp ep{p.part, p.f_conv_w, p.f_conv_b, p.act}; gemm_phase(al, p.w_up0, 1024, 264, 44, ep, smem); })
  PHASE(6, { ALPlain al{p.act, 44}; EpiResid<1> ep{p.out, p.out, p.hb, p.part}; gemm_phase(al, p.w_dn0, FF, 256, 8, ep, smem); })
  PHASE(7, {
    ALPlain al{p.hb, 16};
    { EpiKv ep{p}; gemm_phase(al, p.w_kv, 1024, 256, 6, ep, smem); }
    { EpiBIn ep{p}; gemm_phase(al, p.w_bin, 1024, 256, 9, ep, smem); }
  })
  PHASE(8, {
    for (int item = blockIdx.x; item < 512; item += gridDim.x) {
      const int sel = item & 1, ks4 = (item >> 1) & 3, nt = (item >> 3) & 1, mt = item >> 4;
      ALCmp1 al{p.rawc + (size_t)sel * 8 * T_ * 64, sel ? p.vc_pe : p.kc_pe};
      EpiCmp1P ep{p.hidp + (size_t)(sel * 4 + ks4) * 4096 * 256};
      gemm_tile(al, sel ? p.w_vc1 : p.w_kc1, 2048, mt, nt, ep, smem, ks4 * 8, 8);
    }
  })
  PHASE(9, {
    for (int item = blockIdx.x; item < 64; item += gridDim.x) {
      const int sel = item & 1, mt = item >> 1;
      ALCmp2P al{p.hidp + (size_t)sel * 4 * 4096 * 256};
      EpiCmp2 ep{p, sel};
      gemm_tile(al, sel ? p.w_vc2 : p.w_kc2, 256, mt, 0, ep, smem);
    }
  })
  PHASE(10, phase_nsa(p, smem);)
  PHASE(11, { ALPlain al{p.ob, 16}; EpiResid<1> ep{p.out, p.out, p.hb, p.part}; gemm_phase(al, p.w_bout, 1024, 256, 8, ep, smem); })
  PHASE(12, { ALFfn al{p.hb}; EpiFfnUp ep{p.part, p.f_conv_w + 3 * 5632, p.f_conv_b + 5632, p.act}; gemm_phase(al, p.w_up1, 1024, 264, 44, ep, smem); })
  PHASE(13, { ALPlain al{p.act, 44}; EpiResid<2> ep{p.out, p.out, p.hb, p.part}; gemm_phase(al, p.w_dn1, FF, 256, 8, ep, smem); })
}

extern "C" void kernel_launch(void* const* d_in, const int* in_sizes, int n_in, void* d_out, int out_size, void* d_ws, size_t ws_size, hipStream_t stream) {
  KArgs p{};
  for (int i = 0; i < 29; ++i) p.in[i] = d_in[i];
  p.out = (float*)d_out; p.ws = (char*)d_ws;
  hipMemsetAsync(d_ws, 0, 16384, stream);
  static int grid_blocks = 0;
  if (!grid_blocks) {
    int dev = 0, cus = 0, per_cu = 0;
    hipGetDevice(&dev);
    hipDeviceGetAttribute(&cus, hipDeviceAttributeMultiprocessorCount, dev);
    hipOccupancyMaxActiveBlocksPerMultiprocessor(&per_cu, yoco_megakernel, 256, 0);
    if (per_cu > 2) per_cu = 2;
    if (per_cu < 1) per_cu = 1;
    grid_blocks = cus * per_cu;
    grid_blocks &= ~7;
  }
#if N_LAUNCH_SPLIT
  for (int ph = 0; ph < NPHASE; ++ph) {
    int lo = ph, hi = ph + 1;
    hipLaunchKernelGGL(yoco_megakernel, dim3(grid_blocks), dim3(256), 0, stream, p, lo, hi);
  }
#else
  int lo = 0, hi = NPHASE;
  void* args[] = {&p, &lo, &hi};
  hipError_t e = hipLaunchCooperativeKernel((void*)yoco_megakernel, dim3(grid_blocks), dim3(256), args, 0, stream);
  if (e != hipSuccess) fprintf(stderr, "cooperative launch failed: %s (grid %d)\n", hipGetErrorString(e), grid_blocks);
#endif
}
```

```cpp
#include <hip/hip_runtime.h>
#include <hip/hip_cooperative_groups.h>
#include <stdint.h>
#include <cstdio>
namespace cg = cooperative_groups;

#ifndef N_LAUNCH_SPLIT
#define N_LAUNCH_SPLIT 0
#endif

#define DI __device__ __forceinline__
typedef unsigned short bf16_t;
typedef short bf16x8 __attribute__((ext_vector_type(8)));
typedef short bf16x4 __attribute__((ext_vector_type(4)));
typedef float f32x16 __attribute__((ext_vector_type(16)));
typedef float f32x4 __attribute__((ext_vector_type(4)));
typedef unsigned u32x4 __attribute__((ext_vector_type(4)));
typedef unsigned u32x2 __attribute__((ext_vector_type(2)));

constexpr int T_ = 8192;
constexpr int NTOK = 32768;
constexpr int FF = 2816;
constexpr int NPHASE = 14;
constexpr int SMEM_BYTES = 73728;

struct Params {
  const float* x; const int* pos;
  const float *a_norm, *a_w_in, *a_b_f, *a_q_gain, *a_k_gain, *a_w_out;
  const float *kv_norm, *kv_w, *kc_pe, *vc_pe, *kc_w1, *kc_w2, *vc_w1, *vc_w2, *kc_gain, *ks_gain, *kw_gain;
  const float *b_norm, *b_w_in, *b_b_gate, *b_q_gain, *b_w_out;
  const float *f_norm, *f_w_up, *f_conv_w, *f_conv_b, *f_w_down;
  float* out;
  bf16_t *w_ain, *w_aout, *w_kv, *w_kc1, *w_vc1, *w_kc2, *w_vc2, *w_bin, *w_bout, *w_up0, *w_up1, *w_dn0, *w_dn1;
  bf16_t* hb; float* part; float* lf; float* cc; bf16_t* ob;
  bf16_t *qb, *kb, *vT; bf16_t* act;
  bf16_t *rawc, *ksb, *vsT, *kwb, *vwT, *qn; float* gates; bf16_t *hid, *kcb, *vcT; float* hidp; unsigned* bar;
};

typedef __bf16 bf16v2 __attribute__((ext_vector_type(2)));
typedef float f32x2 __attribute__((ext_vector_type(2)));
struct KArgs { const void* in[29]; float* out; char* ws; };
DI void fill_params(Params& p, const KArgs& ka) {
  p.x = (const float*)ka.in[0]; p.pos = (const int*)ka.in[1];
  p.a_norm = (const float*)ka.in[2]; p.a_w_in = (const float*)ka.in[3]; p.a_b_f = (const float*)ka.in[4]; p.a_q_gain = (const float*)ka.in[5];
  p.a_k_gain = (const float*)ka.in[6]; p.a_w_out = (const float*)ka.in[7]; p.kv_norm = (const float*)ka.in[8]; p.kv_w = (const float*)ka.in[9];
  p.kc_pe = (const float*)ka.in[10]; p.vc_pe = (const float*)ka.in[11]; p.kc_w1 = (const float*)ka.in[12]; p.kc_w2 = (const float*)ka.in[13];
  p.vc_w1 = (const float*)ka.in[14]; p.vc_w2 = (const float*)ka.in[15]; p.kc_gain = (const float*)ka.in[16]; p.ks_gain = (const float*)ka.in[17];
  p.kw_gain = (const float*)ka.in[18]; p.b_norm = (const float*)ka.in[19]; p.b_w_in = (const float*)ka.in[20]; p.b_b_gate = (const float*)ka.in[21];
  p.b_q_gain = (const float*)ka.in[22]; p.b_w_out = (const float*)ka.in[23]; p.f_norm = (const float*)ka.in[24]; p.f_w_up = (const float*)ka.in[25];
  p.f_conv_w = (const float*)ka.in[26]; p.f_conv_b = (const float*)ka.in[27]; p.f_w_down = (const float*)ka.in[28];
  p.out = ka.out;
  char* wsq = ka.ws;
#define TAKE(bytes) (wsq += (((size_t)(bytes)) + 255) & ~(size_t)255, wsq - ((((size_t)(bytes)) + 255) & ~(size_t)255))
  p.bar = (unsigned*)TAKE(16384);
  p.w_ain = (bf16_t*)TAKE((size_t)3200 * 1024 * 2); p.w_aout = (bf16_t*)TAKE((size_t)1024 * 1024 * 2); p.w_kv = (bf16_t*)TAKE((size_t)768 * 1024 * 2);
  p.w_kc1 = (bf16_t*)TAKE((size_t)256 * 2048 * 2); p.w_vc1 = (bf16_t*)TAKE((size_t)256 * 2048 * 2);
  p.w_kc2 = (bf16_t*)TAKE((size_t)128 * 256 * 2); p.w_vc2 = (bf16_t*)TAKE((size_t)128 * 256 * 2);
  p.w_bin = (bf16_t*)TAKE((size_t)1152 * 1024 * 2); p.w_bout = (bf16_t*)TAKE((size_t)1024 * 1024 * 2);
  p.w_up0 = (bf16_t*)TAKE((size_t)5632 * 1024 * 2); p.w_up1 = (bf16_t*)TAKE((size_t)5632 * 1024 * 2);
  p.w_dn0 = (bf16_t*)TAKE((size_t)1024 * FF * 2); p.w_dn1 = (bf16_t*)TAKE((size_t)1024 * FF * 2);
  p.hb = (bf16_t*)TAKE((size_t)NTOK * 1024 * 2); p.part = (float*)TAKE((size_t)NTOK * 16 * 4);
  p.lf = (float*)TAKE((size_t)64 * T_ * 4); p.cc = (float*)TAKE((size_t)64 * T_ * 4);
  p.ob = (bf16_t*)TAKE((size_t)NTOK * 1024 * 2);
  char* R = TAKE((size_t)NTOK * 1024 * 2 * 3);
#undef TAKE
  p.qb = (bf16_t*)R; p.kb = p.qb + (size_t)NTOK * 1024; p.vT = p.kb + (size_t)NTOK * 1024;
  p.act = (bf16_t*)R;
  {
    char* q = R;
    p.qn = (bf16_t*)q; q += (size_t)NTOK * 1024 * 2;
    p.rawc = (bf16_t*)q; q += (size_t)2 * 8 * T_ * 64 * 2;
    p.ksb = (bf16_t*)q; q += (size_t)8 * T_ * 64 * 2;
    p.vsT = (bf16_t*)q; q += (size_t)8 * T_ * 64 * 2;
    p.kwb = (bf16_t*)q; q += (size_t)8 * T_ * 64 * 2;
    p.vwT = (bf16_t*)q; q += (size_t)8 * T_ * 64 * 2;
    p.gates = (float*)q; q += (size_t)NTOK * 48 * 4;
    p.hid = (bf16_t*)q; q += (size_t)2 * 4096 * 256 * 2;
    p.kcb = (bf16_t*)q; q += (size_t)8 * 512 * 64 * 2;
    p.vcT = (bf16_t*)q; q += (size_t)8 * 64 * 512 * 2;
    p.hidp = (float*)q; q += (size_t)2 * 4 * 4096 * 256 * 4;
  }
}

DI bf16_t f2bf(float x) { return __builtin_bit_cast(bf16_t, (__bf16)x); }
DI unsigned pack2(float a, float b) { f32x2 v = {a, b}; return __builtin_bit_cast(unsigned, __builtin_convertvector(v, bf16v2)); }
DI float bf2f(bf16_t v) { return __uint_as_float(((unsigned)v) << 16); }
DI int crow(int i, int h) { return (i & 3) + 8 * (i >> 2) + 4 * h; }
DI f32x16 mfma32(bf16x8 a, bf16x8 b, f32x16 c) { return __builtin_amdgcn_mfma_f32_32x32x16_bf16(a, b, c, 0, 0, 0); }
DI f32x4 mfma16(bf16x8 a, bf16x8 b, f32x4 c) { return __builtin_amdgcn_mfma_f32_16x16x32_bf16(a, b, c, 0, 0, 0); }
DI float row_rstd(const float* part, int row) {
  const f32x4* q = (const f32x4*)(part + (size_t)row * 16);
  f32x4 a = q[0], b = q[1], c = q[2], d = q[3];
  float s = ((a.x + a.y) + (a.z + a.w)) + ((b.x + b.y) + (b.z + b.w)) + ((c.x + c.y) + (c.z + c.w)) + ((d.x + d.y) + (d.z + d.w));
  return rsqrtf(s * (1.0f / 1024.0f) + 1e-6f);
}
DI size_t a_off(int row, int k, int KB) { return (((size_t)((row >> 7) * KB + (k >> 6))) << 13) + ((row & 127) << 6) + (k & 63); }
DI void store_bf4(bf16_t* dst, float a, float b, float c, float d) { u32x2 v; v.x = pack2(a, b); v.y = pack2(c, d); *(u32x2*)dst = v; }

struct WJob { const float* src; bf16_t* dst; const float* gain; int K, Nsrc, Ndst, mode; };
DI WJob get_job(const Params& p, int j) {
  WJob w; w.gain = nullptr; w.mode = 0;
  switch (j) {
    case 0: w.src = p.a_w_in; w.dst = p.w_ain; w.gain = p.a_norm; w.K = 1024; w.Nsrc = 3088; w.Ndst = 3200; break;
    case 1: w.src = p.a_w_out; w.dst = p.w_aout; w.K = 1024; w.Nsrc = 1024; w.Ndst = 1024; break;
    case 2: w.src = p.kv_w; w.dst = p.w_kv; w.gain = p.kv_norm; w.K = 1024; w.Nsrc = 768; w.Ndst = 768; break;
    case 3: w.src = p.kc_w1; w.dst = p.w_kc1; w.K = 2048; w.Nsrc = 256; w.Ndst = 256; break;
    case 4: w.src = p.vc_w1; w.dst = p.w_vc1; w.K = 2048; w.Nsrc = 256; w.Ndst = 256; break;
    case 5: w.src = p.kc_w2; w.dst = p.w_kc2; w.K = 256; w.Nsrc = 64; w.Ndst = 128; break;
    case 6: w.src = p.vc_w2; w.dst = p.w_vc2; w.K = 256; w.Nsrc = 64; w.Ndst = 128; break;
    case 7: w.src = p.b_w_in; w.dst = p.w_bin; w.gain = p.b_norm; w.K = 1024; w.Nsrc = 1072; w.Ndst = 1152; break;
    case 8: w.src = p.b_w_out; w.dst = p.w_bout; w.K = 1024; w.Nsrc = 1024; w.Ndst = 1024; break;
    case 9: w.src = p.f_w_up; w.dst = p.w_up0; w.gain = p.f_norm; w.K = 1024; w.Nsrc = 5632; w.Ndst = 5632; w.mode = 1; break;
    case 10: w.src = p.f_w_up + (size_t)1024 * 5632; w.dst = p.w_up1; w.gain = p.f_norm + 1024; w.K = 1024; w.Nsrc = 5632; w.Ndst = 5632; w.mode = 1; break;
    case 11: w.src = p.f_w_down; w.dst = p.w_dn0; w.K = 2816; w.Nsrc = 1024; w.Ndst = 1024; break;
    default: w.src = p.f_w_down + (size_t)2816 * 1024; w.dst = p.w_dn1; w.K = 2816; w.Nsrc = 1024; w.Ndst = 1024; break;
  }
  return w;
}

DI void prep_load(const WJob& w, int t, int nkt, int tid, f32x4 (&v)[4], int& k0, int& n0d) {
  const int kt = t % nkt, nt = t / nkt;
  k0 = kt << 6; n0d = nt << 6;
  int sbase = n0d;
  if (w.mode == 1) { const int tile = n0d >> 7, half = (n0d >> 6) & 1; sbase = half * FF + tile * 64; }
#pragma unroll
  for (int i = 0; i < 4; ++i) {
    const int kk = (tid >> 4) + 16 * i, col = sbase + (tid & 15) * 4;
    v[i] = (f32x4){0.f, 0.f, 0.f, 0.f};
    if (col < w.Nsrc) v[i] = *(const f32x4*)(w.src + (size_t)(k0 + kk) * w.Nsrc + col);
    const float g = w.gain ? w.gain[k0 + kk] : 1.0f;
    v[i] *= g;
  }
}
DI void prep_lds(float* sT, const f32x4 (&v)[4], int tid) {
#pragma unroll
  for (int i = 0; i < 4; ++i) {
    const int kk = (tid >> 4) + 16 * i, nn = (tid & 15) * 4;
    sT[kk * 65 + nn + 0] = v[i].x; sT[kk * 65 + nn + 1] = v[i].y; sT[kk * 65 + nn + 2] = v[i].z; sT[kk * 65 + nn + 3] = v[i].w;
  }
}
DI void prep_out(const float* sT, const WJob& w, int k0, int n0d, int nkt, int tid) {
  const int n = tid >> 2, kseg = (tid & 3) * 16;
  unsigned o[8];
#pragma unroll
  for (int q = 0; q < 8; ++q) o[q] = pack2(sT[(kseg + 2 * q) * 65 + n], sT[(kseg + 2 * q + 1) * 65 + n]);
  u32x4* dst = (u32x4*)(w.dst + a_off(n0d + n, k0 + kseg, nkt));
  dst[0] = (u32x4){o[0], o[1], o[2], o[3]}; dst[1] = (u32x4){o[4], o[5], o[6], o[7]};
}

DI void phase_prep(const Params& p, char* smem) {
  float* sT0 = (float*)smem;
  float* sT1 = sT0 + 64 * 65;
  const int tid = threadIdx.x;
  {
    const int lane = tid & 63, gw = blockIdx.x * 4 + (tid >> 6), nw = gridDim.x * 4;
    for (int row0 = gw * 4; row0 < NTOK; row0 += nw * 4) {
      f32x4 v[4][4];
#pragma unroll
      for (int rr = 0; rr < 4; ++rr)
#pragma unroll
        for (int i = 0; i < 4; ++i) v[rr][i] = *(const f32x4*)(p.x + (size_t)(row0 + rr) * 1024 + i * 256 + lane * 4);
#pragma unroll
      for (int rr = 0; rr < 4; ++rr) {
        const int row = row0 + rr;
        float ss = 0.f;
#pragma unroll
        for (int i = 0; i < 4; ++i) {
          const f32x4 x = v[rr][i];
          ss += x.x * x.x + x.y * x.y + x.z * x.z + x.w * x.w;
          store_bf4(p.hb + a_off(row, i * 256 + lane * 4, 16), x.x, x.y, x.z, x.w);
        }
#pragma unroll
        for (int o = 32; o >= 1; o >>= 1) ss += __shfl_xor(ss, o);
        if (lane < 16) p.part[(size_t)row * 16 + lane] = lane == 0 ? ss : 0.f;
      }
    }
  }
  {
    int tstart[14];
    tstart[0] = 0;
#pragma unroll
    for (int j = 0; j < 13; ++j) { const WJob w = get_job(p, j); tstart[j + 1] = tstart[j] + (w.K >> 6) * (w.Ndst >> 6); }
    const int total = tstart[13], G = gridDim.x;
    auto find_job = [&](int g) { int j = 0;
#pragma unroll
      for (int q = 1; q < 13; ++q) j += (g >= tstart[q]) ? 1 : 0;
      return j; };
    auto job_base = [&](int j) { int r = 0;
#pragma unroll
      for (int q = 0; q < 13; ++q) r = (q == j) ? tstart[q] : r;
      return r; };
    f32x4 va[4], vb[4]; int k0a = 0, n0a = 0, k0b = 0, n0b = 0, ja = 0, jb = 0;
    int g = blockIdx.x;
    if (g < total) { ja = find_job(g); const WJob w = get_job(p, ja); prep_load(w, g - job_base(ja), w.K >> 6, tid, va, k0a, n0a); }
    for (; g < total; g += G) {
      const int gn = g + G;
      if (gn < total) { jb = find_job(gn); const WJob w = get_job(p, jb); prep_load(w, gn - job_base(jb), w.K >> 6, tid, vb, k0b, n0b); }
      __syncthreads();
      prep_lds(sT0, va, tid);
      __syncthreads();
      { const WJob w = get_job(p, ja); prep_out(sT0, w, k0a, n0a, w.K >> 6, tid); }
#pragma unroll
      for (int i = 0; i < 4; ++i) va[i] = vb[i];
      k0a = k0b; n0a = n0b; ja = jb;
    }
  }
  if (blockIdx.x == 0) {
    for (int i = tid; i < 8 * 64; i += 256) {
      const int bg = i >> 6, d = i & 63;
      p.kcb[((size_t)bg * 512 + 511) * 64 + d] = 0;
      p.vcT[((size_t)(bg * 8 + 7) * 64 + d) * 64 + 63] = 0;
    }
  }
}

template <class AL, class EP>
DI void gemm_tile(const AL& al, const bf16_t* __restrict__ Wt, int K, int mt, int nt, const EP& ep, char* smem, int kb0 = 0, int KBn = -1) {
  bf16_t* sbuf = (bf16_t*)smem;
  constexpr int STAGE = 2 * 128 * 72;
  const int tid = threadIdx.x, lane = tid & 63, wave = tid >> 6, wr = wave >> 1, wc = wave & 1, r = lane & 31, h = lane >> 5;
  const int KBt = K >> 6, KB = KBn < 0 ? KBt : KBn;
  const bf16_t* wbase = Wt + (((size_t)nt * KBt + kb0) << 13) + tid * 8;
  f32x16 acc[2][2];
#pragma unroll
  for (int a = 0; a < 2; ++a)
#pragma unroll
    for (int b = 0; b < 2; ++b)
#pragma unroll
      for (int i = 0; i < 16; ++i) acc[a][b][i] = 0.f;
  u32x4 xa[4], wa[4];
#define GEMM_LOAD(kb_)                                                                  \
  _Pragma("unroll") for (int i = 0; i < 4; ++i) {                                        \
    const int c = tid + 256 * i;                                                         \
    xa[i] = al(mt, c >> 3, (kb0 + (kb_)) * 64 + (c & 7) * 8);                                    \
    wa[i] = *(const u32x4*)(wbase + ((size_t)(kb_) << 13) + 2048 * i);                   \
  }
#define GEMM_STORE(st_)                                                                 \
  _Pragma("unroll") for (int i = 0; i < 4; ++i) {                                        \
    const int c = tid + 256 * i, row = c >> 3, kc = (c & 7) * 8;                         \
    *(u32x4*)(sbuf + (st_) * STAGE + row * 72 + kc) = xa[i];                             \
    *(u32x4*)(sbuf + (st_) * STAGE + 128 * 72 + row * 72 + kc) = wa[i];                  \
  }
#define GEMM_LDF(FW, FX, st_, ks_)                                                      \
  _Pragma("unroll") for (int q = 0; q < 2; ++q) {                                        \
    FW[q] = *(const bf16x8*)(sbuf + (st_) * STAGE + 128 * 72 + (64 * wc + 32 * q + r) * 72 + 16 * (ks_) + 8 * h); \
    FX[q] = *(const bf16x8*)(sbuf + (st_) * STAGE + (64 * wr + 32 * q + r) * 72 + 16 * (ks_) + 8 * h);            \
  }
#define GEMM_MM(FW, FX)                                                                 \
  _Pragma("unroll") for (int ms = 0; ms < 2; ++ms)                                       \
    _Pragma("unroll") for (int ns = 0; ns < 2; ++ns) acc[ms][ns] = mfma32(FW[ns], FX[ms], acc[ms][ns]);
  bf16x8 faw[2], fax[2], fbw[2], fbx[2];
  __syncthreads();
  GEMM_LOAD(0)
  GEMM_STORE(0)
  if (KB > 1) { GEMM_LOAD(1) }
  __syncthreads();
  GEMM_LDF(faw, fax, 0, 0)
  for (int it = 0; it < KB; ++it) {
    const int cur = it & 1;
    if (it + 1 < KB) { GEMM_STORE(cur ^ 1) }
    if (it + 2 < KB) { GEMM_LOAD(it + 2) }
    __builtin_amdgcn_sched_barrier(0);
    GEMM_LDF(fbw, fbx, cur, 1)
    __builtin_amdgcn_sched_barrier(0);
    GEMM_MM(faw, fax)
    __builtin_amdgcn_sched_barrier(0);
    GEMM_LDF(faw, fax, cur, 2)
    __builtin_amdgcn_sched_barrier(0);
    GEMM_MM(fbw, fbx)
    __builtin_amdgcn_sched_barrier(0);
    GEMM_LDF(fbw, fbx, cur, 3)
    __builtin_amdgcn_sched_barrier(0);
    GEMM_MM(faw, fax)
    __builtin_amdgcn_sched_barrier(0);
    __syncthreads();
    if (it + 1 < KB) { GEMM_LDF(faw, fax, cur ^ 1, 0) }
    __builtin_amdgcn_sched_barrier(0);
    GEMM_MM(fbw, fbx)
    __builtin_amdgcn_sched_barrier(0);
  }
#undef GEMM_LDF
#undef GEMM_MM
#undef GEMM_LOAD
#undef GEMM_STORE
  ep(acc, mt, nt, wr, wc, lane, smem);
}

template <class AL, class EP>
DI void gemm_phase(const AL& al, const bf16_t* Wt, int K, int numM, int numN, const EP& ep, char* smem) {
  const int xcd = blockIdx.x & 7, lb = blockIdx.x >> 3, nlb = gridDim.x >> 3;
  const int mper = (numM + 7) >> 3, fullr = mper >> 3, mrem = mper & 7;
  const int nfull = fullr * 8 * numN, total = mper * numN;
  for (int li = lb; li < total; li += nlb) {
    int nt, mtl;
    if (li < nfull) { const int s = li / (8 * numN), rem = li - s * 8 * numN; nt = rem >> 3; mtl = s * 8 + (rem & 7); }
    else { const int rem = li - nfull; nt = rem / mrem; mtl = fullr * 8 + (rem - nt * mrem); }
    const int mt = xcd * mper + mtl;
    if (mt >= numM) continue;
    gemm_tile(al, Wt, K, mt, nt, ep, smem);
  }
}

struct ALPlain { const bf16_t* A; int KB; DI u32x4 operator()(int mt, int ml, int k) const { return *(const u32x4*)(A + (((size_t)(mt * KB + (k >> 6))) << 13) + (ml << 6) + (k & 63)); } };
struct ALFfn {
  const bf16_t* A;
  DI u32x4 operator()(int mt, int ml, int k) const {
    const int b = mt / 66, it = mt - b * 66, t = 126 * it - 2 + ml;
    if (t < 0 || t >= T_) return (u32x4){0, 0, 0, 0};
    return *(const u32x4*)(A + a_off(b * T_ + t, k, 16));
  }
};
struct ALCmp1 {
  const bf16_t* raw; const float* pe;
  DI u32x4 operator()(int mt, int ml, int k) const {
    const int m = mt * 128 + ml;
    if (m >= 4088) return (u32x4){0, 0, 0, 0};
    const int bg = m / 511, n = m - bg * 511;
    u32x4 v = *(const u32x4*)(raw + ((size_t)bg * T_ + 16 * n) * 64 + k);
    const f32x4 p0 = *(const f32x4*)(pe + k), p1 = *(const f32x4*)(pe + k + 4);
    u32x4 o;
    o.x = pack2(bf2f((bf16_t)(v.x & 0xffff)) + p0.x, bf2f((bf16_t)(v.x >> 16)) + p0.y);
    o.y = pack2(bf2f((bf16_t)(v.y & 0xffff)) + p0.z, bf2f((bf16_t)(v.y >> 16)) + p0.w);
    o.z = pack2(bf2f((bf16_t)(v.z & 0xffff)) + p1.x, bf2f((bf16_t)(v.z >> 16)) + p1.y);
    o.w = pack2(bf2f((bf16_t)(v.w & 0xffff)) + p1.z, bf2f((bf16_t)(v.w >> 16)) + p1.w);
    return o;
  }
};
struct ALCmp2 { const bf16_t* A; DI u32x4 operator()(int mt, int ml, int k) const { const int m = mt * 128 + ml; if (m >= 4088) return (u32x4){0, 0, 0, 0}; return *(const u32x4*)(A + (size_t)m * 256 + k); } };

__device__ const float ROPE_INV[8] = {1.0f, 0.19392274474868576f, 0.03760603093086393f, 0.007292664737217109f, 0.001414213562373095f, 0.0002742481756762073f, 5.318295896944988e-05f, 1.031338537721246e-05f};

template <bool ROPE>
DI void norm_store(f32x16 (&a)[2], float rs, const float* gain, int pos, bf16_t* dst, int h) {
  float ss = 0.f;
#pragma unroll
  for (int ns = 0; ns < 2; ++ns)
#pragma unroll
    for (int i = 0; i < 16; ++i) { const float v = a[ns][i] * rs; a[ns][i] = v; ss += v * v; }
  ss += __shfl_xor(ss, 32);
  const float inv = rsqrtf(ss * (1.0f / 64.0f) + 1e-6f);
#pragma unroll
  for (int ns = 0; ns < 2; ++ns)
#pragma unroll
    for (int i = 0; i < 16; ++i) a[ns][i] = a[ns][i] * inv * gain[32 * ns + crow(i, h)];
  if (ROPE) {
    const float fp = (float)pos;
#pragma unroll
    for (int ii = 0; ii < 4; ++ii) {
      const float ang = fp * ROPE_INV[4 * h + ii];
      const float c = cosf(ang), s = sinf(ang);
      const float x1 = a[0][ii], x2 = a[0][4 + ii];
      a[0][ii] = x1 * c - x2 * s; a[0][4 + ii] = x2 * c + x1 * s;
    }
  }
#pragma unroll
  for (int ns = 0; ns < 2; ++ns)
#pragma unroll
    for (int q = 0; q < 4; ++q) store_bf4(dst + 32 * ns + 8 * q + 4 * h, a[ns][4 * q], a[ns][4 * q + 1], a[ns][4 * q + 2], a[ns][4 * q + 3]);
}

struct EpiFoxIn {
  const Params& p;
  DI void operator()(f32x16 (&acc)[2][2], int mt, int nt, int wr, int wc, int lane, char*) const {
    const int r = lane & 31, h = lane >> 5, nb = nt * 128 + 64 * wc;
#pragma unroll
    for (int ms = 0; ms < 2; ++ms) {
      const int row = mt * 128 + 64 * wr + 32 * ms + r;
      const float rs = row_rstd(p.part, row);
      const int b = row >> 13, t = row & 8191;
      if (nb < 2048) {
        const bool isq = nb < 1024;
        norm_store<false>(acc[ms], rs, isq ? p.a_q_gain : p.a_k_gain, 0, (isq ? p.qb : p.kb) + ((size_t)(b * 16 + ((nb & 1023) >> 6)) * T_ + t) * 64, h);
      } else if (nb < 3072) {
        const int head = (nb - 2048) >> 6;
        bf16_t* dst = p.vT + ((size_t)((b * 16 + head) * 128 + (t >> 6))) * 4096 + (t & 63);
#pragma unroll
        for (int ns = 0; ns < 2; ++ns)
#pragma unroll
          for (int i = 0; i < 16; ++i) dst[(32 * ns + crow(i, h)) * 64] = f2bf(acc[ms][ns][i] * rs);
      } else if (nb == 3072) {
#pragma unroll
        for (int i = 0; i < 8; ++i) {
          const int head = crow(i, h);
          const float z = acc[ms][0][i] * rs + p.a_b_f[head];
          p.lf[((size_t)(b * 16 + head)) * T_ + t] = fminf(z, 0.f) - log1pf(expf(-fabsf(z)));
        }
      }
    }
  }
};

template <int MODE>
struct EpiResid {
  const float* res; float* out; bf16_t* hb; float* part;
  DI void operator()(f32x16 (&acc)[2][2], int mt, int nt, int wr, int wc, int lane, char* smem) const {
    float* sU = (float*)smem;
    const int r = lane & 31, h = lane >> 5, tid = threadIdx.x;
    __syncthreads();
#pragma unroll
    for (int ms = 0; ms < 2; ++ms) {
      const int ml = 64 * wr + 32 * ms + r;
#pragma unroll
      for (int ns = 0; ns < 2; ++ns)
#pragma unroll
        for (int i = 0; i < 16; ++i) sU[ml * 132 + 64 * wc + 32 * ns + crow(i, h)] = acc[ms][ns][i];
    }
    __syncthreads();
    const int c4 = (tid & 31) * 4, n = nt * 128 + c4;
#pragma unroll 1
    for (int hh = 0; hh < 2; ++hh) {
      f32x4 rv[8];
#pragma unroll
      for (int it = 0; it < 8; ++it) {
        const int row = mt * 128 + (hh * 8 + it) * 8 + (tid >> 5);
        if (MODE == 0) rv[it] = *(const f32x4*)(res + (size_t)row * 1024 + n);
        else {
          const u32x2 v = *(const u32x2*)(hb + a_off(row, n, 16));
          rv[it] = (f32x4){bf2f((bf16_t)(v.x & 0xffff)), bf2f((bf16_t)(v.x >> 16)), bf2f((bf16_t)(v.y & 0xffff)), bf2f((bf16_t)(v.y >> 16))};
        }
      }
#pragma unroll
      for (int it = 0; it < 8; ++it) {
        const int rl = (hh * 8 + it) * 8 + (tid >> 5), row = mt * 128 + rl;
        const f32x4 o = rv[it] + *(const f32x4*)(sU + rl * 132 + c4);
        if (MODE == 2) *(f32x4*)(out + (size_t)row * 1024 + n) = o;
        else {
          store_bf4(hb + a_off(row, n, 16), o.x, o.y, o.z, o.w);
          float ss = o.x * o.x + o.y * o.y + o.z * o.z + o.w * o.w;
          ss += __shfl_xor(ss, 1); ss += __shfl_xor(ss, 2); ss += __shfl_xor(ss, 4); ss += __shfl_xor(ss, 8); ss += __shfl_xor(ss, 16);
          if ((tid & 31) == 0) { part[(size_t)row * 16 + nt * 2] = ss; part[(size_t)row * 16 + nt * 2 + 1] = 0.f; }
        }
      }
    }
  }
};

struct EpiFfnUp {
  const float* part; const float* cw; const float* cb; bf16_t* act;
  DI void operator()(f32x16 (&acc)[2][2], int mt, int nt, int wr, int wc, int lane, char* smem) const {
    float* sU = (float*)smem;
    const int r = lane & 31, h = lane >> 5, tid = threadIdx.x;
    const int b = mt / 66, it = mt - b * 66, tb = 126 * it - 2;
    __syncthreads();
#pragma unroll
    for (int ms = 0; ms < 2; ++ms) {
      const int ml = 64 * wr + 32 * ms + r, t = tb + ml;
      const float rs = (t >= 0 && t < T_) ? row_rstd(part, b * T_ + t) : 0.f;
#pragma unroll
      for (int ns = 0; ns < 2; ++ns)
#pragma unroll
        for (int i = 0; i < 16; ++i) sU[ml * 129 + 64 * wc + 32 * ns + crow(i, h)] = acc[ms][ns][i] * rs;
    }
    __syncthreads();
    const int jj = tid & 63, rg = tid >> 6, j = nt * 64 + jj;
    const float wg0 = cw[j], wg1 = cw[5632 + j], wg2 = cw[2 * 5632 + j], bgt = cb[j];
    const float wv0 = cw[FF + j], wv1 = cw[5632 + FF + j], wv2 = cw[2 * 5632 + FF + j], bvl = cb[FF + j];
    {
      const int m_lo = rg == 0 ? 2 : 32 * rg, m_hi = 32 * rg + 32;
      float g0 = sU[(m_lo - 2) * 129 + jj], g1 = sU[(m_lo - 1) * 129 + jj];
      float v0 = sU[(m_lo - 2) * 129 + 64 + jj], v1 = sU[(m_lo - 1) * 129 + 64 + jj];
      for (int ml = m_lo; ml < m_hi; ++ml) {
        const int t = tb + ml;
        if (t >= T_) break;
        const float g2 = sU[ml * 129 + jj], v2 = sU[ml * 129 + 64 + jj];
        const float g = bgt + wg0 * g0 + wg1 * g1 + wg2 * g2;
        const float v = bvl + wv0 * v0 + wv1 * v1 + wv2 * v2;
        const float a = g * __builtin_amdgcn_rcpf(1.0f + __expf(-g)) * v;
        act[a_off(b * T_ + t, j, 44)] = f2bf(a);
        g0 = g1; g1 = g2; v0 = v1; v1 = v2;
      }
    }
  }
};

struct EpiKv {
  const Params& p;
  DI void operator()(f32x16 (&acc)[2][2], int mt, int nt, int wr, int wc, int lane, char*) const {
    const int r = lane & 31, h = lane >> 5, g = wc;
#pragma unroll
    for (int ms = 0; ms < 2; ++ms) {
      const int row = mt * 128 + 64 * wr + 32 * ms + r;
      const float rs = row_rstd(p.part, row);
      const int b = row >> 13, t = row & 8191, bg = b * 2 + g;
      if (nt < 2) {
        bf16_t* dst = p.rawc + (((size_t)(nt * 8 + bg)) * T_ + t) * 64;
#pragma unroll
        for (int ns = 0; ns < 2; ++ns)
#pragma unroll
          for (int q = 0; q < 4; ++q)
            store_bf4(dst + 32 * ns + 8 * q + 4 * h, acc[ms][ns][4 * q] * rs, acc[ms][ns][4 * q + 1] * rs, acc[ms][ns][4 * q + 2] * rs, acc[ms][ns][4 * q + 3] * rs);
      } else if (nt == 2 || nt == 4) {
        norm_store<true>(acc[ms], rs, nt == 2 ? p.ks_gain : p.kw_gain, p.pos[row], (nt == 2 ? p.ksb : p.kwb) + ((size_t)bg * T_ + t) * 64, h);
      } else if (nt == 3) {
        bf16_t* dst = p.vsT + ((size_t)bg * 128 + (t >> 6)) * 4096 + (t & 63);
#pragma unroll
        for (int ns = 0; ns < 2; ++ns)
#pragma unroll
          for (int i = 0; i < 16; ++i) dst[(32 * ns + crow(i, h)) * 64] = f2bf(acc[ms][ns][i] * rs);
      } else {
        bf16_t* dst = p.vwT + ((size_t)bg * 128 + (t >> 6)) * 4096 + (t & 63);
#pragma unroll
        for (int ns = 0; ns < 2; ++ns)
#pragma unroll
          for (int i = 0; i < 16; ++i) dst[(32 * ns + crow(i, h)) * 64] = f2bf(acc[ms][ns][i] * rs);
      }
    }
  }
};

struct EpiBIn {
  const Params& p;
  DI void operator()(f32x16 (&acc)[2][2], int mt, int nt, int wr, int wc, int lane, char*) const {
    const int r = lane & 31, h = lane >> 5, nb = nt * 128 + 64 * wc;
#pragma unroll
    for (int ms = 0; ms < 2; ++ms) {
      const int row = mt * 128 + 64 * wr + 32 * ms + r;
      const float rs = row_rstd(p.part, row);
      if (nb < 1024) {
        norm_store<true>(acc[ms], rs, p.b_q_gain, p.pos[row], p.qn + (size_t)row * 1024 + nb, h);
      } else if (nb == 1024) {
#pragma unroll
        for (int ns = 0; ns < 2; ++ns)
#pragma unroll
          for (int i = 0; i < 16; ++i) {
            const int c = 32 * ns + crow(i, h);
            if (c < 48) { const float z = acc[ms][ns][i] * rs + p.b_b_gate[c]; p.gates[(size_t)row * 48 + c] = 1.0f / (1.0f + __expf(-z)); }
          }
      }
    }
  }
};

struct EpiCmp1P {
  float* dst;
  DI void operator()(f32x16 (&acc)[2][2], int mt, int nt, int wr, int wc, int lane, char*) const {
    const int r = lane & 31, h = lane >> 5;
#pragma unroll
    for (int ms = 0; ms < 2; ++ms) {
      const int m = mt * 128 + 64 * wr + 32 * ms + r;
#pragma unroll
      for (int ns = 0; ns < 2; ++ns)
#pragma unroll
        for (int q = 0; q < 4; ++q) {
          f32x4 v = {acc[ms][ns][4 * q], acc[ms][ns][4 * q + 1], acc[ms][ns][4 * q + 2], acc[ms][ns][4 * q + 3]};
          *(f32x4*)(dst + (size_t)m * 256 + nt * 128 + 64 * wc + 32 * ns + 8 * q + 4 * h) = v;
        }
    }
  }
};
DI float gelu_tanh(float x) { return 0.5f * x * (1.0f + tanhf(0.7978845608028654f * (x + 0.044715f * x * x * x))); }
struct ALCmp2P {
  const float* P;
  DI u32x4 operator()(int mt, int ml, int k) const {
    const int m = mt * 128 + ml;
    if (m >= 4088) return (u32x4){0, 0, 0, 0};
    f32x4 a = {0.f, 0.f, 0.f, 0.f}, b = {0.f, 0.f, 0.f, 0.f};
#pragma unroll
    for (int s4 = 0; s4 < 4; ++s4) {
      const float* q = P + ((size_t)s4 * 4096 + m) * 256 + k;
      a += *(const f32x4*)q; b += *(const f32x4*)(q + 4);
    }
    u32x4 o;
    o.x = pack2(gelu_tanh(a.x), gelu_tanh(a.y)); o.y = pack2(gelu_tanh(a.z), gelu_tanh(a.w));
    o.z = pack2(gelu_tanh(b.x), gelu_tanh(b.y)); o.w = pack2(gelu_tanh(b.z), gelu_tanh(b.w));
    return o;
  }
};

struct EpiCmp1 {
  bf16_t* hid;
  DI void operator()(f32x16 (&acc)[2][2], int mt, int nt, int wr, int wc, int lane, char*) const {
    const int r = lane & 31, h = lane >> 5;
#pragma unroll
    for (int ms = 0; ms < 2; ++ms) {
      const int m = mt * 128 + 64 * wr + 32 * ms + r;
      if (m >= 4088) continue;
#pragma unroll
      for (int ns = 0; ns < 2; ++ns) {
        float g[16];
#pragma unroll
        for (int i = 0; i < 16; ++i) { const float x = acc[ms][ns][i]; g[i] = 0.5f * x * (1.0f + tanhf(0.7978845608028654f * (x + 0.044715f * x * x * x))); }
#pragma unroll
        for (int q = 0; q < 4; ++q) store_bf4(hid + (size_t)m * 256 + nt * 128 + 64 * wc + 32 * ns + 8 * q + 4 * h, g[4 * q], g[4 * q + 1], g[4 * q + 2], g[4 * q + 3]);
      }
    }
  }
};

struct EpiCmp2 {
  const Params& p; int sel;
  DI void operator()(f32x16 (&acc)[2][2], int mt, int nt, int wr, int wc, int lane, char*) const {
    if (wc != 0) return;
    const int r = lane & 31, h = lane >> 5;
#pragma unroll
    for (int ms = 0; ms < 2; ++ms) {
      const int m = mt * 128 + 64 * wr + 32 * ms + r;
      if (m < 4088) {
        const int bg = m / 511, n = m - bg * 511, b = bg >> 1;
        if (sel == 0) {
          norm_store<true>(acc[ms], 1.0f, p.kc_gain, p.pos[b * T_ + 16 * n + 31], p.kcb + ((size_t)bg * 512 + n) * 64, h);
        } else {
          bf16_t* dst = p.vcT + ((size_t)(bg * 8 + (n >> 6))) * 4096 + (n & 63);
#pragma unroll
          for (int ns = 0; ns < 2; ++ns)
#pragma unroll
            for (int i = 0; i < 16; ++i) dst[(32 * ns + crow(i, h)) * 64] = f2bf(acc[ms][ns][i]);
        }
      } else {
      }
    }
  }
};

DI void phase_scan(const Params& p, char* smem) {
  float* sW = (float*)smem;
  const int tid = threadIdx.x, lane = tid & 63, w = tid >> 6;
  for (int seq = blockIdx.x; seq < 64; seq += gridDim.x) {
    const float* src = p.lf + (size_t)seq * T_ + tid * 32;
    float* dst = p.cc + (size_t)seq * T_ + tid * 32;
    f32x4 v[8];
#pragma unroll
    for (int i = 0; i < 8; ++i) v[i] = *(const f32x4*)(src + 4 * i);
    float s = 0.f;
#pragma unroll
    for (int i = 0; i < 8; ++i) { s += v[i].x; s += v[i].y; s += v[i].z; s += v[i].w; }
    float inc = s;
#pragma unroll
    for (int o = 1; o < 64; o <<= 1) { const float u = __shfl_up(inc, o); if (lane >= o) inc += u; }
    __syncthreads();
    if (lane == 63) sW[w] = inc;
    __syncthreads();
    float run = inc - s;
    for (int q = 0; q < w; ++q) run += sW[q];
#pragma unroll
    for (int i = 0; i < 8; ++i) {
      f32x4 o;
      run += v[i].x; o.x = run; run += v[i].y; o.y = run; run += v[i].z; o.z = run; run += v[i].w; o.w = run;
      *(f32x4*)(dst + 4 * i) = o;
    }
  }
}

template <int MODE>
DI void flash_step(f32x16 (&o)[2], float& l, const bf16x8 (&qf)[4], const bf16_t* sK, const bf16_t* sV, const float* sC,
                   int kbase, int tq, float bias0, float inv_l, float* sImpRow, int lane, bool selok = true) {
  const int r = lane & 31, h = lane >> 5;
  constexpr float SC = 0.125f * 1.4426950408889634f;
  const int base_hi = (MODE == 2 || MODE == 3) ? ((tq - 31) >> 4) : tq;
  const float bsel = (MODE == 4 && !selok) ? -1e30f : bias0;
  f32x16 s[2];
#pragma unroll
  for (int sub = 0; sub < 2; ++sub) {
#pragma unroll
    for (int i = 0; i < 16; ++i) s[sub][i] = 0.f;
#pragma unroll
    for (int ks = 0; ks < 4; ++ks) {
      const bf16x8 a = *(const bf16x8*)(sK + (32 * sub + r) * 72 + 16 * ks + 8 * h);
      s[sub] = mfma32(a, qf[ks], s[sub]);
    }
  }
  __builtin_amdgcn_sched_barrier(0);
  float ls = 0.f;
#pragma unroll
  for (int sub = 0; sub < 2; ++sub) {
    const int hi = base_hi - kbase - 32 * sub - 4 * h;
    const int lo = (MODE == 1) ? hi - 511 : -1000000;
    const bool nomask = __all((hi >= 27) && (lo <= 0));
    if (MODE == 0) {
#pragma unroll
      for (int q = 0; q < 4; ++q) {
        const f32x4 c4 = *(const f32x4*)(sC + 32 * sub + 8 * q + 4 * h);
#pragma unroll
        for (int j = 0; j < 4; ++j) s[sub][4 * q + j] = fmaf(s[sub][4 * q + j], SC, bias0 - c4[j]);
      }
    } else {
#pragma unroll
      for (int i = 0; i < 16; ++i) s[sub][i] = fmaf(s[sub][i], SC, bsel);
    }
    if (!nomask) {
#pragma unroll
      for (int i = 0; i < 16; ++i) { const int cst = (i & 3) + 8 * (i >> 2); s[sub][i] = (cst <= hi && cst >= lo) ? s[sub][i] : -1e30f; }
    }
#pragma unroll
    for (int i = 0; i < 16; ++i) { const float pv = __builtin_amdgcn_exp2f(s[sub][i]); s[sub][i] = pv; ls += pv; }
  }
  l += ls;
  if (MODE == 2) return;
  if (MODE == 3) {
#pragma unroll
    for (int sub = 0; sub < 2; ++sub)
#pragma unroll
      for (int q = 0; q < 4; ++q) {
        const float p3 = s[sub][4 * q + 3] * inv_l;
        float A = (s[sub][4 * q] + s[sub][4 * q + 1] + s[sub][4 * q + 2]) * inv_l + 0.5f * p3, B = 0.5f * p3;
        A += __shfl_xor(A, 1); A += __shfl_xor(A, 2); A += __shfl_xor(A, 4);
        B += __shfl_xor(B, 1); B += __shfl_xor(B, 2); B += __shfl_xor(B, 4);
        if ((r & 7) == 0) { const int j = ((kbase + 32 * sub) >> 2) + 2 * q + h; atomicAdd(&sImpRow[j], A); atomicAdd(&sImpRow[j + 1], B); }
      }
  }
#pragma unroll
  for (int sub = 0; sub < 2; ++sub)
#pragma unroll
    for (int st = 0; st < 2; ++st) {
      u32x4 pk;
      pk.x = pack2(s[sub][8 * st + 0], s[sub][8 * st + 1]); pk.y = pack2(s[sub][8 * st + 2], s[sub][8 * st + 3]);
      pk.z = pack2(s[sub][8 * st + 4], s[sub][8 * st + 5]); pk.w = pack2(s[sub][8 * st + 6], s[sub][8 * st + 7]);
      const bf16x8 pf = __builtin_bit_cast(bf16x8, pk);
#pragma unroll
      for (int d = 0; d < 2; ++d) {
        const bf16_t* vp = sV + (32 * d + r) * 72 + 32 * sub + 16 * st + 4 * h;
        const bf16x4 lo4 = *(const bf16x4*)vp, hi4 = *(const bf16x4*)(vp + 8);
        const bf16x8 vf = __builtin_shufflevector(lo4, hi4, 0, 1, 2, 3, 4, 5, 6, 7);
        o[d] = mfma32(vf, pf, o[d]);
      }
    }
}

DI void tile_load(u32x4 (&kr)[2], u32x4 (&vr)[2], const bf16_t* kptr, int kstride, const bf16_t* vptr, int vstride, bool withV, int tid) {
#pragma unroll
  for (int i = 0; i < 2; ++i) {
    const int c = tid + 256 * i, row = c >> 3, ch = (c & 7) * 8;
    kr[i] = *(const u32x4*)(kptr + (size_t)row * kstride + ch);
    if (withV) vr[i] = *(const u32x4*)(vptr + (size_t)row * vstride + ch);
  }
}
DI void tile_store(const u32x4 (&kr)[2], const u32x4 (&vr)[2], bf16_t* sK, bf16_t* sV, bool withV, int tid) {
#pragma unroll
  for (int i = 0; i < 2; ++i) {
    const int c = tid + 256 * i, row = c >> 3, ch = (c & 7) * 8;
    *(u32x4*)(sK + row * 72 + ch) = kr[i];
    if (withV) *(u32x4*)(sV + row * 72 + ch) = vr[i];
  }
}

template <class LoadF, class StoreF, class BodyF>
DI void dense_loop(int n, LoadF ld, StoreF st, BodyF body) {
  if (n <= 0) return;
  ld(0); st(0);
  if (n > 1) ld(1);
  __syncthreads();
  for (int e = 0; e < n; ++e) {
    const int cur = e & 1;
    if (e + 1 < n) st(cur ^ 1);
    if (e + 2 < n) ld(e + 2);
    body(e, cur);
    __syncthreads();
  }
}

DI void phase_fox(const Params& p, char* smem) {
  bf16_t* sKV = (bf16_t*)smem;
  float* sC = (float*)(sKV + 4 * 64 * 72);
  const int tid = threadIdx.x, lane = tid & 63, w = tid >> 6, r = lane & 31, h = lane >> 5;
  float gq = 0.f, gk = 0.f;
  for (int i = 0; i < 64; ++i) { gq = fmaxf(gq, fabsf(p.a_q_gain[i])); gk = fmaxf(gk, fabsf(p.a_k_gain[i])); }
  const float smax = 8.0f * gq * gk * 1.05f;
  const float thr = 40.0f + 2.0f * smax;
  const float negM2 = -smax * 1.4426950408889634f;
  for (int item = blockIdx.x; item < 4096; item += gridDim.x) {
    const int bh = item & 63, qt = 63 - (item >> 6), b = bh >> 4, head = bh & 15, t0 = qt * 128;
    const int tq = t0 + 32 * w + r;
    const bf16_t* qrow = p.qb + ((size_t)bh * T_ + tq) * 64;
    bf16x8 qf[4];
#pragma unroll
    for (int ks = 0; ks < 4; ++ks) qf[ks] = *(const bf16x8*)(qrow + 16 * ks + 8 * h);
    const float* cseq = p.cc + (size_t)bh * T_;
    const float cq = cseq[tq] * 1.4426950408889634f, c0 = cseq[t0];
    const bf16_t* kbp = p.kb + (size_t)bh * T_ * 64;
    const bf16_t* vbp = p.vT + (size_t)bh * 128 * 4096;
    f32x16 o[2];
#pragma unroll
    for (int d = 0; d < 2; ++d)
#pragma unroll
      for (int i = 0; i < 16; ++i) o[d][i] = 0.f;
    float l = 0.f;
    u32x4 kr[2], vr[2]; f32x4 cr = (f32x4){0.f, 0.f, 0.f, 0.f};
    const int jmax = 2 * qt + 1;
    int jmin = jmax;
    while (jmin > 0 && !(c0 - cseq[64 * (jmin - 1) + 63] < -thr)) --jmin;
    dense_loop(jmax - jmin + 1,
      [&](int e) { const int jt = jmax - e; tile_load(kr, vr, kbp + (size_t)jt * 4096, 64, vbp + (size_t)jt * 4096, 64, true, tid); if (tid < 16) cr = *(const f32x4*)(cseq + 64 * jt + 4 * tid); },
      [&](int bf) { tile_store(kr, vr, sKV + bf * 2 * 64 * 72, sKV + bf * 2 * 64 * 72 + 64 * 72, true, tid); if (tid < 16) *(f32x4*)(sC + bf * 64 + 4 * tid) = cr * 1.4426950408889634f; },
      [&](int e, int cur) {
        const int kbase = 64 * (jmax - e);
        if (kbase <= t0 + 32 * w + 31) flash_step<0>(o, l, qf, sKV + cur * 2 * 64 * 72, sKV + cur * 2 * 64 * 72 + 64 * 72, sC + cur * 64, kbase, tq, cq + negM2, 0.f, nullptr, lane);
      });
    const float lt = l + __shfl_xor(l, 32);
    const float inv = 1.0f / lt;
    bf16_t* orow = p.ob + a_off(b * T_ + tq, head * 64, 16);
#pragma unroll
    for (int d = 0; d < 2; ++d)
#pragma unroll
      for (int q = 0; q < 4; ++q) store_bf4(orow + 32 * d + 8 * q + 4 * h, o[d][4 * q] * inv, o[d][4 * q + 1] * inv, o[d][4 * q + 2] * inv, o[d][4 * q + 3] * inv);
  }
}

DI void phase_nsa(const Params& p, char* smem) {
  bf16_t* sKV = (bf16_t*)smem;
  float* sU = (float*)(sKV + 4 * 64 * 72);
  float* sImp = sU; float* sO = sU;
  unsigned* sMask = (unsigned*)(sU + 128 * 65);
  int* sList = (int*)(sMask + 64);
  const int tid = threadIdx.x, lane = tid & 63, w = tid >> 6, r = lane & 31, h = lane >> 5;
  float gqm = 0.f, gkm = 0.f;
  for (int i = 0; i < 64; ++i) { gqm = fmaxf(gqm, fabsf(p.b_q_gain[i])); gkm = fmaxf(gkm, fmaxf(fabsf(p.kc_gain[i]), fmaxf(fabsf(p.ks_gain[i]), fabsf(p.kw_gain[i])))); }
  const float negM2 = -8.0f * gqm * gkm * 1.05f * 1.4426950408889634f;
  auto stK = [&](int bf) { return sKV + bf * 2 * 64 * 72; };
  for (int item = blockIdx.x; item < 4096; item += gridDim.x) {
    const int bg = item & 7, tt = 511 - (item >> 3), b = bg >> 1, g = bg & 1, t0 = tt * 16;
    const int tokl = 4 * w + (r >> 3), head = r & 7, tq = t0 + tokl;
    __syncthreads();
    for (int i = tid; i < 16 * 132; i += 256) sImp[i] = 0.f;
    bf16x8 qf[4];
    {
      const bf16_t* qrow = p.qn + ((size_t)b * T_ + tq) * 1024 + (g * 8 + head) * 64;
#pragma unroll
      for (int ks = 0; ks < 4; ++ks) qf[ks] = *(const bf16x8*)(qrow + 16 * ks + 8 * h);
    }
    const float* grow = p.gates + ((size_t)b * T_ + tq) * 48 + g * 8 + head;
    const float gate_c = grow[0], gate_w = grow[32];
    f32x16 o[2];
    float l = 0.f;
    u32x4 kr[2], vr[2];
    const int ncmp = t0 >> 4, nct = (ncmp + 63) >> 6;
    const bf16_t* kcp = p.kcb + (size_t)bg * 512 * 64;
    const bf16_t* vcp = p.vcT + (size_t)bg * 8 * 4096;
    dense_loop(nct,
      [&](int e) { tile_load(kr, vr, kcp + (size_t)e * 4096, 64, vcp, 64, false, tid); },
      [&](int bf) { tile_store(kr, vr, stK(bf), stK(bf) + 64 * 72, false, tid); },
      [&](int e, int cur) { flash_step<2>(o, l, qf, stK(cur), stK(cur) + 64 * 72, nullptr, 64 * e, tq, negM2, 0.f, nullptr, lane); });
    const float lc = l + __shfl_xor(l, 32);
    const float inv_lc = lc > 0.f ? 1.0f / lc : 0.f;
#pragma unroll
    for (int d = 0; d < 2; ++d)
#pragma unroll
      for (int i = 0; i < 16; ++i) o[d][i] = 0.f;
    float l2 = 0.f;
    dense_loop(nct,
      [&](int e) { tile_load(kr, vr, kcp + (size_t)e * 4096, 64, vcp + (size_t)e * 4096, 64, true, tid); },
      [&](int bf) { tile_store(kr, vr, stK(bf), stK(bf) + 64 * 72, true, tid); },
      [&](int e, int cur) { flash_step<3>(o, l2, qf, stK(cur), stK(cur) + 64 * 72, nullptr, 64 * e, tq, negM2, inv_lc, sImp + tokl * 132, lane); });
    __syncthreads();
    const int cur_blk = t0 >> 6;
    for (int tk = 0; tk < 4; ++tk) {
      const int tok = 4 * w + tk;
      float* sc = sImp + tok * 132;
      for (int j = lane; j <= cur_blk; j += 64) if (j == 0 || j == cur_blk || j == cur_blk - 1) sc[j] = 1e6f;
    }
    __syncthreads();
    for (int tk = 0; tk < 4; ++tk) {
      const int tok = 4 * w + tk;
      const float* sc = sImp + tok * 132;
      const bool v0 = lane <= cur_blk, v1 = lane + 64 <= cur_blk;
      const float s0 = v0 ? sc[lane] : -1e30f, s1 = v1 ? sc[lane + 64] : -1e30f;
      int r0 = 0, r1 = 0;
      const int n0 = cur_blk < 63 ? cur_blk + 1 : 64;
      for (int i = 0; i < n0; ++i) {
        const float si = __builtin_bit_cast(float, __builtin_amdgcn_readlane(__builtin_bit_cast(int, s0), i));
        r0 += ((si > s0) || (si == s0 && i < lane)) ? 1 : 0;
        r1 += (si >= s1) ? 1 : 0;
      }
      for (int i = 64; i <= cur_blk; ++i) {
        const float si = __builtin_bit_cast(float, __builtin_amdgcn_readlane(__builtin_bit_cast(int, s1), i - 64));
        r0 += (si > s0) ? 1 : 0;
        r1 += ((si > s1) || (si == s1 && i - 64 < lane)) ? 1 : 0;
      }
      const unsigned long long mk0 = __ballot(v0 && r0 < 16), mk1 = __ballot(v1 && r1 < 16);
      if (lane == 0) {
        sMask[tok * 4 + 0] = (unsigned)mk0; sMask[tok * 4 + 1] = (unsigned)(mk0 >> 32);
        sMask[tok * 4 + 2] = (unsigned)mk1; sMask[tok * 4 + 3] = (unsigned)(mk1 >> 32);
      }
    }
    __syncthreads();
    int n_un;
    {
      unsigned u0 = 0, u1 = 0, u2 = 0, u3 = 0;
      for (int tok = 0; tok < 16; ++tok) { u0 |= sMask[tok * 4]; u1 |= sMask[tok * 4 + 1]; u2 |= sMask[tok * 4 + 2]; u3 |= sMask[tok * 4 + 3]; }
      const int c0 = __popc(u0), c1 = __popc(u1), c2 = __popc(u2), c3 = __popc(u3);
      n_un = c0 + c1 + c2 + c3;
      if (tid < 128) {
        const int wd = tid >> 5, bit = tid & 31;
        const unsigned uw = wd == 0 ? u0 : wd == 1 ? u1 : wd == 2 ? u2 : u3;
        if ((uw >> bit) & 1u) {
          const int pre = (wd > 0 ? c0 : 0) + (wd > 1 ? c1 : 0) + (wd > 2 ? c2 : 0);
          sList[pre + __popc(uw & ((1u << bit) - 1u))] = tid;
        }
      }
    }
    __syncthreads();
    {
      const float sc = gate_c * inv_lc;
      float* orow = sO + (32 * w + r) * 65;
#pragma unroll
      for (int d = 0; d < 2; ++d)
#pragma unroll
        for (int i = 0; i < 16; ++i) orow[32 * d + crow(i, h)] = o[d][i] * sc;
    }
#pragma unroll
    for (int d = 0; d < 2; ++d)
#pragma unroll
      for (int i = 0; i < 16; ++i) o[d][i] = 0.f;
    l = 0.f;
    {
      const bf16_t* ksp = p.ksb + (size_t)bg * T_ * 64;
      const bf16_t* vsp = p.vsT + (size_t)bg * 128 * 4096;
      dense_loop(n_un,
        [&](int e) { const int blk = sList[e]; tile_load(kr, vr, ksp + (size_t)blk * 4096, 64, vsp + (size_t)blk * 4096, 64, true, tid); },
        [&](int bf) { tile_store(kr, vr, stK(bf), stK(bf) + 64 * 72, true, tid); },
        [&](int e, int cur) {
          const int blk = sList[e];
          const int wd = blk >> 5, bit = blk & 31;
          const unsigned wm = sMask[(4 * w) * 4 + wd] | sMask[(4 * w + 1) * 4 + wd] | sMask[(4 * w + 2) * 4 + wd] | sMask[(4 * w + 3) * 4 + wd];
          if ((wm >> bit) & 1u) {
            const bool selok = (sMask[tokl * 4 + wd] >> bit) & 1u;
            flash_step<4>(o, l, qf, stK(cur), stK(cur) + 64 * 72, nullptr, 64 * blk, tq, negM2, 0.f, nullptr, lane, selok);
          }
        });
      const float lt = l + __shfl_xor(l, 32);
      const float sc = grow[16] / lt;
      float* orow = sO + (32 * w + r) * 65;
#pragma unroll
      for (int d = 0; d < 2; ++d)
#pragma unroll
        for (int i = 0; i < 16; ++i) orow[32 * d + crow(i, h)] += o[d][i] * sc;
    }
#pragma unroll
    for (int d = 0; d < 2; ++d)
#pragma unroll
      for (int i = 0; i < 16; ++i) o[d][i] = 0.f;
    l = 0.f;
    {
      const int klo = t0 - 511 > 0 ? t0 - 511 : 0, jt0 = klo >> 6, jt1 = (t0 + 15) >> 6;
      const bf16_t* kwp = p.kwb + (size_t)bg * T_ * 64;
      const bf16_t* vwp = p.vwT + (size_t)bg * 128 * 4096;
      dense_loop(jt1 - jt0 + 1,
        [&](int e) { tile_load(kr, vr, kwp + (size_t)(jt0 + e) * 4096, 64, vwp + (size_t)(jt0 + e) * 4096, 64, true, tid); },
        [&](int bf) { tile_store(kr, vr, stK(bf), stK(bf) + 64 * 72, true, tid); },
        [&](int e, int cur) { flash_step<1>(o, l, qf, stK(cur), stK(cur) + 64 * 72, nullptr, 64 * (jt0 + e), tq, negM2, 0.f, nullptr, lane); });
      const float lt = l + __shfl_xor(l, 32);
      const float sc = gate_w / lt;
      float* orow = sO + (32 * w + r) * 65;
#pragma unroll
      for (int d = 0; d < 2; ++d)
#pragma unroll
        for (int i = 0; i < 16; ++i) orow[32 * d + crow(i, h)] += o[d][i] * sc;
    }
    __syncthreads();
    for (int c = tid; c < 128 * 16; c += 256) {
      const int row = c >> 4, d4 = (c & 15) * 4, tok = row >> 3, hd = row & 7;
      const float* s = sO + row * 65 + d4;
      store_bf4(p.ob + a_off(b * T_ + t0 + tok, (g * 8 + hd) * 64 + d4, 16), s[0], s[1], s[2], s[3]);
    }
  }
}


#define XB_TMO      128
#define XB_XCNT(j)  (256  + 64 * (j))
#define XB_XSUB(j)  (1280 + 64 * (j))
#define XB_XGEN(j)  (2304 + 64 * (j))
#define XB_TOP      3328
#define XB_TOPGEN   3392
#define XCD_BAR_WORDS 3456
#define XB_SPIN_CAP (1u << 18)
#define LAS __attribute__((address_space(3)))
DI unsigned xb_ld(unsigned* p) { return __hip_atomic_load(p, __ATOMIC_RELAXED, __HIP_MEMORY_SCOPE_AGENT); }
DI unsigned xb_add(unsigned* p, unsigned v) { return __hip_atomic_fetch_add(p, v, __ATOMIC_RELAXED, __HIP_MEMORY_SCOPE_AGENT); }
DI unsigned xb_xcc_id() { return (unsigned)__builtin_amdgcn_s_getreg((3 << 11) | 20) & 0xFu; }
#define XB_SPIN(cond, bar) do { unsigned _sp = 0; while (cond) { __builtin_amdgcn_s_sleep(1); \
    if ((++_sp & 255u) == 0u) { if (xb_ld(&(bar)[XB_TMO])) break; if (_sp > XB_SPIN_CAP) { atomicAdd(&(bar)[XB_TMO], 1u); break; } } } } while (0)
struct XcdBarrier { unsigned* bar; unsigned x; volatile LAS unsigned* st; };
DI XcdBarrier xcd_barrier_post(unsigned* bar, volatile LAS unsigned* st) {
  XcdBarrier b; b.bar = bar; b.x = xb_xcc_id(); b.st = st;
  if (threadIdx.x == 0) (void)xb_add(&bar[XB_XCNT(b.x)], 1u);
  return b;
}
DI void xcd_barrier_complete(unsigned* bar, unsigned x, unsigned& nloc, unsigned& nx) {
  const unsigned G = gridDim.x * gridDim.y * gridDim.z;
  unsigned sum, cnt, mine, sp = 0u;
  for (;;) {
    sum = 0u; cnt = 0u; mine = 0u;
#pragma unroll
    for (unsigned j = 0; j < 16; ++j) { const unsigned c = xb_ld(&bar[XB_XCNT(j)]); sum += c; cnt += (c > 0u) ? 1u : 0u; mine = (j == x) ? c : mine; }
    if (sum == G) break;
    __builtin_amdgcn_s_sleep(1);
    if ((++sp & 255u) == 0u) { if (xb_ld(&bar[XB_TMO])) break; if (sp > XB_SPIN_CAP) { atomicAdd(&bar[XB_TMO], 1u); break; } }
  }
  nloc = mine > 0u ? mine : 1u; nx = cnt > 0u ? cnt : 1u;
}
DI void xcd_barrier(const XcdBarrier& b) {
  asm volatile("s_waitcnt vmcnt(0)" ::: "memory");
  __syncthreads();
  if (threadIdx.x == 0) {
    unsigned* bar = b.bar;
    __builtin_amdgcn_s_waitcnt(0);
    unsigned nloc = b.st[0], nx = b.st[1];
    if (nloc == 0u) { xcd_barrier_complete(bar, b.x, nloc, nx); b.st[0] = nloc; b.st[1] = nx; }
    const unsigned old = xb_add(&bar[XB_XSUB(b.x)], 1u);
    const unsigned gen = old / nloc;
    if (old + 1u == (gen + 1u) * nloc) {
      __builtin_amdgcn_fence(__ATOMIC_RELEASE, "agent");
      asm volatile("s_waitcnt vmcnt(0)" ::: "memory");
      const unsigned og = xb_add(&bar[XB_TOP], 1u);
      const unsigned tg = og / nx;
      if (og + 1u == (tg + 1u) * nx) xb_add(&bar[XB_TOPGEN], 1u);
      else XB_SPIN(xb_ld(&bar[XB_TOPGEN]) == tg, bar);
      __builtin_amdgcn_fence(__ATOMIC_ACQUIRE, "agent");
      xb_add(&bar[XB_XGEN(b.x)], 1u);
      asm volatile("s_waitcnt vmcnt(0)" ::: "memory");
    } else {
      XB_SPIN(xb_ld(&bar[XB_XGEN(b.x)]) == gen, bar);
      __builtin_amdgcn_fence(__ATOMIC_ACQUIRE, "agent");
      asm volatile("s_waitcnt vmcnt(0)" ::: "memory");
    }
  }
  __syncthreads();
}

#ifdef ONLY_PHASE
#define PH_ON(n) ((n) == ONLY_PHASE)
#else
#define PH_ON(n) true
#endif
#define REP_PHASE -1
#define PHASE(n, ...) \
  if (PH_ON(n) && ph_lo <= (n) && (n) < ph_hi) { __VA_ARGS__ } \
  if ((n) == REP_PHASE) { cg::this_grid().sync(); { __VA_ARGS__ } } \
  if (ph_lo <= (n) && (n) + 1 < ph_hi) { if (ph_hi > 1000) cg::this_grid().sync(); else xcd_barrier(xb); }

__global__ void __launch_bounds__(256, 2) yoco_megakernel(KArgs ka, int ph_lo, int ph_hi) {
  __shared__ __attribute__((aligned(16))) char smem[SMEM_BYTES];
  Params p;
  fill_params(p, ka);
  __shared__ __attribute__((aligned(16))) unsigned xb_words[4];
  if (threadIdx.x < 4) xb_words[threadIdx.x] = 0u;
  __syncthreads();
  const XcdBarrier xb = xcd_barrier_post(p.bar, (volatile LAS unsigned*)xb_words);
  PHASE(0, phase_prep(p, smem);)
  PHASE(1, { ALPlain al{p.hb, 16}; EpiFoxIn ep{p}; gemm_phase(al, p.w_ain, 1024, 256, 25, ep, smem); })
  PHASE(2, phase_scan(p, smem);)
  PHASE(3, phase_fox(p, smem);)
  PHASE(4, { ALPlain al{p.ob, 16}; EpiResid<0> ep{p.x, p.out, p.hb, p.part}; gemm_phase(al, p.w_aout, 1024, 256, 8, ep, smem); })
  PHASE(5, { ALFfn al{p.hb}; EpiFfnUp ep{p.part, p.f_conv_w, p.f_conv_b, p.act}; gemm_phase(al, p.w_up0, 1024, 264, 44, ep, smem); })
  PHASE(6, { ALPlain al{p.act, 44}; EpiResid<1> ep{p.out, p.out, p.hb, p.part}; gemm_phase(al, p.w_dn0, FF, 256, 8, ep, smem); })
  PHASE(7, {
    ALPlain al{p.hb, 16};
    { EpiKv ep{p}; gemm_phase(al, p.w_kv, 1024, 256, 6, ep, smem); }
    { EpiBIn ep{p}; gemm_phase(al, p.w_bin, 1024, 256, 9, ep, smem); }
  })
  PHASE(8, {
    for (int item = blockIdx.x; item < 512; item += gridDim.x) {
      const int sel = item & 1, ks4 = (item >> 1) & 3, nt = (item >> 3) & 1, mt = item >> 4;
      ALCmp1 al{p.rawc + (size_t)sel * 8 * T_ * 64, sel ? p.vc_pe : p.kc_pe};
      EpiCmp1P ep{p.hidp + (size_t)(sel * 4 + ks4) * 4096 * 256};
      gemm_tile(al, sel ? p.w_vc1 : p.w_kc1, 2048, mt, nt, ep, smem, ks4 * 8, 8);
    }
  })
  PHASE(9, {
    for (int item = blockIdx.x; item < 64; item += gridDim.x) {
      const int sel = item & 1, mt = item >> 1;
      ALCmp2P al{p.hidp + (size_t)sel * 4 * 4096 * 256};
      EpiCmp2 ep{p, sel};
      gemm_tile(al, sel ? p.w_vc2 : p.w_kc2, 256, mt, 0, ep, smem);
    }
  })
  PHASE(10, phase_nsa(p, smem);)
  PHASE(11, { ALPlain al{p.ob, 16}; EpiResid<1> ep{p.out, p.out, p.hb, p.part}; gemm_phase(al, p.w_bout, 1024, 256, 8, ep, smem); })
  PHASE(12, { ALFfn al{p.hb}; EpiFfnUp ep{p.part, p.f_conv_w + 3 * 5632, p.f_conv_b + 5632, p.act}; gemm_phase(al, p.w_up1, 1024, 264, 44, ep, smem); })
  PHASE(13, { ALPlain al{p.act, 44}; EpiResid<2> ep{p.out, p.out, p.hb, p.part}; gemm_phase(al, p.w_dn1, FF, 256, 8, ep, smem); })
}

extern "C" void kernel_launch(void* const* d_in, const int* in_sizes, int n_in, void* d_out, int out_size, void* d_ws, size_t ws_size, hipStream_t stream) {
  KArgs p{};
  for (int i = 0; i < 29; ++i) p.in[i] = d_in[i];
  p.out = (float*)d_out; p.ws = (char*)d_ws;
  hipMemsetAsync(d_ws, 0, 16384, stream);
  static int grid_blocks = 0;
  if (!grid_blocks) {
    int dev = 0, cus = 0, per_cu = 0;
    hipGetDevice(&dev);
    hipDeviceGetAttribute(&cus, hipDeviceAttributeMultiprocessorCount, dev);
    hipOccupancyMaxActiveBlocksPerMultiprocessor(&per_cu, yoco_megakernel, 256, 0);
    if (per_cu > 2) per_cu = 2;
    if (per_cu < 1) per_cu = 1;
    grid_blocks = cus * per_cu;
    grid_blocks &= ~7;
  }
#if N_LAUNCH_SPLIT
  for (int ph = 0; ph < NPHASE; ++ph) {
    int lo = ph, hi = ph + 1;
    hipLaunchKernelGGL(yoco_megakernel, dim3(grid_blocks), dim3(256), 0, stream, p, lo, hi);
  }
#else
  int lo = 0, hi = NPHASE;
  void* args[] = {&p, &lo, &hi};
  hipError_t e = hipLaunchCooperativeKernel((void*)yoco_megakernel, dim3(grid_blocks), dim3(256), args, 0, stream);
  if (e != hipSuccess) fprintf(stderr, "cooperative launch failed: %s (grid %d)\n", hipGetErrorString(e), grid_blocks);
#endif
}
```

```cpp
#include <hip/hip_runtime.h>
#include <hip/hip_cooperative_groups.h>
#include <stdint.h>
#include <cstdio>
namespace cg = cooperative_groups;

#ifndef N_LAUNCH_SPLIT
#define N_LAUNCH_SPLIT 0
#endif

#define DI __device__ __forceinline__
typedef unsigned short bf16_t;
typedef short bf16x8 __attribute__((ext_vector_type(8)));
typedef short bf16x4 __attribute__((ext_vector_type(4)));
typedef float f32x16 __attribute__((ext_vector_type(16)));
typedef float f32x4 __attribute__((ext_vector_type(4)));
typedef unsigned u32x4 __attribute__((ext_vector_type(4)));
typedef unsigned u32x2 __attribute__((ext_vector_type(2)));

constexpr int T_ = 8192;
constexpr int NTOK = 32768;
constexpr int FF = 2816;
constexpr int NPHASE = 14;
constexpr int SMEM_BYTES = 73728;

struct Params {
  const float* x; const int* pos;
  const float *a_norm, *a_w_in, *a_b_f, *a_q_gain, *a_k_gain, *a_w_out;
  const float *kv_norm, *kv_w, *kc_pe, *vc_pe, *kc_w1, *kc_w2, *vc_w1, *vc_w2, *kc_gain, *ks_gain, *kw_gain;
  const float *b_norm, *b_w_in, *b_b_gate, *b_q_gain, *b_w_out;
  const float *f_norm, *f_w_up, *f_conv_w, *f_conv_b, *f_w_down;
  float* out;
  bf16_t *w_ain, *w_aout, *w_kv, *w_kc1, *w_vc1, *w_kc2, *w_vc2, *w_bin, *w_bout, *w_up0, *w_up1, *w_dn0, *w_dn1;
  bf16_t* hb; float* part; float* lf; float* cc; bf16_t* ob;
  bf16_t *qb, *kb, *vT; bf16_t* act;
  bf16_t *rawc, *ksb, *vsT, *kwb, *vwT, *qn; float* gates; bf16_t *hid, *kcb, *vcT; float* hidp; unsigned* bar;
};

typedef __bf16 bf16v2 __attribute__((ext_vector_type(2)));
typedef float f32x2 __attribute__((ext_vector_type(2)));
struct KArgs { const void* in[29]; float* out; char* ws; };
DI void fill_params(Params& p, const KArgs& ka) {
  p.x = (const float*)ka.in[0]; p.pos = (const int*)ka.in[1];
  p.a_norm = (const float*)ka.in[2]; p.a_w_in = (const float*)ka.in[3]; p.a_b_f = (const float*)ka.in[4]; p.a_q_gain = (const float*)ka.in[5];
  p.a_k_gain = (const float*)ka.in[6]; p.a_w_out = (const float*)ka.in[7]; p.kv_norm = (const float*)ka.in[8]; p.kv_w = (const float*)ka.in[9];
  p.kc_pe = (const float*)ka.in[10]; p.vc_pe = (const float*)ka.in[11]; p.kc_w1 = (const float*)ka.in[12]; p.kc_w2 = (const float*)ka.in[13];
  p.vc_w1 = (const float*)ka.in[14]; p.vc_w2 = (const float*)ka.in[15]; p.kc_gain = (const float*)ka.in[16]; p.ks_gain = (const float*)ka.in[17];
  p.kw_gain = (const float*)ka.in[18]; p.b_norm = (const float*)ka.in[19]; p.b_w_in = (const float*)ka.in[20]; p.b_b_gate = (const float*)ka.in[21];
  p.b_q_gain = (const float*)ka.in[22]; p.b_w_out = (const float*)ka.in[23]; p.f_norm = (const float*)ka.in[24]; p.f_w_up = (const float*)ka.in[25];
  p.f_conv_w = (const float*)ka.in[26]; p.f_conv_b = (const float*)ka.in[27]; p.f_w_down = (const float*)ka.in[28];
  p.out = ka.out;
  char* wsq = ka.ws;
#define TAKE(bytes) (wsq += (((size_t)(bytes)) + 255) & ~(size_t)255, wsq - ((((size_t)(bytes)) + 255) & ~(size_t)255))
  p.bar = (unsigned*)TAKE(16384);
  p.w_ain = (bf16_t*)TAKE((size_t)3200 * 1024 * 2); p.w_aout = (bf16_t*)TAKE((size_t)1024 * 1024 * 2); p.w_kv = (bf16_t*)TAKE((size_t)768 * 1024 * 2);
  p.w_kc1 = (bf16_t*)TAKE((size_t)256 * 2048 * 2); p.w_vc1 = (bf16_t*)TAKE((size_t)256 * 2048 * 2);
  p.w_kc2 = (bf16_t*)TAKE((size_t)128 * 256 * 2); p.w_vc2 = (bf16_t*)TAKE((size_t)128 * 256 * 2);
  p.w_bin = (bf16_t*)TAKE((size_t)1152 * 1024 * 2); p.w_bout = (bf16_t*)TAKE((size_t)1024 * 1024 * 2);
  p.w_up0 = (bf16_t*)TAKE((size_t)5632 * 1024 * 2); p.w_up1 = (bf16_t*)TAKE((size_t)5632 * 1024 * 2);
  p.w_dn0 = (bf16_t*)TAKE((size_t)1024 * FF * 2); p.w_dn1 = (bf16_t*)TAKE((size_t)1024 * FF * 2);
  p.hb = (bf16_t*)TAKE((size_t)NTOK * 1024 * 2); p.part = (float*)TAKE((size_t)NTOK * 16 * 4);
  p.lf = (float*)TAKE((size_t)64 * T_ * 4); p.cc = (float*)TAKE((size_t)64 * T_ * 4);
  p.ob = (bf16_t*)TAKE((size_t)NTOK * 1024 * 2);
  char* R = TAKE((size_t)NTOK * 1024 * 2 * 3);
#undef TAKE
  p.qb = (bf16_t*)R; p.kb = p.qb + (size_t)NTOK * 1024; p.vT = p.kb + (size_t)NTOK * 1024;
  p.act = (bf16_t*)R;
  {
    char* q = R;
    p.qn = (bf16_t*)q; q += (size_t)NTOK * 1024 * 2;
    p.rawc = (bf16_t*)q; q += (size_t)2 * 8 * T_ * 64 * 2;
    p.ksb = (bf16_t*)q; q += (size_t)8 * T_ * 64 * 2;
    p.vsT = (bf16_t*)q; q += (size_t)8 * T_ * 64 * 2;
    p.kwb = (bf16_t*)q; q += (size_t)8 * T_ * 64 * 2;
    p.vwT = (bf16_t*)q; q += (size_t)8 * T_ * 64 * 2;
    p.gates = (float*)q; q += (size_t)NTOK * 48 * 4;
    p.hid = (bf16_t*)q; q += (size_t)2 * 4096 * 256 * 2;
    p.kcb = (bf16_t*)q; q += (size_t)8 * 512 * 64 * 2;
    p.vcT = (bf16_t*)q; q += (size_t)8 * 64 * 512 * 2;
    p.hidp = (float*)q; q += (size_t)2 * 4 * 4096 * 256 * 4;
  }
}

DI bf16_t f2bf(float x) { return __builtin_bit_cast(bf16_t, (__bf16)x); }
DI unsigned pack2(float a, float b) { f32x2 v = {a, b}; return __builtin_bit_cast(unsigned, __builtin_convertvector(v, bf16v2)); }
DI float bf2f(bf16_t v) { return __uint_as_float(((unsigned)v) << 16); }
DI int crow(int i, int h) { return (i & 3) + 8 * (i >> 2) + 4 * h; }
DI f32x16 mfma32(bf16x8 a, bf16x8 b, f32x16 c) { return __builtin_amdgcn_mfma_f32_32x32x16_bf16(a, b, c, 0, 0, 0); }
DI f32x4 mfma16(bf16x8 a, bf16x8 b, f32x4 c) { return __builtin_amdgcn_mfma_f32_16x16x32_bf16(a, b, c, 0, 0, 0); }
DI float row_rstd(const float* part, int row) {
  const f32x4* q = (const f32x4*)(part + (size_t)row * 16);
  f32x4 a = q[0], b = q[1], c = q[2], d = q[3];
  float s = ((a.x + a.y) + (a.z + a.w)) + ((b.x + b.y) + (b.z + b.w)) + ((c.x + c.y) + (c.z + c.w)) + ((d.x + d.y) + (d.z + d.w));
  return rsqrtf(s * (1.0f / 1024.0f) + 1e-6f);
}
DI size_t a_off(int row, int k, int KB) { return (((size_t)((row >> 7) * KB + (k >> 6))) << 13) + ((row & 127) << 6) + (k & 63); }
DI void store_bf4(bf16_t* dst, float a, float b, float c, float d) { u32x2 v; v.x = pack2(a, b); v.y = pack2(c, d); *(u32x2*)dst = v; }

struct WJob { const float* src; bf16_t* dst; const float* gain; int K, Nsrc, Ndst, mode; };
DI WJob get_job(const Params& p, int j) {
  WJob w; w.gain = nullptr; w.mode = 0;
  switch (j) {
    case 0: w.src = p.a_w_in; w.dst = p.w_ain; w.gain = p.a_norm; w.K = 1024; w.Nsrc = 3088; w.Ndst = 3200; break;
    case 1: w.src = p.a_w_out; w.dst = p.w_aout; w.K = 1024; w.Nsrc = 1024; w.Ndst = 1024; break;
    case 2: w.src = p.kv_w; w.dst = p.w_kv; w.gain = p.kv_norm; w.K = 1024; w.Nsrc = 768; w.Ndst = 768; break;
    case 3: w.src = p.kc_w1; w.dst = p.w_kc1; w.K = 2048; w.Nsrc = 256; w.Ndst = 256; break;
    case 4: w.src = p.vc_w1; w.dst = p.w_vc1; w.K = 2048; w.Nsrc = 256; w.Ndst = 256; break;
    case 5: w.src = p.kc_w2; w.dst = p.w_kc2; w.K = 256; w.Nsrc = 64; w.Ndst = 128; break;
    case 6: w.src = p.vc_w2; w.dst = p.w_vc2; w.K = 256; w.Nsrc = 64; w.Ndst = 128; break;
    case 7: w.src = p.b_w_in; w.dst = p.w_bin; w.gain = p.b_norm; w.K = 1024; w.Nsrc = 1072; w.Ndst = 1152; break;
    case 8: w.src = p.b_w_out; w.dst = p.w_bout; w.K = 1024; w.Nsrc = 1024; w.Ndst = 1024; break;
    case 9: w.src = p.f_w_up; w.dst = p.w_up0; w.gain = p.f_norm; w.K = 1024; w.Nsrc = 5632; w.Ndst = 5632; w.mode = 1; break;
    case 10: w.src = p.f_w_up + (size_t)1024 * 5632; w.dst = p.w_up1; w.gain = p.f_norm + 1024; w.K = 1024; w.Nsrc = 5632; w.Ndst = 5632; w.mode = 1; break;
    case 11: w.src = p.f_w_down; w.dst = p.w_dn0; w.K = 2816; w.Nsrc = 1024; w.Ndst = 1024; break;
    default: w.src = p.f_w_down + (size_t)2816 * 1024; w.dst = p.w_dn1; w.K = 2816; w.Nsrc = 1024; w.Ndst = 1024; break;
  }
  return w;
}

DI void prep_load(const WJob& w, int t, int nkt, int tid, f32x4 (&v)[4], int& k0, int& n0d) {
  const int kt = t % nkt, nt = t / nkt;
  k0 = kt << 6; n0d = nt << 6;
  int sbase = n0d;
  if (w.mode == 1) { const int tile = n0d >> 7, half = (n0d >> 6) & 1; sbase = half * FF + tile * 64; }
#pragma unroll
  for (int i = 0; i < 4; ++i) {
    const int kk = (tid >> 4) + 16 * i, col = sbase + (tid & 15) * 4;
    v[i] = (f32x4){0.f, 0.f, 0.f, 0.f};
    if (col < w.Nsrc) v[i] = __builtin_nontemporal_load((const f32x4*)(w.src + (size_t)(k0 + kk) * w.Nsrc + col));
    const float g = w.gain ? w.gain[k0 + kk] : 1.0f;
    v[i] *= g;
  }
}
DI void prep_lds(float* sT, const f32x4 (&v)[4], int tid) {
#pragma unroll
  for (int i = 0; i < 4; ++i) {
    const int kk = (tid >> 4) + 16 * i, nn = (tid & 15) * 4;
    sT[kk * 65 + nn + 0] = v[i].x; sT[kk * 65 + nn + 1] = v[i].y; sT[kk * 65 + nn + 2] = v[i].z; sT[kk * 65 + nn + 3] = v[i].w;
  }
}
DI void prep_out(const float* sT, const WJob& w, int k0, int n0d, int nkt, int tid) {
  const int n = tid >> 2, kseg = (tid & 3) * 16;
  unsigned o[8];
#pragma unroll
  for (int q = 0; q < 8; ++q) o[q] = pack2(sT[(kseg + 2 * q) * 65 + n], sT[(kseg + 2 * q + 1) * 65 + n]);
  u32x4* dst = (u32x4*)(w.dst + a_off(n0d + n, k0 + kseg, nkt));
  dst[0] = (u32x4){o[0], o[1], o[2], o[3]}; dst[1] = (u32x4){o[4], o[5], o[6], o[7]};
}

DI void phase_prep(const Params& p, char* smem) {
  float* sT0 = (float*)smem;
  float* sT1 = sT0 + 64 * 65;
  const int tid = threadIdx.x;
  {
    const int lane = tid & 63, gw = blockIdx.x * 4 + (tid >> 6), nw = gridDim.x * 4;
    for (int row0 = gw * 4; row0 < NTOK; row0 += nw * 4) {
      f32x4 v[4][4];
#pragma unroll
      for (int rr = 0; rr < 4; ++rr)
#pragma unroll
        for (int i = 0; i < 4; ++i) v[rr][i] = __builtin_nontemporal_load((const f32x4*)(p.x + (size_t)(row0 + rr) * 1024 + i * 256 + lane * 4));
#pragma unroll
      for (int rr = 0; rr < 4; ++rr) {
        const int row = row0 + rr;
        float ss = 0.f;
#pragma unroll
        for (int i = 0; i < 4; ++i) {
          const f32x4 x = v[rr][i];
          ss += x.x * x.x + x.y * x.y + x.z * x.z + x.w * x.w;
          store_bf4(p.hb + a_off(row, i * 256 + lane * 4, 16), x.x, x.y, x.z, x.w);
        }
#pragma unroll
        for (int o = 32; o >= 1; o >>= 1) ss += __shfl_xor(ss, o);
        if (lane < 16) p.part[(size_t)row * 16 + lane] = lane == 0 ? ss : 0.f;
      }
    }
  }
  {
    int tstart[14];
    tstart[0] = 0;
#pragma unroll
    for (int j = 0; j < 13; ++j) { const WJob w = get_job(p, j); tstart[j + 1] = tstart[j] + (w.K >> 6) * (w.Ndst >> 6); }
    const int total = tstart[13], G = gridDim.x;
    auto find_job = [&](int g) { int j = 0;
#pragma unroll
      for (int q = 1; q < 13; ++q) j += (g >= tstart[q]) ? 1 : 0;
      return j; };
    auto job_base = [&](int j) { int r = 0;
#pragma unroll
      for (int q = 0; q < 13; ++q) r = (q == j) ? tstart[q] : r;
      return r; };
    f32x4 va[4], vb[4]; int k0a = 0, n0a = 0, k0b = 0, n0b = 0, ja = 0, jb = 0;
    int g = blockIdx.x;
    if (g < total) { ja = find_job(g); const WJob w = get_job(p, ja); prep_load(w, g - job_base(ja), w.K >> 6, tid, va, k0a, n0a); }
    for (; g < total; g += G) {
      const int gn = g + G;
      if (gn < total) { jb = find_job(gn); const WJob w = get_job(p, jb); prep_load(w, gn - job_base(jb), w.K >> 6, tid, vb, k0b, n0b); }
      __syncthreads();
      prep_lds(sT0, va, tid);
      __syncthreads();
      { const WJob w = get_job(p, ja); prep_out(sT0, w, k0a, n0a, w.K >> 6, tid); }
#pragma unroll
      for (int i = 0; i < 4; ++i) va[i] = vb[i];
      k0a = k0b; n0a = n0b; ja = jb;
    }
  }
  if (blockIdx.x == 0) {
    for (int i = tid; i < 8 * 64; i += 256) {
      const int bg = i >> 6, d = i & 63;
      p.kcb[((size_t)bg * 512 + 511) * 64 + d] = 0;
      p.vcT[((size_t)(bg * 8 + 7) * 64 + d) * 64 + 63] = 0;
    }
  }
}

template <class AL, class EP>
DI void gemm_tile(const AL& al, const bf16_t* __restrict__ Wt, int K, int mt, int nt, const EP& ep, char* smem, int kb0 = 0, int KBn = -1) {
  bf16_t* sbuf = (bf16_t*)smem;
  constexpr int STAGE = 2 * 128 * 72;
  const int tid = threadIdx.x, lane = tid & 63, wave = tid >> 6, wr = wave >> 1, wc = wave & 1, r = lane & 31, h = lane >> 5;
  const int KBt = K >> 6, KB = KBn < 0 ? KBt : KBn;
  const bf16_t* wbase = Wt + (((size_t)nt * KBt + kb0) << 13) + tid * 8;
  f32x16 acc[2][2];
#pragma unroll
  for (int a = 0; a < 2; ++a)
#pragma unroll
    for (int b = 0; b < 2; ++b)
#pragma unroll
      for (int i = 0; i < 16; ++i) acc[a][b][i] = 0.f;
  u32x4 xa[4], wa[4];
#define GEMM_LOAD(kb_)                                                                  \
  _Pragma("unroll") for (int i = 0; i < 4; ++i) {                                        \
    const int c = tid + 256 * i;                                                         \
    xa[i] = al(mt, c >> 3, (kb0 + (kb_)) * 64 + (c & 7) * 8);                                    \
    wa[i] = *(const u32x4*)(wbase + ((size_t)(kb_) << 13) + 2048 * i);                   \
  }
#define GEMM_STORE(st_)                                                                 \
  _Pragma("unroll") for (int i = 0; i < 4; ++i) {                                        \
    const int c = tid + 256 * i, row = c >> 3, kc = (c & 7) * 8;                         \
    *(u32x4*)(sbuf + (st_) * STAGE + row * 72 + kc) = xa[i];                             \
    *(u32x4*)(sbuf + (st_) * STAGE + 128 * 72 + row * 72 + kc) = wa[i];                  \
  }
#define GEMM_LDF(FW, FX, st_, ks_)                                                      \
  _Pragma("unroll") for (int q = 0; q < 2; ++q) {                                        \
    FW[q] = *(const bf16x8*)(sbuf + (st_) * STAGE + 128 * 72 + (64 * wc + 32 * q + r) * 72 + 16 * (ks_) + 8 * h); \
    FX[q] = *(const bf16x8*)(sbuf + (st_) * STAGE + (64 * wr + 32 * q + r) * 72 + 16 * (ks_) + 8 * h);            \
  }
#define GEMM_MM(FW, FX)                                                                 \
  _Pragma("unroll") for (int ms = 0; ms < 2; ++ms)                                       \
    _Pragma("unroll") for (int ns = 0; ns < 2; ++ns) acc[ms][ns] = mfma32(FW[ns], FX[ms], acc[ms][ns]);
  bf16x8 faw[2], fax[2], fbw[2], fbx[2];
  __syncthreads();
  GEMM_LOAD(0)
  GEMM_STORE(0)
  if (KB > 1) { GEMM_LOAD(1) }
  __syncthreads();
  GEMM_LDF(faw, fax, 0, 0)
  for (int it = 0; it < KB; ++it) {
    const int cur = it & 1;
    if (it + 1 < KB) { GEMM_STORE(cur ^ 1) }
    if (it + 2 < KB) { GEMM_LOAD(it + 2) }
    __builtin_amdgcn_sched_barrier(0);
    GEMM_LDF(fbw, fbx, cur, 1)
    __builtin_amdgcn_sched_barrier(0);
    GEMM_MM(faw, fax)
    __builtin_amdgcn_sched_barrier(0);
    GEMM_LDF(faw, fax, cur, 2)
    __builtin_amdgcn_sched_barrier(0);
    GEMM_MM(fbw, fbx)
    __builtin_amdgcn_sched_barrier(0);
    GEMM_LDF(fbw, fbx, cur, 3)
    __builtin_amdgcn_sched_barrier(0);
    GEMM_MM(faw, fax)
    __builtin_amdgcn_sched_barrier(0);
    __syncthreads();
    if (it + 1 < KB) { GEMM_LDF(faw, fax, cur ^ 1, 0) }
    __builtin_amdgcn_sched_barrier(0);
    GEMM_MM(fbw, fbx)
    __builtin_amdgcn_sched_barrier(0);
  }
#undef GEMM_LDF
#undef GEMM_MM
#undef GEMM_LOAD
#undef GEMM_STORE
  ep(acc, mt, nt, wr, wc, lane, smem);
}

template <class AL, class EP>
DI void gemm_phase(const AL& al, const bf16_t* Wt, int K, int numM, int numN, const EP& ep, char* smem) {
  const int xcd = blockIdx.x & 7, lb = blockIdx.x >> 3, nlb = gridDim.x >> 3;
  const int mper = (numM + 7) >> 3, fullr = mper >> 3, mrem = mper & 7;
  const int nfull = fullr * 8 * numN, total = mper * numN;
  for (int li = lb; li < total; li += nlb) {
    int nt, mtl;
    if (li < nfull) { const int s = li / (8 * numN), rem = li - s * 8 * numN; nt = rem >> 3; mtl = s * 8 + (rem & 7); }
    else { const int rem = li - nfull; nt = rem / mrem; mtl = fullr * 8 + (rem - nt * mrem); }
    const int mt = xcd * mper + mtl;
    if (mt >= numM) continue;
    gemm_tile(al, Wt, K, mt, nt, ep, smem);
  }
}

struct ALPlain { const bf16_t* A; int KB; DI u32x4 operator()(int mt, int ml, int k) const { return *(const u32x4*)(A + (((size_t)(mt * KB + (k >> 6))) << 13) + (ml << 6) + (k & 63)); } };
struct ALFfn {
  const bf16_t* A;
  DI u32x4 operator()(int mt, int ml, int k) const {
    const int b = mt / 66, it = mt - b * 66, t = 126 * it - 2 + ml;
    if (t < 0 || t >= T_) return (u32x4){0, 0, 0, 0};
    return *(const u32x4*)(A + a_off(b * T_ + t, k, 16));
  }
};
struct ALCmp1 {
  const bf16_t* raw; const float* pe;
  DI u32x4 operator()(int mt, int ml, int k) const {
    const int m = mt * 128 + ml;
    if (m >= 4088) return (u32x4){0, 0, 0, 0};
    const int bg = m / 511, n = m - bg * 511;
    u32x4 v = *(const u32x4*)(raw + ((size_t)bg * T_ + 16 * n) * 64 + k);
    const f32x4 p0 = *(const f32x4*)(pe + k), p1 = *(const f32x4*)(pe + k + 4);
    u32x4 o;
    o.x = pack2(bf2f((bf16_t)(v.x & 0xffff)) + p0.x, bf2f((bf16_t)(v.x >> 16)) + p0.y);
    o.y = pack2(bf2f((bf16_t)(v.y & 0xffff)) + p0.z, bf2f((bf16_t)(v.y >> 16)) + p0.w);
    o.z = pack2(bf2f((bf16_t)(v.z & 0xffff)) + p1.x, bf2f((bf16_t)(v.z >> 16)) + p1.y);
    o.w = pack2(bf2f((bf16_t)(v.w & 0xffff)) + p1.z, bf2f((bf16_t)(v.w >> 16)) + p1.w);
    return o;
  }
};
struct ALCmp2 { const bf16_t* A; DI u32x4 operator()(int mt, int ml, int k) const { const int m = mt * 128 + ml; if (m >= 4088) return (u32x4){0, 0, 0, 0}; return *(const u32x4*)(A + (size_t)m * 256 + k); } };

__device__ const float ROPE_INV[8] = {1.0f, 0.19392274474868576f, 0.03760603093086393f, 0.007292664737217109f, 0.001414213562373095f, 0.0002742481756762073f, 5.318295896944988e-05f, 1.031338537721246e-05f};

template <bool ROPE>
DI void norm_store(f32x16 (&a)[2], float rs, const float* gain, int pos, bf16_t* dst, int h) {
  float ss = 0.f;
#pragma unroll
  for (int ns = 0; ns < 2; ++ns)
#pragma unroll
    for (int i = 0; i < 16; ++i) { const float v = a[ns][i] * rs; a[ns][i] = v; ss += v * v; }
  ss += __shfl_xor(ss, 32);
  const float inv = rsqrtf(ss * (1.0f / 64.0f) + 1e-6f);
#pragma unroll
  for (int ns = 0; ns < 2; ++ns)
#pragma unroll
    for (int i = 0; i < 16; ++i) a[ns][i] = a[ns][i] * inv * gain[32 * ns + crow(i, h)];
  if (ROPE) {
    const float fp = (float)pos;
#pragma unroll
    for (int ii = 0; ii < 4; ++ii) {
      const float ang = fp * ROPE_INV[4 * h + ii];
      const float c = cosf(ang), s = sinf(ang);
      const float x1 = a[0][ii], x2 = a[0][4 + ii];
      a[0][ii] = x1 * c - x2 * s; a[0][4 + ii] = x2 * c + x1 * s;
    }
  }
#pragma unroll
  for (int ns = 0; ns < 2; ++ns)
#pragma unroll
    for (int q = 0; q < 4; ++q) store_bf4(dst + 32 * ns + 8 * q + 4 * h, a[ns][4 * q], a[ns][4 * q + 1], a[ns][4 * q + 2], a[ns][4 * q + 3]);
}

struct EpiFoxIn {
  const Params& p;
  DI void operator()(f32x16 (&acc)[2][2], int mt, int nt, int wr, int wc, int lane, char*) const {
    const int r = lane & 31, h = lane >> 5, nb = nt * 128 + 64 * wc;
#pragma unroll
    for (int ms = 0; ms < 2; ++ms) {
      const int row = mt * 128 + 64 * wr + 32 * ms + r;
      const float rs = row_rstd(p.part, row);
      const int b = row >> 13, t = row & 8191;
      if (nb < 2048) {
        const bool isq = nb < 1024;
        norm_store<false>(acc[ms], rs, isq ? p.a_q_gain : p.a_k_gain, 0, (isq ? p.qb : p.kb) + ((size_t)(b * 16 + ((nb & 1023) >> 6)) * T_ + t) * 64, h);
      } else if (nb < 3072) {
        const int head = (nb - 2048) >> 6;
        bf16_t* dst = p.vT + ((size_t)((b * 16 + head) * 128 + (t >> 6))) * 4096 + (t & 63);
#pragma unroll
        for (int ns = 0; ns < 2; ++ns)
#pragma unroll
          for (int i = 0; i < 16; ++i) dst[(32 * ns + crow(i, h)) * 64] = f2bf(acc[ms][ns][i] * rs);
      } else if (nb == 3072) {
#pragma unroll
        for (int i = 0; i < 8; ++i) {
          const int head = crow(i, h);
          const float z = acc[ms][0][i] * rs + p.a_b_f[head];
          p.lf[((size_t)(b * 16 + head)) * T_ + t] = fminf(z, 0.f) - log1pf(expf(-fabsf(z)));
        }
      }
    }
  }
};

template <int MODE>
struct EpiResid {
  const float* res; float* out; bf16_t* hb; float* part;
  DI void operator()(f32x16 (&acc)[2][2], int mt, int nt, int wr, int wc, int lane, char* smem) const {
    float* sU = (float*)smem;
    const int r = lane & 31, h = lane >> 5, tid = threadIdx.x;
    __syncthreads();
#pragma unroll
    for (int ms = 0; ms < 2; ++ms) {
      const int ml = 64 * wr + 32 * ms + r;
#pragma unroll
      for (int ns = 0; ns < 2; ++ns)
#pragma unroll
        for (int i = 0; i < 16; ++i) sU[ml * 132 + 64 * wc + 32 * ns + crow(i, h)] = acc[ms][ns][i];
    }
    __syncthreads();
    const int c4 = (tid & 31) * 4, n = nt * 128 + c4;
#pragma unroll 1
    for (int hh = 0; hh < 2; ++hh) {
      f32x4 rv[8];
#pragma unroll
      for (int it = 0; it < 8; ++it) {
        const int row = mt * 128 + (hh * 8 + it) * 8 + (tid >> 5);
        if (MODE == 0) rv[it] = __builtin_nontemporal_load((const f32x4*)(res + (size_t)row * 1024 + n));
        else {
          const u32x2 v = *(const u32x2*)(hb + a_off(row, n, 16));
          rv[it] = (f32x4){bf2f((bf16_t)(v.x & 0xffff)), bf2f((bf16_t)(v.x >> 16)), bf2f((bf16_t)(v.y & 0xffff)), bf2f((bf16_t)(v.y >> 16))};
        }
      }
#pragma unroll
      for (int it = 0; it < 8; ++it) {
        const int rl = (hh * 8 + it) * 8 + (tid >> 5), row = mt * 128 + rl;
        const f32x4 o = rv[it] + *(const f32x4*)(sU + rl * 132 + c4);
        if (MODE == 2) __builtin_nontemporal_store(o, (f32x4*)(out + (size_t)row * 1024 + n));
        else {
          store_bf4(hb + a_off(row, n, 16), o.x, o.y, o.z, o.w);
          float ss = o.x * o.x + o.y * o.y + o.z * o.z + o.w * o.w;
          ss += __shfl_xor(ss, 1); ss += __shfl_xor(ss, 2); ss += __shfl_xor(ss, 4); ss += __shfl_xor(ss, 8); ss += __shfl_xor(ss, 16);
          if ((tid & 31) == 0) { part[(size_t)row * 16 + nt * 2] = ss; part[(size_t)row * 16 + nt * 2 + 1] = 0.f; }
        }
      }
    }
  }
};

struct EpiFfnUp {
  const float* part; const float* cw; const float* cb; bf16_t* act;
  DI void operator()(f32x16 (&acc)[2][2], int mt, int nt, int wr, int wc, int lane, char* smem) const {
    float* sU = (float*)smem;
    const int r = lane & 31, h = lane >> 5, tid = threadIdx.x;
    const int b = mt / 66, it = mt - b * 66, tb = 126 * it - 2;
    __syncthreads();
#pragma unroll
    for (int ms = 0; ms < 2; ++ms) {
      const int ml = 64 * wr + 32 * ms + r, t = tb + ml;
      const float rs = (t >= 0 && t < T_) ? row_rstd(part, b * T_ + t) : 0.f;
#pragma unroll
      for (int ns = 0; ns < 2; ++ns)
#pragma unroll
        for (int i = 0; i < 16; ++i) sU[ml * 129 + 64 * wc + 32 * ns + crow(i, h)] = acc[ms][ns][i] * rs;
    }
    __syncthreads();
    const int jj = tid & 63, rg = tid >> 6, j = nt * 64 + jj;
    const float wg0 = cw[j], wg1 = cw[5632 + j], wg2 = cw[2 * 5632 + j], bgt = cb[j];
    const float wv0 = cw[FF + j], wv1 = cw[5632 + FF + j], wv2 = cw[2 * 5632 + FF + j], bvl = cb[FF + j];
    {
      const int m_lo = rg == 0 ? 2 : 32 * rg, m_hi = 32 * rg + 32;
      float g0 = sU[(m_lo - 2) * 129 + jj], g1 = sU[(m_lo - 1) * 129 + jj];
      float v0 = sU[(m_lo - 2) * 129 + 64 + jj], v1 = sU[(m_lo - 1) * 129 + 64 + jj];
      for (int ml = m_lo; ml < m_hi; ++ml) {
        const int t = tb + ml;
        if (t >= T_) break;
        const float g2 = sU[ml * 129 + jj], v2 = sU[ml * 129 + 64 + jj];
        const float g = bgt + wg0 * g0 + wg1 * g1 + wg2 * g2;
        const float v = bvl + wv0 * v0 + wv1 * v1 + wv2 * v2;
        const float a = g * __builtin_amdgcn_rcpf(1.0f + __expf(-g)) * v;
        act[a_off(b * T_ + t, j, 44)] = f2bf(a);
        g0 = g1; g1 = g2; v0 = v1; v1 = v2;
      }
    }
  }
};

struct EpiKv {
  const Params& p;
  DI void operator()(f32x16 (&acc)[2][2], int mt, int nt, int wr, int wc, int lane, char*) const {
    const int r = lane & 31, h = lane >> 5, g = wc;
#pragma unroll
    for (int ms = 0; ms < 2; ++ms) {
      const int row = mt * 128 + 64 * wr + 32 * ms + r;
      const float rs = row_rstd(p.part, row);
      const int b = row >> 13, t = row & 8191, bg = b * 2 + g;
      if (nt < 2) {
        bf16_t* dst = p.rawc + (((size_t)(nt * 8 + bg)) * T_ + t) * 64;
#pragma unroll
        for (int ns = 0; ns < 2; ++ns)
#pragma unroll
          for (int q = 0; q < 4; ++q)
            store_bf4(dst + 32 * ns + 8 * q + 4 * h, acc[ms][ns][4 * q] * rs, acc[ms][ns][4 * q + 1] * rs, acc[ms][ns][4 * q + 2] * rs, acc[ms][ns][4 * q + 3] * rs);
      } else if (nt == 2 || nt == 4) {
        norm_store<true>(acc[ms], rs, nt == 2 ? p.ks_gain : p.kw_gain, p.pos[row], (nt == 2 ? p.ksb : p.kwb) + ((size_t)bg * T_ + t) * 64, h);
      } else if (nt == 3) {
        bf16_t* dst = p.vsT + ((size_t)bg * 128 + (t >> 6)) * 4096 + (t & 63);
#pragma unroll
        for (int ns = 0; ns < 2; ++ns)
#pragma unroll
          for (int i = 0; i < 16; ++i) dst[(32 * ns + crow(i, h)) * 64] = f2bf(acc[ms][ns][i] * rs);
      } else {
        bf16_t* dst = p.vwT + ((size_t)bg * 128 + (t >> 6)) * 4096 + (t & 63);
#pragma unroll
        for (int ns = 0; ns < 2; ++ns)
#pragma unroll
          for (int i = 0; i < 16; ++i) dst[(32 * ns + crow(i, h)) * 64] = f2bf(acc[ms][ns][i] * rs);
      }
    }
  }
};

struct EpiBIn {
  const Params& p;
  DI void operator()(f32x16 (&acc)[2][2], int mt, int nt, int wr, int wc, int lane, char*) const {
    const int r = lane & 31, h = lane >> 5, nb = nt * 128 + 64 * wc;
#pragma unroll
    for (int ms = 0; ms < 2; ++ms) {
      const int row = mt * 128 + 64 * wr + 32 * ms + r;
      const float rs = row_rstd(p.part, row);
      if (nb < 1024) {
        norm_store<true>(acc[ms], rs, p.b_q_gain, p.pos[row], p.qn + (size_t)row * 1024 + nb, h);
      } else if (nb == 1024) {
#pragma unroll
        for (int ns = 0; ns < 2; ++ns)
#pragma unroll
          for (int i = 0; i < 16; ++i) {
            const int c = 32 * ns + crow(i, h);
            if (c < 48) { const float z = acc[ms][ns][i] * rs + p.b_b_gate[c]; p.gates[(size_t)row * 48 + c] = 1.0f / (1.0f + __expf(-z)); }
          }
      }
    }
  }
};

struct EpiCmp1P {
  float* dst;
  DI void operator()(f32x16 (&acc)[2][2], int mt, int nt, int wr, int wc, int lane, char*) const {
    const int r = lane & 31, h = lane >> 5;
#pragma unroll
    for (int ms = 0; ms < 2; ++ms) {
      const int m = mt * 128 + 64 * wr + 32 * ms + r;
#pragma unroll
      for (int ns = 0; ns < 2; ++ns)
#pragma unroll
        for (int q = 0; q < 4; ++q) {
          f32x4 v = {acc[ms][ns][4 * q], acc[ms][ns][4 * q + 1], acc[ms][ns][4 * q + 2], acc[ms][ns][4 * q + 3]};
          *(f32x4*)(dst + (size_t)m * 256 + nt * 128 + 64 * wc + 32 * ns + 8 * q + 4 * h) = v;
        }
    }
  }
};
DI float gelu_tanh(float x) { return 0.5f * x * (1.0f + tanhf(0.7978845608028654f * (x + 0.044715f * x * x * x))); }
struct ALCmp2P {
  const float* P;
  DI u32x4 operator()(int mt, int ml, int k) const {
    const int m = mt * 128 + ml;
    if (m >= 4088) return (u32x4){0, 0, 0, 0};
    f32x4 a = {0.f, 0.f, 0.f, 0.f}, b = {0.f, 0.f, 0.f, 0.f};
#pragma unroll
    for (int s4 = 0; s4 < 4; ++s4) {
      const float* q = P + ((size_t)s4 * 4096 + m) * 256 + k;
      a += *(const f32x4*)q; b += *(const f32x4*)(q + 4);
    }
    u32x4 o;
    o.x = pack2(gelu_tanh(a.x), gelu_tanh(a.y)); o.y = pack2(gelu_tanh(a.z), gelu_tanh(a.w));
    o.z = pack2(gelu_tanh(b.x), gelu_tanh(b.y)); o.w = pack2(gelu_tanh(b.z), gelu_tanh(b.w));
    return o;
  }
};

struct EpiCmp1 {
  bf16_t* hid;
  DI void operator()(f32x16 (&acc)[2][2], int mt, int nt, int wr, int wc, int lane, char*) const {
    const int r = lane & 31, h = lane >> 5;
#pragma unroll
    for (int ms = 0; ms < 2; ++ms) {
      const int m = mt * 128 + 64 * wr + 32 * ms + r;
      if (m >= 4088) continue;
#pragma unroll
      for (int ns = 0; ns < 2; ++ns) {
        float g[16];
#pragma unroll
        for (int i = 0; i < 16; ++i) { const float x = acc[ms][ns][i]; g[i] = 0.5f * x * (1.0f + tanhf(0.7978845608028654f * (x + 0.044715f * x * x * x))); }
#pragma unroll
        for (int q = 0; q < 4; ++q) store_bf4(hid + (size_t)m * 256 + nt * 128 + 64 * wc + 32 * ns + 8 * q + 4 * h, g[4 * q], g[4 * q + 1], g[4 * q + 2], g[4 * q + 3]);
      }
    }
  }
};

struct EpiCmp2 {
  const Params& p; int sel;
  DI void operator()(f32x16 (&acc)[2][2], int mt, int nt, int wr, int wc, int lane, char*) const {
    if (wc != 0) return;
    const int r = lane & 31, h = lane >> 5;
#pragma unroll
    for (int ms = 0; ms < 2; ++ms) {
      const int m = mt * 128 + 64 * wr + 32 * ms + r;
      if (m < 4088) {
        const int bg = m / 511, n = m - bg * 511, b = bg >> 1;
        if (sel == 0) {
          norm_store<true>(acc[ms], 1.0f, p.kc_gain, p.pos[b * T_ + 16 * n + 31], p.kcb + ((size_t)bg * 512 + n) * 64, h);
        } else {
          bf16_t* dst = p.vcT + ((size_t)(bg * 8 + (n >> 6))) * 4096 + (n & 63);
#pragma unroll
          for (int ns = 0; ns < 2; ++ns)
#pragma unroll
            for (int i = 0; i < 16; ++i) dst[(32 * ns + crow(i, h)) * 64] = f2bf(acc[ms][ns][i]);
        }
      } else {
      }
    }
  }
};

DI void phase_scan(const Params& p, char* smem) {
  float* sW = (float*)smem;
  const int tid = threadIdx.x, lane = tid & 63, w = tid >> 6;
  for (int seq = blockIdx.x; seq < 64; seq += gridDim.x) {
    const float* src = p.lf + (size_t)seq * T_ + tid * 32;
    float* dst = p.cc + (size_t)seq * T_ + tid * 32;
    f32x4 v[8];
#pragma unroll
    for (int i = 0; i < 8; ++i) v[i] = *(const f32x4*)(src + 4 * i);
    float s = 0.f;
#pragma unroll
    for (int i = 0; i < 8; ++i) { s += v[i].x; s += v[i].y; s += v[i].z; s += v[i].w; }
    float inc = s;
#pragma unroll
    for (int o = 1; o < 64; o <<= 1) { const float u = __shfl_up(inc, o); if (lane >= o) inc += u; }
    __syncthreads();
    if (lane == 63) sW[w] = inc;
    __syncthreads();
    float run = inc - s;
    for (int q = 0; q < w; ++q) run += sW[q];
#pragma unroll
    for (int i = 0; i < 8; ++i) {
      f32x4 o;
      run += v[i].x; o.x = run; run += v[i].y; o.y = run; run += v[i].z; o.z = run; run += v[i].w; o.w = run;
      *(f32x4*)(dst + 4 * i) = o;
    }
  }
}

template <int MODE>
DI void flash_step(f32x16 (&o)[2], float& l, const bf16x8 (&qf)[4], const bf16_t* sK, const bf16_t* sV, const float* sC,
                   int kbase, int tq, float bias0, float inv_l, float* sImpRow, int lane, bool selok = true) {
  const int r = lane & 31, h = lane >> 5;
  constexpr float SC = 0.125f * 1.4426950408889634f;
  const int base_hi = (MODE == 2 || MODE == 3) ? ((tq - 31) >> 4) : tq;
  const float bsel = (MODE == 4 && !selok) ? -1e30f : bias0;
  f32x16 s[2];
#pragma unroll
  for (int sub = 0; sub < 2; ++sub) {
#pragma unroll
    for (int i = 0; i < 16; ++i) s[sub][i] = 0.f;
#pragma unroll
    for (int ks = 0; ks < 4; ++ks) {
      const bf16x8 a = *(const bf16x8*)(sK + (32 * sub + r) * 72 + 16 * ks + 8 * h);
      s[sub] = mfma32(a, qf[ks], s[sub]);
    }
  }
  __builtin_amdgcn_sched_barrier(0);
  float ls = 0.f;
#pragma unroll
  for (int sub = 0; sub < 2; ++sub) {
    const int hi = base_hi - kbase - 32 * sub - 4 * h;
    const int lo = (MODE == 1) ? hi - 511 : -1000000;
    const bool nomask = __all((hi >= 27) && (lo <= 0));
    if (MODE == 0) {
#pragma unroll
      for (int q = 0; q < 4; ++q) {
        const f32x4 c4 = *(const f32x4*)(sC + 32 * sub + 8 * q + 4 * h);
#pragma unroll
        for (int j = 0; j < 4; ++j) s[sub][4 * q + j] = fmaf(s[sub][4 * q + j], SC, bias0 - c4[j]);
      }
    } else {
#pragma unroll
      for (int i = 0; i < 16; ++i) s[sub][i] = fmaf(s[sub][i], SC, bsel);
    }
    if (!nomask) {
#pragma unroll
      for (int i = 0; i < 16; ++i) { const int cst = (i & 3) + 8 * (i >> 2); s[sub][i] = (cst <= hi && cst >= lo) ? s[sub][i] : -1e30f; }
    }
#pragma unroll
    for (int i = 0; i < 16; ++i) { const float pv = __builtin_amdgcn_exp2f(s[sub][i]); s[sub][i] = pv; ls += pv; }
  }
  l += ls;
  if (MODE == 2) return;
  if (MODE == 3) {
#pragma unroll
    for (int sub = 0; sub < 2; ++sub)
#pragma unroll
      for (int q = 0; q < 4; ++q) {
        const float p3 = s[sub][4 * q + 3] * inv_l;
        float A = (s[sub][4 * q] + s[sub][4 * q + 1] + s[sub][4 * q + 2]) * inv_l + 0.5f * p3, B = 0.5f * p3;
        A += __shfl_xor(A, 1); A += __shfl_xor(A, 2); A += __shfl_xor(A, 4);
        B += __shfl_xor(B, 1); B += __shfl_xor(B, 2); B += __shfl_xor(B, 4);
        if ((r & 7) == 0) { const int j = ((kbase + 32 * sub) >> 2) + 2 * q + h; atomicAdd(&sImpRow[j], A); atomicAdd(&sImpRow[j + 1], B); }
      }
  }
#pragma unroll
  for (int sub = 0; sub < 2; ++sub)
#pragma unroll
    for (int st = 0; st < 2; ++st) {
      u32x4 pk;
      pk.x = pack2(s[sub][8 * st + 0], s[sub][8 * st + 1]); pk.y = pack2(s[sub][8 * st + 2], s[sub][8 * st + 3]);
      pk.z = pack2(s[sub][8 * st + 4], s[sub][8 * st + 5]); pk.w = pack2(s[sub][8 * st + 6], s[sub][8 * st + 7]);
      const bf16x8 pf = __builtin_bit_cast(bf16x8, pk);
#pragma unroll
      for (int d = 0; d < 2; ++d) {
        const bf16_t* vp = sV + (32 * d + r) * 72 + 32 * sub + 16 * st + 4 * h;
        const bf16x4 lo4 = *(const bf16x4*)vp, hi4 = *(const bf16x4*)(vp + 8);
        const bf16x8 vf = __builtin_shufflevector(lo4, hi4, 0, 1, 2, 3, 4, 5, 6, 7);
        o[d] = mfma32(vf, pf, o[d]);
      }
    }
}

DI void tile_load(u32x4 (&kr)[2], u32x4 (&vr)[2], const bf16_t* kptr, int kstride, const bf16_t* vptr, int vstride, bool withV, int tid) {
#pragma unroll
  for (int i = 0; i < 2; ++i) {
    const int c = tid + 256 * i, row = c >> 3, ch = (c & 7) * 8;
    kr[i] = *(const u32x4*)(kptr + (size_t)row * kstride + ch);
    if (withV) vr[i] = *(const u32x4*)(vptr + (size_t)row * vstride + ch);
  }
}
DI void tile_store(const u32x4 (&kr)[2], const u32x4 (&vr)[2], bf16_t* sK, bf16_t* sV, bool withV, int tid) {
#pragma unroll
  for (int i = 0; i < 2; ++i) {
    const int c = tid + 256 * i, row = c >> 3, ch = (c & 7) * 8;
    *(u32x4*)(sK + row * 72 + ch) = kr[i];
    if (withV) *(u32x4*)(sV + row * 72 + ch) = vr[i];
  }
}

template <class LoadF, class StoreF, class BodyF>
DI void dense_loop(int n, LoadF ld, StoreF st, BodyF body) {
  if (n <= 0) return;
  ld(0); st(0);
  if (n > 1) ld(1);
  __syncthreads();
  for (int e = 0; e < n; ++e) {
    const int cur = e & 1;
    if (e + 1 < n) st(cur ^ 1);
    if (e + 2 < n) ld(e + 2);
    body(e, cur);
    __syncthreads();
  }
}

DI void phase_fox(const Params& p, char* smem) {
  bf16_t* sKV = (bf16_t*)smem;
  float* sC = (float*)(sKV + 4 * 64 * 72);
  const int tid = threadIdx.x, lane = tid & 63, w = tid >> 6, r = lane & 31, h = lane >> 5;
  float gq = 0.f, gk = 0.f;
  for (int i = 0; i < 64; ++i) { gq = fmaxf(gq, fabsf(p.a_q_gain[i])); gk = fmaxf(gk, fabsf(p.a_k_gain[i])); }
  const float smax = 8.0f * gq * gk * 1.05f;
  const float thr = 40.0f + 2.0f * smax;
  const float negM2 = -smax * 1.4426950408889634f;
  for (int item = blockIdx.x; item < 4096; item += gridDim.x) {
    const int bh = item & 63, qt = 63 - (item >> 6), b = bh >> 4, head = bh & 15, t0 = qt * 128;
    const int tq = t0 + 32 * w + r;
    const bf16_t* qrow = p.qb + ((size_t)bh * T_ + tq) * 64;
    bf16x8 qf[4];
#pragma unroll
    for (int ks = 0; ks < 4; ++ks) qf[ks] = *(const bf16x8*)(qrow + 16 * ks + 8 * h);
    const float* cseq = p.cc + (size_t)bh * T_;
    const float cq = cseq[tq] * 1.4426950408889634f, c0 = cseq[t0];
    const bf16_t* kbp = p.kb + (size_t)bh * T_ * 64;
    const bf16_t* vbp = p.vT + (size_t)bh * 128 * 4096;
    f32x16 o[2];
#pragma unroll
    for (int d = 0; d < 2; ++d)
#pragma unroll
      for (int i = 0; i < 16; ++i) o[d][i] = 0.f;
    float l = 0.f;
    u32x4 kr[2], vr[2]; f32x4 cr = (f32x4){0.f, 0.f, 0.f, 0.f};
    const int jmax = 2 * qt + 1;
    int jmin = jmax;
    while (jmin > 0 && !(c0 - cseq[64 * (jmin - 1) + 63] < -thr)) --jmin;
    dense_loop(jmax - jmin + 1,
      [&](int e) { const int jt = jmax - e; tile_load(kr, vr, kbp + (size_t)jt * 4096, 64, vbp + (size_t)jt * 4096, 64, true, tid); if (tid < 16) cr = *(const f32x4*)(cseq + 64 * jt + 4 * tid); },
      [&](int bf) { tile_store(kr, vr, sKV + bf * 2 * 64 * 72, sKV + bf * 2 * 64 * 72 + 64 * 72, true, tid); if (tid < 16) *(f32x4*)(sC + bf * 64 + 4 * tid) = cr * 1.4426950408889634f; },
      [&](int e, int cur) {
        const int kbase = 64 * (jmax - e);
        if (kbase <= t0 + 32 * w + 31) flash_step<0>(o, l, qf, sKV + cur * 2 * 64 * 72, sKV + cur * 2 * 64 * 72 + 64 * 72, sC + cur * 64, kbase, tq, cq + negM2, 0.f, nullptr, lane);
      });
    const float lt = l + __shfl_xor(l, 32);
    const float inv = 1.0f / lt;
    bf16_t* orow = p.ob + a_off(b * T_ + tq, head * 64, 16);
#pragma unroll
    for (int d = 0; d < 2; ++d)
#pragma unroll
      for (int q = 0; q < 4; ++q) store_bf4(orow + 32 * d + 8 * q + 4 * h, o[d][4 * q] * inv, o[d][4 * q + 1] * inv, o[d][4 * q + 2] * inv, o[d][4 * q + 3] * inv);
  }
}

DI void phase_nsa(const Params& p, char* smem) {
  bf16_t* sKV = (bf16_t*)smem;
  float* sU = (float*)(sKV + 4 * 64 * 72);
  float* sImp = sU; float* sO = sU;
  unsigned* sMask = (unsigned*)(sU + 128 * 65);
  int* sList = (int*)(sMask + 64);
  const int tid = threadIdx.x, lane = tid & 63, w = tid >> 6, r = lane & 31, h = lane >> 5;
  float gqm = 0.f, gkm = 0.f;
  for (int i = 0; i < 64; ++i) { gqm = fmaxf(gqm, fabsf(p.b_q_gain[i])); gkm = fmaxf(gkm, fmaxf(fabsf(p.kc_gain[i]), fmaxf(fabsf(p.ks_gain[i]), fabsf(p.kw_gain[i])))); }
  const float negM2 = -8.0f * gqm * gkm * 1.05f * 1.4426950408889634f;
  auto stK = [&](int bf) { return sKV + bf * 2 * 64 * 72; };
  for (int item = blockIdx.x; item < 4096; item += gridDim.x) {
    const int bg = item & 7, tt = 511 - (item >> 3), b = bg >> 1, g = bg & 1, t0 = tt * 16;
    const int tokl = 4 * w + (r >> 3), head = r & 7, tq = t0 + tokl;
    __syncthreads();
    for (int i = tid; i < 16 * 132; i += 256) sImp[i] = 0.f;
    bf16x8 qf[4];
    {
      const bf16_t* qrow = p.qn + ((size_t)b * T_ + tq) * 1024 + (g * 8 + head) * 64;
#pragma unroll
      for (int ks = 0; ks < 4; ++ks) qf[ks] = *(const bf16x8*)(qrow + 16 * ks + 8 * h);
    }
    const float* grow = p.gates + ((size_t)b * T_ + tq) * 48 + g * 8 + head;
    const float gate_c = grow[0], gate_w = grow[32];
    f32x16 o[2];
    float l = 0.f;
    u32x4 kr[2], vr[2];
    const int ncmp = t0 >> 4, nct = (ncmp + 63) >> 6;
    const bf16_t* kcp = p.kcb + (size_t)bg * 512 * 64;
    const bf16_t* vcp = p.vcT + (size_t)bg * 8 * 4096;
    dense_loop(nct,
      [&](int e) { tile_load(kr, vr, kcp + (size_t)e * 4096, 64, vcp, 64, false, tid); },
      [&](int bf) { tile_store(kr, vr, stK(bf), stK(bf) + 64 * 72, false, tid); },
      [&](int e, int cur) { flash_step<2>(o, l, qf, stK(cur), stK(cur) + 64 * 72, nullptr, 64 * e, tq, negM2, 0.f, nullptr, lane); });
    const float lc = l + __shfl_xor(l, 32);
    const float inv_lc = lc > 0.f ? 1.0f / lc : 0.f;
#pragma unroll
    for (int d = 0; d < 2; ++d)
#pragma unroll
      for (int i = 0; i < 16; ++i) o[d][i] = 0.f;
    float l2 = 0.f;
    dense_loop(nct,
      [&](int e) { tile_load(kr, vr, kcp + (size_t)e * 4096, 64, vcp + (size_t)e * 4096, 64, true, tid); },
      [&](int bf) { tile_store(kr, vr, stK(bf), stK(bf) + 64 * 72, true, tid); },
      [&](int e, int cur) { flash_step<3>(o, l2, qf, stK(cur), stK(cur) + 64 * 72, nullptr, 64 * e, tq, negM2, inv_lc, sImp + tokl * 132, lane); });
    __syncthreads();
    const int cur_blk = t0 >> 6;
    for (int tk = 0; tk < 4; ++tk) {
      const int tok = 4 * w + tk;
      float* sc = sImp + tok * 132;
      for (int j = lane; j <= cur_blk; j += 64) if (j == 0 || j == cur_blk || j == cur_blk - 1) sc[j] = 1e6f;
    }
    __syncthreads();
    for (int tk = 0; tk < 4; ++tk) {
      const int tok = 4 * w + tk;
      const float* sc = sImp + tok * 132;
      const bool v0 = lane <= cur_blk, v1 = lane + 64 <= cur_blk;
      const float s0 = v0 ? sc[lane] : -1e30f, s1 = v1 ? sc[lane + 64] : -1e30f;
      int r0 = 0, r1 = 0;
      const int n0 = cur_blk < 63 ? cur_blk + 1 : 64;
      for (int i = 0; i < n0; ++i) {
        const float si = __builtin_bit_cast(float, __builtin_amdgcn_readlane(__builtin_bit_cast(int, s0), i));
        r0 += ((si > s0) || (si == s0 && i < lane)) ? 1 : 0;
        r1 += (si >= s1) ? 1 : 0;
      }
      for (int i = 64; i <= cur_blk; ++i) {
        const float si = __builtin_bit_cast(float, __builtin_amdgcn_readlane(__builtin_bit_cast(int, s1), i - 64));
        r0 += (si > s0) ? 1 : 0;
        r1 += ((si > s1) || (si == s1 && i - 64 < lane)) ? 1 : 0;
      }
      const unsigned long long mk0 = __ballot(v0 && r0 < 16), mk1 = __ballot(v1 && r1 < 16);
      if (lane == 0) {
        sMask[tok * 4 + 0] = (unsigned)mk0; sMask[tok * 4 + 1] = (unsigned)(mk0 >> 32);
        sMask[tok * 4 + 2] = (unsigned)mk1; sMask[tok * 4 + 3] = (unsigned)(mk1 >> 32);
      }
    }
    __syncthreads();
    int n_un;
    {
      unsigned u0 = 0, u1 = 0, u2 = 0, u3 = 0;
      for (int tok = 0; tok < 16; ++tok) { u0 |= sMask[tok * 4]; u1 |= sMask[tok * 4 + 1]; u2 |= sMask[tok * 4 + 2]; u3 |= sMask[tok * 4 + 3]; }
      const int c0 = __popc(u0), c1 = __popc(u1), c2 = __popc(u2), c3 = __popc(u3);
      n_un = c0 + c1 + c2 + c3;
      if (tid < 128) {
        const int wd = tid >> 5, bit = tid & 31;
        const unsigned uw = wd == 0 ? u0 : wd == 1 ? u1 : wd == 2 ? u2 : u3;
        if ((uw >> bit) & 1u) {
          const int pre = (wd > 0 ? c0 : 0) + (wd > 1 ? c1 : 0) + (wd > 2 ? c2 : 0);
          sList[pre + __popc(uw & ((1u << bit) - 1u))] = tid;
        }
      }
    }
    __syncthreads();
    {
      const float sc = gate_c * inv_lc;
      float* orow = sO + (32 * w + r) * 65;
#pragma unroll
      for (int d = 0; d < 2; ++d)
#pragma unroll
        for (int i = 0; i < 16; ++i) orow[32 * d + crow(i, h)] = o[d][i] * sc;
    }
#pragma unroll
    for (int d = 0; d < 2; ++d)
#pragma unroll
      for (int i = 0; i < 16; ++i) o[d][i] = 0.f;
    l = 0.f;
    {
      const bf16_t* ksp = p.ksb + (size_t)bg * T_ * 64;
      const bf16_t* vsp = p.vsT + (size_t)bg * 128 * 4096;
      dense_loop(n_un,
        [&](int e) { const int blk = sList[e]; tile_load(kr, vr, ksp + (size_t)blk * 4096, 64, vsp + (size_t)blk * 4096, 64, true, tid); },
        [&](int bf) { tile_store(kr, vr, stK(bf), stK(bf) + 64 * 72, true, tid); },
        [&](int e, int cur) {
          const int blk = sList[e];
          const int wd = blk >> 5, bit = blk & 31;
          const unsigned wm = sMask[(4 * w) * 4 + wd] | sMask[(4 * w + 1) * 4 + wd] | sMask[(4 * w + 2) * 4 + wd] | sMask[(4 * w + 3) * 4 + wd];
          if ((wm >> bit) & 1u) {
            const bool selok = (sMask[tokl * 4 + wd] >> bit) & 1u;
            flash_step<4>(o, l, qf, stK(cur), stK(cur) + 64 * 72, nullptr, 64 * blk, tq, negM2, 0.f, nullptr, lane, selok);
          }
        });
      const float lt = l + __shfl_xor(l, 32);
      const float sc = grow[16] / lt;
      float* orow = sO + (32 * w + r) * 65;
#pragma unroll
      for (int d = 0; d < 2; ++d)
#pragma unroll
        for (int i = 0; i < 16; ++i) orow[32 * d + crow(i, h)] += o[d][i] * sc;
    }
#pragma unroll
    for (int d = 0; d < 2; ++d)
#pragma unroll
      for (int i = 0; i < 16; ++i) o[d][i] = 0.f;
    l = 0.f;
    {
      const int klo = t0 - 511 > 0 ? t0 - 511 : 0, jt0 = klo >> 6, jt1 = (t0 + 15) >> 6;
      const bf16_t* kwp = p.kwb + (size_t)bg * T_ * 64;
      const bf16_t* vwp = p.vwT + (size_t)bg * 128 * 4096;
      dense_loop(jt1 - jt0 + 1,
        [&](int e) { tile_load(kr, vr, kwp + (size_t)(jt0 + e) * 4096, 64, vwp + (size_t)(jt0 + e) * 4096, 64, true, tid); },
        [&](int bf) { tile_store(kr, vr, stK(bf), stK(bf) + 64 * 72, true, tid); },
        [&](int e, int cur) { flash_step<1>(o, l, qf, stK(cur), stK(cur) + 64 * 72, nullptr, 64 * (jt0 + e), tq, negM2, 0.f, nullptr, lane); });
      const float lt = l + __shfl_xor(l, 32);
      const float sc = gate_w / lt;
      float* orow = sO + (32 * w + r) * 65;
#pragma unroll
      for (int d = 0; d < 2; ++d)
#pragma unroll
        for (int i = 0; i < 16; ++i) orow[32 * d + crow(i, h)] += o[d][i] * sc;
    }
    __syncthreads();
    for (int c = tid; c < 128 * 16; c += 256) {
      const int row = c >> 4, d4 = (c & 15) * 4, tok = row >> 3, hd = row & 7;
      const float* s = sO + row * 65 + d4;
      store_bf4(p.ob + a_off(b * T_ + t0 + tok, (g * 8 + hd) * 64 + d4, 16), s[0], s[1], s[2], s[3]);
    }
  }
}


#define XB_TMO      128
#define XB_XCNT(j)  (256  + 64 * (j))
#define XB_XSUB(j)  (1280 + 64 * (j))
#define XB_XGEN(j)  (2304 + 64 * (j))
#define XB_TOP      3328
#define XB_TOPGEN   3392
#define XCD_BAR_WORDS 3456
#define XB_SPIN_CAP (1u << 18)
#define LAS __attribute__((address_space(3)))
DI unsigned xb_ld(unsigned* p) { return __hip_atomic_load(p, __ATOMIC_RELAXED, __HIP_MEMORY_SCOPE_AGENT); }
DI unsigned xb_add(unsigned* p, unsigned v) { return __hip_atomic_fetch_add(p, v, __ATOMIC_RELAXED, __HIP_MEMORY_SCOPE_AGENT); }
DI unsigned xb_xcc_id() { return (unsigned)__builtin_amdgcn_s_getreg((3 << 11) | 20) & 0xFu; }
#define XB_SPIN(cond, bar) do { unsigned _sp = 0; while (cond) { __builtin_amdgcn_s_sleep(1); \
    if ((++_sp & 255u) == 0u) { if (xb_ld(&(bar)[XB_TMO])) break; if (_sp > XB_SPIN_CAP) { atomicAdd(&(bar)[XB_TMO], 1u); break; } } } } while (0)
struct XcdBarrier { unsigned* bar; unsigned x; volatile LAS unsigned* st; };
DI XcdBarrier xcd_barrier_post(unsigned* bar, volatile LAS unsigned* st) {
  XcdBarrier b; b.bar = bar; b.x = xb_xcc_id(); b.st = st;
  if (threadIdx.x == 0) (void)xb_add(&bar[XB_XCNT(b.x)], 1u);
  return b;
}
DI void xcd_barrier_complete(unsigned* bar, unsigned x, unsigned& nloc, unsigned& nx) {
  const unsigned G = gridDim.x * gridDim.y * gridDim.z;
  unsigned sum, cnt, mine, sp = 0u;
  for (;;) {
    sum = 0u; cnt = 0u; mine = 0u;
#pragma unroll
    for (unsigned j = 0; j < 16; ++j) { const unsigned c = xb_ld(&bar[XB_XCNT(j)]); sum += c; cnt += (c > 0u) ? 1u : 0u; mine = (j == x) ? c : mine; }
    if (sum == G) break;
    __builtin_amdgcn_s_sleep(1);
    if ((++sp & 255u) == 0u) { if (xb_ld(&bar[XB_TMO])) break; if (sp > XB_SPIN_CAP) { atomicAdd(&bar[XB_TMO], 1u); break; } }
  }
  nloc = mine > 0u ? mine : 1u; nx = cnt > 0u ? cnt : 1u;
}
DI void xcd_barrier(const XcdBarrier& b) {
  asm volatile("s_waitcnt vmcnt(0)" ::: "memory");
  __syncthreads();
  if (threadIdx.x == 0) {
    unsigned* bar = b.bar;
    __builtin_amdgcn_s_waitcnt(0);
    unsigned nloc = b.st[0], nx = b.st[1];
    if (nloc == 0u) { xcd_barrier_complete(bar, b.x, nloc, nx); b.st[0] = nloc; b.st[1] = nx; }
    const unsigned old = xb_add(&bar[XB_XSUB(b.x)], 1u);
    const unsigned gen = old / nloc;
    if (old + 1u == (gen + 1u) * nloc) {
      __builtin_amdgcn_fence(__ATOMIC_RELEASE, "agent");
      asm volatile("s_waitcnt vmcnt(0)" ::: "memory");
      const unsigned og = xb_add(&bar[XB_TOP], 1u);
      const unsigned tg = og / nx;
      if (og + 1u == (tg + 1u) * nx) xb_add(&bar[XB_TOPGEN], 1u);
      else XB_SPIN(xb_ld(&bar[XB_TOPGEN]) == tg, bar);
      __builtin_amdgcn_fence(__ATOMIC_ACQUIRE, "agent");
      xb_add(&bar[XB_XGEN(b.x)], 1u);
      asm volatile("s_waitcnt vmcnt(0)" ::: "memory");
    } else {
      XB_SPIN(xb_ld(&bar[XB_XGEN(b.x)]) == gen, bar);
      __builtin_amdgcn_fence(__ATOMIC_ACQUIRE, "agent");
      asm volatile("s_waitcnt vmcnt(0)" ::: "memory");
    }
  }
  __syncthreads();
}

#ifdef ONLY_PHASE
#define PH_ON(n) ((n) == ONLY_PHASE)
#else
#define PH_ON(n) true
#endif
#define REP_PHASE -1
#define PHASE(n, ...) \
  if (PH_ON(n) && ph_lo <= (n) && (n) < ph_hi) { __VA_ARGS__ } \
  if ((n) == REP_PHASE) { cg::this_grid().sync(); { __VA_ARGS__ } } \
  if (ph_lo <= (n) && (n) + 1 < ph_hi) { if (ph_hi > 1000) cg::this_grid().sync(); else xcd_barrier(xb); }

__global__ void __launch_bounds__(256, 2) yoco_megakernel(KArgs ka, int ph_lo, int ph_hi) {
  __shared__ __attribute__((aligned(16))) char smem[SMEM_BYTES];
  Params p;
  fill_params(p, ka);
  __shared__ __attribute__((aligned(16))) unsigned xb_words[4];
  if (threadIdx.x < 4) xb_words[threadIdx.x] = 0u;
  __syncthreads();
  const XcdBarrier xb = xcd_barrier_post(p.bar, (volatile LAS unsigned*)xb_words);
  PHASE(0, phase_prep(p, smem);)
  PHASE(1, { ALPlain al{p.hb, 16}; EpiFoxIn ep{p}; gemm_phase(al, p.w_ain, 1024, 256, 25, ep, smem); })
  PHASE(2, phase_scan(p, smem);)
  PHASE(3, phase_fox(p, smem);)
  PHASE(4, { ALPlain al{p.ob, 16}; EpiResid<0> ep{p.x, p.out, p.hb, p.part}; gemm_phase(al, p.w_aout, 1024, 256, 8, ep, smem); })
  PHASE(5, { ALFfn al{p.hb}; EpiFfnUp ep{p.part, p.f_conv_w, p.f_conv_b, p.act}; gemm_phase(al, p.w_up0, 1024, 264, 44, ep, smem); })
  PHASE(6, { ALPlain al{p.act, 44}; EpiResid<1> ep{p.out, p.out, p.hb, p.part}; gemm_phase(al, p.w_dn0, FF, 256, 8, ep, smem); })
  PHASE(7, {
    ALPlain al{p.hb, 16};
    { EpiKv ep{p}; gemm_phase(al, p.w_kv, 1024, 256, 6, ep, smem); }
    { EpiBIn ep{p}; gemm_phase(al, p.w_bin, 1024, 256, 9, ep, smem); }
  })
  PHASE(8, {
    for (int item = blockIdx.x; item < 512; item += gridDim.x) {
      const int sel = item & 1, ks4 = (item >> 1) & 3, nt = (item >> 3) & 1, mt = item >> 4;
      ALCmp1 al{p.rawc + (size_t)sel * 8 * T_ * 64, sel ? p.vc_pe : p.kc_pe};
      EpiCmp1P ep{p.hidp + (size_t)(sel * 4 + ks4) * 4096 * 256};
      gemm_tile(al, sel ? p.w_vc1 : p.w_kc1, 2048, mt, nt, ep, smem, ks4 * 8, 8);
    }
  })
  PHASE(9, {
    for (int item = blockIdx.x; item < 64; item += gridDim.x) {
      const int sel = item & 1, mt = item >> 1;
      ALCmp2P al{p.hidp + (size_t)sel * 4 * 4096 * 256};
      EpiCmp2 ep{p, sel};
      gemm_tile(al, sel ? p.w_vc2 : p.w_kc2, 256, mt, 0, ep, smem);
    }
  })
  PHASE(10, phase_nsa(p, smem);)
  PHASE(11, { ALPlain al{p.ob, 16}; EpiResid<1> ep{p.out, p.out, p.hb, p.part}; gemm_phase(al, p.w_bout, 1024, 256, 8, ep, smem); })
  PHASE(12, { ALFfn al{p.hb}; EpiFfnUp ep{p.part, p.f_conv_w + 3 * 5632, p.f_conv_b + 5632, p.act}; gemm_phase(al, p.w_up1, 1024, 264, 44, ep, smem); })
  PHASE(13, { ALPlain al{p.act, 44}; EpiResid<2> ep{p.out, p.out, p.hb, p.part}; gemm_phase(al, p.w_dn1, FF, 256, 8, ep, smem); })
}

extern "C" void kernel_launch(void* const* d_in, const int* in_sizes, int n_in, void* d_out, int out_size, void* d_ws, size_t ws_size, hipStream_t stream) {
  KArgs p{};
  for (int i = 0; i < 29; ++i) p.in[i] = d_in[i];
  p.out = (float*)d_out; p.ws = (char*)d_ws;
  hipMemsetAsync(d_ws, 0, 16384, stream);
  static int grid_blocks = 0;
  if (!grid_blocks) {
    int dev = 0, cus = 0, per_cu = 0;
    hipGetDevice(&dev);
    hipDeviceGetAttribute(&cus, hipDeviceAttributeMultiprocessorCount, dev);
    hipOccupancyMaxActiveBlocksPerMultiprocessor(&per_cu, yoco_megakernel, 256, 0);
    if (per_cu > 2) per_cu = 2;
    if (per_cu < 1) per_cu = 1;
    grid_blocks = cus * per_cu;
    grid_blocks &= ~7;
  }
#if N_LAUNCH_SPLIT
  for (int ph = 0; ph < NPHASE; ++ph) {
    int lo = ph, hi = ph + 1;
    hipLaunchKernelGGL(yoco_megakernel, dim3(grid_blocks), dim3(256), 0, stream, p, lo, hi);
  }
#else
  int lo = 0, hi = NPHASE;
  void* args[] = {&p, &lo, &hi};
  hipError_t e = hipLaunchCooperativeKernel((void*)yoco_megakernel, dim3(grid_blocks), dim3(256), args, 0, stream);
  if (e != hipSuccess) fprintf(stderr, "cooperative launch failed: %s (grid %d)\n", hipGetErrorString(e), grid_blocks);
#endif
}
```
